# Optimizing an MI355X kernel written in HIP

```python
import jax
import jax.numpy as jnp
from jax import lax
import numpy as np

D_MODEL = 1024
BATCH = 2
SEQ = 16384
DEPTH = 4

EPS = 1e-6
N_BRANCH = 3
MLA_HEADS = 8
MLA_Q_LORA = 256
MLA_KV_LORA = 128
MLA_NOPE = 64
MLA_ROPE = 32
MLA_V = 64
ROPE_THETA = 10000.0
Q_BLOCK = 128
MLSTM_HEADS = 4
MLSTM_QK = 64
MLSTM_V = 128
MLSTM_CHUNK = 64
CONV_K = 4
DIL_HEADS = 8
DIL_HEAD_DIM = 64
DIL_PATTERNS = ((128, 1), (512, 4), (2048, 16))
DIL_WIDTH = DIL_HEADS * DIL_HEAD_DIM
N_GROUPS = 4
EXPERTS_PER_GROUP = 4
N_EXPERTS = N_GROUPS * EXPERTS_PER_GROUP
TOP_K_FINE = 2
EXPERT_FF = 256
IN_SIZES = (MLA_Q_LORA, MLA_KV_LORA, MLA_ROPE,
            2 * MLSTM_HEADS * MLSTM_QK, MLSTM_HEADS * MLSTM_V, MLSTM_HEADS * MLSTM_V, MLSTM_HEADS, MLSTM_HEADS,
            DIL_WIDTH, DIL_WIDTH, DIL_WIDTH,
            N_BRANCH * D_MODEL)
IN_WIDTH = sum(IN_SIZES)

kernel_name = 'hybrid_mla_mlstm_dilated_hmoe_block'


def rmsnorm(x, gain):
    xf = x.astype(jnp.float32)
    y = xf * lax.rsqrt(jnp.mean(xf * xf, axis=-1, keepdims=True) + EPS)
    return (y * gain.astype(jnp.float32)).astype(x.dtype)


def rope(x, pos):
    half = x.shape[-1] // 2
    inv = ROPE_THETA ** (-jnp.arange(half, dtype=jnp.float32) / half)
    ang = pos.astype(jnp.float32)[:, None] * inv[None, :]
    cos = jnp.cos(ang)[None, :, None, :]
    sin = jnp.sin(ang)[None, :, None, :]
    xf = x.astype(jnp.float32)
    x1, x2 = xf[..., :half], xf[..., half:]
    return jnp.concatenate([x1 * cos - x2 * sin, x1 * sin + x2 * cos], axis=-1).astype(x.dtype)


def causal_conv(x, w, b):
    C = x.shape[-1]
    y = lax.conv_general_dilated(x, w[:, None, :], window_strides=(1,), padding=((CONV_K - 1, 0),),
                                 dimension_numbers=('NWC', 'WIO', 'NWC'), feature_group_count=C)
    return y + b


def blocked_causal_attention(q, k, v):
    B, S, H, Dq = q.shape
    Dv = v.shape[-1]
    nq = S // Q_BLOCK
    scale = Dq ** -0.5
    qb = q.reshape(B, nq, Q_BLOCK, H, Dq).transpose(1, 0, 2, 3, 4)
    kpos = jnp.arange(S)

    def one_block(args):
        qi, j = args
        s = jnp.einsum('bqhd,bkhd->bhqk', qi, k).astype(jnp.float32) * scale
        qpos = j * Q_BLOCK + jnp.arange(Q_BLOCK)
        s = jnp.where(kpos[None, :] <= qpos[:, None], s, -jnp.inf)
        p = jax.nn.softmax(s, axis=-1)
        return jnp.einsum('bhqk,bkhd->bqhd', p.astype(v.dtype), v)

    o = lax.map(one_block, (qb, jnp.arange(nq)))
    return o.transpose(1, 0, 2, 3, 4).reshape(B, S, H, Dv)


def mla_branch(cq_raw, ckv_raw, kr, q_norm, kv_norm, w_uq, w_ukv, q_gain, k_gain):
    B, S, _ = cq_raw.shape
    cq = rmsnorm(cq_raw, q_norm)
    ckv = rmsnorm(ckv_raw, kv_norm)
    q = jnp.einsum('bsr,rn->bsn', cq, w_uq).reshape(B, S, MLA_HEADS, MLA_NOPE + MLA_ROPE)
    kv = jnp.einsum('bsr,rn->bsn', ckv, w_ukv).reshape(B, S, MLA_HEADS, MLA_NOPE + MLA_V)
    k_nope, v = kv[..., :MLA_NOPE], kv[..., MLA_NOPE:]
    k = jnp.concatenate([k_nope, jnp.broadcast_to(kr[:, :, None, :], (B, S, MLA_HEADS, MLA_ROPE))], axis=-1)
    q = rmsnorm(q, q_gain)
    k = rmsnorm(k, k_gain)
    pos = jnp.arange(S)
    q = jnp.concatenate([q[..., :MLA_NOPE], rope(q[..., MLA_NOPE:], pos)], axis=-1)
    k = jnp.concatenate([k[..., :MLA_NOPE], rope(k[..., MLA_NOPE:], pos)], axis=-1)
    o = blocked_causal_attention(q, k, v)
    return o.reshape(B, S, MLA_HEADS * MLA_V)


def mlstm_chunkwise(q, k, v, ig, fg):
    out_dtype = v.dtype
    B, S, H, dk = q.shape
    dv = v.shape[-1]
    L = MLSTM_CHUNK
    nc = S // L
    q = q.astype(jnp.float32)
    k = k.astype(jnp.float32) * (dk ** -0.5)
    v = v.astype(jnp.float32)
    ig = ig.astype(jnp.float32)
    logf = jax.nn.log_sigmoid(fg.astype(jnp.float32))

    def to_chunks(t):
        t = t.reshape((B, nc, L) + t.shape[2:])
        return jnp.swapaxes(jnp.moveaxis(t, 1, 0), 2, 3)

    causal = jnp.tril(jnp.ones((L, L), dtype=bool))

    def step(carry, xs):
        C, n, m = carry
        qc, kc, vc, ic, lf = xs
        b = jnp.cumsum(lf, axis=-1)
        dlog = jnp.where(causal, b[..., :, None] - b[..., None, :] + ic[..., None, :], -jnp.inf)
        inter = b + m[..., None]
        m_t = jnp.maximum(inter, jnp.max(dlog, axis=-1))
        sc = jnp.einsum('bhtd,bhsd->bhts', qc, kc) * jnp.exp(dlog - m_t[..., None])
        decay = jnp.exp(inter - m_t)
        num = decay[..., None] * jnp.einsum('bhtd,bhdv->bhtv', qc, C) + jnp.einsum('bhts,bhsv->bhtv', sc, vc)
        den = decay * jnp.einsum('bhtd,bhd->bht', qc, n) + jnp.sum(sc, axis=-1)
        h = num / jnp.maximum(jnp.abs(den), jnp.exp(-m_t))[..., None]
        b_end = b[..., -1]
        wlog = b_end[..., None] - b + ic
        m_new = jnp.maximum(b_end + m, jnp.max(wlog, axis=-1))
        carry_decay = jnp.exp(b_end + m - m_new)
        w = jnp.exp(wlog - m_new[..., None])
        C_new = carry_decay[..., None, None] * C + jnp.einsum('bhs,bhsd,bhsv->bhdv', w, kc, vc)
        n_new = carry_decay[..., None] * n + jnp.einsum('bhs,bhsd->bhd', w, kc)
        return (C_new, n_new, m_new), h

    init = (jnp.zeros((B, H, dk, dv), jnp.float32), jnp.zeros((B, H, dk), jnp.float32), jnp.zeros((B, H), jnp.float32))
    _, hs = lax.scan(step, init, (to_chunks(q), to_chunks(k), to_chunks(v), to_chunks(ig), to_chunks(logf)))
    hs = jnp.moveaxis(jnp.swapaxes(hs, 2, 3), 0, 1).reshape(B, S, H, dv)
    return hs.astype(out_dtype)


def mlstm_branch(qk_raw, v_raw, o_raw, i_raw, f_raw, conv_w, conv_b, b_i, b_f, head_gain):
    B, S, _ = qk_raw.shape
    qk = jax.nn.silu(causal_conv(qk_raw, conv_w, conv_b))
    q = qk[..., :MLSTM_HEADS * MLSTM_QK].reshape(B, S, MLSTM_HEADS, MLSTM_QK)
    k = qk[..., MLSTM_HEADS * MLSTM_QK:].reshape(B, S, MLSTM_HEADS, MLSTM_QK)
    v = v_raw.reshape(B, S, MLSTM_HEADS, MLSTM_V)
    h = mlstm_chunkwise(q, k, v, i_raw + b_i, f_raw + b_f)
    h = rmsnorm(h, head_gain.reshape(MLSTM_HEADS, MLSTM_V))
    return h.reshape(B, S, MLSTM_HEADS * MLSTM_V) * jax.nn.sigmoid(o_raw)


def dilated_window_attention(q, k, v, window, dilation):
    B, S, H, Dh = q.shape
    blk = window // dilation
    span = blk * dilation
    s_pad = -(-S // span) * span
    nb = s_pad // span

    def fold(t):
        t = jnp.pad(t, ((0, 0), (0, s_pad - S), (0, 0), (0, 0)))
        return t.reshape(B, nb, blk, dilation, H, Dh)

    def with_prev(t):
        prev = jnp.concatenate([jnp.zeros_like(t[:, :1]), t[:, :-1]], axis=1)
        return jnp.concatenate([prev, t], axis=2)

    qb = fold(q)
    kk = with_prev(fold(k))
    vv = with_prev(fold(v))
    s = jnp.einsum('bnqrhd,bnkrhd->bnrhqk', qb, kk).astype(jnp.float32) * (Dh ** -0.5)
    iq = jnp.arange(blk)[:, None]
    ik = jnp.arange(2 * blk)[None, :]
    dist = iq + blk - ik
    in_band = (dist >= 0) & (dist <= blk)
    before_start = (jnp.arange(nb) == 0)[:, None, None] & (ik < blk)[None]
    mask = in_band[None] & ~before_start
    s = jnp.where(mask[None, :, None, None], s, -jnp.inf)
    m = jnp.max(s, axis=-1, keepdims=True)
    p = jnp.exp(s - m)
    den = jnp.sum(p, axis=-1)
    o = jnp.einsum('bnrhqk,bnkrhd->bnqrhd', p, vv.astype(jnp.float32))
    o = o / jnp.transpose(den, (0, 1, 4, 2, 3))[..., None]
    lse = jnp.transpose(m[..., 0] + jnp.log(den), (0, 1, 4, 2, 3))
    o = o.reshape(B, s_pad, H, Dh)[:, :S]
    lse = lse.reshape(B, s_pad, H)[:, :S]
    return o, lse


def dilated_branch(q_raw, k_raw, v_raw, q_gain, k_gain):
    B, S, _ = q_raw.shape
    q = rmsnorm(q_raw.reshape(B, S, DIL_HEADS, DIL_HEAD_DIM), q_gain)
    k = rmsnorm(k_raw.reshape(B, S, DIL_HEADS, DIL_HEAD_DIM), k_gain)
    v = v_raw.reshape(B, S, DIL_HEADS, DIL_HEAD_DIM)
    outs, lses = [], []
    for window, dilation in DIL_PATTERNS:
        o, lse = dilated_window_attention(q, k, v, window, dilation)
        outs.append(o)
        lses.append(lse)
    w = jax.nn.softmax(jnp.stack(lses, axis=-1), axis=-1)
    o = jnp.einsum('bshp,bshpd->bshd', w, jnp.stack(outs, axis=-2))
    return o.astype(v_raw.dtype).reshape(B, S, DIL_WIDTH)


def token_mixer(u, w_in, mla_q_norm, mla_kv_norm, mla_w_uq, mla_w_ukv, mla_q_gain, mla_k_gain,
                mlstm_conv_w, mlstm_conv_b, mlstm_b_i, mlstm_b_f, mlstm_head_gain, dil_q_gain, dil_k_gain,
                w_branch_a, w_branch_b, w_branch_c, w_out):
    B, S, D = u.shape
    proj = jnp.einsum('bsd,dn->bsn', u, w_in)
    points = np.cumsum(IN_SIZES)[:-1].tolist()
    (cq, ckv, kr, m_qk, m_v, m_o, m_i, m_f, d_q, d_k, d_v, gates) = jnp.split(proj, points, axis=-1)
    ya = mla_branch(cq, ckv, kr, mla_q_norm, mla_kv_norm, mla_w_uq, mla_w_ukv, mla_q_gain, mla_k_gain)
    yb = mlstm_branch(m_qk, m_v, m_o, m_i, m_f, mlstm_conv_w, mlstm_conv_b, mlstm_b_i, mlstm_b_f, mlstm_head_gain)
    yc = dilated_branch(d_q, d_k, d_v, dil_q_gain, dil_k_gain)
    g = jax.nn.sigmoid(gates).reshape(B, S, N_BRANCH, D)
    merged = (g[:, :, 0] * jnp.einsum('bsn,nd->bsd', ya, w_branch_a)
              + g[:, :, 1] * jnp.einsum('bsn,nd->bsd', yb, w_branch_b)
              + g[:, :, 2] * jnp.einsum('bsn,nd->bsd', yc, w_branch_c))
    return jnp.einsum('bsd,de->bse', merged, w_out)


def hier_moe(h, w_rg, b_rg, w_re, b_re, w_gate, w_up, w_down):
    B, S, D = h.shape
    lg = jnp.einsum('bsd,dg->bsg', h, w_rg).astype(jnp.float32) + b_rg.astype(jnp.float32)
    p_group = jax.nn.softmax(lg, axis=-1)
    g_idx = jnp.argmax(lg, axis=-1)
    p_sel = jnp.take_along_axis(p_group, g_idx[..., None], axis=-1)[..., 0]
    le = (jnp.einsum('bsd,de->bse', h, w_re).astype(jnp.float32) + b_re.astype(jnp.float32))
    le = le.reshape(B, S, N_GROUPS, EXPERTS_PER_GROUP)
    le = jnp.take_along_axis(le, g_idx[..., None, None], axis=2)[:, :, 0]
    top_v, top_i = lax.top_k(le, TOP_K_FINE)
    w2 = jax.nn.softmax(top_v, axis=-1) * p_sel[..., None]
    expert_id = g_idx[..., None] * EXPERTS_PER_GROUP + top_i
    combine = jnp.einsum('bsk,bske->bse', w2, jax.nn.one_hot(expert_id, N_EXPERTS, dtype=jnp.float32))
    hid = jax.nn.silu(jnp.einsum('bsd,edf->bsef', h, w_gate)) * jnp.einsum('bsd,edf->bsef', h, w_up)
    hid = hid * combine.astype(h.dtype)[..., None]
    return jnp.einsum('bsef,efd->bsd', hid, w_down)


def setup_inputs(seed: int = 0) -> dict:
    key = jax.random.key(seed)
    ks = iter(jax.random.split(key, 40))
    L, D = DEPTH, D_MODEL

    def nrm(shape, scale):
        return scale * jax.random.normal(next(ks), shape, jnp.float32)

    def gain(shape):
        return 1.0 + 0.02 * jax.random.normal(next(ks), shape, jnp.float32)

    return {
        'x': nrm((BATCH, SEQ, D), 1.0),
        'c': nrm((BATCH, D), 1.0),
        'w_ada': nrm((L, D, 6 * D), 0.5 * D ** -0.5),
        'b_ada': nrm((L, 6 * D), 0.02),
        'attn_norm': gain((L, D)),
        'w_in': nrm((L, D, IN_WIDTH), D ** -0.5),
        'mla_q_norm': gain((L, MLA_Q_LORA)),
        'mla_kv_norm': gain((L, MLA_KV_LORA)),
        'mla_w_uq': nrm((L, MLA_Q_LORA, MLA_HEADS * (MLA_NOPE + MLA_ROPE)), MLA_Q_LORA ** -0.5),
        'mla_w_ukv': nrm((L, MLA_KV_LORA, MLA_HEADS * (MLA_NOPE + MLA_V)), MLA_KV_LORA ** -0.5),
        'mla_q_gain': gain((L, MLA_NOPE + MLA_ROPE)),
        'mla_k_gain': gain((L, MLA_NOPE + MLA_ROPE)),
        'mlstm_conv_w': nrm((L, CONV_K, 2 * MLSTM_HEADS * MLSTM_QK), CONV_K ** -0.5),
        'mlstm_conv_b': nrm((L, 2 * MLSTM_HEADS * MLSTM_QK), 0.02),
        'mlstm_b_i': nrm((L, MLSTM_HEADS), 0.1),
        'mlstm_b_f': 3.0 + 3.0 * jax.random.uniform(next(ks), (L, MLSTM_HEADS), jnp.float32),
        'mlstm_head_gain': gain((L, MLSTM_HEADS * MLSTM_V)),
        'dil_q_gain': gain((L, DIL_HEAD_DIM)),
        'dil_k_gain': gain((L, DIL_HEAD_DIM)),
        'w_branch_a': nrm((L, MLA_HEADS * MLA_V, D), (MLA_HEADS * MLA_V) ** -0.5),
        'w_branch_b': nrm((L, MLSTM_HEADS * MLSTM_V, D), (MLSTM_HEADS * MLSTM_V) ** -0.5),
        'w_branch_c': nrm((L, DIL_WIDTH, D), DIL_WIDTH ** -0.5),
        'w_out': nrm((L, D, D), D ** -0.5),
        'ffn_norm': gain((L, D)),
        'w_router_group': nrm((L, D, N_GROUPS), D ** -0.5),
        'b_router_group': nrm((L, N_GROUPS), 0.01),
        'w_router_expert': nrm((L, D, N_EXPERTS), D ** -0.5),
        'b_router_expert': nrm((L, N_EXPERTS), 0.01),
        'w_exp_gate': nrm((L, N_EXPERTS, D, EXPERT_FF), D ** -0.5),
        'w_exp_up': nrm((L, N_EXPERTS, D, EXPERT_FF), D ** -0.5),
        'w_exp_down': nrm((L, N_EXPERTS, EXPERT_FF, D), EXPERT_FF ** -0.5),
    }


def reference(x, c, w_ada, b_ada, attn_norm, w_in, mla_q_norm, mla_kv_norm, mla_w_uq, mla_w_ukv,
              mla_q_gain, mla_k_gain, mlstm_conv_w, mlstm_conv_b, mlstm_b_i, mlstm_b_f, mlstm_head_gain,
              dil_q_gain, dil_k_gain, w_branch_a, w_branch_b, w_branch_c, w_out, ffn_norm,
              w_router_group, b_router_group, w_router_expert, b_router_expert,
              w_exp_gate, w_exp_up, w_exp_down):
    B, S, D = x.shape
    c_act = jax.nn.silu(c)
    for l in range(DEPTH):
        mod = (jnp.einsum('bd,dm->bm', c_act, w_ada[l]) + b_ada[l]).reshape(B, 6, D)[:, :, None, :]
        sh_a, sc_a, g_a, sh_f, sc_f, g_f = (mod[:, i] for i in range(6))
        u = rmsnorm(x, attn_norm[l]) * (1.0 + sc_a) + sh_a
        y = token_mixer(u, w_in[l], mla_q_norm[l], mla_kv_norm[l], mla_w_uq[l], mla_w_ukv[l],
                        mla_q_gain[l], mla_k_gain[l], mlstm_conv_w[l], mlstm_conv_b[l], mlstm_b_i[l],
                        mlstm_b_f[l], mlstm_head_gain[l], dil_q_gain[l], dil_k_gain[l],
                        w_branch_a[l], w_branch_b[l], w_branch_c[l], w_out[l])
        x = x + g_a * y
        hf = rmsnorm(x, ffn_norm[l]) * (1.0 + sc_f) + sh_f
        x = x + g_f * hier_moe(hf, w_router_group[l], b_router_group[l], w_router_expert[l],
                               b_router_expert[l], w_exp_gate[l], w_exp_up[l], w_exp_down[l])
    return x
```

```cpp
#include <hip/hip_runtime.h>
#include <cstdio>
#include <cstdint>
#ifndef MK_F16
#define MK_F16 1
#endif
#ifndef MK_MULTI
#define MK_MULTI 0
#endif
#ifndef MK_PH_MASK
#define MK_PH_MASK 0xffffffffu
#endif
#ifndef MK_ABL
#define MK_ABL 0
#endif
#ifndef MK_CHECK
#define MK_CHECK 0
#endif
#ifndef MK_CHECK_FROM
#define MK_CHECK_FROM 23
#endif
#ifndef MK_CHECK_LAYER
#define MK_CHECK_LAYER 0
#endif
#ifndef MK_CHECK_INJECT
#define MK_CHECK_INJECT 1.0f
#endif
#ifndef MK_ZERO_LO
#define MK_ZERO_LO 0
#define MK_ZERO_HI 0
#endif
#ifndef MK_CHECK_TIGHT
#define MK_CHECK_TIGHT 1.0f
#endif
#ifndef MK_BIG
#define MK_BIG 0.0f
#endif
#ifndef MK_UPD_BIG
#define MK_UPD_BIG 2.0f
#endif
#ifndef MK_CNT_WORD
#define MK_CNT_WORD 22
#endif
#ifndef MK_COPY_FROM_IN
#define MK_COPY_FROM_IN 1
#endif
namespace pg8 {
#define PG8_LAS __attribute__((address_space(3)))
typedef unsigned short bf16_t;
typedef short bf16x8 __attribute__((ext_vector_type(8)));
typedef float f32x4 __attribute__((ext_vector_type(4)));
typedef unsigned u32x4 __attribute__((ext_vector_type(4)));
constexpr int BM = 256, BK = 64, HALF = 128, HTB = HALF * BK * 2  , STAGE_BYTES = 8 * HTB, NXCD = 8, WGM = 8;

__host__ __device__ __forceinline__ int lds_byte(int r, int c) { const int st = (r >> 4) * 2 + (c >> 5), rr = r & 15, cc = c & 31, ob = rr * 64 + cc * 2; return st * 1024 + (ob ^ (((ob >> 9) & 1) << 5)); }
__host__ __device__ __forceinline__ void stage_rc(int b, int& R, int& C) { const int st = b / 1024, sb = b % 1024, swz = sb ^ (((sb >> 9) & 1) << 5); R = (st >> 1) * 16 + swz / 64; C = (st & 1) * 32 + (swz % 64) / 2; }
__host__ __device__ __forceinline__ int perm32(int rho) { const int n = rho >> 4, i = rho & 15; return 8 * (i >> 2) + 4 * n + (i & 3); }

struct Unit { int pm, pn, pb, aux; };
struct Gemm { const bf16_t* A; const bf16_t* Bt; int M, N, K; };

struct StaticOrder {
    int nM, nN, nwg, G, c;
    __host__ __device__ void init(int M, int N, int G_, int c_) { nM = M / BM; nN = N / BM; nwg = nM * nN; G = G_; c = c_; }
    __host__ __device__ bool next(int i, Unit& u) const {
        const long L = (long)i * G + c; if (L >= nwg) return false;
        int wgid = (int)L; { const int q = nwg / NXCD, r = nwg % NXCD, xcd = wgid % NXCD, off = wgid / NXCD; wgid = (xcd < r ? xcd * (q + 1) : r * (q + 1) + (xcd - r) * q) + off; }
        const int nig = WGM * nN, gid = wgid / nig, fm = gid * WGM, gsz = (nM - fm) < WGM ? (nM - fm) : WGM;
        u.pm = fm + ((wgid % nig) % gsz); u.pn = (wgid % nig) / gsz; u.pb = u.pn; u.aux = 0; return true;
    }
    __device__ __forceinline__ void a_ready(const Unit&) const {}
    __device__ __forceinline__ void done(const Unit&) const {}
};
typedef _Float16 h16x2 __attribute__((ext_vector_type(2))); typedef _Float16 h16x8 __attribute__((ext_vector_type(8)));
#if MK_F16
__device__ __forceinline__ unsigned cvt_pk_bf16(float lo, float hi) { typedef float f2_ __attribute__((ext_vector_type(2))); const f2_ v = {lo, hi}; return __builtin_bit_cast(unsigned, __builtin_convertvector(v, h16x2)); }
#define PG8_MFMA16(a, b, c) __builtin_amdgcn_mfma_f32_16x16x32_f16(__builtin_bit_cast(pg8::h16x8, (a)), __builtin_bit_cast(pg8::h16x8, (b)), (c), 0, 0, 0)
#else
__device__ __forceinline__ unsigned cvt_pk_bf16(float lo, float hi) { unsigned r; asm volatile("v_cvt_pk_bf16_f32 %0, %1, %2" : "=v"(r) : "v"(lo), "v"(hi)); return r; }
#define PG8_MFMA16(a, b, c) __builtin_amdgcn_mfma_f32_16x16x32_bf16((a), (b), (c), 0, 0, 0)
#endif
typedef float f32x2 __attribute__((ext_vector_type(2)));
template <class Epi, class Sched, bool ALIGN_EPI = false, bool SP2 = false>
__device__ __forceinline__ void gemm_phase(PG8_LAS unsigned char* lds, const Gemm g, const Sched& S, const Epi& E, const int wave_id) {
    Gemm gl = g; { const unsigned long long a_ = (unsigned long long)g.A, b_ = (unsigned long long)g.Bt; unsigned al = __builtin_amdgcn_readfirstlane((unsigned)a_), ah = __builtin_amdgcn_readfirstlane((unsigned)(a_ >> 32)), bl = __builtin_amdgcn_readfirstlane((unsigned)b_), bh = __builtin_amdgcn_readfirstlane((unsigned)(b_ >> 32));
        asm volatile("" : "+s"(al), "+s"(ah), "+s"(bl), "+s"(bh)); gl.A = (const bf16_t*)(((unsigned long long)ah << 32) | al); gl.Bt = (const bf16_t*)(((unsigned long long)bh << 32) | bl); }
    int lid_; asm volatile("v_mbcnt_lo_u32_b32 %0, -1, 0\n\tv_mbcnt_hi_u32_b32 %0, -1, %0" : "=v"(lid_));
    const int tid_ = wave_id * 64 + lid_;
    const int tid = tid_, wid = __builtin_amdgcn_readfirstlane(tid >> 6), lane = tid & 63, wr = wid >> 2, wc = wid & 3, fr = lane & 15, fq = lane >> 4;
    const int K = gl.K, nt = K / BK;
    unsigned voffA[2], voffB[2];
#pragma unroll
    for (int i = 0; i < 2; ++i) { int R, C; stage_rc(tid * 16 + i * 8192, R, C); const int Rb = Epi::PERM ? ((R & ~31) + perm32(R & 31)) : R;
        voffA[i] = (unsigned)(R * K + C) * 2u; voffB[i] = (unsigned)(Rb * K + C) * 2u; }
    const size_t kstep = (size_t)(BK * 2);
    const size_t hstep = (size_t)HALF * K * 2;
    const size_t tstep = 2 * hstep;
    const unsigned ldsw = (unsigned)wid * 1024u;
    const int aoff = lds_byte(wr * 64 + fr, fq * 8), boff = lds_byte(wc * 32 + fr, fq * 8);
#define PG8_SA(b, h) (((b) * 2 + (h)) * HTB)
#define PG8_SB(b, h) ((4 + (b) * 2 + (h)) * HTB)
#define PG8_STAGE(bufoff, gbase, voff) do { _Pragma("unroll") for (int _i = 0; _i < 2; ++_i) \
        __builtin_amdgcn_global_load_lds((const unsigned*)((const char*)(gbase) + (voff)[_i]), (PG8_LAS unsigned*)(lds + (bufoff) + ldsw + _i * 8192), 16, 0, 0); } while (0)
#define PG8_LDA(dst, b, h) do { _Pragma("unroll") for (int m = 0; m < 4; ++m) _Pragma("unroll") for (int k = 0; k < 2; ++k) dst[m][k] = *(const PG8_LAS bf16x8*)(lds + PG8_SA(b, h) + aoff + m * 2048 + k * 1024); } while (0)
#define PG8_LDB(dst, b, h) do { _Pragma("unroll") for (int n = 0; n < 2; ++n) _Pragma("unroll") for (int k = 0; k < 2; ++k) dst[n][k] = *(const PG8_LAS bf16x8*)(lds + PG8_SB(b, h) + boff + n * 2048 + k * 1024); } while (0)
#define PG8_MMA(ai, bj, At, Bt) do { __builtin_amdgcn_s_setprio(1); _Pragma("unroll") for (int m = 0; m < 4; ++m) _Pragma("unroll") for (int n = 0; n < 2; ++n) _Pragma("unroll") for (int k = 0; k < 2; ++k) \
        acc[ai][bj][m][n] = PG8_MFMA16(Bt[n][k], At[m][k], acc[ai][bj][m][n]); __builtin_amdgcn_s_setprio(0); } while (0)
#define PG8_WAIT_V(n) asm volatile("s_waitcnt vmcnt(" #n ")" ::: "memory")
#define PG8_WAIT_L(n) asm volatile("s_waitcnt lgkmcnt(" #n ")" ::: "memory")
#define PG8_BAR __builtin_amdgcn_s_barrier()
#define PG8_SCHED __builtin_amdgcn_sched_barrier(0)
    float zf_ = 0.f; asm volatile("" : "+v"(zf_));
    Unit cur, nxt; int ui = 0;
    if (!S.next(0, cur)) return;
    f32x4 acc[2][2][4][2];
#pragma unroll
    for (int a = 0; a < 2; ++a)
#pragma unroll
        for (int b = 0; b < 2; ++b)
#pragma unroll
            for (int m = 0; m < 4; ++m)
#pragma unroll
                for (int n = 0; n < 2; ++n) acc[a][b][m][n] = (f32x4){zf_, zf_, zf_, zf_};
    bf16x8 At[4][2], B0[2][2], B1[2][2];
    const char* cA = (const char*)gl.A + (size_t)cur.pm * tstep; const char* cB = (const char*)gl.Bt + (size_t)cur.pb * tstep;
    S.a_ready(cur);
    if constexpr (SP2) {
        PG8_STAGE(PG8_SB(0, 0), cB, voffB); PG8_STAGE(PG8_SB(0, 1), cB + hstep, voffB); PG8_STAGE(PG8_SA(0, 0), cA, voffA); PG8_STAGE(PG8_SA(0, 1), cA + hstep, voffA);
        if (wr == 1) PG8_BAR;
        PG8_WAIT_V(2); PG8_BAR;
        PG8_STAGE(PG8_SB(1, 0), cB + kstep, voffB); PG8_STAGE(PG8_SA(1, 0), cA + kstep, voffA); PG8_STAGE(PG8_SB(1, 1), cB + hstep + kstep, voffB);
        PG8_WAIT_V(6); PG8_BAR;
    } else {
        PG8_STAGE(PG8_SB(0, 0), cB, voffB); PG8_STAGE(PG8_SA(0, 0), cA, voffA); PG8_STAGE(PG8_SB(0, 1), cB + hstep, voffB); PG8_STAGE(PG8_SA(0, 1), cA + hstep, voffA);
        if (wr == 1) PG8_BAR;
        PG8_WAIT_V(4); PG8_BAR;
        PG8_STAGE(PG8_SB(1, 0), cB + kstep, voffB); PG8_STAGE(PG8_SA(1, 0), cA + kstep, voffA); PG8_STAGE(PG8_SB(1, 1), cB + hstep + kstep, voffB);
        PG8_WAIT_V(6); PG8_BAR;
    }
    for (;;) {
        const bool has_next = S.next(ui + 1, nxt);
        const char* nA = has_next ? (const char*)gl.A + (size_t)nxt.pm * tstep : cA; const char* nB = has_next ? (const char*)gl.Bt + (size_t)nxt.pb * tstep : cB;
        _Pragma("clang loop unroll(disable)")
        for (int t = 0; t < nt; t += 2) {
            const bool last = (t == nt - 2);
            const char* a1 = cA + (size_t)(t + 1) * kstep;
            const char* a2 = last ? nA : cA + (size_t)(t + 2) * kstep; const char* b2 = last ? nB : cB + (size_t)(t + 2) * kstep;
            const char* a3 = a2 + kstep; const char* b3 = b2 + kstep;
            if (last && has_next) S.a_ready(nxt);
            if constexpr (SP2) {
            PG8_LDB(B0, 0, 0); PG8_LDB(B1, 0, 1); PG8_SCHED; PG8_LDA(At, 0, 0); PG8_STAGE(PG8_SA(1, 1), a1 + hstep, voffA);
            PG8_WAIT_V(8); PG8_WAIT_L(0); PG8_BAR; PG8_MMA(0, 0, At, B0); PG8_MMA(0, 1, At, B1); PG8_BAR; PG8_SCHED;
            PG8_LDA(At, 0, 1); PG8_STAGE(PG8_SB(0, 0), b2, voffB); PG8_STAGE(PG8_SB(0, 1), b2 + hstep, voffB); PG8_STAGE(PG8_SA(0, 0), a2, voffA);
            PG8_WAIT_V(8); PG8_WAIT_L(0); PG8_BAR; PG8_MMA(1, 0, At, B0); PG8_MMA(1, 1, At, B1); PG8_BAR; PG8_SCHED;
            PG8_LDB(B0, 1, 0); PG8_LDB(B1, 1, 1); PG8_SCHED; PG8_LDA(At, 1, 0); PG8_STAGE(PG8_SA(0, 1), a2 + hstep, voffA);
            PG8_WAIT_V(8); PG8_WAIT_L(0); PG8_BAR; PG8_MMA(0, 0, At, B0); PG8_MMA(0, 1, At, B1); PG8_BAR; PG8_SCHED;
            PG8_LDA(At, 1, 1); PG8_STAGE(PG8_SB(1, 0), b3, voffB); PG8_STAGE(PG8_SB(1, 1), b3 + hstep, voffB); PG8_STAGE(PG8_SA(1, 0), a3, voffA);
            PG8_WAIT_V(8); PG8_WAIT_L(0); PG8_BAR; PG8_MMA(1, 0, At, B0); PG8_MMA(1, 1, At, B1); PG8_BAR; PG8_SCHED;
            } else {
            PG8_LDB(B0, 0, 0); PG8_SCHED; PG8_LDA(At, 0, 0); PG8_STAGE(PG8_SA(1, 1), a1 + hstep, voffA);
            PG8_WAIT_L(8); PG8_BAR; PG8_WAIT_L(0); PG8_MMA(0, 0, At, B0); PG8_BAR; PG8_SCHED;
            PG8_LDB(B1, 0, 1); PG8_STAGE(PG8_SB(0, 0), b2, voffB);
            PG8_BAR; PG8_WAIT_L(0); PG8_MMA(0, 1, At, B1); PG8_BAR;
            PG8_LDA(At, 0, 1); PG8_STAGE(PG8_SA(0, 0), a2, voffA);
            PG8_BAR; PG8_WAIT_L(0); PG8_MMA(1, 0, At, B0); PG8_BAR; PG8_SCHED;
            PG8_STAGE(PG8_SB(0, 1), b2 + hstep, voffB);
            PG8_WAIT_V(6); PG8_BAR; PG8_MMA(1, 1, At, B1); PG8_BAR;
            PG8_LDB(B0, 1, 0); PG8_SCHED; PG8_LDA(At, 1, 0); PG8_STAGE(PG8_SA(0, 1), a2 + hstep, voffA);
            PG8_WAIT_L(8); PG8_BAR; PG8_WAIT_L(0); PG8_MMA(0, 0, At, B0); PG8_BAR; PG8_SCHED;
            PG8_LDB(B1, 1, 1); PG8_STAGE(PG8_SB(1, 0), b3, voffB);
            PG8_BAR; PG8_WAIT_L(0); PG8_MMA(0, 1, At, B1); PG8_BAR;
            PG8_LDA(At, 1, 1); PG8_STAGE(PG8_SA(1, 0), a3, voffA);
            PG8_BAR; PG8_WAIT_L(0); PG8_MMA(1, 0, At, B0); PG8_BAR; PG8_SCHED;
            PG8_STAGE(PG8_SB(1, 1), b3 + hstep, voffB);
            PG8_WAIT_V(6); PG8_BAR; PG8_MMA(1, 1, At, B1); PG8_BAR;
            }
        }
        if constexpr (ALIGN_EPI) { if (wr == 0) PG8_BAR; }
        if constexpr (!Epi::AFTER_DRAIN) { int fr_e = fr, fq_e = fq; asm volatile("" : "+v"(fr_e), "+v"(fq_e));
            E(acc, cur, wr, wc, fr_e, fq_e); S.done(cur); }
        if (!has_next) break;
#pragma unroll
        for (int a = 0; a < 2; ++a)
#pragma unroll
            for (int b = 0; b < 2; ++b)
#pragma unroll
                for (int m = 0; m < 4; ++m)
#pragma unroll
                    for (int n = 0; n < 2; ++n) acc[a][b][m][n] = (f32x4){zf_, zf_, zf_, zf_};
        cur = nxt; cA = nA; cB = nB; ++ui;
        if constexpr (ALIGN_EPI) { if (wr == 1) PG8_BAR; }
    }
    PG8_WAIT_V(0);
    if constexpr (!ALIGN_EPI) { if (wr == 0) PG8_BAR; }
    PG8_BAR;
    if constexpr (Epi::AFTER_DRAIN) { E.fused(acc, cur, wr, wc, fr, fq, lds, wid, lane); S.done(cur); }
#undef PG8_SA
#undef PG8_SB
#undef PG8_STAGE
#undef PG8_LDA
#undef PG8_LDB
#undef PG8_MMA
#undef PG8_WAIT_V
#undef PG8_WAIT_L
#undef PG8_BAR
#undef PG8_SCHED
}
}

typedef unsigned short u16;
typedef unsigned int u32;
constexpr int NTOK = 32768, SEQ = 16384, DM = 1024, NL = 4, NWAVES = 8, NTHR = 512;
constexpr int INW = 6568;
constexpr int MAXROWS = NTOK + 24 * 256;
constexpr float EPS = 1e-6f;
constexpr float LOG2E = 1.4426950408889634f;
constexpr size_t MiB = 1u << 20;
constexpr size_t WS_CTL = 0, CTL_ZERO_BYTES = 1 * MiB;
constexpr size_t WS_MOD = 1 * MiB;
constexpr size_t WS_ROPE = 2 * MiB;
constexpr size_t WS_SSQQ = 4 * MiB, WS_SSQKV = 4 * MiB + 512 * 1024;
constexpr size_t WS_IF = 5 * MiB;
constexpr size_t WS_ROUT = 6 * MiB;
constexpr size_t WS_TOK = 7 * MiB;
constexpr size_t WS_MLS = 8 * MiB;
constexpr size_t WS_WIN = 16 * MiB, WS_WUQ = 29 * MiB, WS_WUKV = 29 * MiB + 512 * 1024, WS_WBR = 30 * MiB, WS_WOUT = 33 * MiB, WS_WGU = 35 * MiB, WS_WDC = 51 * MiB;
constexpr size_t WS_ACT = 76 * MiB, SLOT = 32 * MiB;
constexpr size_t WS_END = WS_ACT + 14 * SLOT;
#define ACT(i) (WS_ACT + (size_t)(i) * SLOT)
constexpr int CW_BAR = 4096, CW_MOE = 16384;
constexpr int RING_BYTES = 131072, LDSCTL_OFF = RING_BYTES, MISC_OFF = LDSCTL_OFF + 320, TAB_OFF = LDSCTL_OFF + 1024, PTAB_OFF = LDSCTL_OFF + 4096, LDS_BYTES = 147456;

#define GAS __attribute__((address_space(1)))
#define LAS __attribute__((address_space(3)))
typedef unsigned v4u __attribute__((ext_vector_type(4)));
typedef unsigned v2u __attribute__((ext_vector_type(2)));
typedef float f32x4 __attribute__((ext_vector_type(4)));
#define LDS_WAIT() asm volatile("s_waitcnt lgkmcnt(0)" ::: "memory")
__device__ __forceinline__ u32 f2bf(float f) { u32 u = __builtin_bit_cast(u32, f); return (u + 0x7fffu + ((u >> 16) & 1u)) >> 16; }
__device__ __forceinline__ u32 pk2(float lo, float hi) { return pg8::cvt_pk_bf16(lo, hi); }
#if MK_F16
__device__ __forceinline__ float bflo(u32 w) { return (float)__builtin_bit_cast(pg8::h16x2, w)[0]; }
__device__ __forceinline__ float bfhi(u32 w) { return (float)__builtin_bit_cast(pg8::h16x2, w)[1]; }
__device__ __forceinline__ float bf1(u16 w) { return (float)__builtin_bit_cast(_Float16, w); }
#else
__device__ __forceinline__ float bflo(u32 w) { return __uint_as_float(w << 16); }
__device__ __forceinline__ float bfhi(u32 w) { return __uint_as_float(w & 0xffff0000u); }
__device__ __forceinline__ float bf1(u16 w) { return __uint_as_float(((u32)w) << 16); }
#endif
__device__ __forceinline__ float fsigmoid(float x) { return __builtin_amdgcn_rcpf(1.0f + __expf(-x)); }
__device__ __forceinline__ float fsilu(float x) { return x * fsigmoid(x); }
__device__ __forceinline__ float bperm_f(int srclane, float v) { return __int_as_float(__builtin_amdgcn_ds_bpermute(srclane << 2, __float_as_int(v))); }
__device__ __forceinline__ float wave_sum(float v, int lane) {
#pragma unroll
    for (int o = 1; o < 64; o <<= 1) v += bperm_f(lane ^ o, v);
    return v;
}

__device__ __forceinline__ void* ldsptr(LAS unsigned char* lds, int i) {
    int off_ = PTAB_OFF + 8 * i; asm volatile("" : "+v"(off_));
    const unsigned long long v = *(volatile LAS unsigned long long*)(lds + off_);
    const unsigned lo = __builtin_amdgcn_readfirstlane((unsigned)v), hi = __builtin_amdgcn_readfirstlane((unsigned)(v >> 32));
    unsigned lo2 = lo, hi2 = hi; asm volatile("" : "+s"(lo2), "+s"(hi2));
    return (void*)(uintptr_t)(((unsigned long long)hi2 << 32) | lo2);
}
struct Params { const float* in[31]; float* out; unsigned char* ws; int ph_lo, ph_hi; };
struct Frame {
    LAS unsigned char* lds; int tid, lane, wave, G, bid;
    unsigned char* ws;
};
#define FIN(i) ((const float*)ldsptr(F.lds, (i)))

__device__ __forceinline__ void conv_tile(const float* Wk0, int ldw, const float* ksc, u16* dst, int ldk, int srcc, LAS float* scr, int lane) {
#pragma unroll 8
    for (int i = 0; i < 32; ++i) { const int kk = 2 * i + (lane >> 5); float v = 0.f;
        if (Wk0 != nullptr && srcc >= 0) { v = Wk0[(size_t)kk * ldw + srcc]; if (ksc) v *= ksc[kk]; }
        scr[kk * 33 + (lane & 31)] = v; }
    LDS_WAIT(); asm volatile("" ::: "memory");
    const int c = lane & 7;
#pragma unroll
    for (int j = 0; j < 4; ++j) { const int n = (lane >> 3) + 8 * j; const LAS float* s = scr + (8 * c) * 33 + n;
        v4u o; o.x = pk2(s[0 * 33], s[1 * 33]); o.y = pk2(s[2 * 33], s[3 * 33]); o.z = pk2(s[4 * 33], s[5 * 33]); o.w = pk2(s[6 * 33], s[7 * 33]);
        *(v4u*)(dst + (size_t)n * ldk + 8 * c) = o; }
    LDS_WAIT(); asm volatile("" ::: "memory");
}
__device__ __forceinline__ int win_srccol(int n) {
    const int pn = n >> 8, j = n & 255;
    if (pn == 0) return j;
    if (pn == 1) { if (j < 128) return 256 + j; if (j < 160) return 384 + (j - 128); if (j < 164) return 1952 + (j - 160); if (j < 168) return 1956 + (j - 164); return -1; }
    if (pn < 8) return 416 + (pn - 2) * 256 + j;
    if (pn < 12) { const int base = pn < 10 ? 1960 : 2472, half = (pn - 8) & 1, bj = j >> 7, wc = (j & 127) >> 5, i32 = j & 31; return base + (half * 4 + wc) * 64 + bj * 32 + i32; }
    if (pn < 14) return 2984 + (pn - 12) * 256 + j;
    return 3496 + (n - 3584);
}
__device__ __forceinline__ void cls_experts(int cls, int& ea, int& eb) {
    const int g = cls / 6, p = cls % 6; const int a = p < 3 ? 0 : (p < 5 ? 1 : 2); const int b = p < 3 ? p + 1 : (p < 5 ? p - 1 : 3);
    ea = g * 4 + a; eb = g * 4 + b;
}
__device__ __forceinline__ void conv_phase(Frame& F, int l) {
    LAS float* scr = (LAS float*)(F.lds + F.wave * 16384);
    const int gw = F.bid * NWAVES + F.wave, NGW = F.G * NWAVES, lane = F.lane, ln = lane & 31;
    constexpr int I_WIN = 208 * 16, I_UQ = 24 * 4, I_UKV = 32 * 4, I_BR = 3 * 32 * 8, I_OUT = 32 * 16, I_GU = 16 * 16 * 16, I_DC = 24 * 32 * 8;
    constexpr int NITEMS = I_WIN + I_UQ + I_UKV + I_BR + I_OUT + I_GU + I_DC;
    unsigned char* ws = F.ws;
    for (int it = gw; it < NITEMS; it += NGW) {
        int r = it;
        if (r < I_WIN) { const int nb = r / 16, kb = r % 16; const float* W = FIN(5) + (size_t)l * 1024 * INW;
            conv_tile(W + (size_t)kb * 64 * INW, INW, nullptr, (u16*)(ws + WS_WIN) + (size_t)nb * 32 * 1024 + kb * 64, 1024, win_srccol(nb * 32 + ln), scr, lane); continue; } r -= I_WIN;
        if (r < I_UQ) { const int nb = r / 4, kb = r % 4; const float* W = FIN(8) + (size_t)l * 256 * 768;
            conv_tile(W + (size_t)kb * 64 * 768, 768, FIN(6) + l * 256 + kb * 64, (u16*)(ws + WS_WUQ) + (size_t)nb * 32 * 256 + kb * 64, 256, nb * 32 + ln, scr, lane); continue; } r -= I_UQ;
        if (r < I_UKV) { const int nb = r / 4, kb = r % 4; const float* W = FIN(9) + (size_t)l * 128 * 1024;
            conv_tile(kb < 2 ? W + (size_t)kb * 64 * 1024 : nullptr, 1024, kb < 2 ? FIN(7) + l * 128 + kb * 64 : nullptr, (u16*)(ws + WS_WUKV) + (size_t)nb * 32 * 256 + kb * 64, 256, nb * 32 + ln, scr, lane); continue; } r -= I_UKV;
        if (r < I_BR) { const int br = r / 256, q = r % 256, nb = q / 8, kb = q % 8; const float* W = (br == 0 ? FIN(19) : (br == 1 ? FIN(20) : FIN(21))) + (size_t)l * 512 * 1024;
            conv_tile(W + (size_t)kb * 64 * 1024, 1024, nullptr, (u16*)(ws + WS_WBR) + (size_t)br * 1024 * 512 + (size_t)nb * 32 * 512 + kb * 64, 512, nb * 32 + ln, scr, lane); continue; } r -= I_BR;
        if (r < I_OUT) { const int nb = r / 16, kb = r % 16; const float* W = FIN(22) + (size_t)l * 1024 * 1024;
            conv_tile(W + (size_t)kb * 64 * 1024, 1024, nullptr, (u16*)(ws + WS_WOUT) + (size_t)nb * 32 * 1024 + kb * 64, 1024, nb * 32 + ln, scr, lane); continue; } r -= I_OUT;
        if (r < I_GU) { const int e = r / 256, q = r % 256, nb = q / 16, kb = q % 16;
            const int p = nb >> 3, jp = (nb & 7) * 32, bj = jp >> 7, f = p * 128 + (jp & 127) + ln;
            const float* W = (bj ? FIN(29) : FIN(28)) + ((size_t)l * 16 + e) * 1024 * 256;
            conv_tile(W + (size_t)kb * 64 * 256, 256, nullptr, (u16*)(ws + WS_WGU) + ((size_t)e * 512 + nb * 32) * 1024 + kb * 64, 1024, f, scr, lane); continue; } r -= I_GU;
        { const int cls = r / 256, q = r % 256, nb = q / 8, kb = q % 8; int ea, eb; cls_experts(cls, ea, eb);
            const int e = kb < 4 ? ea : eb, k0 = (kb & 3) * 64; const float* W = FIN(30) + ((size_t)l * 16 + e) * 256 * 1024;
            conv_tile(W + (size_t)k0 * 1024, 1024, nullptr, (u16*)(ws + WS_WDC) + ((size_t)cls * 1024 + nb * 32) * 512 + kb * 64, 512, nb * 32 + ln, scr, lane); }
    }
}

__device__ __forceinline__ void pre_phase(Frame& F) {
    const float* c = FIN(1); const float* w_ada = FIN(2); const float* b_ada = FIN(3);
    float* mod = (float*)(F.ws + WS_MOD);
    LAS float* scr = (LAS float*)F.lds;
    for (int u = F.bid; u < NL * 96; u += F.G) {
        const int l = u / 96, j0 = (u % 96) * 64, jc = F.tid & 63, dg = F.tid >> 6;
        const float* W = w_ada + (size_t)l * 1024 * 6144 + j0 + jc;
        float a0 = 0.f, a1 = 0.f;
        for (int d = dg * 128; d < dg * 128 + 128; ++d) { const float w = W[(size_t)d * 6144]; a0 += fsilu(c[d]) * w; a1 += fsilu(c[1024 + d]) * w; }
        scr[(dg * 64 + jc) * 2 + 0] = a0; scr[(dg * 64 + jc) * 2 + 1] = a1;
        __syncthreads();
        if (F.tid < 128) { const int jc2 = F.tid & 63, b = F.tid >> 6; float s = b_ada[l * 6144 + j0 + jc2];
#pragma unroll
            for (int g = 0; g < 8; ++g) s += scr[(g * 64 + jc2) * 2 + b];
            mod[(size_t)(l * 2 + b) * 6144 + j0 + jc2] = s; }
        __syncthreads();
    }
    float* ct = (float*)(F.ws + WS_ROPE); float* st = ct + SEQ * 16;
    for (int idx = F.bid * NTHR + F.tid; idx < SEQ * 16; idx += F.G * NTHR) {
        const int pos = idx >> 4, i = idx & 15;
        double inv = (i & 3) == 0 ? 1.0 : ((i & 3) == 1 ? 0.5623413251903491 : ((i & 3) == 2 ? 0.31622776601683794 : 0.1778279410038923));
        const int dec = i >> 2; inv = dec == 0 ? inv : (dec == 1 ? inv * 0.1 : (dec == 2 ? inv * 0.01 : inv * 0.001));
        const float ang = (float)pos * (float)inv;
        double rev = (double)ang * 0.15915494309189535; rev -= __builtin_rint(rev);
        ct[idx] = __builtin_amdgcn_cosf((float)rev); st[idx] = __builtin_amdgcn_sinf((float)rev);
    }
}

__device__ __forceinline__ void norm_rows(Frame& F, const float* xin, const float* gain, const float* modl  , int ish, int isc, u16* U) {
    const int gw = F.bid * NWAVES + F.wave, NGW = F.G * NWAVES, lane = F.lane;
    for (int m = gw; m < NTOK; m += NGW) {
        const int b = m / SEQ;
        const f32x4* xr = (const f32x4*)(xin + (size_t)m * DM) + lane;
        f32x4 v[4]; float s = 0.f;
#pragma unroll
        for (int j = 0; j < 4; ++j) { v[j] = xr[64 * j]; s += (v[j].x * v[j].x + v[j].y * v[j].y) + (v[j].z * v[j].z + v[j].w * v[j].w); }
        const float rstd = 1.0f / sqrtf(wave_sum(s, lane) * (1.f / DM) + EPS);
        v2u* o8 = (v2u*)(U + (size_t)m * DM) + lane;
#pragma unroll
        for (int j = 0; j < 4; ++j) { const int c0 = 4 * lane + 256 * j;
            const f32x4 g = *(const f32x4*)(gain + c0), sc = *(const f32x4*)(modl + (size_t)(b * 6 + isc) * 1024 + c0), sh = *(const f32x4*)(modl + (size_t)(b * 6 + ish) * 1024 + c0);
            const f32x4 y = (v[j] * rstd) * g * (sc + 1.0f) + sh;
            v2u w; w.x = pk2(y.x, y.y); w.y = pk2(y.z, y.w); o8[64 * j] = w; }
    }
}
#define XB_TMO      128
#define XB_XCNT(j)  (256  + 64 * (j))
#define XB_XSUB(j)  (1280 + 64 * (j))
#define XB_XGEN(j)  (2304 + 64 * (j))
#define XB_TOP      3328
#define XB_TOPGEN   3392
#define XCD_BAR_WORDS 3456
#define XB_SPIN_CAP (1u << 18)

__device__ __forceinline__ unsigned xb_ld(unsigned* p)              { return __hip_atomic_load(p, __ATOMIC_RELAXED, __HIP_MEMORY_SCOPE_AGENT); }
__device__ __forceinline__ unsigned xb_add(unsigned* p, unsigned v) { return __hip_atomic_fetch_add(p, v, __ATOMIC_RELAXED, __HIP_MEMORY_SCOPE_AGENT); }
__device__ __forceinline__ unsigned xb_xcc_id() { return (unsigned)__builtin_amdgcn_s_getreg((3 << 11) | 20) & 0xFu; }
#define XB_SPIN(cond, bar) do { unsigned _sp = 0; while (cond) { __builtin_amdgcn_s_sleep(1); \
    if ((++_sp & 255u) == 0u) { if (xb_ld(&(bar)[XB_TMO])) break; if (_sp > XB_SPIN_CAP) { atomicAdd(&(bar)[XB_TMO], 1u); break; } } } } while (0)

struct XcdBarrier {
    unsigned* bar; unsigned x;
    volatile LAS unsigned* st;
    bool lead;
};

__device__ __forceinline__ XcdBarrier xcd_barrier_post(unsigned* bar, volatile LAS unsigned* st) {
    XcdBarrier b; b.bar = bar; b.x = xb_xcc_id(); b.st = st; b.lead = (threadIdx.x == 0);
    if (b.lead) (void)xb_add(&bar[XB_XCNT(b.x)], 1u);
    return b;
}
__device__ __forceinline__ void xcd_barrier_complete(unsigned* bar, unsigned x, unsigned& nloc, unsigned& nx) {
    const unsigned G = gridDim.x * gridDim.y * gridDim.z;
    unsigned sum, cnt, mine, sp = 0u;
    for (;;) {
        sum = 0u; cnt = 0u; mine = 0u;
#pragma unroll
        for (unsigned j = 0; j < 16; ++j) { const unsigned c = xb_ld(&bar[XB_XCNT(j)]); sum += c; cnt += (c > 0u) ? 1u : 0u; mine = (j == x) ? c : mine; }
        if (sum == G) break;
        __builtin_amdgcn_s_sleep(1);
        if ((++sp & 255u) == 0u) { if (xb_ld(&bar[XB_TMO])) break; if (sp > XB_SPIN_CAP) { atomicAdd(&bar[XB_TMO], 1u); break; } }
    }
    nloc = mine > 0u ? mine : 1u; nx = cnt > 0u ? cnt : 1u;
}

__device__ __forceinline__ void xcd_barrier(const XcdBarrier& b) {
    asm volatile("s_waitcnt vmcnt(0)" ::: "memory");
    __syncthreads();
    if (b.lead) {
        unsigned* bar = b.bar;
        __builtin_amdgcn_s_waitcnt(0);
        unsigned nloc = b.st[0], nx = b.st[1];
        if (nloc == 0u) { xcd_barrier_complete(bar, b.x, nloc, nx); b.st[0] = nloc; b.st[1] = nx; }
        const unsigned old = xb_add(&bar[XB_XSUB(b.x)], 1u);
        const unsigned gen = old / nloc;
        if (old + 1u == (gen + 1u) * nloc) {
            __builtin_amdgcn_fence(__ATOMIC_RELEASE, "agent");
            asm volatile("s_waitcnt vmcnt(0)" ::: "memory");
            const unsigned og = xb_add(&bar[XB_TOP], 1u);
            const unsigned tg = og / nx;
            if (og + 1u == (tg + 1u) * nx) xb_add(&bar[XB_TOPGEN], 1u);
            else XB_SPIN(xb_ld(&bar[XB_TOPGEN]) == tg, bar);
            __builtin_amdgcn_fence(__ATOMIC_ACQUIRE, "agent");
            xb_add(&bar[XB_XGEN(b.x)], 1u);
            asm volatile("s_waitcnt vmcnt(0)" ::: "memory");
        } else {
            XB_SPIN(xb_ld(&bar[XB_XGEN(b.x)]) == gen, bar);
            __builtin_amdgcn_fence(__ATOMIC_ACQUIRE, "agent");
            asm volatile("s_waitcnt vmcnt(0)" ::: "memory");
        }
    }
    __syncthreads();
}

typedef pg8::f32x4 A4;
#define EPI_ARGS const A4 (&acc)[2][2][4][2], const pg8::Unit& u, int wr, int wc, int fr, int fq
__device__ __forceinline__ v4u pack8(A4 a, A4 b) { v4u w; w.x = pk2(a[0], a[1]); w.y = pk2(a[2], a[3]); w.z = pk2(b[0], b[1]); w.w = pk2(b[2], b[3]); return w; }
__device__ __forceinline__ float dot4(A4 a) { return (a[0] * a[0] + a[1] * a[1]) + (a[2] * a[2] + a[3] * a[3]); }
__device__ __forceinline__ float logsigmoidf(float x) { const float e = __expf(-fabsf(x)); return fminf(x, 0.f) - __logf(1.0f + e); }

struct EpiG1 {
    static constexpr bool PERM = true, AFTER_DRAIN = false;
    unsigned char* ws; const float *b_i, *b_f, *dqg, *dkg;
    __device__ __forceinline__ void operator()(EPI_ARGS) const {
        u16* const CQ = (u16*)(ws + ACT(2)); u16* const C1 = (u16*)(ws + ACT(2) + 16 * MiB); u16* const DV = (u16*)(ws + ACT(8));
        float* const ssqq = (float*)(ws + WS_SSQQ); float* const ssqkv = (float*)(ws + WS_SSQKV); float* const IF = (float*)(ws + WS_IF);
        const int pn = u.pn, row0 = u.pm * 256 + wr * 64 + fr, cw = 32 * wc + 8 * fq;
        if (pn == 0) {
#pragma unroll
            for (int ai = 0; ai < 2; ++ai)
#pragma unroll
                for (int m = 0; m < 4; ++m) { const size_t row = row0 + ai * 128 + m * 16; float ss = 0.f;
#pragma unroll
                    for (int bj = 0; bj < 2; ++bj) { ss += dot4(acc[ai][bj][m][0]) + dot4(acc[ai][bj][m][1]); *(v4u*)(CQ + row * 256 + bj * 128 + cw) = pack8(acc[ai][bj][m][0], acc[ai][bj][m][1]); }
                    ss += bperm_f((fq * 16 + fr) ^ 16, ss); ss += bperm_f((fq * 16 + fr) ^ 32, ss);
                    if (fq == 0) ssqq[row * 4 + wc] = ss; }
        } else if (pn == 1) {
#pragma unroll
            for (int ai = 0; ai < 2; ++ai)
#pragma unroll
                for (int m = 0; m < 4; ++m) { const size_t row = row0 + ai * 128 + m * 16;
                    float ss = dot4(acc[ai][0][m][0]) + dot4(acc[ai][0][m][1]);
#pragma unroll
                    for (int bj = 0; bj < 2; ++bj) *(v4u*)(C1 + row * 256 + bj * 128 + cw) = pack8(acc[ai][bj][m][0], acc[ai][bj][m][1]);
                    ss += bperm_f((fq * 16 + fr) ^ 16, ss); ss += bperm_f((fq * 16 + fr) ^ 32, ss);
                    if (fq == 0) { ssqkv[row * 4 + wc] = ss;
                        if (wc == 1) { const A4 gi = acc[ai][1][m][0], gf = acc[ai][1][m][1]; A4 o0, o1;
#pragma unroll
                            for (int i = 0; i < 4; ++i) { o0[i] = gi[i] + b_i[i]; o1[i] = logsigmoidf(gf[i] + b_f[i]); }
                            *(A4*)(IF + row * 8) = o0; *(A4*)(IF + row * 8 + 4) = o1; } } }
        } else if (pn < 8) {
            u16* dst = (u16*)(ws + WS_ACT + (size_t)(3 + ((pn - 2) >> 1)) * SLOT); const int cb = (pn & 1) * 256; const bool sg = pn >= 6;
#pragma unroll
            for (int ai = 0; ai < 2; ++ai)
#pragma unroll
                for (int m = 0; m < 4; ++m) { const size_t row = row0 + ai * 128 + m * 16;
#pragma unroll
                    for (int bj = 0; bj < 2; ++bj) { A4 a = acc[ai][bj][m][0], b = acc[ai][bj][m][1];
                        if (sg) {
#pragma unroll
                            for (int i = 0; i < 4; ++i) { a[i] = fsigmoid(a[i]); b[i] = fsigmoid(b[i]); } }
                        *(v4u*)(dst + row * 512 + cb + bj * 128 + cw) = pack8(a, b); } }
        } else if (pn < 12) {
            const bool isq = pn < 10; u16* dst = (u16*)(ws + WS_ACT + (size_t)(isq ? 6 : 7) * SLOT); const float* gn = isq ? dqg : dkg; const int head = (pn & 1) * 4 + wc;
            const float osc = isq ? 0.125f * LOG2E : 1.0f;
#pragma unroll
            for (int ai = 0; ai < 2; ++ai)
#pragma unroll
                for (int m = 0; m < 4; ++m) { const size_t row = row0 + ai * 128 + m * 16;
                    float ss = (dot4(acc[ai][0][m][0]) + dot4(acc[ai][0][m][1])) + (dot4(acc[ai][1][m][0]) + dot4(acc[ai][1][m][1]));
                    ss += bperm_f((fq * 16 + fr) ^ 16, ss); ss += bperm_f((fq * 16 + fr) ^ 32, ss);
                    const float rstd = osc / sqrtf(ss * (1.f / 64.f) + EPS);
#pragma unroll
                    for (int bj = 0; bj < 2; ++bj) { const A4 g0 = *(const A4*)(gn + bj * 32 + 8 * fq), g1 = *(const A4*)(gn + bj * 32 + 8 * fq + 4);
                        *(v4u*)(dst + row * 512 + head * 64 + bj * 32 + 8 * fq) = pack8(acc[ai][bj][m][0] * rstd * g0, acc[ai][bj][m][1] * rstd * g1); }
                    asm volatile("" ::: "memory"); }
        } else {
            const int cb = (pn & 1) * 256;
#pragma unroll
            for (int ai = 0; ai < 2; ++ai)
#pragma unroll
                for (int m = 0; m < 4; ++m) { const size_t row = row0 + ai * 128 + m * 16;
#pragma unroll
                    for (int bj = 0; bj < 2; ++bj) *(v4u*)(DV + row * 512 + cb + bj * 128 + cw) = pack8(acc[ai][bj][m][0], acc[ai][bj][m][1]); }
        }
    }
};
struct EpiQU {
    static constexpr bool PERM = true, AFTER_DRAIN = false;
    u16* Q; const float* ssqq;
    __device__ __forceinline__ void operator()(EPI_ARGS) const {
        const int row0 = u.pm * 256 + wr * 64 + fr, col0 = u.pn * 256 + 32 * wc + 8 * fq;
#pragma unroll
        for (int ai = 0; ai < 2; ++ai)
#pragma unroll
            for (int m = 0; m < 4; ++m) { const size_t row = row0 + ai * 128 + m * 16; const A4 s4 = *(const A4*)(ssqq + row * 4);
                const float r = 1.0f / sqrtf(((s4[0] + s4[1]) + (s4[2] + s4[3])) * (1.f / 256.f) + EPS);
#pragma unroll
                for (int bj = 0; bj < 2; ++bj) *(v4u*)(Q + row * 768 + col0 + bj * 128) = pack8(acc[ai][bj][m][0] * r, acc[ai][bj][m][1] * r);
                asm volatile("" ::: "memory"); }
    }
};
struct EpiKVU {
    static constexpr bool PERM = true, AFTER_DRAIN = false;
    u16 *K, *V; const float* ssqkv;
    __device__ __forceinline__ void operator()(EPI_ARGS) const {
        const int row0 = u.pm * 256 + wr * 64 + fr;
#pragma unroll
        for (int ai = 0; ai < 2; ++ai)
#pragma unroll
            for (int m = 0; m < 4; ++m) { const size_t row = row0 + ai * 128 + m * 16; const A4 s4 = *(const A4*)(ssqkv + row * 4);
                const float r = 1.0f / sqrtf(((s4[0] + s4[1]) + (s4[2] + s4[3])) * (1.f / 128.f) + EPS);
#pragma unroll
                for (int bj = 0; bj < 2; ++bj) { const int head = 2 * u.pn + bj; const v4u w = pack8(acc[ai][bj][m][0] * r, acc[ai][bj][m][1] * r);
                    if (wc < 2) *(v4u*)(K + row * 768 + head * 96 + 32 * wc + 8 * fq) = w; else *(v4u*)(V + row * 512 + head * 64 + 32 * (wc - 2) + 8 * fq) = w; }
                asm volatile("" ::: "memory"); }
    }
};
struct EpiGate {
    static constexpr bool PERM = true, AFTER_DRAIN = false;
    u16* GT;
    __device__ __forceinline__ void operator()(EPI_ARGS) const {
        const int row0 = u.pm * 256 + wr * 64 + fr, col0 = u.pn * 256 + 32 * wc + 8 * fq;
#pragma unroll
        for (int ai = 0; ai < 2; ++ai)
#pragma unroll
            for (int m = 0; m < 4; ++m) { const size_t row = row0 + ai * 128 + m * 16;
#pragma unroll
                for (int bj = 0; bj < 2; ++bj) { A4 a = acc[ai][bj][m][0], b = acc[ai][bj][m][1];
#pragma unroll
                    for (int i = 0; i < 4; ++i) { a[i] = fsigmoid(a[i]); b[i] = fsigmoid(b[i]); }
                    *(v4u*)(GT + row * 3072 + col0 + bj * 128) = pack8(a, b); } }
    }
};
template <int IDX> struct EpiMerge {
    static constexpr bool PERM = true, AFTER_DRAIN = false;
    const u16* GT; u16* M; unsigned* dbg;
    __device__ __forceinline__ void operator()(EPI_ARGS) const {
        const int row0 = u.pm * 256 + wr * 64 + fr, col0 = u.pn * 256 + 32 * wc + 8 * fq;
#pragma unroll
        for (int ai = 0; ai < 2; ++ai)
#pragma unroll
            for (int m = 0; m < 4; ++m) { const size_t row = row0 + ai * 128 + m * 16;
#pragma unroll
                for (int bj = 0; bj < 2; ++bj) { const v4u g = *(const v4u*)(GT + row * 3072 + IDX * 1024 + col0 + bj * 128);
                    A4 a = acc[ai][bj][m][0], b = acc[ai][bj][m][1];
                    a[0] *= bflo(g.x); a[1] *= bfhi(g.x); a[2] *= bflo(g.y); a[3] *= bfhi(g.y); b[0] *= bflo(g.z); b[1] *= bfhi(g.z); b[2] *= bflo(g.w); b[3] *= bfhi(g.w);
                    if ((MK_ABL >> IDX) & 1) { a = (A4){0.f, 0.f, 0.f, 0.f}; b = a; }
#if MK_CHECK
                    for (int i_ = 0; i_ < 4; ++i_) { if (fabsf(a[i_]) > MK_UPD_BIG) atomicAdd(dbg + IDX, 1u); if (fabsf(b[i_]) > MK_UPD_BIG) atomicAdd(dbg + IDX, 1u); }
#endif
                    u16* mp = M + row * 1024 + col0 + bj * 128;
                    if (IDX > 0) { const v4u p = *(const v4u*)mp; a[0] += bflo(p.x); a[1] += bfhi(p.x); a[2] += bflo(p.y); a[3] += bfhi(p.y); b[0] += bflo(p.z); b[1] += bfhi(p.z); b[2] += bflo(p.w); b[3] += bfhi(p.w); }
                    *(v4u*)mp = pack8(a, b); }
                asm volatile("" ::: "memory"); }
    }
};
struct EpiOut {
    static constexpr bool PERM = false, AFTER_DRAIN = false;
    const float* xin; float* xout; const float* ga  ; unsigned* dbg;
    __device__ __forceinline__ void operator()(EPI_ARGS) const {
        const int row0 = u.pm * 256 + wr * 64 + fr, col0 = u.pn * 256 + 32 * wc + 4 * fq, b = (u.pm * 256) / SEQ;
        A4 g[2][2];
#pragma unroll
        for (int bj = 0; bj < 2; ++bj)
#pragma unroll
            for (int n = 0; n < 2; ++n) g[bj][n] = *(const A4*)(ga + (size_t)b * 6144 + col0 + bj * 128 + n * 16);
#pragma unroll
        for (int ai = 0; ai < 2; ++ai)
#pragma unroll
            for (int m = 0; m < 4; ++m) { const size_t off = (size_t)(row0 + ai * 128 + m * 16) * 1024 + col0;
#pragma unroll
                for (int bj = 0; bj < 2; ++bj)
#pragma unroll
                    for (int n = 0; n < 2; ++n) { const A4 xi = *(const A4*)(xin + off + bj * 128 + n * 16); *(A4*)(xout + off + bj * 128 + n * 16) = xi + g[bj][n] * acc[ai][bj][m][n];
#if MK_CHECK
                        { const A4 up = g[bj][n] * acc[ai][bj][m][n]; for (int i_ = 0; i_ < 4; ++i_) if (fabsf(up[i_]) > MK_UPD_BIG) atomicAdd(dbg, 1u); }
#endif
                    }
                asm volatile("" ::: "memory"); }
    }
};
struct EpiGU {
    static constexpr bool PERM = true, AFTER_DRAIN = false;
    u16* HID; const float* wrow;
    __device__ __forceinline__ void operator()(EPI_ARGS) const {
        const int row0 = u.pm * 256 + wr * 64 + fr, slot = u.pn >> 1, p = u.pn & 1, col0 = slot * 256 + p * 128 + 32 * wc + 8 * fq;
#pragma unroll
        for (int ai = 0; ai < 2; ++ai)
#pragma unroll
            for (int m = 0; m < 4; ++m) { const size_t row = row0 + ai * 128 + m * 16; const float w = wrow[row * 2 + slot];
                A4 h0, h1;
#pragma unroll
                for (int i = 0; i < 4; ++i) { h0[i] = fsilu(acc[ai][0][m][0][i]) * acc[ai][1][m][0][i] * w; h1[i] = fsilu(acc[ai][0][m][1][i]) * acc[ai][1][m][1][i] * w; }
                *(v4u*)(HID + row * 512 + col0) = pack8(h0, h1);
                asm volatile("" ::: "memory"); }
    }
};
struct EpiDown {
    static constexpr bool PERM = false, AFTER_DRAIN = false;
    float* x; const int* tok; const float* gf  ; unsigned* dbg;
    __device__ __forceinline__ void operator()(EPI_ARGS) const {
        const int row0 = u.pm * 256 + wr * 64 + fr, col0 = u.pn * 256 + 32 * wc + 4 * fq;
#pragma unroll
        for (int ai = 0; ai < 2; ++ai)
#pragma unroll
            for (int m = 0; m < 4; ++m) { const int t = tok[row0 + ai * 128 + m * 16];
                if (t >= 0) { const int b = t / SEQ; const size_t off = (size_t)t * 1024 + col0;
#pragma unroll
                    for (int bj = 0; bj < 2; ++bj)
#pragma unroll
                        for (int n = 0; n < 2; ++n) { const A4 g = *(const A4*)(gf + (size_t)b * 6144 + col0 + bj * 128 + n * 16); const A4 xi = *(const A4*)(x + off + bj * 128 + n * 16);
                            *(A4*)(x + off + bj * 128 + n * 16) = xi + g * acc[ai][bj][m][n];
#if MK_CHECK
                            { const A4 up = g * acc[ai][bj][m][n]; for (int i_ = 0; i_ < 4; ++i_) if (fabsf(up[i_]) > MK_UPD_BIG) atomicAdd(dbg, 1u); }
#endif
                        } }
                asm volatile("" ::: "memory"); }
    }
};
struct MoeOrder {
    const LAS int* ul;
    __device__ __forceinline__ bool next(int i, pg8::Unit& u) const {
        if (i >= ul[0]) return false;
        const int v = __builtin_amdgcn_readfirstlane(ul[1 + i]); u.pm = v & 255; u.pn = (v >> 8) & 3; u.pb = v >> 16; u.aux = 0; return true;
    }
    __device__ __forceinline__ void a_ready(const pg8::Unit&) const {}
    __device__ __forceinline__ void done(const pg8::Unit&) const {}
};

__device__ __forceinline__ void l3post_phase(Frame& F, u16* Q, u16* K, const u16* C1, const float* qg, const float* kg) {
    const float* ct = (const float*)(F.ws + WS_ROPE); const float* st = ct + SEQ * 16;
    for (int idx = F.bid * NTHR + F.tid; idx < NTOK * 16; idx += F.G * NTHR) {
        const int isk = idx & 1, h = (idx >> 1) & 7, row = idx >> 4, pos = row % SEQ;
        u16* p = (isk ? K : Q) + (size_t)row * 768 + h * 96; const float* gn = isk ? kg : qg;
        float v[96];
#pragma unroll
        for (int c = 0; c < 8; ++c) { const v4u w = *(const v4u*)(p + c * 8); v[c * 8 + 0] = bflo(w.x); v[c * 8 + 1] = bfhi(w.x); v[c * 8 + 2] = bflo(w.y); v[c * 8 + 3] = bfhi(w.y); v[c * 8 + 4] = bflo(w.z); v[c * 8 + 5] = bfhi(w.z); v[c * 8 + 6] = bflo(w.w); v[c * 8 + 7] = bfhi(w.w); }
        const u16* p2 = isk ? (C1 + (size_t)row * 256 + 128) : (p + 64);
#pragma unroll
        for (int c = 0; c < 4; ++c) { const v4u w = *(const v4u*)(p2 + c * 8); v[64 + c * 8 + 0] = bflo(w.x); v[64 + c * 8 + 1] = bfhi(w.x); v[64 + c * 8 + 2] = bflo(w.y); v[64 + c * 8 + 3] = bfhi(w.y); v[64 + c * 8 + 4] = bflo(w.z); v[64 + c * 8 + 5] = bfhi(w.z); v[64 + c * 8 + 6] = bflo(w.w); v[64 + c * 8 + 7] = bfhi(w.w); }
        float ss = 0.f;
#pragma unroll
        for (int d = 0; d < 96; ++d) ss += v[d] * v[d];
        const float rs = (1.0f / sqrtf(ss * (1.f / 96.f) + EPS)) * (isk ? 1.0f : 0.10206207261596577f * LOG2E);
#pragma unroll
        for (int d = 0; d < 96; ++d) v[d] = v[d] * rs * gn[d];
#pragma unroll
        for (int i = 0; i < 16; ++i) { const float cs = ct[pos * 16 + i], sn = st[pos * 16 + i], x1 = v[64 + i], x2 = v[80 + i]; v[64 + i] = x1 * cs - x2 * sn; v[80 + i] = x1 * sn + x2 * cs; }
#pragma unroll
        for (int c = 0; c < 12; ++c) { v4u w; w.x = pk2(v[c * 8 + 0], v[c * 8 + 1]); w.y = pk2(v[c * 8 + 2], v[c * 8 + 3]); w.z = pk2(v[c * 8 + 4], v[c * 8 + 5]); w.w = pk2(v[c * 8 + 6], v[c * 8 + 7]); *(v4u*)(p + c * 8) = w; }
    }
}

__device__ __forceinline__ void mla_naive_phase(Frame& F, const u16* Q, const u16* K, const u16* V, u16* YA) {
    LAS float* Ks = (LAS float*)F.lds;
    LAS float* Vs = (LAS float*)(F.lds + 64 * 96 * 4);
    for (int item = F.bid; item < 256; item += F.G) {
        const int bh = item >> 4, pr = item & 15, b = bh >> 3, h = bh & 7;
        for (int half = 0; half < 2; ++half) {
            const int qb = half ? 31 - pr : pr, qpos = qb * 512 + F.tid; const size_t qrow = (size_t)b * SEQ + qpos;
            float q[96], o[64];
#pragma unroll
            for (int c = 0; c < 12; ++c) { const v4u w = *(const v4u*)(Q + qrow * 768 + h * 96 + c * 8); q[c * 8 + 0] = bflo(w.x); q[c * 8 + 1] = bfhi(w.x); q[c * 8 + 2] = bflo(w.y); q[c * 8 + 3] = bfhi(w.y); q[c * 8 + 4] = bflo(w.z); q[c * 8 + 5] = bfhi(w.z); q[c * 8 + 6] = bflo(w.w); q[c * 8 + 7] = bfhi(w.w); }
#pragma unroll
            for (int d = 0; d < 64; ++d) o[d] = 0.f;
            float mx = -1e30f, l = 0.f;
            const int ntile = (qb + 1) * 8;
            for (int kt = 0; kt < ntile; ++kt) {
                __syncthreads();
                for (int e = F.tid; e < 64 * 12; e += NTHR) { const int kr = e / 12, c = e % 12; const v4u w = *(const v4u*)(K + ((size_t)b * SEQ + kt * 64 + kr) * 768 + h * 96 + c * 8);
                    LAS float* d = Ks + kr * 96 + c * 8; d[0] = bflo(w.x); d[1] = bfhi(w.x); d[2] = bflo(w.y); d[3] = bfhi(w.y); d[4] = bflo(w.z); d[5] = bfhi(w.z); d[6] = bflo(w.w); d[7] = bfhi(w.w); }
                { const int kr = F.tid >> 3, c = F.tid & 7; const v4u w = *(const v4u*)(V + ((size_t)b * SEQ + kt * 64 + kr) * 512 + h * 64 + c * 8);
                    LAS float* d = Vs + kr * 64 + c * 8; d[0] = bflo(w.x); d[1] = bfhi(w.x); d[2] = bflo(w.y); d[3] = bfhi(w.y); d[4] = bflo(w.z); d[5] = bfhi(w.z); d[6] = bflo(w.w); d[7] = bfhi(w.w); }
                __syncthreads();
                const int kbase = kt * 64;
                if (kbase <= qpos) {
                    for (int j = 0; j < 64; ++j) {
                        if (kbase + j <= qpos) {
                            float s = 0.f;
#pragma unroll
                            for (int d = 0; d < 96; ++d) s += q[d] * Ks[j * 96 + d];
                            if (s > mx) { const float a = exp2f(mx - s); l *= a;
#pragma unroll
                                for (int d = 0; d < 64; ++d) o[d] *= a;
                                mx = s; }
                            const float p = exp2f(s - mx); l += p;
#pragma unroll
                            for (int d = 0; d < 64; ++d) o[d] += p * Vs[j * 64 + d];
                        }
                    }
                }
            }
            const float il = 1.0f / l;
#pragma unroll
            for (int c = 0; c < 8; ++c) { v4u w; w.x = pk2(o[c * 8 + 0] * il, o[c * 8 + 1] * il); w.y = pk2(o[c * 8 + 2] * il, o[c * 8 + 3] * il); w.z = pk2(o[c * 8 + 4] * il, o[c * 8 + 5] * il); w.w = pk2(o[c * 8 + 6] * il, o[c * 8 + 7] * il);
                *(v4u*)(YA + qrow * 512 + h * 64 + c * 8) = w; }
        }
    }
    __syncthreads();
}

__device__ __forceinline__ void dil_naive_phase(Frame& F, const u16* DQ, const u16* DK, const u16* DV, u16* YC) {
    for (int idx = F.bid * NTHR + F.tid; idx < NTOK * 8; idx += F.G * NTHR) {
        const int h = idx & 7, row = idx >> 3, b = row / SEQ, pos = row % SEQ;
        float q[64], o[64];
#pragma unroll
        for (int c = 0; c < 8; ++c) { const v4u w = *(const v4u*)(DQ + (size_t)row * 512 + h * 64 + c * 8); q[c * 8 + 0] = bflo(w.x); q[c * 8 + 1] = bfhi(w.x); q[c * 8 + 2] = bflo(w.y); q[c * 8 + 3] = bfhi(w.y); q[c * 8 + 4] = bflo(w.z); q[c * 8 + 5] = bfhi(w.z); q[c * 8 + 6] = bflo(w.w); q[c * 8 + 7] = bfhi(w.w); }
#pragma unroll
        for (int d = 0; d < 64; ++d) o[d] = 0.f;
        float mx = -1e30f, l = 0.f;
        for (int pt = 0; pt < 3; ++pt) {
            const int r = pt == 0 ? 1 : (pt == 1 ? 4 : 16);
            for (int j = 0; j <= 128; ++j) {
                const int tk = pos - j * r; if (tk < 0) break;
                const size_t kro = ((size_t)b * SEQ + tk) * 512 + h * 64;
                float s = 0.f;
#pragma unroll
                for (int c = 0; c < 8; ++c) { const v4u w = *(const v4u*)(DK + kro + c * 8);
                    s += q[c * 8 + 0] * bflo(w.x) + q[c * 8 + 1] * bfhi(w.x) + q[c * 8 + 2] * bflo(w.y) + q[c * 8 + 3] * bfhi(w.y) + q[c * 8 + 4] * bflo(w.z) + q[c * 8 + 5] * bfhi(w.z) + q[c * 8 + 6] * bflo(w.w) + q[c * 8 + 7] * bfhi(w.w); }
                if (s > mx) { const float a = exp2f(mx - s); l *= a;
#pragma unroll
                    for (int d = 0; d < 64; ++d) o[d] *= a;
                    mx = s; }
                const float p = exp2f(s - mx); l += p;
#pragma unroll
                for (int c = 0; c < 8; ++c) { const v4u w = *(const v4u*)(DV + kro + c * 8);
                    o[c * 8 + 0] += p * bflo(w.x); o[c * 8 + 1] += p * bfhi(w.x); o[c * 8 + 2] += p * bflo(w.y); o[c * 8 + 3] += p * bfhi(w.y); o[c * 8 + 4] += p * bflo(w.z); o[c * 8 + 5] += p * bfhi(w.z); o[c * 8 + 6] += p * bflo(w.w); o[c * 8 + 7] += p * bfhi(w.w); }
            }
        }
        const float il = 1.0f / l;
#pragma unroll
        for (int c = 0; c < 8; ++c) { v4u w; w.x = pk2(o[c * 8 + 0] * il, o[c * 8 + 1] * il); w.y = pk2(o[c * 8 + 2] * il, o[c * 8 + 3] * il); w.z = pk2(o[c * 8 + 4] * il, o[c * 8 + 5] * il); w.w = pk2(o[c * 8 + 6] * il, o[c * 8 + 7] * il);
            *(v4u*)(YC + (size_t)row * 512 + h * 64 + c * 8) = w; }
    }
}

__device__ __forceinline__ void stage_conv(LAS float* dst  , const u16* MQK, size_t row0, int pos0, int ch0, const float* cw, const float* cb, float scale, int tid) {
    const int d = tid & 63, sg = tid >> 6, ch = ch0 + d;
    const float w0 = cw[ch], w1 = cw[512 + ch], w2 = cw[1024 + ch], w3 = cw[1536 + ch], bb = cb[ch];
    float x[11];
#pragma unroll
    for (int i = 0; i < 11; ++i) { const int s = sg * 8 - 3 + i; x[i] = (pos0 + s >= 0) ? bf1(MQK[(size_t)((long)row0 + s) * 512 + ch]) : 0.f; }
#pragma unroll
    for (int i = 0; i < 8; ++i) { const float y = bb + w0 * x[i] + w1 * x[i + 1] + w2 * x[i + 2] + w3 * x[i + 3]; dst[(sg * 8 + i) * 65 + d] = fsilu(y) * scale; }
}
__device__ __forceinline__ float wave_incl_scan_add(float v, int lane) {
#pragma unroll
    for (int o = 1; o < 64; o <<= 1) { const float t = bperm_f(lane >= o ? lane - o : lane, v); if (lane >= o) v += t; }
    return v;
}
__device__ __forceinline__ float wave_incl_scan_max(float v, int lane) {
#pragma unroll
    for (int o = 1; o < 64; o <<= 1) { const float t = bperm_f(lane >= o ? lane - o : lane, v); if (lane >= o) v = fmaxf(v, t); }
    return v;
}
__device__ __forceinline__ float wave_max(float v, int lane) {
#pragma unroll
    for (int o = 1; o < 64; o <<= 1) v = fmaxf(v, bperm_f(lane ^ o, v));
    return v;
}
__device__ __forceinline__ void mlstm_a_phase(Frame& F, const u16* MQK, const u16* MV, const float* IF, const float* cw, const float* cb, float* ST) {
    LAS float* Ks = (LAS float*)F.lds;
    LAS float* Vs = Ks + 64 * 65;
    LAS float* ws = Vs + 64 * 128;
    float* mloc = (float*)(F.ws + WS_MLS); float* bend = mloc + 2048; float* nst = (float*)(F.ws + WS_MLS + 65536);
    const int tid = F.tid;
    for (int u = F.bid; u < 2048; u += F.G) {
        const int bh = u >> 8, c = u & 255, b = bh >> 2, h = bh & 3, pos0 = c * 64; const size_t row0 = (size_t)b * SEQ + pos0;
        __syncthreads();
        stage_conv(Ks, MQK, row0, pos0, 256 + h * 64, cw, cb, 0.125f, tid);
        for (int e = tid; e < 64 * 16; e += NTHR) { const int s = e >> 4, cc = e & 15; const v4u w = *(const v4u*)(MV + (row0 + s) * 512 + h * 128 + cc * 8);
            LAS float* d = Vs + s * 128 + cc * 8; d[0] = bflo(w.x); d[1] = bfhi(w.x); d[2] = bflo(w.y); d[3] = bfhi(w.y); d[4] = bflo(w.z); d[5] = bfhi(w.z); d[6] = bflo(w.w); d[7] = bfhi(w.w); }
        if (tid < 64) { const float ig = IF[(row0 + tid) * 8 + h], lf = IF[(row0 + tid) * 8 + 4 + h];
            const float bs = wave_incl_scan_add(lf, tid), be = bperm_f(63, bs);
            const float wl = be - bs + ig, ml = wave_max(wl, tid);
            ws[tid] = __expf(wl - ml);
            if (tid == 0) { mloc[u] = ml; bend[u] = be; } }
        __syncthreads();
        const int d = tid >> 3, vg = tid & 7;
        float acc[16]; float an = 0.f;
#pragma unroll
        for (int i = 0; i < 16; ++i) acc[i] = 0.f;
        for (int s = 0; s < 64; ++s) { const float kw = Ks[s * 65 + d] * ws[s]; an += kw;
            const LAS f32x4* vp = (const LAS f32x4*)(Vs + s * 128 + vg * 16);
#pragma unroll
            for (int i = 0; i < 4; ++i) { const f32x4 vv = vp[i]; acc[4 * i + 0] += kw * vv.x; acc[4 * i + 1] += kw * vv.y; acc[4 * i + 2] += kw * vv.z; acc[4 * i + 3] += kw * vv.w; } }
        float* o = ST + (size_t)u * 8192 + d * 128 + vg * 16;
#pragma unroll
        for (int i = 0; i < 4; ++i) *(f32x4*)(o + 4 * i) = (f32x4){acc[4 * i], acc[4 * i + 1], acc[4 * i + 2], acc[4 * i + 3]};
        if (vg == 0) nst[(size_t)u * 64 + d] = an;
    }
    __syncthreads();
}
__device__ __forceinline__ void mlstm_b_phase(Frame& F, float* ST) {
    const float* mloc = (const float*)(F.ws + WS_MLS); const float* bend = mloc + 2048; float* mprev = (float*)(F.ws + WS_MLS) + 4096; float* nst = (float*)(F.ws + WS_MLS + 65536);
    for (int gt = F.bid * NTHR + F.tid; gt < 8 * 8256; gt += F.G * NTHR) {
        const int bh = gt / 8256, e = gt % 8256;
        float* p; int stride;
        if (e < 8192) { p = ST + (size_t)bh * 256 * 8192 + e; stride = 8192; } else { p = nst + (size_t)bh * 256 * 64 + (e - 8192); stride = 64; }
        float C = 0.f, m = 0.f;
        for (int c0 = 0; c0 < 256; c0 += 8) {
            float val[8];
#pragma unroll
            for (int i = 0; i < 8; ++i) val[i] = p[(size_t)(c0 + i) * stride];
#pragma unroll
            for (int i = 0; i < 8; ++i) { const int c = c0 + i; const float be = bend[bh * 256 + c], ml = mloc[bh * 256 + c];
                p[(size_t)c * stride] = C; if (e == 0) mprev[bh * 256 + c] = m;
                const float mn = fmaxf(be + m, ml); C = __expf(be + m - mn) * C + __expf(ml - mn) * val[i]; m = mn; }
        }
    }
}
__device__ __forceinline__ void mlstm_c_phase(Frame& F, const u16* MQK, const u16* MV, const u16* MO, const float* IF, const float* cw, const float* cb, const float* hg, const float* ST, u16* YB) {
    LAS float* Qs = (LAS float*)F.lds;
    LAS float* Ks = Qs + 64 * 65;
    LAS float* Vs = Ks + 64 * 65;
    LAS float* Cs = Vs + 64 * 128;
    LAS float* Ss = Cs + 64 * 128;
    LAS float* bsv = Ss + 64 * 65;
    LAS float* gsv = bsv + 64;
    LAS float* mtv = gsv + 64;
    LAS float* dcv = mtv + 64;
    LAS float* npv = dcv + 64;
    const float* mprev = (const float*)(F.ws + WS_MLS) + 4096; const float* nst = (const float*)(F.ws + WS_MLS + 65536);
    const int tid = F.tid;
    for (int u = F.bid; u < 2048; u += F.G) {
        const int bh = u >> 8, c = u & 255, b = bh >> 2, h = bh & 3, pos0 = c * 64; const size_t row0 = (size_t)b * SEQ + pos0;
        __syncthreads();
        stage_conv(Qs, MQK, row0, pos0, h * 64, cw, cb, 1.0f, tid);
        stage_conv(Ks, MQK, row0, pos0, 256 + h * 64, cw, cb, 0.125f, tid);
        for (int e = tid; e < 64 * 16; e += NTHR) { const int s = e >> 4, cc = e & 15; const v4u w = *(const v4u*)(MV + (row0 + s) * 512 + h * 128 + cc * 8);
            LAS float* d = Vs + s * 128 + cc * 8; d[0] = bflo(w.x); d[1] = bfhi(w.x); d[2] = bflo(w.y); d[3] = bfhi(w.y); d[4] = bflo(w.z); d[5] = bfhi(w.z); d[6] = bflo(w.w); d[7] = bfhi(w.w); }
        for (int e = tid; e < 2048; e += NTHR) ((LAS f32x4*)Cs)[e] = ((const f32x4*)(ST + (size_t)u * 8192))[e];
        if (tid < 64) { const float ig = IF[(row0 + tid) * 8 + h], lf = IF[(row0 + tid) * 8 + 4 + h], m = mprev[u];
            const float bs = wave_incl_scan_add(lf, tid), gs = ig - bs, gmx = wave_incl_scan_max(gs, tid);
            const float inter = bs + m, mt = fmaxf(inter, bs + gmx);
            bsv[tid] = bs; gsv[tid] = gs; mtv[tid] = mt; dcv[tid] = __expf(inter - mt); npv[tid] = nst[(size_t)u * 64 + tid]; }
        __syncthreads();
        const int t = tid >> 3, g8 = tid & 7;
        float den;
        {   float sa[8]; float qn = 0.f;
#pragma unroll
            for (int i = 0; i < 8; ++i) sa[i] = 0.f;
            for (int d = 0; d < 64; ++d) { const float qv = Qs[t * 65 + d]; qn += qv * npv[d];
#pragma unroll
                for (int i = 0; i < 8; ++i) sa[i] += qv * Ks[(g8 * 8 + i) * 65 + d]; }
            const float bt = bsv[t], mt = mtv[t]; float rs = 0.f;
#pragma unroll
            for (int i = 0; i < 8; ++i) { const int s = g8 * 8 + i; const float sc = (s <= t) ? sa[i] * __expf(bt + gsv[s] - mt) : 0.f; Ss[t * 65 + s] = sc; rs += sc; }
            { const int ln_ = tid & 63; rs += bperm_f(ln_ ^ 1, rs); rs += bperm_f(ln_ ^ 2, rs); rs += bperm_f(ln_ ^ 4, rs); }
            den = dcv[t] * qn + rs;
        }
        __syncthreads();
        float acc[16];
#pragma unroll
        for (int i = 0; i < 16; ++i) acc[i] = 0.f;
        { const float dc = dcv[t];
            for (int d = 0; d < 64; ++d) { const float qd = Qs[t * 65 + d] * dc; const LAS f32x4* cp = (const LAS f32x4*)(Cs + d * 128 + g8 * 16);
#pragma unroll
                for (int i = 0; i < 4; ++i) { const f32x4 vv = cp[i]; acc[4 * i + 0] += qd * vv.x; acc[4 * i + 1] += qd * vv.y; acc[4 * i + 2] += qd * vv.z; acc[4 * i + 3] += qd * vv.w; } }
            for (int s = 0; s < 64; ++s) { const float p = Ss[t * 65 + s]; const LAS f32x4* vp = (const LAS f32x4*)(Vs + s * 128 + g8 * 16);
#pragma unroll
                for (int i = 0; i < 4; ++i) { const f32x4 vv = vp[i]; acc[4 * i + 0] += p * vv.x; acc[4 * i + 1] += p * vv.y; acc[4 * i + 2] += p * vv.z; acc[4 * i + 3] += p * vv.w; } } }
        const float inv = 1.0f / fmaxf(fabsf(den), __expf(-mtv[t]));
        float ss = 0.f;
#pragma unroll
        for (int i = 0; i < 16; ++i) { acc[i] *= inv; ss += acc[i] * acc[i]; }
        { const int ln_ = tid & 63; ss += bperm_f(ln_ ^ 1, ss); ss += bperm_f(ln_ ^ 2, ss); ss += bperm_f(ln_ ^ 4, ss); }
        const float rstd = 1.0f / sqrtf(ss * (1.f / 128.f) + EPS);
        const size_t ob = (row0 + t) * 512 + h * 128 + g8 * 16;
#pragma unroll
        for (int j = 0; j < 2; ++j) { const v4u mo = *(const v4u*)(MO + ob + j * 8); const float* gp = hg + h * 128 + g8 * 16 + j * 8;
            float y[8];
#pragma unroll
            for (int i = 0; i < 8; ++i) y[i] = acc[j * 8 + i] * rstd * gp[i];
            y[0] *= bflo(mo.x); y[1] *= bfhi(mo.x); y[2] *= bflo(mo.y); y[3] *= bfhi(mo.y); y[4] *= bflo(mo.z); y[5] *= bfhi(mo.z); y[6] *= bflo(mo.w); y[7] *= bfhi(mo.w);
            v4u w; w.x = pk2(y[0], y[1]); w.y = pk2(y[2], y[3]); w.z = pk2(y[4], y[5]); w.w = pk2(y[6], y[7]);
            *(v4u*)(YB + ob + j * 8) = w; }
    }
    __syncthreads();
}

__device__ __forceinline__ void router_phase(Frame& F, const float* x, const float* gain, const float* modl, const float* wrg, const float* brg, const float* wre, const float* bre, u32* cnt) {
    const int gw = F.bid * NWAVES + F.wave, NGW = F.G * NWAVES, lane = F.lane;
    int* cls_o = (int*)(F.ws + WS_ROUT); int* slot_o = cls_o + NTOK; float* wa_o = (float*)(slot_o + NTOK); float* wb_o = wa_o + NTOK; float* rstd_o = wb_o + NTOK;
    for (int m = gw; m < NTOK; m += NGW) {
        const int b = m / SEQ;
        const f32x4* xr = (const f32x4*)(x + (size_t)m * DM) + lane;
        f32x4 v[4]; float s = 0.f;
#pragma unroll
        for (int j = 0; j < 4; ++j) { v[j] = xr[64 * j]; s += (v[j].x * v[j].x + v[j].y * v[j].y) + (v[j].z * v[j].z + v[j].w * v[j].w); }
        const float rstd = 1.0f / sqrtf(wave_sum(s, lane) * (1.f / DM) + EPS);
        LAS float* hrow = (LAS float*)(F.lds + F.wave * 4096 + 0);
#pragma unroll
        for (int j = 0; j < 4; ++j) { const int c0 = 4 * lane + 256 * j;
            const f32x4 g = *(const f32x4*)(gain + c0), sc = *(const f32x4*)(modl + (size_t)(b * 6 + 4) * 1024 + c0), sh = *(const f32x4*)(modl + (size_t)(b * 6 + 3) * 1024 + c0);
            *(LAS f32x4*)(hrow + c0) = (v[j] * rstd) * g * (sc + 1.0f) + sh; }
        LDS_WAIT(); asm volatile("" ::: "memory");
        float part = 0.f;
        { const int jj = lane % 20, pp = lane / 20; const int cb = pp * 342, ce = pp == 2 ? 1024 : cb + 342;
            if (lane < 60) { const float* wp = jj < 4 ? wrg + jj : wre + (jj - 4); const int ws_ = jj < 4 ? 4 : 16;
                for (int c = cb; c < ce; ++c) part += hrow[c] * wp[(size_t)c * ws_]; } }
        part += bperm_f(lane + 20 < 64 ? lane + 20 : lane, part) * (lane < 20 ? 1.f : 0.f) + 0.f;
        LAS float* lgs = hrow;
        { const float p2 = bperm_f(lane + 40 < 64 ? lane + 40 : lane, part); asm volatile("" ::: "memory"); if (lane < 20) lgs[lane] = part + p2; }
        LDS_WAIT(); asm volatile("" ::: "memory");
        float lg[20];
        if (lane == 0) {
#pragma unroll
            for (int i = 0; i < 20; ++i) lg[i] = lgs[i]; }
        LDS_WAIT(); asm volatile("" ::: "memory");
        if (lane == 0) {
            float g0 = lg[0] + brg[0], g1 = lg[1] + brg[1], g2 = lg[2] + brg[2], g3 = lg[3] + brg[3];
            int gi = 0; float gm = g0; if (g1 > gm) { gm = g1; gi = 1; } if (g2 > gm) { gm = g2; gi = 2; } if (g3 > gm) { gm = g3; gi = 3; }
            const float psel = 1.0f / (expf(g0 - gm) + expf(g1 - gm) + expf(g2 - gm) + expf(g3 - gm));
            float e0, e1, e2, e3;
            if (gi == 0) { e0 = lg[4]; e1 = lg[5]; e2 = lg[6]; e3 = lg[7]; } else if (gi == 1) { e0 = lg[8]; e1 = lg[9]; e2 = lg[10]; e3 = lg[11]; }
            else if (gi == 2) { e0 = lg[12]; e1 = lg[13]; e2 = lg[14]; e3 = lg[15]; } else { e0 = lg[16]; e1 = lg[17]; e2 = lg[18]; e3 = lg[19]; }
            e0 += bre[gi * 4 + 0]; e1 += bre[gi * 4 + 1]; e2 += bre[gi * 4 + 2]; e3 += bre[gi * 4 + 3];
            int i1 = 0; float v1 = e0; if (e1 > v1) { v1 = e1; i1 = 1; } if (e2 > v1) { v1 = e2; i1 = 2; } if (e3 > v1) { v1 = e3; i1 = 3; }
            int i2 = -1; float v2 = 0.f;
            if (i1 != 0) { v2 = e0; i2 = 0; }
            if (i1 != 1 && (i2 < 0 || e1 > v2)) { v2 = e1; i2 = 1; }
            if (i1 != 2 && (i2 < 0 || e2 > v2)) { v2 = e2; i2 = 2; }
            if (i1 != 3 && (i2 < 0 || e3 > v2)) { v2 = e3; i2 = 3; }
            const float ex = expf(v2 - v1), w1 = psel / (1.0f + ex), w2 = psel * ex / (1.0f + ex);
            const int a = i1 < i2 ? i1 : i2, bb = i1 < i2 ? i2 : i1;
            const int pair = a == 0 ? bb - 1 : (a == 1 ? bb + 1 : 5);
            const int cls = gi * 6 + pair;
            const u32 sl = __hip_atomic_fetch_add(cnt + cls, 1u, __ATOMIC_RELAXED, __HIP_MEMORY_SCOPE_AGENT);
            cls_o[m] = cls; slot_o[m] = (int)sl; wa_o[m] = i1 < i2 ? w1 : w2; wb_o[m] = i1 < i2 ? w2 : w1; rstd_o[m] = rstd;
        }
    }
}
__device__ __forceinline__ void moe_table(Frame& F, const u32* cnt) {
    LAS int* tab = (LAS int*)(F.lds + TAB_OFF);
    if (F.tid == 0) { int rt = 0;
        for (int c = 0; c < 24; ++c) { const int n = (int)__hip_atomic_load(cnt + c, __ATOMIC_RELAXED, __HIP_MEMORY_SCOPE_AGENT); const int nt = (n + 255) >> 8; tab[256 + c] = rt * 256; for (int i = 0; i < nt; ++i) tab[1 + rt + i] = c; rt += nt; }
        tab[0] = rt; }
    __syncthreads();
}
__device__ __forceinline__ void moe_units(Frame& F, int mode) {
    LAS int* tab = (LAS int*)(F.lds + TAB_OFF); LAS int* ul = tab + 320;
    if (F.tid == 0) { const int nrt = tab[0]; int n = 0;
        for (int L = F.bid; L < nrt * 4; L += F.G) { const int rt = L >> 2, pn = L & 3, cls = tab[1 + rt]; int pb;
            if (mode == 0) { int ea, eb; cls_experts(cls, ea, eb); pb = ((pn >> 1) ? eb : ea) * 2 + (pn & 1); } else pb = cls * 4 + pn;
            ul[1 + n] = rt | (pn << 8) | (pb << 16); ++n; }
        ul[0] = n; }
    __syncthreads();
}
__device__ __forceinline__ void scatter_phase(Frame& F, const float* x, const float* gain, const float* modl, const u32* cnt, u16* HS) {
    moe_table(F, cnt);
    const LAS int* tab = (const LAS int*)(F.lds + TAB_OFF);
    const int gw = F.bid * NWAVES + F.wave, NGW = F.G * NWAVES, lane = F.lane;
    const int* cls_o = (const int*)(F.ws + WS_ROUT); const int* slot_o = cls_o + NTOK; const float* wa_o = (const float*)(slot_o + NTOK); const float* wb_o = wa_o + NTOK; const float* rstd_o = wb_o + NTOK;
    int* tok = (int*)(F.ws + WS_TOK); float* wrow = (float*)(F.ws + WS_TOK + 262144);
    for (int c = F.bid; c < 24; c += F.G) { const int n = (int)__hip_atomic_load(cnt + c, __ATOMIC_RELAXED, __HIP_MEMORY_SCOPE_AGENT); const int base = tab[256 + c], end = base + (((n + 255) >> 8) << 8);
        for (int r = base + n + F.tid; r < end; r += NTHR) { tok[r] = -1; wrow[2 * r] = 0.f; wrow[2 * r + 1] = 0.f; } }
    for (int m = gw; m < NTOK; m += NGW) {
        const int b = m / SEQ; const int pos = tab[256 + cls_o[m]] + slot_o[m]; const float rstd = rstd_o[m];
        const f32x4* xr = (const f32x4*)(x + (size_t)m * DM) + lane;
        v2u* o8 = (v2u*)(HS + (size_t)pos * DM) + lane;
#pragma unroll
        for (int j = 0; j < 4; ++j) { const int c0 = 4 * lane + 256 * j; const f32x4 v = xr[64 * j];
            const f32x4 g = *(const f32x4*)(gain + c0), sc = *(const f32x4*)(modl + (size_t)(b * 6 + 4) * 1024 + c0), sh = *(const f32x4*)(modl + (size_t)(b * 6 + 3) * 1024 + c0);
            const f32x4 y = (v * rstd) * g * (sc + 1.0f) + sh;
            v2u w; w.x = pk2(y.x, y.y); w.y = pk2(y.z, y.w); o8[64 * j] = w; }
        if (lane == 0) { tok[pos] = m; wrow[2 * pos] = wa_o[m]; wrow[2 * pos + 1] = wb_o[m]; }
    }
}

#if MK_CHECK
constexpr int CW_CHK = 32768, NCHK = 25, CHK_BLOCKS = 48;
__device__ __forceinline__ float blk_sum(float v, float* sh) {
    __syncthreads(); sh[threadIdx.x] = v; __syncthreads();
    for (int o = 128; o > 0; o >>= 1) { if ((int)threadIdx.x < o) sh[threadIdx.x] += sh[threadIdx.x + o]; __syncthreads(); }
    const float r = sh[0]; __syncthreads(); return r;
}
__device__ __forceinline__ float blk_max(float v, float* sh) {
    __syncthreads(); sh[threadIdx.x] = v; __syncthreads();
    for (int o = 128; o > 0; o >>= 1) { if ((int)threadIdx.x < o) sh[threadIdx.x] = fmaxf(sh[threadIdx.x], sh[threadIdx.x + o]); __syncthreads(); }
    const float r = sh[0]; __syncthreads(); return r;
}
__device__ __forceinline__ unsigned hsh(unsigned a, unsigned b) { unsigned x = a * 2654435761u + b * 40503u + 12345u; x ^= x >> 15; x *= 2246822519u; x ^= x >> 13; x *= 3266489917u; x ^= x >> 16; return x; }
__device__ __forceinline__ void chk_report(u32* ctl, int k, float ratio) { if (threadIdx.x == 0) atomicMax(ctl + CW_CHK + k, __float_as_uint(fminf(fabsf(ratio) * MK_CHECK_TIGHT, 1e30f))); }
__device__ __forceinline__ float convsilu(const u16* MQK, size_t rowb  , int pos, int ch, const float* cw, const float* cb) {
    float y = cb[ch];
    for (int j = 0; j < 4; ++j) { const int p = pos - 3 + j; if (p >= 0) y += cw[j * 512 + ch] * bf1(MQK[(rowb + p) * 512 + ch]); }
    return y / (1.0f + expf(-y));
}
template <int K> __global__ void __launch_bounds__(256) chk(Params P) {
    __shared__ float sh[256]; __shared__ float big[12288];
    unsigned char* ws = P.ws; u32* ctl = (u32*)(ws + WS_CTL); const int tid = threadIdx.x, bk = blockIdx.x;
    const int l = P.ph_lo; const float* mod0 = (const float*)(ws + WS_MOD) + (size_t)l * 2 * 6144;
    const u16* U = (const u16*)(ws + ACT(0));
    if (K == 0) {
        const int row = hsh(bk, 1) % NTOK, col = hsh(bk, 2) % DM, b = row / SEQ; const float* x = (l == 0 ? P.in[0] : P.out) + (size_t)row * DM;
        float s = 0.f; for (int c = tid; c < DM; c += 256) s += x[c] * x[c];
        const float rstd = 1.0f / sqrtf(blk_sum(s, sh) / DM + EPS);
        const float e = x[col] * rstd * (P.in[4] + (size_t)l * (1024))[col] * (1.0f + mod0[(b * 6 + 1) * 1024 + col]) + mod0[(b * 6 + 0) * 1024 + col];
        chk_report(ctl, K, (bf1(U[(size_t)row * DM + col]) - e) / (0.01f * (fabsf(e) + 1.0f)));
    }
    if (K == 1 || K == 5) {
        const int row = hsh(bk, 3) % NTOK; int j;
        if (K == 1) { j = hsh(bk, 4) % 2472; if (j >= 1960) j += 1024; } else j = 3496 + hsh(bk, 4) % 3072;
        float s = 0.f; for (int k = tid; k < DM; k += 256) s += bf1(U[(size_t)row * DM + k]) * (P.in[5] + (size_t)l * (1024 * INW))[(size_t)k * INW + j];
        const float e = blk_sum(s, sh); float a, ee = e, tol;
        if (K == 5) { a = bf1(((const u16*)(ws + ACT(4)))[(size_t)row * 3072 + (j - 3496)]); ee = 1.0f / (1.0f + expf(-e)); tol = 0.02f; }
        else {
            tol = 0.03f * (fabsf(e) + 0.5f);
            if (j < 256) a = bf1(((const u16*)(ws + ACT(2)))[(size_t)row * 256 + j]);
            else if (j < 384) a = bf1(((const u16*)(ws + ACT(2) + 16 * MiB))[(size_t)row * 256 + (j - 256)]);
            else if (j < 416) a = bf1(((const u16*)(ws + ACT(2) + 16 * MiB))[(size_t)row * 256 + 128 + (j - 384)]);
            else if (j < 928) a = bf1(((const u16*)(ws + ACT(3)))[(size_t)row * 512 + (j - 416)]);
            else if (j < 1440) a = bf1(((const u16*)(ws + ACT(4)))[(size_t)row * 512 + (j - 928)]);
            else if (j < 1952) { a = bf1(((const u16*)(ws + ACT(5)))[(size_t)row * 512 + (j - 1440)]); ee = 1.0f / (1.0f + expf(-e)); tol = 0.02f; }
            else if (j < 1956) { a = ((const float*)(ws + WS_IF))[(size_t)row * 8 + (j - 1952)]; ee = e + (P.in[14] + (size_t)l * (4))[j - 1952]; }
            else if (j < 1960) { a = ((const float*)(ws + WS_IF))[(size_t)row * 8 + 4 + (j - 1956)]; const float z = e + (P.in[15] + (size_t)l * (4))[j - 1956]; ee = -log1pf(expf(-z)); tol = 0.05f * fabsf(ee) + 1e-3f; }
            else a = bf1(((const u16*)(ws + ACT(8)))[(size_t)row * 512 + (j - 2984)]);
        }
        chk_report(ctl, K, (a - ee) / tol);
    }
    if (K == 2) {
        const int row = hsh(bk, 5) % NTOK, isq = hsh(bk, 6) & 1, h = hsh(bk, 7) & 7; const int base = (isq ? 1960 : 2472) + h * 64;
        float d = 0.f; if (tid < 64) for (int k = 0; k < DM; ++k) d += bf1(U[(size_t)row * DM + k]) * (P.in[5] + (size_t)l * (1024 * INW))[(size_t)k * INW + base + tid];
        const float ss = blk_sum(tid < 64 ? d * d : 0.f, sh), rstd = 1.0f / sqrtf(ss / 64.f + EPS);
        float r = 0.f;
        if (tid < 64) { const float e = d * rstd * (isq ? (P.in[17] + (size_t)l * (64))[tid] * 0.125f * LOG2E : (P.in[18] + (size_t)l * (64))[tid]); const float a = bf1(((const u16*)(ws + ACT(isq ? 6 : 7)))[(size_t)row * 512 + h * 64 + tid]); r = fabsf(a - e) / (0.03f * (fabsf(e) + 0.3f)); }
        chk_report(ctl, K, blk_max(r, sh));
    }
    if (K == 3) {
        const int b = bk & 1, h = (bk >> 1) & 3, t = 5 + 41 * (bk >> 3); const size_t rowb = (size_t)b * SEQ;
        const u16* MQK = (const u16*)(ws + ACT(3)); const u16* MV = (const u16*)(ws + ACT(4)); const u16* MO = (const u16*)(ws + ACT(5)); const float* IF = (const float*)(ws + WS_IF);
        float C[64], n[64];
#pragma unroll
        for (int d = 0; d < 64; ++d) { C[d] = 0.f; n[d] = 0.f; }
        for (int s = 0; s <= t; ++s) {
            __syncthreads();
            if (tid < 64) sh[tid] = convsilu(MQK, rowb, s, 256 + h * 64 + tid, (P.in[12] + (size_t)l * (2048)), (P.in[13] + (size_t)l * (512))) * 0.125f;
            __syncthreads();
            const float f = expf(IF[(rowb + s) * 8 + 4 + h]), ii = expf(IF[(rowb + s) * 8 + h]);
            const float vv = tid < 128 ? bf1(MV[(rowb + s) * 512 + h * 128 + tid]) : 0.f;
#pragma unroll
            for (int d = 0; d < 64; ++d) { const float kk = sh[d]; C[d] = f * C[d] + ii * kk * vv; n[d] = f * n[d] + ii * kk; }
        }
        __syncthreads();
        if (tid < 64) sh[tid] = convsilu(MQK, rowb, t, h * 64 + tid, (P.in[12] + (size_t)l * (2048)), (P.in[13] + (size_t)l * (512)));
        __syncthreads();
        float num = 0.f, den = 0.f;
#pragma unroll
        for (int d = 0; d < 64; ++d) { num += C[d] * sh[d]; den += n[d] * sh[d]; }
        const float hv = tid < 128 ? num / fmaxf(fabsf(den), 1.0f) : 0.f;
        const float ss = blk_sum(hv * hv, sh), rstd = 1.0f / sqrtf(ss / 128.f + EPS);
        float r = 0.f;
        if (tid < 128) { const float e = hv * rstd * (P.in[16] + (size_t)l * (512))[h * 128 + tid] * bf1(MO[(rowb + t) * 512 + h * 128 + tid]); const float a = bf1(((const u16*)(ws + ACT(13)))[(rowb + t) * 512 + h * 128 + tid]); r = fabsf(a - e) / (0.03f * (fabsf(e) + 0.2f)); }
        chk_report(ctl, K, blk_max(r, sh));
    }
    if (K == 4) {
        const int row = hsh(bk, 8) % NTOK, h = hsh(bk, 9) & 7, which = bk % 3, pos = row % SEQ;
        const u16* CQ = (const u16*)(ws + ACT(2)); const u16* C1 = (const u16*)(ws + ACT(2) + 16 * MiB);
        const float* ct = (const float*)(ws + WS_ROPE); const float* st = ct + SEQ * 16;
        float r = 0.f;
        if (which == 0) {
            float s = 0.f; { const float v = bf1(CQ[(size_t)row * 256 + tid]); s = v * v; }
            const float rq = 1.0f / sqrtf(blk_sum(s, sh) / 256.f + EPS);
            __syncthreads(); big[tid] = bf1(CQ[(size_t)row * 256 + tid]) * rq * (P.in[6] + (size_t)l * (256))[tid]; __syncthreads();
            float q = 0.f; if (tid < 96) for (int k = 0; k < 256; ++k) q += big[k] * (P.in[8] + (size_t)l * (256 * 768))[(size_t)k * 768 + h * 96 + tid];
            const float rs = 1.0f / sqrtf(blk_sum(tid < 96 ? q * q : 0.f, sh) / 96.f + EPS);
            __syncthreads(); if (tid < 96) big[512 + tid] = q * rs * (P.in[10] + (size_t)l * (96))[tid]; __syncthreads();
            if (tid < 96) { float e = big[512 + tid];
                if (tid >= 64 && tid < 80) { const int i = tid - 64; e = big[512 + 64 + i] * ct[pos * 16 + i] - big[512 + 80 + i] * st[pos * 16 + i]; }
                if (tid >= 80) { const int i = tid - 80; e = big[512 + 64 + i] * st[pos * 16 + i] + big[512 + 80 + i] * ct[pos * 16 + i]; }
                e *= 0.10206207261596577f * LOG2E;
                const float a = bf1(((const u16*)(ws + ACT(6)))[(size_t)row * 768 + h * 96 + tid]); r = fabsf(a - e) / (0.03f * (fabsf(e) + 0.05f)); }
        } else {
            float s = 0.f; if (tid < 128) { const float v = bf1(C1[(size_t)row * 256 + tid]); s = v * v; }
            const float rk = 1.0f / sqrtf(blk_sum(s, sh) / 128.f + EPS);
            __syncthreads(); if (tid < 128) big[tid] = bf1(C1[(size_t)row * 256 + tid]) * rk * (P.in[7] + (size_t)l * (128))[tid]; __syncthreads();
            if (which == 2) {
                if (tid < 64) { float v = 0.f; for (int k = 0; k < 128; ++k) v += big[k] * (P.in[9] + (size_t)l * (128 * 1024))[(size_t)k * 1024 + h * 128 + 64 + tid];
                    const float a = bf1(((const u16*)(ws + ACT(9)))[(size_t)row * 512 + h * 64 + tid]); r = fabsf(a - v) / (0.03f * (fabsf(v) + 0.3f)); }
            } else {
                float kk = 0.f;
                if (tid < 64) for (int k = 0; k < 128; ++k) kk += big[k] * (P.in[9] + (size_t)l * (128 * 1024))[(size_t)k * 1024 + h * 128 + tid];
                if (tid >= 64 && tid < 96) kk = bf1(C1[(size_t)row * 256 + 128 + (tid - 64)]);
                const float rs = 1.0f / sqrtf(blk_sum(tid < 96 ? kk * kk : 0.f, sh) / 96.f + EPS);
                __syncthreads(); if (tid < 96) big[512 + tid] = kk * rs * (P.in[11] + (size_t)l * (96))[tid]; __syncthreads();
                if (tid < 96) { float e = big[512 + tid];
                    if (tid >= 64 && tid < 80) { const int i = tid - 64; e = big[512 + 64 + i] * ct[pos * 16 + i] - big[512 + 80 + i] * st[pos * 16 + i]; }
                    if (tid >= 80) { const int i = tid - 80; e = big[512 + 64 + i] * st[pos * 16 + i] + big[512 + 80 + i] * ct[pos * 16 + i]; }
                    const float a = bf1(((const u16*)(ws + ACT(6) + 48 * MiB))[(size_t)row * 768 + h * 96 + tid]); r = fabsf(a - e) / (0.03f * (fabsf(e) + 0.3f)); }
            }
        }
        chk_report(ctl, K, blk_max(r, sh));
    }
    if (K == 6) {
        const int row = hsh(bk, 10) % NTOK, d = hsh(bk, 11) % DM; float e = 0.f;
        for (int i = 0; i < 3; ++i) { const u16* Y = (const u16*)(ws + ACT(i == 0 ? 3 : (i == 1 ? 13 : 12))); const float* W = i == 0 ? (P.in[19] + (size_t)l * (512 * 1024)) : (i == 1 ? (P.in[20] + (size_t)l * (512 * 1024)) : (P.in[21] + (size_t)l * (512 * 1024)));
            float s = 0.f; for (int n = tid; n < 512; n += 256) s += bf1(Y[(size_t)row * 512 + n]) * W[(size_t)n * 1024 + d];
            e += bf1(((const u16*)(ws + ACT(4)))[(size_t)row * 3072 + i * 1024 + d]) * blk_sum(s, sh); }
        chk_report(ctl, K, (bf1(U[(size_t)row * DM + d]) - e) / (0.03f * (fabsf(e) + 0.1f)));
    }
    if (K == 7) {
        const int row = hsh(bk, 12) % NTOK, d = hsh(bk, 13) % DM, b = row / SEQ;
        float s = 0.f; for (int k = tid; k < DM; k += 256) s += bf1(U[(size_t)row * DM + k]) * (P.in[22] + (size_t)l * (1024 * 1024))[(size_t)k * 1024 + d];
        const float e = mod0[(b * 6 + 2) * 1024 + d] * blk_sum(s, sh) * MK_CHECK_INJECT, a = P.out[(size_t)row * DM + d] - ((const float*)(ws + WS_ROUT + 768 * 1024))[bk * DM + d];
        chk_report(ctl, K, (a - e) / (0.03f * fabsf(e) + 0.005f));
    }
    if (K == 8 || K == 9) {
        const int t = hsh(bk, 14) % NTOK, b = t / SEQ; const u32* cnt = ctl + CW_MOE + l * 64;
        const int* cls_o = (const int*)(ws + WS_ROUT); const int* slot_o = cls_o + NTOK;
        const int cls = cls_o[t]; int base = 0; for (int c = 0; c < cls; ++c) base += (((int)cnt[c] + 255) >> 8) << 8;
        const int pos = base + slot_o[t]; int ea, eb; cls_experts(cls, ea, eb);
        const u16* HID = (const u16*)(ws + ACT(3)); const float* wrow = (const float*)(ws + WS_TOK + 262144); const int* tok = (const int*)(ws + WS_TOK);
        if (K == 8) {
            const float* x = P.out + (size_t)t * DM;
            float s = 0.f; for (int c = tid; c < DM; c += 256) s += x[c] * x[c];
            const float rstd = 1.0f / sqrtf(blk_sum(s, sh) / DM + EPS);
            __syncthreads(); for (int c = tid; c < DM; c += 256) big[c] = x[c] * rstd * (P.in[23] + (size_t)l * (1024))[c] * (1.0f + mod0[(b * 6 + 4) * 1024 + c]) + mod0[(b * 6 + 3) * 1024 + c]; __syncthreads();
            if (tid < 20) { float lgv = 0.f; for (int c = 0; c < DM; ++c) lgv += big[c] * (tid < 4 ? (P.in[24] + (size_t)l * (4096))[c * 4 + tid] : (P.in[26] + (size_t)l * (16384))[c * 16 + (tid - 4)]); big[2048 + tid] = lgv + (tid < 4 ? (P.in[25] + (size_t)l * (4))[tid] : (P.in[27] + (size_t)l * (16))[tid - 4]); }
            __syncthreads();
            float r = 0.f;
            if (tid == 0) { const float* L = big + 2048; int g = 0; for (int i = 1; i < 4; ++i) if (L[i] > L[g]) g = i;
                float se = 0.f; for (int i = 0; i < 4; ++i) se += expf(L[i] - L[g]); const float psel = 1.0f / se;
                const float* E = L + 4 + g * 4; int i1 = 0; for (int i = 1; i < 4; ++i) if (E[i] > E[i1]) i1 = i;
                int i2 = -1; for (int i = 0; i < 4; ++i) if (i != i1 && (i2 < 0 || E[i] > E[i2])) i2 = i;
                float gap = 1e9f; for (int i = 0; i < 4; ++i) { if (i != g) gap = fminf(gap, L[g] - L[i]); if (i != i1 && i != i2) gap = fminf(gap, E[i2] - E[i]); }
                const float ex = expf(E[i2] - E[i1]), w1 = psel / (1.0f + ex), w2 = psel - w1;
                const int a = i1 < i2 ? i1 : i2, bb = i1 < i2 ? i2 : i1; const int pair = a == 0 ? bb - 1 : (a == 1 ? bb + 1 : 5);
                if (gap > 0.01f) { if (g * 6 + pair != cls) r = 100.f; if (tok[pos] != t) r = 200.f;
                    const float wa = i1 < i2 ? w1 : w2, wb = i1 < i2 ? w2 : w1; r = fmaxf(r, fabsf(wrow[2 * pos] - wa) / 0.005f); r = fmaxf(r, fabsf(wrow[2 * pos + 1] - wb) / 0.005f); } }
            r = blk_max(r, sh);
            const int slot = hsh(bk, 15) & 1, f = hsh(bk, 16) & 255, e = slot ? eb : ea;
            float sg = 0.f, su = 0.f; const u16* HS = (const u16*)(ws + ACT(0));
            for (int c = tid; c < DM; c += 256) { const float hv = bf1(HS[(size_t)pos * DM + c]); sg += hv * (P.in[28] + (size_t)l * (16 * 1024 * 256))[((size_t)e * 1024 + c) * 256 + f]; su += hv * (P.in[29] + (size_t)l * (16 * 1024 * 256))[((size_t)e * 1024 + c) * 256 + f]; }
            float rh = 0.f; for (int c = tid; c < DM; c += 256) rh = fmaxf(rh, fabsf(bf1(HS[(size_t)pos * DM + c]) - big[c]) / (0.01f * (fabsf(big[c]) + 1.0f)));
            r = fmaxf(r, blk_max(rh, sh));
            const float gte = blk_sum(sg, sh), upe = blk_sum(su, sh); const float ee = gte / (1.0f + expf(-gte)) * upe * wrow[2 * pos + slot];
            r = fmaxf(r, fabsf(bf1(HID[(size_t)pos * 512 + slot * 256 + f]) - ee) / (0.03f * (fabsf(ee) + 0.05f)));
            chk_report(ctl, K, r);
        } else {
            const int d = hsh(bk, 17) % DM; float s = 0.f;
            for (int k = tid; k < 512; k += 256) { const int e = k < 256 ? ea : eb; s += bf1(HID[(size_t)pos * 512 + k]) * (P.in[30] + (size_t)l * (16 * 256 * 1024))[((size_t)e * 256 + (k & 255)) * 1024 + d]; }
            const float e = mod0[(b * 6 + 5) * 1024 + d] * blk_sum(s, sh), a = P.out[(size_t)t * DM + d] - ((const float*)(ws + WS_ROUT + 768 * 1024))[bk * DM + d];
            chk_report(ctl, K, (a - e) / (0.03f * fabsf(e) + 0.003f));
        }
    }
    if (K == 21) {
        const int row = hsh(bk, 12) % NTOK; for (int c = tid; c < DM; c += 256) ((float*)(ws + WS_ROUT + 768 * 1024))[bk * DM + c] = (l == 0 ? P.in[0] : P.out)[(size_t)row * DM + c];
    }
    if (K == 13) {
        float r = 0.f;
        for (int q = 0; q < 8; ++q) { const int pos = hsh(bk * 8 + q, 21) % SEQ, i = tid & 15; if (tid < 16) {
            const float inv = (float)exp2(-(double)i / 16.0 * 13.287712379549449); const float ang = (float)pos * inv;
            const float ce = (float)cos((double)ang), se = (float)sin((double)ang);
            const float* ct = (const float*)(ws + WS_ROPE); const float* st = ct + SEQ * 16;
            r = fmaxf(r, fmaxf(fabsf(ct[pos * 16 + i] - ce), fabsf(st[pos * 16 + i] - se)) / 2e-3f); } }
        chk_report(ctl, 13, blk_max(r, sh));
    }
    if (K == 14) {
        const int ll = bk & 3, b = (bk >> 2) & 1, j = hsh(bk, 22) % 6144;
        float s = 0.f; for (int d = tid; d < DM; d += 256) { const float cv = P.in[1][b * 1024 + d]; s += cv / (1.0f + expf(-cv)) * P.in[2][((size_t)ll * 1024 + d) * 6144 + j]; }
        const float e = blk_sum(s, sh) + P.in[3][ll * 6144 + j], a = ((const float*)(ws + WS_MOD))[(size_t)(ll * 2 + b) * 6144 + j];
        chk_report(ctl, 14, (a - e) / (1e-3f * (fabsf(e) + 0.1f)));
    }
    if (K == 20) {
        const int t = hsh(bk, 14) % NTOK; for (int c = tid; c < DM; c += 256) ((float*)(ws + WS_ROUT + 768 * 1024))[bk * DM + c] = P.out[(size_t)t * DM + c];
    }
    if (K == 10) {
        const int b = bk & 1, h = (bk >> 1) & 7, q = hsh(bk, 18) % 12000; const size_t rowb = (size_t)b * SEQ;
        const u16* Q = (const u16*)(ws + ACT(6)); const u16* Kb = (const u16*)(ws + ACT(6) + 48 * MiB); const u16* V = (const u16*)(ws + ACT(9));
        float mx = -1e30f;
        for (int k = tid; k <= q; k += 256) { float s = 0.f; for (int d = 0; d < 96; ++d) s += bf1(Q[(rowb + q) * 768 + h * 96 + d]) * bf1(Kb[(rowb + k) * 768 + h * 96 + d]); big[k] = s; mx = fmaxf(mx, s); }
        mx = blk_max(mx, sh); float l = 0.f;
        for (int k = tid; k <= q; k += 256) { const float p = exp2f(big[k] - mx); big[k] = p; l += p; }
        l = blk_sum(l, sh); float r = 0.f;
        if (tid < 64) { float o = 0.f; for (int k = 0; k <= q; ++k) o += big[k] * bf1(V[(rowb + k) * 512 + h * 64 + tid]); o /= l;
            const float a = bf1(((const u16*)(ws + ACT(3)))[(rowb + q) * 512 + h * 64 + tid]); r = fabsf(a - o) / (0.02f * (fabsf(o) + 0.05f)); }
        chk_report(ctl, K, blk_max(r, sh));
    }
    if (K == 11) {
        const int b = bk & 1, h = (bk >> 1) & 7, pos = (bk < 16) ? (int)(hsh(bk, 19) % 300) : (int)(hsh(bk, 19) % SEQ); const size_t rowb = (size_t)b * SEQ;
        const u16* DQ = (const u16*)(ws + ACT(6)); const u16* DK = (const u16*)(ws + ACT(7)); const u16* DV = (const u16*)(ws + ACT(8));
        float r = 0.f;
        if (tid < 64) { float op[3], lse[3];
            for (int pt = 0; pt < 3; ++pt) { const int window = pt == 0 ? 128 : (pt == 1 ? 512 : 2048), dil = pt == 0 ? 1 : (pt == 1 ? 4 : 16), blk = window / dil, span = window;
                const int n = pos / span, i = (pos % span) / dil, rho = pos % dil; float m = -1e30f;
                for (int pass = 0; pass < 2; ++pass) { float den = 0.f, o = 0.f;
                    for (int ik = 0; ik < 2 * blk; ++ik) { const int dist = i + blk - ik; if (dist < 0 || dist > blk) continue; if (n == 0 && ik < blk) continue;
                        const int kp = ik < blk ? (n - 1) * span + ik * dil + rho : n * span + (ik - blk) * dil + rho;
                        float s = 0.f; for (int d = 0; d < 64; ++d) s += bf1(DQ[(rowb + pos) * 512 + h * 64 + d]) * bf1(DK[(rowb + kp) * 512 + h * 64 + d]);
                        if (pass == 0) m = fmaxf(m, s); else { const float p = exp2f(s - m); den += p; o += p * bf1(DV[(rowb + kp) * 512 + h * 64 + tid]); } }
                    if (pass == 1) { op[pt] = o / den; lse[pt] = m + log2f(den); } } }
            const float lm = fmaxf(lse[0], fmaxf(lse[1], lse[2])); const float w0 = exp2f(lse[0] - lm), w1 = exp2f(lse[1] - lm), w2 = exp2f(lse[2] - lm);
            const float e = (w0 * op[0] + w1 * op[1] + w2 * op[2]) / (w0 + w1 + w2);
            const float a = bf1(((const u16*)(ws + ACT(12)))[(rowb + pos) * 512 + h * 64 + tid]); r = fabsf(a - e) / (0.02f * (fabsf(e) + 0.05f)); }
        chk_report(ctl, K, blk_max(r, sh));
    }
}
__global__ void __launch_bounds__(128) chk_mlstm_full(Params P) {
    __shared__ float kq[128]; __shared__ float red[128];
    unsigned char* ws = P.ws; u32* ctl = (u32*)(ws + WS_CTL); const int tid = threadIdx.x, b = blockIdx.x >> 2, h = blockIdx.x & 3, l = P.ph_lo; const size_t rowb = (size_t)b * SEQ;
    const u16* MQK = (const u16*)(ws + ACT(3)); const u16* MV = (const u16*)(ws + ACT(4)); const u16* MO = (const u16*)(ws + ACT(5)); const float* IF = (const float*)(ws + WS_IF); const u16* YB = (const u16*)(ws + ACT(13));
    const float* cw = P.in[12] + (size_t)l * 2048; const float* cb = P.in[13] + (size_t)l * 512; const float hgain = (P.in[16] + (size_t)l * 512)[h * 128 + tid];
    float C[64], n[64];
#pragma unroll
    for (int d = 0; d < 64; ++d) { C[d] = 0.f; n[d] = 0.f; }
    float m = 0.f, worst = 0.f; unsigned nbad = 0;
    for (int t = 0; t < SEQ; ++t) {
        __syncthreads();
        kq[tid] = tid < 64 ? convsilu(MQK, rowb, t, 256 + h * 64 + tid, cw, cb) * 0.125f : convsilu(MQK, rowb, t, h * 64 + (tid - 64), cw, cb);
        __syncthreads();
        const float lf = IF[(rowb + t) * 8 + 4 + h], ig = IF[(rowb + t) * 8 + h];
        const float mn = fmaxf(lf + m, ig), fa = expf(lf + m - mn), ia = expf(ig - mn); m = mn;
        const float vv = bf1(MV[(rowb + t) * 512 + h * 128 + tid]);
        float num = 0.f, den = 0.f;
#pragma unroll
        for (int d = 0; d < 64; ++d) { const float kk = kq[d], qq = kq[64 + d]; C[d] = fa * C[d] + ia * kk * vv; n[d] = fa * n[d] + ia * kk; num += C[d] * qq; den += n[d] * qq; }
        const float hv = num / fmaxf(fabsf(den), expf(-m));
        red[tid] = hv * hv; __syncthreads();
        for (int o = 64; o > 0; o >>= 1) { if (tid < o) red[tid] += red[tid + o]; __syncthreads(); }
        const float rstd = 1.0f / sqrtf(red[0] / 128.f + EPS);
        const float e = hv * rstd * hgain * bf1(MO[(rowb + t) * 512 + h * 128 + tid]), a = bf1(YB[(rowb + t) * 512 + h * 128 + tid]);
        const float r = fabsf(a - e) / (0.05f * (fabsf(e) + 0.3f)); worst = fmaxf(worst, r); if (r > 1.0f) ++nbad;
    }
    atomicMax(ctl + CW_CHK + 12, __float_as_uint(fminf(worst, 1e30f))); atomicAdd(ctl + CW_CHK + 15, nbad);
}
__global__ void __launch_bounds__(256) chk_g1_full(Params P) {
    unsigned char* ws = P.ws; u32* ctl = (u32*)(ws + WS_CTL); const int l = P.ph_lo; const u16* U = (const u16*)(ws + ACT(0)); const float* W = P.in[5] + (size_t)l * 1024 * INW;
    const int jb = blockIdx.x % 10, rb = blockIdx.x / 10; int j = jb * 256 + threadIdx.x; const bool act = j < 2472; if (j >= 1960) j += 1024;
    __shared__ float us[8][1024];
    for (int e = threadIdx.x; e < 8 * 1024; e += 256) us[e >> 10][e & 1023] = bf1(U[((size_t)rb * 8 + (e >> 10)) * 1024 + (e & 1023)]);
    __syncthreads();
    float acc[8];
#pragma unroll
    for (int r = 0; r < 8; ++r) acc[r] = 0.f;
    if (act) for (int k = 0; k < 1024; ++k) { const float w = W[(size_t)k * INW + j];
#pragma unroll
        for (int r = 0; r < 8; ++r) acc[r] += us[r][k] * w; }
    unsigned nbad = 0; float worst = 0.f;
    if (act) {
#pragma unroll
        for (int r = 0; r < 8; ++r) { const size_t row = (size_t)rb * 8 + r; const float e = acc[r]; float a, ee = e, tol = 0.03f * (fabsf(e) + 0.5f);
            if (j < 256) a = bf1(((const u16*)(ws + ACT(2)))[row * 256 + j]);
            else if (j < 384) a = bf1(((const u16*)(ws + ACT(2) + 16 * MiB))[row * 256 + (j - 256)]);
            else if (j < 416) a = bf1(((const u16*)(ws + ACT(2) + 16 * MiB))[row * 256 + 128 + (j - 384)]);
            else if (j < 928) a = bf1(((const u16*)(ws + ACT(3)))[row * 512 + (j - 416)]);
            else if (j < 1440) a = bf1(((const u16*)(ws + ACT(4)))[row * 512 + (j - 928)]);
            else if (j < 1952) { a = bf1(((const u16*)(ws + ACT(5)))[row * 512 + (j - 1440)]); ee = 1.0f / (1.0f + expf(-e)); tol = 0.02f; }
            else if (j < 1956) { a = ((const float*)(ws + WS_IF))[row * 8 + (j - 1952)]; ee = e + (P.in[14] + l * 4)[j - 1952]; }
            else if (j < 1960) { a = ((const float*)(ws + WS_IF))[row * 8 + 4 + (j - 1956)]; const float z = e + (P.in[15] + l * 4)[j - 1956]; ee = -log1pf(expf(-z)); tol = 0.05f * fabsf(ee) + 1e-3f; }
            else a = bf1(((const u16*)(ws + ACT(8)))[row * 512 + (j - 2984)]);
            const float rr = fabsf(a - ee) / tol; if (!(rr <= 1.0f)) ++nbad; worst = fmaxf(worst, rr); } }
    if (nbad) { atomicAdd(ctl + CW_CHK + 17, nbad); atomicMax(ctl + CW_CHK + 16, __float_as_uint(fminf(worst, 1e30f))); }
}
__global__ void chk_copy_x(Params P) { const int l = P.ph_lo; const float* src = (l == 0 && MK_COPY_FROM_IN) ? P.in[0] : P.out; float* dst = (float*)(P.ws + ACT(10));
    for (size_t i = (size_t)blockIdx.x * blockDim.x + threadIdx.x; i < (size_t)NTOK * DM; i += (size_t)gridDim.x * blockDim.x) dst[i] = src[i]; }
template <int MODE> __global__ void __launch_bounds__(256) chk_resid_full(Params P) {
    unsigned char* ws = P.ws; u32* ctl = (u32*)(ws + WS_CTL); const int l = P.ph_lo; const float* xold = (const float*)(ws + ACT(10)); const float* mod0 = (const float*)(ws + WS_MOD) + (size_t)l * 2 * 6144;
    constexpr int KD = MODE == 0 ? 1024 : 512; const u16* A = (const u16*)(ws + (MODE == 0 ? ACT(0) : ACT(3)));
    const int db = blockIdx.x & 3, rb = blockIdx.x >> 2, d = db * 256 + threadIdx.x; const int* tok = (const int*)(ws + WS_TOK);
    __shared__ float as[8][KD]; __shared__ int cl[8]; __shared__ int total;
    if (threadIdx.x == 0) { int tt = 0; if (MODE == 1) for (int c = 0; c < 24; ++c) tt += (((int)ctl[CW_MOE + l * 64 + c] + 255) >> 8) << 8; total = tt; }
    __syncthreads();
    if (MODE == 1 && (int)(blockIdx.x >> 2) * 8 >= total) return;
    for (int e = threadIdx.x; e < 8 * KD; e += 256) as[e / KD][e % KD] = bf1(A[((size_t)rb * 8 + e / KD) * KD + e % KD]);
    if (MODE == 1 && threadIdx.x < 8) { const int pos = rb * 8 + threadIdx.x, t = tok[pos]; int c = -1; if (t >= 0) c = ((const int*)(ws + WS_ROUT))[t]; cl[threadIdx.x] = c; }
    __syncthreads();
    unsigned nbad = 0; float worst = 0.f;
    for (int r = 0; r < 8; ++r) { int t = rb * 8 + r; const float* W; int ea = 0, eb = 0;
        if (MODE == 1) { t = tok[rb * 8 + r]; if (t < 0 || t >= NTOK) continue; cls_experts(cl[r], ea, eb); }
        float acc = 0.f;
        if (MODE == 0) { W = P.in[22] + (size_t)l * 1024 * 1024; for (int k = 0; k < 1024; ++k) acc += as[r][k] * W[(size_t)k * 1024 + d]; }
        else { W = P.in[30] + (size_t)l * 16 * 256 * 1024; for (int k = 0; k < 512; ++k) acc += as[r][k] * W[((size_t)(k < 256 ? ea : eb) * 256 + (k & 255)) * 1024 + d]; }
        const int b = t / SEQ; const float e = mod0[(b * 6 + (MODE == 0 ? 2 : 5)) * 1024 + d] * acc, a = P.out[(size_t)t * DM + d] - xold[(size_t)t * DM + d];
        const float rr = fabsf(a - e) / (0.03f * fabsf(e) + 0.005f); if (!(rr <= 1.0f)) ++nbad; worst = fmaxf(worst, rr); }
    if (nbad) { atomicAdd(ctl + CW_CHK + 25 + MODE, nbad); atomicMax(ctl + CW_CHK + 23 + MODE, __float_as_uint(fminf(worst, 1e30f))); }
}
__global__ void chk_count_big(Params P) {
    u32* ctl = (u32*)(P.ws + WS_CTL); unsigned n = 0;
    for (size_t i = (size_t)blockIdx.x * blockDim.x + threadIdx.x; i < (size_t)NTOK * DM; i += (size_t)gridDim.x * blockDim.x) n += fabsf(P.out[i]) > MK_BIG ? 1u : 0u;
    if (n) atomicAdd(ctl + CW_CHK + 18, n);
}
__global__ void chk_encode(Params P) {
    const u32* ctl = (const u32*)(P.ws + WS_CTL); int first = -1;
    for (int k = NCHK - 1; k >= MK_CHECK_FROM; --k) if (__uint_as_float(ctl[CW_CHK + k]) > 1.0f) first = k;
    if (MK_BIG > 0.f) { const unsigned n = ctl[CW_CHK + MK_CNT_WORD]; first = -1; if (n) { first = 0; unsigned m = n; while (m > 1u) { m >>= 2; ++first; } } }
    const float s = first < 0 ? 1.0f : 1.0f - 0.07f * (float)(first + 1);
    for (size_t i = (size_t)blockIdx.x * blockDim.x + threadIdx.x; i < (size_t)NTOK * DM; i += (size_t)gridDim.x * blockDim.x) { const int pos = (int)((i / DM) % SEQ); float v = P.out[i] * s; if (pos >= MK_ZERO_LO && pos < MK_ZERO_HI) v = 0.f; P.out[i] = v; }
}
#endif

constexpr int NPH_LAYER = 13, NPH_TOTAL = 1 + NL * NPH_LAYER;
template <unsigned MASK> __global__ void __launch_bounds__(NTHR, 2) mega_fwd(Params P) {
    extern __shared__ __attribute__((aligned(16))) unsigned char lds_raw[];
    Frame F;
    F.lds = (LAS unsigned char*)lds_raw; F.tid = threadIdx.x; F.lane = F.tid & 63; F.wave = __builtin_amdgcn_readfirstlane(F.tid >> 6); F.G = gridDim.x; F.bid = blockIdx.x;
    F.ws = P.ws;
    u32* ctl = (u32*)(P.ws + WS_CTL);
    for (int u = F.tid; u < (LDS_BYTES - LDSCTL_OFF) / 4; u += NTHR) ((LAS unsigned*)(F.lds + LDSCTL_OFF))[u] = 0u;
    if (F.tid == 0) { LAS unsigned long long* pt = (LAS unsigned long long*)(F.lds + PTAB_OFF);
#pragma unroll
        for (int i = 0; i < 31; ++i) pt[i] = (unsigned long long)(uintptr_t)P.in[i];
        pt[31] = (unsigned long long)(uintptr_t)P.out; pt[32] = (unsigned long long)(uintptr_t)P.ws; }
    __syncthreads();
    constexpr bool SINGLE = (MASK & (MASK - 1u)) != 0u;
    XcdBarrier bar; bar.bar = ctl + CW_BAR; bar.x = 0; bar.st = nullptr; bar.lead = false;
    if (SINGLE) bar = xcd_barrier_post(ctl + CW_BAR, (volatile LAS unsigned*)(F.lds + MISC_OFF) + 8);
#define IN(k) true
#define EN(n) (((MASK & (unsigned)(MK_PH_MASK)) >> (n)) & 1u)
#define SEAM(k) do { if (SINGLE && !(l == NL - 1 && (k) == pb + 12)) xcd_barrier(bar); } while (0)
    LAS unsigned char* lds = F.lds;
#define INP(i) ((const float*)ldsptr(lds, (i)))
#define OUTP ((float*)ldsptr(lds, 31))
#define PHASE_FRAME() Frame Fp = F; { unsigned char* w_ = (unsigned char*)ldsptr(lds, 32); int t_; asm volatile("v_mbcnt_lo_u32_b32 %0, -1, 0\n\tv_mbcnt_hi_u32_b32 %0, -1, %0" : "=v"(t_)); t_ += F.wave * 64; Fp.ws = w_; Fp.tid = t_; Fp.lane = t_ & 63; Fp.wave = __builtin_amdgcn_readfirstlane(t_ >> 6); } unsigned char* const ws = Fp.ws; (void)ws

    if (EN(0) && P.ph_lo == 0) { PHASE_FRAME(); pre_phase(Fp); if (SINGLE) xcd_barrier(bar); }
    for (int l = P.ph_lo; l < P.ph_hi; ++l) {
        const int pb = 0;
        if (EN(1) && IN(pb + 0)) { PHASE_FRAME(); conv_phase(Fp, l);
            norm_rows(Fp, l == 0 ? INP(0) : OUTP, INP(4) + l * 1024, (const float*)(ws + WS_MOD) + (size_t)l * 2 * 6144, 0, 1, (u16*)(ws + ACT(0))); SEAM(pb + 0); }
        if (EN(2) && IN(pb + 1)) { PHASE_FRAME();
            pg8::Gemm g{(const u16*)(ws + ACT(0)), (const u16*)(ws + WS_WIN), NTOK, 3584, 1024}; pg8::StaticOrder S; S.init(NTOK, 3584, F.G, F.bid);
            EpiG1 E{ws, INP(14) + l * 4, INP(15) + l * 4, INP(17) + l * 64, INP(18) + l * 64};
            pg8::gemm_phase<EpiG1, pg8::StaticOrder, true, true>(lds, g, S, E, F.wave);
            SEAM(pb + 1); }
        if (EN(3) && IN(pb + 2)) { PHASE_FRAME();
            dil_naive_phase(Fp, (const u16*)(ws + ACT(6)), (const u16*)(ws + ACT(7)), (const u16*)(ws + ACT(8)), (u16*)(ws + ACT(12)));
            mlstm_a_phase(Fp, (const u16*)(ws + ACT(3)), (const u16*)(ws + ACT(4)), (const float*)(ws + WS_IF), INP(12) + l * 2048, INP(13) + l * 512, (float*)(ws + ACT(10))); SEAM(pb + 2); }
        if (EN(4) && IN(pb + 3)) { PHASE_FRAME();
            { pg8::Gemm g{(const u16*)(ws + ACT(2)), (const u16*)(ws + WS_WUQ), NTOK, 768, 256}; pg8::StaticOrder S; S.init(NTOK, 768, F.G, F.bid); EpiQU E{(u16*)(ws + ACT(6)), (const float*)(ws + WS_SSQQ)};
              pg8::gemm_phase<EpiQU, pg8::StaticOrder, true, true>(lds, g, S, E, F.wave); }
            { pg8::Gemm g{(const u16*)(ws + ACT(2) + 16 * MiB), (const u16*)(ws + WS_WUKV), NTOK, 1024, 256}; pg8::StaticOrder S; S.init(NTOK, 1024, F.G, F.bid);
              EpiKVU E{(u16*)(ws + ACT(6) + 48 * MiB), (u16*)(ws + ACT(9)), (const float*)(ws + WS_SSQKV)};
              pg8::gemm_phase<EpiKVU, pg8::StaticOrder, true, true>(lds, g, S, E, F.wave); }
            mlstm_b_phase(Fp, (float*)(ws + ACT(10)));
            SEAM(pb + 3); }
        if (EN(5) && IN(pb + 4)) { PHASE_FRAME();
            l3post_phase(Fp, (u16*)(ws + ACT(6)), (u16*)(ws + ACT(6) + 48 * MiB), (const u16*)(ws + ACT(2) + 16 * MiB), INP(10) + l * 96, INP(11) + l * 96);
            mlstm_c_phase(Fp, (const u16*)(ws + ACT(3)), (const u16*)(ws + ACT(4)), (const u16*)(ws + ACT(5)), (const float*)(ws + WS_IF), INP(12) + l * 2048, INP(13) + l * 512, INP(16) + l * 512, (const float*)(ws + ACT(10)), (u16*)(ws + ACT(13))); SEAM(pb + 4); }
        if (EN(6) && IN(pb + 5)) { PHASE_FRAME(); mla_naive_phase(Fp, (const u16*)(ws + ACT(6)), (const u16*)(ws + ACT(6) + 48 * MiB), (const u16*)(ws + ACT(9)), (u16*)(ws + ACT(3))); SEAM(pb + 5); }
        if (EN(7) && IN(pb + 6)) { PHASE_FRAME();
            pg8::Gemm g{(const u16*)(ws + ACT(0)), (const u16*)(ws + WS_WIN) + (size_t)3584 * 1024, NTOK, 3072, 1024}; pg8::StaticOrder S; S.init(NTOK, 3072, F.G, F.bid); EpiGate E{(u16*)(ws + ACT(4))};
            pg8::gemm_phase<EpiGate, pg8::StaticOrder, true, true>(lds, g, S, E, F.wave);
            SEAM(pb + 6); }
        if (EN(8) && IN(pb + 7)) { PHASE_FRAME();
            pg8::StaticOrder S; S.init(NTOK, 1024, F.G, F.bid); const u16* GT = (const u16*)(ws + ACT(4)); u16* M = (u16*)(ws + ACT(0)); const u16* WBR = (const u16*)(ws + WS_WBR);
            { pg8::Gemm g{(const u16*)(ws + ACT(3)), WBR, NTOK, 1024, 512}; EpiMerge<0> E{GT, M, (unsigned*)(ws + WS_CTL) + 32768 + 21}; pg8::gemm_phase<EpiMerge<0>, pg8::StaticOrder, true, true>(lds, g, S, E, F.wave); }
            { pg8::Gemm g{(const u16*)(ws + ACT(13)), WBR + (size_t)1024 * 512, NTOK, 1024, 512}; EpiMerge<1> E{GT, M, (unsigned*)(ws + WS_CTL) + 32768 + 21}; pg8::gemm_phase<EpiMerge<1>, pg8::StaticOrder, true, true>(lds, g, S, E, F.wave); }
            { pg8::Gemm g{(const u16*)(ws + ACT(12)), WBR + (size_t)2 * 1024 * 512, NTOK, 1024, 512}; EpiMerge<2> E{GT, M, (unsigned*)(ws + WS_CTL) + 32768 + 21}; pg8::gemm_phase<EpiMerge<2>, pg8::StaticOrder, true, true>(lds, g, S, E, F.wave); }
            SEAM(pb + 7); }
        if (EN(9) && IN(pb + 8)) { PHASE_FRAME();
            pg8::Gemm g{(const u16*)(ws + ACT(0)), (const u16*)(ws + WS_WOUT), NTOK, 1024, 1024}; pg8::StaticOrder S; S.init(NTOK, 1024, F.G, F.bid);
            EpiOut E{l == 0 ? INP(0) : OUTP, OUTP, (const float*)(ws + WS_MOD) + (size_t)l * 2 * 6144 + 2 * 1024, (unsigned*)(ws + WS_CTL) + 32768 + 19};
            pg8::gemm_phase<EpiOut, pg8::StaticOrder, true, true>(lds, g, S, E, F.wave);
            SEAM(pb + 8); }
        if (EN(10) && IN(pb + 9)) { PHASE_FRAME();
            router_phase(Fp, OUTP, INP(23) + l * 1024, (const float*)(ws + WS_MOD) + (size_t)l * 2 * 6144, INP(24) + l * 4096, INP(25) + l * 4, INP(26) + l * 16384, INP(27) + l * 16, (u32*)(ws + WS_CTL) + CW_MOE + l * 64); SEAM(pb + 9); }
        if (EN(11) && IN(pb + 10)) { PHASE_FRAME();
            scatter_phase(Fp, OUTP, INP(23) + l * 1024, (const float*)(ws + WS_MOD) + (size_t)l * 2 * 6144, (const u32*)(ws + WS_CTL) + CW_MOE + l * 64, (u16*)(ws + ACT(0))); SEAM(pb + 10); }
        if (EN(12) && IN(pb + 11)) { PHASE_FRAME();
            moe_table(Fp, (const u32*)(ws + WS_CTL) + CW_MOE + l * 64); moe_units(Fp, 0);
            pg8::Gemm g{(const u16*)(ws + ACT(0)), (const u16*)(ws + WS_WGU), MAXROWS, 1024, 1024}; MoeOrder S{(const LAS int*)(lds + TAB_OFF) + 320}; EpiGU E{(u16*)(ws + ACT(3)), (const float*)(ws + WS_TOK + 262144)};
            pg8::gemm_phase<EpiGU, MoeOrder, true, true>(lds, g, S, E, F.wave);
            SEAM(pb + 11); }
        if (EN(13) && IN(pb + 12)) { PHASE_FRAME();
            moe_table(Fp, (const u32*)(ws + WS_CTL) + CW_MOE + l * 64); moe_units(Fp, 1);
            pg8::Gemm g{(const u16*)(ws + ACT(3)), (const u16*)(ws + WS_WDC), MAXROWS, 1024, 512}; MoeOrder S{(const LAS int*)(lds + TAB_OFF) + 320};
            EpiDown E{OUTP, (const int*)(ws + WS_TOK), (const float*)(ws + WS_MOD) + (size_t)l * 2 * 6144 + 5 * 1024, (unsigned*)(ws + WS_CTL) + 32768 + 20};
            pg8::gemm_phase<EpiDown, MoeOrder, true, true>(lds, g, S, E, F.wave);
            SEAM(pb + 12); }
    }
#undef IN
#undef SEAM
}

extern "C" void kernel_launch(void* const* d_in, const int* in_sizes, int n_in, void* d_out, int out_size, void* d_ws, size_t ws_size, hipStream_t stream) {
    static int grid = 0;
    if (grid == 0) {
        if (n_in != 31 || out_size != NTOK * DM || ws_size < WS_END) { fprintf(stderr, "kernel_launch: unexpected shapes (n_in %d, out %d, ws %zu < %zu)\n", n_in, out_size, ws_size, (size_t)WS_END); grid = -1; return; }
        int dev = 0, cus = 0, per_cu = 0;
        if (hipGetDevice(&dev) != hipSuccess || hipDeviceGetAttribute(&cus, hipDeviceAttributeMultiprocessorCount, dev) != hipSuccess) { grid = -1; return; }
#if MK_MULTI
#define SETATTR(K) if (hipFuncSetAttribute((const void*)mega_fwd<(1u << (K))>, hipFuncAttributeMaxDynamicSharedMemorySize, LDS_BYTES) != hipSuccess) { fprintf(stderr, "kernel_launch: hipFuncSetAttribute failed\n"); grid = -1; return; }
        SETATTR(0) SETATTR(1) SETATTR(2) SETATTR(3) SETATTR(4) SETATTR(5) SETATTR(6) SETATTR(7) SETATTR(8) SETATTR(9) SETATTR(10) SETATTR(11) SETATTR(12) SETATTR(13)
#else
        if (hipFuncSetAttribute((const void*)mega_fwd<0x3fffu>, hipFuncAttributeMaxDynamicSharedMemorySize, LDS_BYTES) != hipSuccess) { fprintf(stderr, "kernel_launch: hipFuncSetAttribute failed\n"); grid = -1; return; }
        if (hipOccupancyMaxActiveBlocksPerMultiprocessor(&per_cu, (const void*)mega_fwd<0x3fffu>, NTHR, LDS_BYTES) != hipSuccess || per_cu < 1) { fprintf(stderr, "kernel_launch: occupancy query says %d\n", per_cu); }
#endif
        (void)hipGetLastError();
        grid = cus;
    }
    if (grid < 0) return;
    if (hipMemsetAsync((char*)d_ws + WS_CTL, 0, CTL_ZERO_BYTES, stream) != hipSuccess) return;
    Params p{};
    for (int i = 0; i < 31; ++i) p.in[i] = (const float*)d_in[i];
    p.out = (float*)d_out; p.ws = (unsigned char*)d_ws;
#if MK_MULTI
#define LAUNCH1(K) hipLaunchKernelGGL(mega_fwd<(1u << (K))>, dim3(grid), dim3(NTHR), LDS_BYTES, stream, p)
    p.ph_lo = 0; p.ph_hi = 0; LAUNCH1(0);
    for (int l = 0; l < NL; ++l) { p.ph_lo = l; p.ph_hi = l + 1;
#if MK_CHECK
#define CHK(K) do { if (l == MK_CHECK_LAYER) hipLaunchKernelGGL(chk<K>, dim3(CHK_BLOCKS), dim3(256), 0, stream, p); } while (0)
#else
#define CHK(K) do { } while (0)
#endif
#if MK_CHECK
#define CHKX(M) do { if (l == MK_CHECK_LAYER) { Params q_ = p; if (M) q_.ph_lo = 5; hipLaunchKernelGGL(chk_copy_x, dim3(2048), dim3(256), 0, stream, q_); } } while (0)
#define CHKR(M, NB) do { if (l == MK_CHECK_LAYER) hipLaunchKernelGGL(chk_resid_full<M>, dim3(4 * (NB)), dim3(256), 0, stream, p); } while (0)
#else
#define CHKX(M) do { } while (0)
#define CHKR(M, NB) do { } while (0)
#endif
#if MK_CHECK
#define CHKG() do { if (l == MK_CHECK_LAYER) hipLaunchKernelGGL(chk_g1_full, dim3(10 * (NTOK / 8)), dim3(256), 0, stream, p); } while (0)
#else
#define CHKG() do { } while (0)
#endif
#if MK_CHECK
#define CHKM() do { if (l == MK_CHECK_LAYER) hipLaunchKernelGGL(chk_mlstm_full, dim3(8), dim3(128), 0, stream, p); } while (0)
#else
#define CHKM() do { } while (0)
#endif
        CHK(13); CHK(14); LAUNCH1(1); CHK(0); LAUNCH1(2); CHK(1); CHK(2); CHKG(); LAUNCH1(3); CHK(11); LAUNCH1(4); LAUNCH1(5); CHK(3); CHK(4); CHKM(); LAUNCH1(6); CHK(10); LAUNCH1(7); CHK(5); LAUNCH1(8); CHK(6); CHK(21); CHKX(0); LAUNCH1(9); CHK(7); CHKR(0, NTOK / 8);
        LAUNCH1(10); LAUNCH1(11); LAUNCH1(12); CHK(8); CHK(20); CHKX(1); LAUNCH1(13); CHK(9); CHKR(1, MAXROWS / 8); }
#if MK_CHECK
    if (MK_BIG > 0.f) hipLaunchKernelGGL(chk_count_big, dim3(1024), dim3(256), 0, stream, p);
    hipLaunchKernelGGL(chk_encode, dim3(1024), dim3(256), 0, stream, p);
#endif
#else
    p.ph_lo = 0; p.ph_hi = NL;
    hipLaunchKernelGGL(mega_fwd<0x3fffu>, dim3(grid), dim3(NTHR), LDS_BYTES, stream, p);
#endif
}
```

```cpp
#include <hip/hip_runtime.h>
#include <cstdio>
#include <cstdint>
#ifndef MK_F16
#define MK_F16 1
#endif
#ifndef MK_MULTI
#define MK_MULTI 0
#endif
#ifndef MK_PH_MASK
#define MK_PH_MASK 0xffffffffu
#endif
#ifndef MK_ABL
#define MK_ABL 0
#endif
#ifndef MK_CHECK
#define MK_CHECK 0
#endif
#ifndef MK_CHECK_FROM
#define MK_CHECK_FROM 23
#endif
#ifndef MK_CHECK_LAYER
#define MK_CHECK_LAYER 0
#endif
#ifndef MK_CHECK_INJECT
#define MK_CHECK_INJECT 1.0f
#endif
#ifndef MK_ZERO_LO
#define MK_ZERO_LO 0
#define MK_ZERO_HI 0
#endif
#ifndef MK_CHECK_TIGHT
#define MK_CHECK_TIGHT 1.0f
#endif
#ifndef MK_BIG
#define MK_BIG 0.0f
#endif
#ifndef MK_UPD_BIG
#define MK_UPD_BIG 2.0f
#endif
#ifndef MK_CNT_WORD
#define MK_CNT_WORD 22
#endif
#ifndef MK_COPY_FROM_IN
#define MK_COPY_FROM_IN 1
#endif
#ifndef MK_MLA_MFMA
#define MK_MLA_MFMA 1
#endif
namespace pg8 {
#define PG8_LAS __attribute__((address_space(3)))
typedef unsigned short bf16_t;
typedef short bf16x8 __attribute__((ext_vector_type(8)));
typedef float f32x4 __attribute__((ext_vector_type(4)));
typedef unsigned u32x4 __attribute__((ext_vector_type(4)));
constexpr int BM = 256, BK = 64, HALF = 128, HTB = HALF * BK * 2  , STAGE_BYTES = 8 * HTB, NXCD = 8, WGM = 8;

__host__ __device__ __forceinline__ int lds_byte(int r, int c) { const int st = (r >> 4) * 2 + (c >> 5), rr = r & 15, cc = c & 31, ob = rr * 64 + cc * 2; return st * 1024 + (ob ^ (((ob >> 9) & 1) << 5)); }
__host__ __device__ __forceinline__ void stage_rc(int b, int& R, int& C) { const int st = b / 1024, sb = b % 1024, swz = sb ^ (((sb >> 9) & 1) << 5); R = (st >> 1) * 16 + swz / 64; C = (st & 1) * 32 + (swz % 64) / 2; }
__host__ __device__ __forceinline__ int perm32(int rho) { const int n = rho >> 4, i = rho & 15; return 8 * (i >> 2) + 4 * n + (i & 3); }

struct Unit { int pm, pn, pb, aux; };
struct Gemm { const bf16_t* A; const bf16_t* Bt; int M, N, K; };

struct StaticOrder {
    int nM, nN, nwg, G, c;
    __host__ __device__ void init(int M, int N, int G_, int c_) { nM = M / BM; nN = N / BM; nwg = nM * nN; G = G_; c = c_; }
    __host__ __device__ bool next(int i, Unit& u) const {
        const long L = (long)i * G + c; if (L >= nwg) return false;
        int wgid = (int)L; { const int q = nwg / NXCD, r = nwg % NXCD, xcd = wgid % NXCD, off = wgid / NXCD; wgid = (xcd < r ? xcd * (q + 1) : r * (q + 1) + (xcd - r) * q) + off; }
        const int nig = WGM * nN, gid = wgid / nig, fm = gid * WGM, gsz = (nM - fm) < WGM ? (nM - fm) : WGM;
        u.pm = fm + ((wgid % nig) % gsz); u.pn = (wgid % nig) / gsz; u.pb = u.pn; u.aux = 0; return true;
    }
    __device__ __forceinline__ void a_ready(const Unit&) const {}
    __device__ __forceinline__ void done(const Unit&) const {}
};
typedef _Float16 h16x2 __attribute__((ext_vector_type(2))); typedef _Float16 h16x8 __attribute__((ext_vector_type(8)));
#if MK_F16
__device__ __forceinline__ unsigned cvt_pk_bf16(float lo, float hi) { typedef float f2_ __attribute__((ext_vector_type(2))); const f2_ v = {lo, hi}; return __builtin_bit_cast(unsigned, __builtin_convertvector(v, h16x2)); }
#define PG8_MFMA16(a, b, c) __builtin_amdgcn_mfma_f32_16x16x32_f16(__builtin_bit_cast(pg8::h16x8, (a)), __builtin_bit_cast(pg8::h16x8, (b)), (c), 0, 0, 0)
#else
__device__ __forceinline__ unsigned cvt_pk_bf16(float lo, float hi) { unsigned r; asm volatile("v_cvt_pk_bf16_f32 %0, %1, %2" : "=v"(r) : "v"(lo), "v"(hi)); return r; }
#define PG8_MFMA16(a, b, c) __builtin_amdgcn_mfma_f32_16x16x32_bf16((a), (b), (c), 0, 0, 0)
#endif
typedef float f32x2 __attribute__((ext_vector_type(2)));
template <class Epi, class Sched, bool ALIGN_EPI = false, bool SP2 = false>
__device__ __forceinline__ void gemm_phase(PG8_LAS unsigned char* lds, const Gemm g, const Sched& S, const Epi& E, const int wave_id) {
    Gemm gl = g; { const unsigned long long a_ = (unsigned long long)g.A, b_ = (unsigned long long)g.Bt; unsigned al = __builtin_amdgcn_readfirstlane((unsigned)a_), ah = __builtin_amdgcn_readfirstlane((unsigned)(a_ >> 32)), bl = __builtin_amdgcn_readfirstlane((unsigned)b_), bh = __builtin_amdgcn_readfirstlane((unsigned)(b_ >> 32));
        asm volatile("" : "+s"(al), "+s"(ah), "+s"(bl), "+s"(bh)); gl.A = (const bf16_t*)(((unsigned long long)ah << 32) | al); gl.Bt = (const bf16_t*)(((unsigned long long)bh << 32) | bl); }
    int lid_; asm volatile("v_mbcnt_lo_u32_b32 %0, -1, 0\n\tv_mbcnt_hi_u32_b32 %0, -1, %0" : "=v"(lid_));
    const int tid_ = wave_id * 64 + lid_;
    const int tid = tid_, wid = __builtin_amdgcn_readfirstlane(tid >> 6), lane = tid & 63, wr = wid >> 2, wc = wid & 3, fr = lane & 15, fq = lane >> 4;
    const int K = gl.K, nt = K / BK;
    unsigned voffA[2], voffB[2];
#pragma unroll
    for (int i = 0; i < 2; ++i) { int R, C; stage_rc(tid * 16 + i * 8192, R, C); const int Rb = Epi::PERM ? ((R & ~31) + perm32(R & 31)) : R;
        voffA[i] = (unsigned)(R * K + C) * 2u; voffB[i] = (unsigned)(Rb * K + C) * 2u; }
    const size_t kstep = (size_t)(BK * 2);
    const size_t hstep = (size_t)HALF * K * 2;
    const size_t tstep = 2 * hstep;
    const unsigned ldsw = (unsigned)wid * 1024u;
    const int aoff = lds_byte(wr * 64 + fr, fq * 8), boff = lds_byte(wc * 32 + fr, fq * 8);
#define PG8_SA(b, h) (((b) * 2 + (h)) * HTB)
#define PG8_SB(b, h) ((4 + (b) * 2 + (h)) * HTB)
#define PG8_STAGE(bufoff, gbase, voff) do { _Pragma("unroll") for (int _i = 0; _i < 2; ++_i) \
        __builtin_amdgcn_global_load_lds((const unsigned*)((const char*)(gbase) + (voff)[_i]), (PG8_LAS unsigned*)(lds + (bufoff) + ldsw + _i * 8192), 16, 0, 0); } while (0)
#define PG8_LDA(dst, b, h) do { _Pragma("unroll") for (int m = 0; m < 4; ++m) _Pragma("unroll") for (int k = 0; k < 2; ++k) dst[m][k] = *(const PG8_LAS bf16x8*)(lds + PG8_SA(b, h) + aoff + m * 2048 + k * 1024); } while (0)
#define PG8_LDB(dst, b, h) do { _Pragma("unroll") for (int n = 0; n < 2; ++n) _Pragma("unroll") for (int k = 0; k < 2; ++k) dst[n][k] = *(const PG8_LAS bf16x8*)(lds + PG8_SB(b, h) + boff + n * 2048 + k * 1024); } while (0)
#define PG8_MMA(ai, bj, At, Bt) do { __builtin_amdgcn_s_setprio(1); _Pragma("unroll") for (int m = 0; m < 4; ++m) _Pragma("unroll") for (int n = 0; n < 2; ++n) _Pragma("unroll") for (int k = 0; k < 2; ++k) \
        acc[ai][bj][m][n] = PG8_MFMA16(Bt[n][k], At[m][k], acc[ai][bj][m][n]); __builtin_amdgcn_s_setprio(0); } while (0)
#define PG8_WAIT_V(n) asm volatile("s_waitcnt vmcnt(" #n ")" ::: "memory")
#define PG8_WAIT_L(n) asm volatile("s_waitcnt lgkmcnt(" #n ")" ::: "memory")
#define PG8_BAR __builtin_amdgcn_s_barrier()
#define PG8_SCHED __builtin_amdgcn_sched_barrier(0)
    float zf_ = 0.f; asm volatile("" : "+v"(zf_));
    Unit cur, nxt; int ui = 0;
    if (!S.next(0, cur)) return;
    f32x4 acc[2][2][4][2];
#pragma unroll
    for (int a = 0; a < 2; ++a)
#pragma unroll
        for (int b = 0; b < 2; ++b)
#pragma unroll
            for (int m = 0; m < 4; ++m)
#pragma unroll
                for (int n = 0; n < 2; ++n) acc[a][b][m][n] = (f32x4){zf_, zf_, zf_, zf_};
    bf16x8 At[4][2], B0[2][2], B1[2][2];
    const char* cA = (const char*)gl.A + (size_t)cur.pm * tstep; const char* cB = (const char*)gl.Bt + (size_t)cur.pb * tstep;
    S.a_ready(cur);
    if constexpr (SP2) {
        PG8_STAGE(PG8_SB(0, 0), cB, voffB); PG8_STAGE(PG8_SB(0, 1), cB + hstep, voffB); PG8_STAGE(PG8_SA(0, 0), cA, voffA); PG8_STAGE(PG8_SA(0, 1), cA + hstep, voffA);
        if (wr == 1) PG8_BAR;
        PG8_WAIT_V(2); PG8_BAR;
        PG8_STAGE(PG8_SB(1, 0), cB + kstep, voffB); PG8_STAGE(PG8_SA(1, 0), cA + kstep, voffA); PG8_STAGE(PG8_SB(1, 1), cB + hstep + kstep, voffB);
        PG8_WAIT_V(6); PG8_BAR;
    } else {
        PG8_STAGE(PG8_SB(0, 0), cB, voffB); PG8_STAGE(PG8_SA(0, 0), cA, voffA); PG8_STAGE(PG8_SB(0, 1), cB + hstep, voffB); PG8_STAGE(PG8_SA(0, 1), cA + hstep, voffA);
        if (wr == 1) PG8_BAR;
        PG8_WAIT_V(4); PG8_BAR;
        PG8_STAGE(PG8_SB(1, 0), cB + kstep, voffB); PG8_STAGE(PG8_SA(1, 0), cA + kstep, voffA); PG8_STAGE(PG8_SB(1, 1), cB + hstep + kstep, voffB);
        PG8_WAIT_V(6); PG8_BAR;
    }
    for (;;) {
        const bool has_next = S.next(ui + 1, nxt);
        const char* nA = has_next ? (const char*)gl.A + (size_t)nxt.pm * tstep : cA; const char* nB = has_next ? (const char*)gl.Bt + (size_t)nxt.pb * tstep : cB;
        _Pragma("clang loop unroll(disable)")
        for (int t = 0; t < nt; t += 2) {
            const bool last = (t == nt - 2);
            const char* a1 = cA + (size_t)(t + 1) * kstep;
            const char* a2 = last ? nA : cA + (size_t)(t + 2) * kstep; const char* b2 = last ? nB : cB + (size_t)(t + 2) * kstep;
            const char* a3 = a2 + kstep; const char* b3 = b2 + kstep;
            if (last && has_next) S.a_ready(nxt);
            if constexpr (SP2) {
            PG8_LDB(B0, 0, 0); PG8_LDB(B1, 0, 1); PG8_SCHED; PG8_LDA(At, 0, 0); PG8_STAGE(PG8_SA(1, 1), a1 + hstep, voffA);
            PG8_WAIT_V(8); PG8_WAIT_L(0); PG8_BAR; PG8_MMA(0, 0, At, B0); PG8_MMA(0, 1, At, B1); PG8_BAR; PG8_SCHED;
            PG8_LDA(At, 0, 1); PG8_STAGE(PG8_SB(0, 0), b2, voffB); PG8_STAGE(PG8_SB(0, 1), b2 + hstep, voffB); PG8_STAGE(PG8_SA(0, 0), a2, voffA);
            PG8_WAIT_V(8); PG8_WAIT_L(0); PG8_BAR; PG8_MMA(1, 0, At, B0); PG8_MMA(1, 1, At, B1); PG8_BAR; PG8_SCHED;
            PG8_LDB(B0, 1, 0); PG8_LDB(B1, 1, 1); PG8_SCHED; PG8_LDA(At, 1, 0); PG8_STAGE(PG8_SA(0, 1), a2 + hstep, voffA);
            PG8_WAIT_V(8); PG8_WAIT_L(0); PG8_BAR; PG8_MMA(0, 0, At, B0); PG8_MMA(0, 1, At, B1); PG8_BAR; PG8_SCHED;
            PG8_LDA(At, 1, 1); PG8_STAGE(PG8_SB(1, 0), b3, voffB); PG8_STAGE(PG8_SB(1, 1), b3 + hstep, voffB); PG8_STAGE(PG8_SA(1, 0), a3, voffA);
            PG8_WAIT_V(8); PG8_WAIT_L(0); PG8_BAR; PG8_MMA(1, 0, At, B0); PG8_MMA(1, 1, At, B1); PG8_BAR; PG8_SCHED;
            } else {
            PG8_LDB(B0, 0, 0); PG8_SCHED; PG8_LDA(At, 0, 0); PG8_STAGE(PG8_SA(1, 1), a1 + hstep, voffA);
            PG8_WAIT_L(8); PG8_BAR; PG8_WAIT_L(0); PG8_MMA(0, 0, At, B0); PG8_BAR; PG8_SCHED;
            PG8_LDB(B1, 0, 1); PG8_STAGE(PG8_SB(0, 0), b2, voffB);
            PG8_BAR; PG8_WAIT_L(0); PG8_MMA(0, 1, At, B1); PG8_BAR;
            PG8_LDA(At, 0, 1); PG8_STAGE(PG8_SA(0, 0), a2, voffA);
            PG8_BAR; PG8_WAIT_L(0); PG8_MMA(1, 0, At, B0); PG8_BAR; PG8_SCHED;
            PG8_STAGE(PG8_SB(0, 1), b2 + hstep, voffB);
            PG8_WAIT_V(6); PG8_BAR; PG8_MMA(1, 1, At, B1); PG8_BAR;
            PG8_LDB(B0, 1, 0); PG8_SCHED; PG8_LDA(At, 1, 0); PG8_STAGE(PG8_SA(0, 1), a2 + hstep, voffA);
            PG8_WAIT_L(8); PG8_BAR; PG8_WAIT_L(0); PG8_MMA(0, 0, At, B0); PG8_BAR; PG8_SCHED;
            PG8_LDB(B1, 1, 1); PG8_STAGE(PG8_SB(1, 0), b3, voffB);
            PG8_BAR; PG8_WAIT_L(0); PG8_MMA(0, 1, At, B1); PG8_BAR;
            PG8_LDA(At, 1, 1); PG8_STAGE(PG8_SA(1, 0), a3, voffA);
            PG8_BAR; PG8_WAIT_L(0); PG8_MMA(1, 0, At, B0); PG8_BAR; PG8_SCHED;
            PG8_STAGE(PG8_SB(1, 1), b3 + hstep, voffB);
            PG8_WAIT_V(6); PG8_BAR; PG8_MMA(1, 1, At, B1); PG8_BAR;
            }
        }
        if constexpr (ALIGN_EPI) { if (wr == 0) PG8_BAR; }
        if constexpr (!Epi::AFTER_DRAIN) { int fr_e = fr, fq_e = fq; asm volatile("" : "+v"(fr_e), "+v"(fq_e));
            E(acc, cur, wr, wc, fr_e, fq_e); S.done(cur); }
        if (!has_next) break;
#pragma unroll
        for (int a = 0; a < 2; ++a)
#pragma unroll
            for (int b = 0; b < 2; ++b)
#pragma unroll
                for (int m = 0; m < 4; ++m)
#pragma unroll
                    for (int n = 0; n < 2; ++n) acc[a][b][m][n] = (f32x4){zf_, zf_, zf_, zf_};
        cur = nxt; cA = nA; cB = nB; ++ui;
        if constexpr (ALIGN_EPI) { if (wr == 1) PG8_BAR; }
    }
    PG8_WAIT_V(0);
    if constexpr (!ALIGN_EPI) { if (wr == 0) PG8_BAR; }
    PG8_BAR;
    if constexpr (Epi::AFTER_DRAIN) { E.fused(acc, cur, wr, wc, fr, fq, lds, wid, lane); S.done(cur); }
#undef PG8_SA
#undef PG8_SB
#undef PG8_STAGE
#undef PG8_LDA
#undef PG8_LDB
#undef PG8_MMA
#undef PG8_WAIT_V
#undef PG8_WAIT_L
#undef PG8_BAR
#undef PG8_SCHED
}
}

typedef unsigned short u16;
typedef unsigned int u32;
constexpr int NTOK = 32768, SEQ = 16384, DM = 1024, NL = 4, NWAVES = 8, NTHR = 512;
constexpr int INW = 6568;
constexpr int MAXROWS = NTOK + 24 * 256;
constexpr float EPS = 1e-6f;
constexpr float LOG2E = 1.4426950408889634f;
constexpr size_t MiB = 1u << 20;
constexpr size_t WS_CTL = 0, CTL_ZERO_BYTES = 1 * MiB;
constexpr size_t WS_MOD = 1 * MiB;
constexpr size_t WS_ROPE = 2 * MiB;
constexpr size_t WS_SSQQ = 4 * MiB, WS_SSQKV = 4 * MiB + 512 * 1024;
constexpr size_t WS_IF = 5 * MiB;
constexpr size_t WS_ROUT = 6 * MiB;
constexpr size_t WS_TOK = 7 * MiB;
constexpr size_t WS_MLS = 8 * MiB;
constexpr size_t WS_WIN = 16 * MiB, WS_WUQ = 29 * MiB, WS_WUKV = 29 * MiB + 512 * 1024, WS_WBR = 30 * MiB, WS_WOUT = 33 * MiB, WS_WGU = 35 * MiB, WS_WDC = 51 * MiB;
constexpr size_t WS_ACT = 76 * MiB, SLOT = 32 * MiB;
constexpr size_t WS_END = WS_ACT + 14 * SLOT;
#define ACT(i) (WS_ACT + (size_t)(i) * SLOT)
constexpr int CW_BAR = 4096, CW_MOE = 16384;
constexpr int RING_BYTES = 131072, LDSCTL_OFF = RING_BYTES, MISC_OFF = LDSCTL_OFF + 320, TAB_OFF = LDSCTL_OFF + 1024, PTAB_OFF = LDSCTL_OFF + 4096, LDS_BYTES = 147456;

#define GAS __attribute__((address_space(1)))
#define LAS __attribute__((address_space(3)))
typedef unsigned v4u __attribute__((ext_vector_type(4)));
typedef unsigned v2u __attribute__((ext_vector_type(2)));
typedef float f32x4 __attribute__((ext_vector_type(4)));
#define LDS_WAIT() asm volatile("s_waitcnt lgkmcnt(0)" ::: "memory")
__device__ __forceinline__ u32 f2bf(float f) { u32 u = __builtin_bit_cast(u32, f); return (u + 0x7fffu + ((u >> 16) & 1u)) >> 16; }
__device__ __forceinline__ u32 pk2(float lo, float hi) { return pg8::cvt_pk_bf16(lo, hi); }
#if MK_F16
__device__ __forceinline__ float bflo(u32 w) { return (float)__builtin_bit_cast(pg8::h16x2, w)[0]; }
__device__ __forceinline__ float bfhi(u32 w) { return (float)__builtin_bit_cast(pg8::h16x2, w)[1]; }
__device__ __forceinline__ float bf1(u16 w) { return (float)__builtin_bit_cast(_Float16, w); }
#else
__device__ __forceinline__ float bflo(u32 w) { return __uint_as_float(w << 16); }
__device__ __forceinline__ float bfhi(u32 w) { return __uint_as_float(w & 0xffff0000u); }
__device__ __forceinline__ float bf1(u16 w) { return __uint_as_float(((u32)w) << 16); }
#endif
__device__ __forceinline__ float fsigmoid(float x) { return __builtin_amdgcn_rcpf(1.0f + __expf(-x)); }
__device__ __forceinline__ float fsilu(float x) { return x * fsigmoid(x); }
__device__ __forceinline__ float bperm_f(int srclane, float v) { return __int_as_float(__builtin_amdgcn_ds_bpermute(srclane << 2, __float_as_int(v))); }
__device__ __forceinline__ float wave_sum(float v, int lane) {
#pragma unroll
    for (int o = 1; o < 64; o <<= 1) v += bperm_f(lane ^ o, v);
    return v;
}

__device__ __forceinline__ void* ldsptr(LAS unsigned char* lds, int i) {
    int off_ = PTAB_OFF + 8 * i; asm volatile("" : "+v"(off_));
    const unsigned long long v = *(volatile LAS unsigned long long*)(lds + off_);
    const unsigned lo = __builtin_amdgcn_readfirstlane((unsigned)v), hi = __builtin_amdgcn_readfirstlane((unsigned)(v >> 32));
    unsigned lo2 = lo, hi2 = hi; asm volatile("" : "+s"(lo2), "+s"(hi2));
    return (void*)(uintptr_t)(((unsigned long long)hi2 << 32) | lo2);
}
struct Params { const float* in[31]; float* out; unsigned char* ws; int ph_lo, ph_hi; };
struct Frame {
    LAS unsigned char* lds; int tid, lane, wave, G, bid;
    unsigned char* ws;
};
#define FIN(i) ((const float*)ldsptr(F.lds, (i)))

__device__ __forceinline__ void conv_tile(const float* Wk0, int ldw, const float* ksc, u16* dst, int ldk, int srcc, LAS float* scr, int lane) {
#pragma unroll 8
    for (int i = 0; i < 32; ++i) { const int kk = 2 * i + (lane >> 5); float v = 0.f;
        if (Wk0 != nullptr && srcc >= 0) { v = Wk0[(size_t)kk * ldw + srcc]; if (ksc) v *= ksc[kk]; }
        scr[kk * 33 + (lane & 31)] = v; }
    LDS_WAIT(); asm volatile("" ::: "memory");
    const int c = lane & 7;
#pragma unroll
    for (int j = 0; j < 4; ++j) { const int n = (lane >> 3) + 8 * j; const LAS float* s = scr + (8 * c) * 33 + n;
        v4u o; o.x = pk2(s[0 * 33], s[1 * 33]); o.y = pk2(s[2 * 33], s[3 * 33]); o.z = pk2(s[4 * 33], s[5 * 33]); o.w = pk2(s[6 * 33], s[7 * 33]);
        *(v4u*)(dst + (size_t)n * ldk + 8 * c) = o; }
    LDS_WAIT(); asm volatile("" ::: "memory");
}
__device__ __forceinline__ int win_srccol(int n) {
    const int pn = n >> 8, j = n & 255;
    if (pn == 0) return j;
    if (pn == 1) { if (j < 128) return 256 + j; if (j < 160) return 384 + (j - 128); if (j < 164) return 1952 + (j - 160); if (j < 168) return 1956 + (j - 164); return -1; }
    if (pn < 8) return 416 + (pn - 2) * 256 + j;
    if (pn < 12) { const int base = pn < 10 ? 1960 : 2472, half = (pn - 8) & 1, bj = j >> 7, wc = (j & 127) >> 5, i32 = j & 31; return base + (half * 4 + wc) * 64 + bj * 32 + i32; }
    if (pn < 14) return 2984 + (pn - 12) * 256 + j;
    return 3496 + (n - 3584);
}
__device__ __forceinline__ void cls_experts(int cls, int& ea, int& eb) {
    const int g = cls / 6, p = cls % 6; const int a = p < 3 ? 0 : (p < 5 ? 1 : 2); const int b = p < 3 ? p + 1 : (p < 5 ? p - 1 : 3);
    ea = g * 4 + a; eb = g * 4 + b;
}
__device__ __forceinline__ void conv_phase(Frame& F, int l) {
    LAS float* scr = (LAS float*)(F.lds + F.wave * 16384);
    const int gw = F.bid * NWAVES + F.wave, NGW = F.G * NWAVES, lane = F.lane, ln = lane & 31;
    constexpr int I_WIN = 208 * 16, I_UQ = 24 * 4, I_UKV = 32 * 4, I_BR = 3 * 32 * 8, I_OUT = 32 * 16, I_GU = 16 * 16 * 16, I_DC = 24 * 32 * 8;
    constexpr int NITEMS = I_WIN + I_UQ + I_UKV + I_BR + I_OUT + I_GU + I_DC;
    unsigned char* ws = F.ws;
    for (int it = gw; it < NITEMS; it += NGW) {
        int r = it;
        if (r < I_WIN) { const int nb = r / 16, kb = r % 16; const float* W = FIN(5) + (size_t)l * 1024 * INW;
            conv_tile(W + (size_t)kb * 64 * INW, INW, nullptr, (u16*)(ws + WS_WIN) + (size_t)nb * 32 * 1024 + kb * 64, 1024, win_srccol(nb * 32 + ln), scr, lane); continue; } r -= I_WIN;
        if (r < I_UQ) { const int nb = r / 4, kb = r % 4; const float* W = FIN(8) + (size_t)l * 256 * 768;
            conv_tile(W + (size_t)kb * 64 * 768, 768, FIN(6) + l * 256 + kb * 64, (u16*)(ws + WS_WUQ) + (size_t)nb * 32 * 256 + kb * 64, 256, nb * 32 + ln, scr, lane); continue; } r -= I_UQ;
        if (r < I_UKV) { const int nb = r / 4, kb = r % 4; const float* W = FIN(9) + (size_t)l * 128 * 1024;
            conv_tile(kb < 2 ? W + (size_t)kb * 64 * 1024 : nullptr, 1024, kb < 2 ? FIN(7) + l * 128 + kb * 64 : nullptr, (u16*)(ws + WS_WUKV) + (size_t)nb * 32 * 256 + kb * 64, 256, nb * 32 + ln, scr, lane); continue; } r -= I_UKV;
        if (r < I_BR) { const int br = r / 256, q = r % 256, nb = q / 8, kb = q % 8; const float* W = (br == 0 ? FIN(19) : (br == 1 ? FIN(20) : FIN(21))) + (size_t)l * 512 * 1024;
            conv_tile(W + (size_t)kb * 64 * 1024, 1024, nullptr, (u16*)(ws + WS_WBR) + (size_t)br * 1024 * 512 + (size_t)nb * 32 * 512 + kb * 64, 512, nb * 32 + ln, scr, lane); continue; } r -= I_BR;
        if (r < I_OUT) { const int nb = r / 16, kb = r % 16; const float* W = FIN(22) + (size_t)l * 1024 * 1024;
            conv_tile(W + (size_t)kb * 64 * 1024, 1024, nullptr, (u16*)(ws + WS_WOUT) + (size_t)nb * 32 * 1024 + kb * 64, 1024, nb * 32 + ln, scr, lane); continue; } r -= I_OUT;
        if (r < I_GU) { const int e = r / 256, q = r % 256, nb = q / 16, kb = q % 16;
            const int p = nb >> 3, jp = (nb & 7) * 32, bj = jp >> 7, f = p * 128 + (jp & 127) + ln;
            const float* W = (bj ? FIN(29) : FIN(28)) + ((size_t)l * 16 + e) * 1024 * 256;
            conv_tile(W + (size_t)kb * 64 * 256, 256, nullptr, (u16*)(ws + WS_WGU) + ((size_t)e * 512 + nb * 32) * 1024 + kb * 64, 1024, f, scr, lane); continue; } r -= I_GU;
        { const int cls = r / 256, q = r % 256, nb = q / 8, kb = q % 8; int ea, eb; cls_experts(cls, ea, eb);
            const int e = kb < 4 ? ea : eb, k0 = (kb & 3) * 64; const float* W = FIN(30) + ((size_t)l * 16 + e) * 256 * 1024;
            conv_tile(W + (size_t)k0 * 1024, 1024, nullptr, (u16*)(ws + WS_WDC) + ((size_t)cls * 1024 + nb * 32) * 512 + kb * 64, 512, nb * 32 + ln, scr, lane); }
    }
}

__device__ __forceinline__ void pre_phase(Frame& F) {
    const float* c = FIN(1); const float* w_ada = FIN(2); const float* b_ada = FIN(3);
    float* mod = (float*)(F.ws + WS_MOD);
    LAS float* scr = (LAS float*)F.lds;
    for (int u = F.bid; u < NL * 96; u += F.G) {
        const int l = u / 96, j0 = (u % 96) * 64, jc = F.tid & 63, dg = F.tid >> 6;
        const float* W = w_ada + (size_t)l * 1024 * 6144 + j0 + jc;
        float a0 = 0.f, a1 = 0.f;
        for (int d = dg * 128; d < dg * 128 + 128; ++d) { const float w = W[(size_t)d * 6144]; a0 += fsilu(c[d]) * w; a1 += fsilu(c[1024 + d]) * w; }
        scr[(dg * 64 + jc) * 2 + 0] = a0; scr[(dg * 64 + jc) * 2 + 1] = a1;
        __syncthreads();
        if (F.tid < 128) { const int jc2 = F.tid & 63, b = F.tid >> 6; float s = b_ada[l * 6144 + j0 + jc2];
#pragma unroll
            for (int g = 0; g < 8; ++g) s += scr[(g * 64 + jc2) * 2 + b];
            mod[(size_t)(l * 2 + b) * 6144 + j0 + jc2] = s; }
        __syncthreads();
    }
    float* ct = (float*)(F.ws + WS_ROPE); float* st = ct + SEQ * 16;
    for (int idx = F.bid * NTHR + F.tid; idx < SEQ * 16; idx += F.G * NTHR) {
        const int pos = idx >> 4, i = idx & 15;
        double inv = (i & 3) == 0 ? 1.0 : ((i & 3) == 1 ? 0.5623413251903491 : ((i & 3) == 2 ? 0.31622776601683794 : 0.1778279410038923));
        const int dec = i >> 2; inv = dec == 0 ? inv : (dec == 1 ? inv * 0.1 : (dec == 2 ? inv * 0.01 : inv * 0.001));
        const float ang = (float)pos * (float)inv;
        double rev = (double)ang * 0.15915494309189535; rev -= __builtin_rint(rev);
        ct[idx] = __builtin_amdgcn_cosf((float)rev); st[idx] = __builtin_amdgcn_sinf((float)rev);
    }
}

__device__ __forceinline__ void norm_rows(Frame& F, const float* xin, const float* gain, const float* modl  , int ish, int isc, u16* U) {
    const int gw = F.bid * NWAVES + F.wave, NGW = F.G * NWAVES, lane = F.lane;
    for (int m = gw; m < NTOK; m += NGW) {
        const int b = m / SEQ;
        const f32x4* xr = (const f32x4*)(xin + (size_t)m * DM) + lane;
        f32x4 v[4]; float s = 0.f;
#pragma unroll
        for (int j = 0; j < 4; ++j) { v[j] = xr[64 * j]; s += (v[j].x * v[j].x + v[j].y * v[j].y) + (v[j].z * v[j].z + v[j].w * v[j].w); }
        const float rstd = 1.0f / sqrtf(wave_sum(s, lane) * (1.f / DM) + EPS);
        v2u* o8 = (v2u*)(U + (size_t)m * DM) + lane;
#pragma unroll
        for (int j = 0; j < 4; ++j) { const int c0 = 4 * lane + 256 * j;
            const f32x4 g = *(const f32x4*)(gain + c0), sc = *(const f32x4*)(modl + (size_t)(b * 6 + isc) * 1024 + c0), sh = *(const f32x4*)(modl + (size_t)(b * 6 + ish) * 1024 + c0);
            const f32x4 y = (v[j] * rstd) * g * (sc + 1.0f) + sh;
            v2u w; w.x = pk2(y.x, y.y); w.y = pk2(y.z, y.w); o8[64 * j] = w; }
    }
}
#define XB_TMO      128
#define XB_XCNT(j)  (256  + 64 * (j))
#define XB_XSUB(j)  (1280 + 64 * (j))
#define XB_XGEN(j)  (2304 + 64 * (j))
#define XB_TOP      3328
#define XB_TOPGEN   3392
#define XCD_BAR_WORDS 3456
#define XB_SPIN_CAP (1u << 18)

__device__ __forceinline__ unsigned xb_ld(unsigned* p)              { return __hip_atomic_load(p, __ATOMIC_RELAXED, __HIP_MEMORY_SCOPE_AGENT); }
__device__ __forceinline__ unsigned xb_add(unsigned* p, unsigned v) { return __hip_atomic_fetch_add(p, v, __ATOMIC_RELAXED, __HIP_MEMORY_SCOPE_AGENT); }
__device__ __forceinline__ unsigned xb_xcc_id() { return (unsigned)__builtin_amdgcn_s_getreg((3 << 11) | 20) & 0xFu; }
#define XB_SPIN(cond, bar) do { unsigned _sp = 0; while (cond) { __builtin_amdgcn_s_sleep(1); \
    if ((++_sp & 255u) == 0u) { if (xb_ld(&(bar)[XB_TMO])) break; if (_sp > XB_SPIN_CAP) { atomicAdd(&(bar)[XB_TMO], 1u); break; } } } } while (0)

struct XcdBarrier {
    unsigned* bar; unsigned x;
    volatile LAS unsigned* st;
    bool lead;
};

__device__ __forceinline__ XcdBarrier xcd_barrier_post(unsigned* bar, volatile LAS unsigned* st) {
    XcdBarrier b; b.bar = bar; b.x = xb_xcc_id(); b.st = st; b.lead = (threadIdx.x == 0);
    if (b.lead) (void)xb_add(&bar[XB_XCNT(b.x)], 1u);
    return b;
}
__device__ __forceinline__ void xcd_barrier_complete(unsigned* bar, unsigned x, unsigned& nloc, unsigned& nx) {
    const unsigned G = gridDim.x * gridDim.y * gridDim.z;
    unsigned sum, cnt, mine, sp = 0u;
    for (;;) {
        sum = 0u; cnt = 0u; mine = 0u;
#pragma unroll
        for (unsigned j = 0; j < 16; ++j) { const unsigned c = xb_ld(&bar[XB_XCNT(j)]); sum += c; cnt += (c > 0u) ? 1u : 0u; mine = (j == x) ? c : mine; }
        if (sum == G) break;
        __builtin_amdgcn_s_sleep(1);
        if ((++sp & 255u) == 0u) { if (xb_ld(&bar[XB_TMO])) break; if (sp > XB_SPIN_CAP) { atomicAdd(&bar[XB_TMO], 1u); break; } }
    }
    nloc = mine > 0u ? mine : 1u; nx = cnt > 0u ? cnt : 1u;
}

__device__ __forceinline__ void xcd_barrier(const XcdBarrier& b) {
    asm volatile("s_waitcnt vmcnt(0)" ::: "memory");
    __syncthreads();
    if (b.lead) {
        unsigned* bar = b.bar;
        __builtin_amdgcn_s_waitcnt(0);
        unsigned nloc = b.st[0], nx = b.st[1];
        if (nloc == 0u) { xcd_barrier_complete(bar, b.x, nloc, nx); b.st[0] = nloc; b.st[1] = nx; }
        const unsigned old = xb_add(&bar[XB_XSUB(b.x)], 1u);
        const unsigned gen = old / nloc;
        if (old + 1u == (gen + 1u) * nloc) {
            __builtin_amdgcn_fence(__ATOMIC_RELEASE, "agent");
            asm volatile("s_waitcnt vmcnt(0)" ::: "memory");
            const unsigned og = xb_add(&bar[XB_TOP], 1u);
            const unsigned tg = og / nx;
            if (og + 1u == (tg + 1u) * nx) xb_add(&bar[XB_TOPGEN], 1u);
            else XB_SPIN(xb_ld(&bar[XB_TOPGEN]) == tg, bar);
            __builtin_amdgcn_fence(__ATOMIC_ACQUIRE, "agent");
            xb_add(&bar[XB_XGEN(b.x)], 1u);
            asm volatile("s_waitcnt vmcnt(0)" ::: "memory");
        } else {
            XB_SPIN(xb_ld(&bar[XB_XGEN(b.x)]) == gen, bar);
            __builtin_amdgcn_fence(__ATOMIC_ACQUIRE, "agent");
            asm volatile("s_waitcnt vmcnt(0)" ::: "memory");
        }
    }
    __syncthreads();
}

typedef pg8::f32x4 A4;
#define EPI_ARGS const A4 (&acc)[2][2][4][2], const pg8::Unit& u, int wr, int wc, int fr, int fq
__device__ __forceinline__ v4u pack8(A4 a, A4 b) { v4u w; w.x = pk2(a[0], a[1]); w.y = pk2(a[2], a[3]); w.z = pk2(b[0], b[1]); w.w = pk2(b[2], b[3]); return w; }
__device__ __forceinline__ float dot4(A4 a) { return (a[0] * a[0] + a[1] * a[1]) + (a[2] * a[2] + a[3] * a[3]); }
__device__ __forceinline__ float logsigmoidf(float x) { const float e = __expf(-fabsf(x)); return fminf(x, 0.f) - __logf(1.0f + e); }

struct EpiG1 {
    static constexpr bool PERM = true, AFTER_DRAIN = false;
    unsigned char* ws; const float *b_i, *b_f, *dqg, *dkg;
    __device__ __forceinline__ void operator()(EPI_ARGS) const {
        u16* const CQ = (u16*)(ws + ACT(2)); u16* const C1 = (u16*)(ws + ACT(2) + 16 * MiB); u16* const DV = (u16*)(ws + ACT(8));
        float* const ssqq = (float*)(ws + WS_SSQQ); float* const ssqkv = (float*)(ws + WS_SSQKV); float* const IF = (float*)(ws + WS_IF);
        const int pn = u.pn, row0 = u.pm * 256 + wr * 64 + fr, cw = 32 * wc + 8 * fq;
        if (pn == 0) {
#pragma unroll
            for (int ai = 0; ai < 2; ++ai)
#pragma unroll
                for (int m = 0; m < 4; ++m) { const size_t row = row0 + ai * 128 + m * 16; float ss = 0.f;
#pragma unroll
                    for (int bj = 0; bj < 2; ++bj) { ss += dot4(acc[ai][bj][m][0]) + dot4(acc[ai][bj][m][1]); *(v4u*)(CQ + row * 256 + bj * 128 + cw) = pack8(acc[ai][bj][m][0], acc[ai][bj][m][1]); }
                    ss += bperm_f((fq * 16 + fr) ^ 16, ss); ss += bperm_f((fq * 16 + fr) ^ 32, ss);
                    if (fq == 0) ssqq[row * 4 + wc] = ss; }
        } else if (pn == 1) {
#pragma unroll
            for (int ai = 0; ai < 2; ++ai)
#pragma unroll
                for (int m = 0; m < 4; ++m) { const size_t row = row0 + ai * 128 + m * 16;
                    float ss = dot4(acc[ai][0][m][0]) + dot4(acc[ai][0][m][1]);
#pragma unroll
                    for (int bj = 0; bj < 2; ++bj) *(v4u*)(C1 + row * 256 + bj * 128 + cw) = pack8(acc[ai][bj][m][0], acc[ai][bj][m][1]);
                    ss += bperm_f((fq * 16 + fr) ^ 16, ss); ss += bperm_f((fq * 16 + fr) ^ 32, ss);
                    if (fq == 0) { ssqkv[row * 4 + wc] = ss;
                        if (wc == 1) { const A4 gi = acc[ai][1][m][0], gf = acc[ai][1][m][1]; A4 o0, o1;
#pragma unroll
                            for (int i = 0; i < 4; ++i) { o0[i] = gi[i] + b_i[i]; o1[i] = logsigmoidf(gf[i] + b_f[i]); }
                            *(A4*)(IF + row * 8) = o0; *(A4*)(IF + row * 8 + 4) = o1; } } }
        } else if (pn < 8) {
            u16* dst = (u16*)(ws + WS_ACT + (size_t)(3 + ((pn - 2) >> 1)) * SLOT); const int cb = (pn & 1) * 256; const bool sg = pn >= 6;
#pragma unroll
            for (int ai = 0; ai < 2; ++ai)
#pragma unroll
                for (int m = 0; m < 4; ++m) { const size_t row = row0 + ai * 128 + m * 16;
#pragma unroll
                    for (int bj = 0; bj < 2; ++bj) { A4 a = acc[ai][bj][m][0], b = acc[ai][bj][m][1];
                        if (sg) {
#pragma unroll
                            for (int i = 0; i < 4; ++i) { a[i] = fsigmoid(a[i]); b[i] = fsigmoid(b[i]); } }
                        *(v4u*)(dst + row * 512 + cb + bj * 128 + cw) = pack8(a, b); } }
        } else if (pn < 12) {
            const bool isq = pn < 10; u16* dst = (u16*)(ws + WS_ACT + (size_t)(isq ? 6 : 7) * SLOT); const float* gn = isq ? dqg : dkg; const int head = (pn & 1) * 4 + wc;
            const float osc = isq ? 0.125f * LOG2E : 1.0f;
#pragma unroll
            for (int ai = 0; ai < 2; ++ai)
#pragma unroll
                for (int m = 0; m < 4; ++m) { const size_t row = row0 + ai * 128 + m * 16;
                    float ss = (dot4(acc[ai][0][m][0]) + dot4(acc[ai][0][m][1])) + (dot4(acc[ai][1][m][0]) + dot4(acc[ai][1][m][1]));
                    ss += bperm_f((fq * 16 + fr) ^ 16, ss); ss += bperm_f((fq * 16 + fr) ^ 32, ss);
                    const float rstd = osc / sqrtf(ss * (1.f / 64.f) + EPS);
#pragma unroll
                    for (int bj = 0; bj < 2; ++bj) { const A4 g0 = *(const A4*)(gn + bj * 32 + 8 * fq), g1 = *(const A4*)(gn + bj * 32 + 8 * fq + 4);
                        *(v4u*)(dst + row * 512 + head * 64 + bj * 32 + 8 * fq) = pack8(acc[ai][bj][m][0] * rstd * g0, acc[ai][bj][m][1] * rstd * g1); }
                    asm volatile("" ::: "memory"); }
        } else {
            const int cb = (pn & 1) * 256;
#pragma unroll
            for (int ai = 0; ai < 2; ++ai)
#pragma unroll
                for (int m = 0; m < 4; ++m) { const size_t row = row0 + ai * 128 + m * 16;
#pragma unroll
                    for (int bj = 0; bj < 2; ++bj) *(v4u*)(DV + row * 512 + cb + bj * 128 + cw) = pack8(acc[ai][bj][m][0], acc[ai][bj][m][1]); }
        }
    }
};
struct EpiQU {
    static constexpr bool PERM = true, AFTER_DRAIN = false;
    u16* Q; const float* ssqq;
    __device__ __forceinline__ void operator()(EPI_ARGS) const {
        const int row0 = u.pm * 256 + wr * 64 + fr, col0 = u.pn * 256 + 32 * wc + 8 * fq;
#pragma unroll
        for (int ai = 0; ai < 2; ++ai)
#pragma unroll
            for (int m = 0; m < 4; ++m) { const size_t row = row0 + ai * 128 + m * 16; const A4 s4 = *(const A4*)(ssqq + row * 4);
                const float r = 1.0f / sqrtf(((s4[0] + s4[1]) + (s4[2] + s4[3])) * (1.f / 256.f) + EPS);
#pragma unroll
                for (int bj = 0; bj < 2; ++bj) *(v4u*)(Q + row * 768 + col0 + bj * 128) = pack8(acc[ai][bj][m][0] * r, acc[ai][bj][m][1] * r);
                asm volatile("" ::: "memory"); }
    }
};
struct EpiKVU {
    static constexpr bool PERM = true, AFTER_DRAIN = false;
    u16 *K, *V; const float* ssqkv;
    __device__ __forceinline__ void operator()(EPI_ARGS) const {
        const int row0 = u.pm * 256 + wr * 64 + fr;
#pragma unroll
        for (int ai = 0; ai < 2; ++ai)
#pragma unroll
            for (int m = 0; m < 4; ++m) { const size_t row = row0 + ai * 128 + m * 16; const A4 s4 = *(const A4*)(ssqkv + row * 4);
                const float r = 1.0f / sqrtf(((s4[0] + s4[1]) + (s4[2] + s4[3])) * (1.f / 128.f) + EPS);
#pragma unroll
                for (int bj = 0; bj < 2; ++bj) { const int head = 2 * u.pn + bj; const v4u w = pack8(acc[ai][bj][m][0] * r, acc[ai][bj][m][1] * r);
                    if (wc < 2) *(v4u*)(K + row * 768 + head * 96 + 32 * wc + 8 * fq) = w; else *(v4u*)(V + row * 512 + head * 64 + 32 * (wc - 2) + 8 * fq) = w; }
                asm volatile("" ::: "memory"); }
    }
};
struct EpiGate {
    static constexpr bool PERM = true, AFTER_DRAIN = false;
    u16* GT;
    __device__ __forceinline__ void operator()(EPI_ARGS) const {
        const int row0 = u.pm * 256 + wr * 64 + fr, col0 = u.pn * 256 + 32 * wc + 8 * fq;
#pragma unroll
        for (int ai = 0; ai < 2; ++ai)
#pragma unroll
            for (int m = 0; m < 4; ++m) { const size_t row = row0 + ai * 128 + m * 16;
#pragma unroll
                for (int bj = 0; bj < 2; ++bj) { A4 a = acc[ai][bj][m][0], b = acc[ai][bj][m][1];
#pragma unroll
                    for (int i = 0; i < 4; ++i) { a[i] = fsigmoid(a[i]); b[i] = fsigmoid(b[i]); }
                    *(v4u*)(GT + row * 3072 + col0 + bj * 128) = pack8(a, b); } }
    }
};
template <int IDX> struct EpiMerge {
    static constexpr bool PERM = true, AFTER_DRAIN = false;
    const u16* GT; u16* M; unsigned* dbg;
    __device__ __forceinline__ void operator()(EPI_ARGS) const {
        const int row0 = u.pm * 256 + wr * 64 + fr, col0 = u.pn * 256 + 32 * wc + 8 * fq;
#pragma unroll
        for (int ai = 0; ai < 2; ++ai)
#pragma unroll
            for (int m = 0; m < 4; ++m) { const size_t row = row0 + ai * 128 + m * 16;
#pragma unroll
                for (int bj = 0; bj < 2; ++bj) { const v4u g = *(const v4u*)(GT + row * 3072 + IDX * 1024 + col0 + bj * 128);
                    A4 a = acc[ai][bj][m][0], b = acc[ai][bj][m][1];
                    a[0] *= bflo(g.x); a[1] *= bfhi(g.x); a[2] *= bflo(g.y); a[3] *= bfhi(g.y); b[0] *= bflo(g.z); b[1] *= bfhi(g.z); b[2] *= bflo(g.w); b[3] *= bfhi(g.w);
                    if ((MK_ABL >> IDX) & 1) { a = (A4){0.f, 0.f, 0.f, 0.f}; b = a; }
#if MK_CHECK
                    for (int i_ = 0; i_ < 4; ++i_) { if (fabsf(a[i_]) > MK_UPD_BIG) atomicAdd(dbg + IDX, 1u); if (fabsf(b[i_]) > MK_UPD_BIG) atomicAdd(dbg + IDX, 1u); }
#endif
                    u16* mp = M + row * 1024 + col0 + bj * 128;
                    if (IDX > 0) { const v4u p = *(const v4u*)mp; a[0] += bflo(p.x); a[1] += bfhi(p.x); a[2] += bflo(p.y); a[3] += bfhi(p.y); b[0] += bflo(p.z); b[1] += bfhi(p.z); b[2] += bflo(p.w); b[3] += bfhi(p.w); }
                    *(v4u*)mp = pack8(a, b); }
                asm volatile("" ::: "memory"); }
    }
};
struct EpiOut {
    static constexpr bool PERM = false, AFTER_DRAIN = false;
    const float* xin; float* xout; const float* ga  ; unsigned* dbg;
    __device__ __forceinline__ void operator()(EPI_ARGS) const {
        const int row0 = u.pm * 256 + wr * 64 + fr, col0 = u.pn * 256 + 32 * wc + 4 * fq, b = (u.pm * 256) / SEQ;
        A4 g[2][2];
#pragma unroll
        for (int bj = 0; bj < 2; ++bj)
#pragma unroll
            for (int n = 0; n < 2; ++n) g[bj][n] = *(const A4*)(ga + (size_t)b * 6144 + col0 + bj * 128 + n * 16);
#pragma unroll
        for (int ai = 0; ai < 2; ++ai)
#pragma unroll
            for (int m = 0; m < 4; ++m) { const size_t off = (size_t)(row0 + ai * 128 + m * 16) * 1024 + col0;
#pragma unroll
                for (int bj = 0; bj < 2; ++bj)
#pragma unroll
                    for (int n = 0; n < 2; ++n) { const A4 xi = *(const A4*)(xin + off + bj * 128 + n * 16); *(A4*)(xout + off + bj * 128 + n * 16) = xi + g[bj][n] * acc[ai][bj][m][n];
#if MK_CHECK
                        { const A4 up = g[bj][n] * acc[ai][bj][m][n]; for (int i_ = 0; i_ < 4; ++i_) if (fabsf(up[i_]) > MK_UPD_BIG) atomicAdd(dbg, 1u); }
#endif
                    }
                asm volatile("" ::: "memory"); }
    }
};
struct EpiGU {
    static constexpr bool PERM = true, AFTER_DRAIN = false;
    u16* HID; const float* wrow;
    __device__ __forceinline__ void operator()(EPI_ARGS) const {
        const int row0 = u.pm * 256 + wr * 64 + fr, slot = u.pn >> 1, p = u.pn & 1, col0 = slot * 256 + p * 128 + 32 * wc + 8 * fq;
#pragma unroll
        for (int ai = 0; ai < 2; ++ai)
#pragma unroll
            for (int m = 0; m < 4; ++m) { const size_t row = row0 + ai * 128 + m * 16; const float w = wrow[row * 2 + slot];
                A4 h0, h1;
#pragma unroll
                for (int i = 0; i < 4; ++i) { h0[i] = fsilu(acc[ai][0][m][0][i]) * acc[ai][1][m][0][i] * w; h1[i] = fsilu(acc[ai][0][m][1][i]) * acc[ai][1][m][1][i] * w; }
                *(v4u*)(HID + row * 512 + col0) = pack8(h0, h1);
                asm volatile("" ::: "memory"); }
    }
};
struct EpiDown {
    static constexpr bool PERM = false, AFTER_DRAIN = false;
    float* x; const int* tok; const float* gf  ; unsigned* dbg;
    __device__ __forceinline__ void operator()(EPI_ARGS) const {
        const int row0 = u.pm * 256 + wr * 64 + fr, col0 = u.pn * 256 + 32 * wc + 4 * fq;
#pragma unroll
        for (int ai = 0; ai < 2; ++ai)
#pragma unroll
            for (int m = 0; m < 4; ++m) { const int t = tok[row0 + ai * 128 + m * 16];
                if (t >= 0) { const int b = t / SEQ; const size_t off = (size_t)t * 1024 + col0;
#pragma unroll
                    for (int bj = 0; bj < 2; ++bj)
#pragma unroll
                        for (int n = 0; n < 2; ++n) { const A4 g = *(const A4*)(gf + (size_t)b * 6144 + col0 + bj * 128 + n * 16); const A4 xi = *(const A4*)(x + off + bj * 128 + n * 16);
                            *(A4*)(x + off + bj * 128 + n * 16) = xi + g * acc[ai][bj][m][n];
#if MK_CHECK
                            { const A4 up = g * acc[ai][bj][m][n]; for (int i_ = 0; i_ < 4; ++i_) if (fabsf(up[i_]) > MK_UPD_BIG) atomicAdd(dbg, 1u); }
#endif
                        } }
                asm volatile("" ::: "memory"); }
    }
};
struct MoeOrder {
    const LAS int* ul;
    __device__ __forceinline__ bool next(int i, pg8::Unit& u) const {
        if (i >= ul[0]) return false;
        const int v = __builtin_amdgcn_readfirstlane(ul[1 + i]); u.pm = v & 255; u.pn = (v >> 8) & 3; u.pb = v >> 16; u.aux = 0; return true;
    }
    __device__ __forceinline__ void a_ready(const pg8::Unit&) const {}
    __device__ __forceinline__ void done(const pg8::Unit&) const {}
};

__device__ __forceinline__ void l3post_phase(Frame& F, u16* Q, u16* K, const u16* C1, const float* qg, const float* kg) {
    const float* ct = (const float*)(F.ws + WS_ROPE); const float* st = ct + SEQ * 16;
    for (int idx = F.bid * NTHR + F.tid; idx < NTOK * 16; idx += F.G * NTHR) {
        const int isk = idx & 1, h = (idx >> 1) & 7, row = idx >> 4, pos = row % SEQ;
        u16* p = (isk ? K : Q) + (size_t)row * 768 + h * 96; const float* gn = isk ? kg : qg;
        float v[96];
#pragma unroll
        for (int c = 0; c < 8; ++c) { const v4u w = *(const v4u*)(p + c * 8); v[c * 8 + 0] = bflo(w.x); v[c * 8 + 1] = bfhi(w.x); v[c * 8 + 2] = bflo(w.y); v[c * 8 + 3] = bfhi(w.y); v[c * 8 + 4] = bflo(w.z); v[c * 8 + 5] = bfhi(w.z); v[c * 8 + 6] = bflo(w.w); v[c * 8 + 7] = bfhi(w.w); }
        const u16* p2 = isk ? (C1 + (size_t)row * 256 + 128) : (p + 64);
#pragma unroll
        for (int c = 0; c < 4; ++c) { const v4u w = *(const v4u*)(p2 + c * 8); v[64 + c * 8 + 0] = bflo(w.x); v[64 + c * 8 + 1] = bfhi(w.x); v[64 + c * 8 + 2] = bflo(w.y); v[64 + c * 8 + 3] = bfhi(w.y); v[64 + c * 8 + 4] = bflo(w.z); v[64 + c * 8 + 5] = bfhi(w.z); v[64 + c * 8 + 6] = bflo(w.w); v[64 + c * 8 + 7] = bfhi(w.w); }
        float ss = 0.f;
#pragma unroll
        for (int d = 0; d < 96; ++d) ss += v[d] * v[d];
        const float rs = (1.0f / sqrtf(ss * (1.f / 96.f) + EPS)) * (isk ? 1.0f : 0.10206207261596577f * LOG2E);
#pragma unroll
        for (int d = 0; d < 96; ++d) v[d] = v[d] * rs * gn[d];
#pragma unroll
        for (int i = 0; i < 16; ++i) { const float cs = ct[pos * 16 + i], sn = st[pos * 16 + i], x1 = v[64 + i], x2 = v[80 + i]; v[64 + i] = x1 * cs - x2 * sn; v[80 + i] = x1 * sn + x2 * cs; }
#pragma unroll
        for (int c = 0; c < 12; ++c) { v4u w; w.x = pk2(v[c * 8 + 0], v[c * 8 + 1]); w.y = pk2(v[c * 8 + 2], v[c * 8 + 3]); w.z = pk2(v[c * 8 + 4], v[c * 8 + 5]); w.w = pk2(v[c * 8 + 6], v[c * 8 + 7]); *(v4u*)(p + c * 8) = w; }
    }
}

__device__ __forceinline__ void mla_naive_phase(Frame& F, const u16* Q, const u16* K, const u16* V, u16* YA) {
    LAS float* Ks = (LAS float*)F.lds;
    LAS float* Vs = (LAS float*)(F.lds + 64 * 96 * 4);
    for (int item = F.bid; item < 256; item += F.G) {
        const int bh = item >> 4, pr = item & 15, b = bh >> 3, h = bh & 7;
        for (int half = 0; half < 2; ++half) {
            const int qb = half ? 31 - pr : pr, qpos = qb * 512 + F.tid; const size_t qrow = (size_t)b * SEQ + qpos;
            float q[96], o[64];
#pragma unroll
            for (int c = 0; c < 12; ++c) { const v4u w = *(const v4u*)(Q + qrow * 768 + h * 96 + c * 8); q[c * 8 + 0] = bflo(w.x); q[c * 8 + 1] = bfhi(w.x); q[c * 8 + 2] = bflo(w.y); q[c * 8 + 3] = bfhi(w.y); q[c * 8 + 4] = bflo(w.z); q[c * 8 + 5] = bfhi(w.z); q[c * 8 + 6] = bflo(w.w); q[c * 8 + 7] = bfhi(w.w); }
#pragma unroll
            for (int d = 0; d < 64; ++d) o[d] = 0.f;
            float mx = -1e30f, l = 0.f;
            const int ntile = (qb + 1) * 8;
            for (int kt = 0; kt < ntile; ++kt) {
                __syncthreads();
                for (int e = F.tid; e < 64 * 12; e += NTHR) { const int kr = e / 12, c = e % 12; const v4u w = *(const v4u*)(K + ((size_t)b * SEQ + kt * 64 + kr) * 768 + h * 96 + c * 8);
                    LAS float* d = Ks + kr * 96 + c * 8; d[0] = bflo(w.x); d[1] = bfhi(w.x); d[2] = bflo(w.y); d[3] = bfhi(w.y); d[4] = bflo(w.z); d[5] = bfhi(w.z); d[6] = bflo(w.w); d[7] = bfhi(w.w); }
                { const int kr = F.tid >> 3, c = F.tid & 7; const v4u w = *(const v4u*)(V + ((size_t)b * SEQ + kt * 64 + kr) * 512 + h * 64 + c * 8);
                    LAS float* d = Vs + kr * 64 + c * 8; d[0] = bflo(w.x); d[1] = bfhi(w.x); d[2] = bflo(w.y); d[3] = bfhi(w.y); d[4] = bflo(w.z); d[5] = bfhi(w.z); d[6] = bflo(w.w); d[7] = bfhi(w.w); }
                __syncthreads();
                const int kbase = kt * 64;
                if (kbase <= qpos) {
                    for (int j = 0; j < 64; ++j) {
                        if (kbase + j <= qpos) {
                            float s = 0.f;
#pragma unroll
                            for (int d = 0; d < 96; ++d) s += q[d] * Ks[j * 96 + d];
                            if (s > mx) { const float a = exp2f(mx - s); l *= a;
#pragma unroll
                                for (int d = 0; d < 64; ++d) o[d] *= a;
                                mx = s; }
                            const float p = exp2f(s - mx); l += p;
#pragma unroll
                            for (int d = 0; d < 64; ++d) o[d] += p * Vs[j * 64 + d];
                        }
                    }
                }
            }
            const float il = 1.0f / l;
#pragma unroll
            for (int c = 0; c < 8; ++c) { v4u w; w.x = pk2(o[c * 8 + 0] * il, o[c * 8 + 1] * il); w.y = pk2(o[c * 8 + 2] * il, o[c * 8 + 3] * il); w.z = pk2(o[c * 8 + 4] * il, o[c * 8 + 5] * il); w.w = pk2(o[c * 8 + 6] * il, o[c * 8 + 7] * il);
                *(v4u*)(YA + qrow * 512 + h * 64 + c * 8) = w; }
        }
    }
    __syncthreads();
}

__device__ __forceinline__ void dil_naive_phase(Frame& F, const u16* DQ, const u16* DK, const u16* DV, u16* YC) {
    for (int idx = F.bid * NTHR + F.tid; idx < NTOK * 8; idx += F.G * NTHR) {
        const int h = idx & 7, row = idx >> 3, b = row / SEQ, pos = row % SEQ;
        float q[64], o[64];
#pragma unroll
        for (int c = 0; c < 8; ++c) { const v4u w = *(const v4u*)(DQ + (size_t)row * 512 + h * 64 + c * 8); q[c * 8 + 0] = bflo(w.x); q[c * 8 + 1] = bfhi(w.x); q[c * 8 + 2] = bflo(w.y); q[c * 8 + 3] = bfhi(w.y); q[c * 8 + 4] = bflo(w.z); q[c * 8 + 5] = bfhi(w.z); q[c * 8 + 6] = bflo(w.w); q[c * 8 + 7] = bfhi(w.w); }
#pragma unroll
        for (int d = 0; d < 64; ++d) o[d] = 0.f;
        float mx = -1e30f, l = 0.f;
        for (int pt = 0; pt < 3; ++pt) {
            const int r = pt == 0 ? 1 : (pt == 1 ? 4 : 16);
            for (int j = 0; j <= 128; ++j) {
                const int tk = pos - j * r; if (tk < 0) break;
                const size_t kro = ((size_t)b * SEQ + tk) * 512 + h * 64;
                float s = 0.f;
#pragma unroll
                for (int c = 0; c < 8; ++c) { const v4u w = *(const v4u*)(DK + kro + c * 8);
                    s += q[c * 8 + 0] * bflo(w.x) + q[c * 8 + 1] * bfhi(w.x) + q[c * 8 + 2] * bflo(w.y) + q[c * 8 + 3] * bfhi(w.y) + q[c * 8 + 4] * bflo(w.z) + q[c * 8 + 5] * bfhi(w.z) + q[c * 8 + 6] * bflo(w.w) + q[c * 8 + 7] * bfhi(w.w); }
                if (s > mx) { const float a = exp2f(mx - s); l *= a;
#pragma unroll
                    for (int d = 0; d < 64; ++d) o[d] *= a;
                    mx = s; }
                const float p = exp2f(s - mx); l += p;
#pragma unroll
                for (int c = 0; c < 8; ++c) { const v4u w = *(const v4u*)(DV + kro + c * 8);
                    o[c * 8 + 0] += p * bflo(w.x); o[c * 8 + 1] += p * bfhi(w.x); o[c * 8 + 2] += p * bflo(w.y); o[c * 8 + 3] += p * bfhi(w.y); o[c * 8 + 4] += p * bflo(w.z); o[c * 8 + 5] += p * bfhi(w.z); o[c * 8 + 6] += p * bflo(w.w); o[c * 8 + 7] += p * bfhi(w.w); }
            }
        }
        const float il = 1.0f / l;
#pragma unroll
        for (int c = 0; c < 8; ++c) { v4u w; w.x = pk2(o[c * 8 + 0] * il, o[c * 8 + 1] * il); w.y = pk2(o[c * 8 + 2] * il, o[c * 8 + 3] * il); w.z = pk2(o[c * 8 + 4] * il, o[c * 8 + 5] * il); w.w = pk2(o[c * 8 + 6] * il, o[c * 8 + 7] * il);
            *(v4u*)(YC + (size_t)row * 512 + h * 64 + c * 8) = w; }
    }
}

__device__ __forceinline__ void stage_conv(LAS float* dst  , const u16* MQK, size_t row0, int pos0, int ch0, const float* cw, const float* cb, float scale, int tid) {
    const int d = tid & 63, sg = tid >> 6, ch = ch0 + d;
    const float w0 = cw[ch], w1 = cw[512 + ch], w2 = cw[1024 + ch], w3 = cw[1536 + ch], bb = cb[ch];
    float x[11];
#pragma unroll
    for (int i = 0; i < 11; ++i) { const int s = sg * 8 - 3 + i; x[i] = (pos0 + s >= 0) ? bf1(MQK[(size_t)((long)row0 + s) * 512 + ch]) : 0.f; }
#pragma unroll
    for (int i = 0; i < 8; ++i) { const float y = bb + w0 * x[i] + w1 * x[i + 1] + w2 * x[i + 2] + w3 * x[i + 3]; dst[(sg * 8 + i) * 65 + d] = fsilu(y) * scale; }
}
__device__ __forceinline__ float wave_incl_scan_add(float v, int lane) {
#pragma unroll
    for (int o = 1; o < 64; o <<= 1) { const float t = bperm_f(lane >= o ? lane - o : lane, v); if (lane >= o) v += t; }
    return v;
}
__device__ __forceinline__ float wave_incl_scan_max(float v, int lane) {
#pragma unroll
    for (int o = 1; o < 64; o <<= 1) { const float t = bperm_f(lane >= o ? lane - o : lane, v); if (lane >= o) v = fmaxf(v, t); }
    return v;
}
__device__ __forceinline__ float wave_max(float v, int lane) {
#pragma unroll
    for (int o = 1; o < 64; o <<= 1) v = fmaxf(v, bperm_f(lane ^ o, v));
    return v;
}
__device__ __forceinline__ void mlstm_a_phase(Frame& F, const u16* MQK, const u16* MV, const float* IF, const float* cw, const float* cb, float* ST) {
    LAS float* Ks = (LAS float*)F.lds;
    LAS float* Vs = Ks + 64 * 65;
    LAS float* ws = Vs + 64 * 128;
    float* mloc = (float*)(F.ws + WS_MLS); float* bend = mloc + 2048; float* nst = (float*)(F.ws + WS_MLS + 65536);
    const int tid = F.tid;
    for (int u = F.bid; u < 2048; u += F.G) {
        const int bh = u >> 8, c = u & 255, b = bh >> 2, h = bh & 3, pos0 = c * 64; const size_t row0 = (size_t)b * SEQ + pos0;
        __syncthreads();
        stage_conv(Ks, MQK, row0, pos0, 256 + h * 64, cw, cb, 0.125f, tid);
        for (int e = tid; e < 64 * 16; e += NTHR) { const int s = e >> 4, cc = e & 15; const v4u w = *(const v4u*)(MV + (row0 + s) * 512 + h * 128 + cc * 8);
            LAS float* d = Vs + s * 128 + cc * 8; d[0] = bflo(w.x); d[1] = bfhi(w.x); d[2] = bflo(w.y); d[3] = bfhi(w.y); d[4] = bflo(w.z); d[5] = bfhi(w.z); d[6] = bflo(w.w); d[7] = bfhi(w.w); }
        if (tid < 64) { const float ig = IF[(row0 + tid) * 8 + h], lf = IF[(row0 + tid) * 8 + 4 + h];
            const float bs = wave_incl_scan_add(lf, tid), be = bperm_f(63, bs);
            const float wl = be - bs + ig, ml = wave_max(wl, tid);
            ws[tid] = __expf(wl - ml);
            if (tid == 0) { mloc[u] = ml; bend[u] = be; } }
        __syncthreads();
        const int d = tid >> 3, vg = tid & 7;
        float acc[16]; float an = 0.f;
#pragma unroll
        for (int i = 0; i < 16; ++i) acc[i] = 0.f;
        for (int s = 0; s < 64; ++s) { const float kw = Ks[s * 65 + d] * ws[s]; an += kw;
            const LAS f32x4* vp = (const LAS f32x4*)(Vs + s * 128 + vg * 16);
#pragma unroll
            for (int i = 0; i < 4; ++i) { const f32x4 vv = vp[i]; acc[4 * i + 0] += kw * vv.x; acc[4 * i + 1] += kw * vv.y; acc[4 * i + 2] += kw * vv.z; acc[4 * i + 3] += kw * vv.w; } }
        float* o = ST + (size_t)u * 8192 + d * 128 + vg * 16;
#pragma unroll
        for (int i = 0; i < 4; ++i) *(f32x4*)(o + 4 * i) = (f32x4){acc[4 * i], acc[4 * i + 1], acc[4 * i + 2], acc[4 * i + 3]};
        if (vg == 0) nst[(size_t)u * 64 + d] = an;
    }
    __syncthreads();
}
__device__ __forceinline__ void mlstm_b_phase(Frame& F, float* ST) {
    const float* mloc = (const float*)(F.ws + WS_MLS); const float* bend = mloc + 2048; float* mprev = (float*)(F.ws + WS_MLS) + 4096; float* nst = (float*)(F.ws + WS_MLS + 65536);
    for (int gt = F.bid * NTHR + F.tid; gt < 8 * 8256; gt += F.G * NTHR) {
        const int bh = gt / 8256, e = gt % 8256;
        float* p; int stride;
        if (e < 8192) { p = ST + (size_t)bh * 256 * 8192 + e; stride = 8192; } else { p = nst + (size_t)bh * 256 * 64 + (e - 8192); stride = 64; }
        float C = 0.f, m = 0.f;
        for (int c0 = 0; c0 < 256; c0 += 8) {
            float val[8];
#pragma unroll
            for (int i = 0; i < 8; ++i) val[i] = p[(size_t)(c0 + i) * stride];
#pragma unroll
            for (int i = 0; i < 8; ++i) { const int c = c0 + i; const float be = bend[bh * 256 + c], ml = mloc[bh * 256 + c];
                p[(size_t)c * stride] = C; if (e == 0) mprev[bh * 256 + c] = m;
                const float mn = fmaxf(be + m, ml); C = __expf(be + m - mn) * C + __expf(ml - mn) * val[i]; m = mn; }
        }
    }
}
__device__ __forceinline__ void mlstm_c_phase(Frame& F, const u16* MQK, const u16* MV, const u16* MO, const float* IF, const float* cw, const float* cb, const float* hg, const float* ST, u16* YB) {
    LAS float* Qs = (LAS float*)F.lds;
    LAS float* Ks = Qs + 64 * 65;
    LAS float* Vs = Ks + 64 * 65;
    LAS float* Cs = Vs + 64 * 128;
    LAS float* Ss = Cs + 64 * 128;
    LAS float* bsv = Ss + 64 * 65;
    LAS float* gsv = bsv + 64;
    LAS float* mtv = gsv + 64;
    LAS float* dcv = mtv + 64;
    LAS float* npv = dcv + 64;
    const float* mprev = (const float*)(F.ws + WS_MLS) + 4096; const float* nst = (const float*)(F.ws + WS_MLS + 65536);
    const int tid = F.tid;
    for (int u = F.bid; u < 2048; u += F.G) {
        const int bh = u >> 8, c = u & 255, b = bh >> 2, h = bh & 3, pos0 = c * 64; const size_t row0 = (size_t)b * SEQ + pos0;
        __syncthreads();
        stage_conv(Qs, MQK, row0, pos0, h * 64, cw, cb, 1.0f, tid);
        stage_conv(Ks, MQK, row0, pos0, 256 + h * 64, cw, cb, 0.125f, tid);
        for (int e = tid; e < 64 * 16; e += NTHR) { const int s = e >> 4, cc = e & 15; const v4u w = *(const v4u*)(MV + (row0 + s) * 512 + h * 128 + cc * 8);
            LAS float* d = Vs + s * 128 + cc * 8; d[0] = bflo(w.x); d[1] = bfhi(w.x); d[2] = bflo(w.y); d[3] = bfhi(w.y); d[4] = bflo(w.z); d[5] = bfhi(w.z); d[6] = bflo(w.w); d[7] = bfhi(w.w); }
        for (int e = tid; e < 2048; e += NTHR) ((LAS f32x4*)Cs)[e] = ((const f32x4*)(ST + (size_t)u * 8192))[e];
        if (tid < 64) { const float ig = IF[(row0 + tid) * 8 + h], lf = IF[(row0 + tid) * 8 + 4 + h], m = mprev[u];
            const float bs = wave_incl_scan_add(lf, tid), gs = ig - bs, gmx = wave_incl_scan_max(gs, tid);
            const float inter = bs + m, mt = fmaxf(inter, bs + gmx);
            bsv[tid] = bs; gsv[tid] = gs; mtv[tid] = mt; dcv[tid] = __expf(inter - mt); npv[tid] = nst[(size_t)u * 64 + tid]; }
        __syncthreads();
        const int t = tid >> 3, g8 = tid & 7;
        float den;
        {   float sa[8]; float qn = 0.f;
#pragma unroll
            for (int i = 0; i < 8; ++i) sa[i] = 0.f;
            for (int d = 0; d < 64; ++d) { const float qv = Qs[t * 65 + d]; qn += qv * npv[d];
#pragma unroll
                for (int i = 0; i < 8; ++i) sa[i] += qv * Ks[(g8 * 8 + i) * 65 + d]; }
            const float bt = bsv[t], mt = mtv[t]; float rs = 0.f;
#pragma unroll
            for (int i = 0; i < 8; ++i) { const int s = g8 * 8 + i; const float sc = (s <= t) ? sa[i] * __expf(bt + gsv[s] - mt) : 0.f; Ss[t * 65 + s] = sc; rs += sc; }
            { const int ln_ = tid & 63; rs += bperm_f(ln_ ^ 1, rs); rs += bperm_f(ln_ ^ 2, rs); rs += bperm_f(ln_ ^ 4, rs); }
            den = dcv[t] * qn + rs;
        }
        __syncthreads();
        float acc[16];
#pragma unroll
        for (int i = 0; i < 16; ++i) acc[i] = 0.f;
        { const float dc = dcv[t];
            for (int d = 0; d < 64; ++d) { const float qd = Qs[t * 65 + d] * dc; const LAS f32x4* cp = (const LAS f32x4*)(Cs + d * 128 + g8 * 16);
#pragma unroll
                for (int i = 0; i < 4; ++i) { const f32x4 vv = cp[i]; acc[4 * i + 0] += qd * vv.x; acc[4 * i + 1] += qd * vv.y; acc[4 * i + 2] += qd * vv.z; acc[4 * i + 3] += qd * vv.w; } }
            for (int s = 0; s < 64; ++s) { const float p = Ss[t * 65 + s]; const LAS f32x4* vp = (const LAS f32x4*)(Vs + s * 128 + g8 * 16);
#pragma unroll
                for (int i = 0; i < 4; ++i) { const f32x4 vv = vp[i]; acc[4 * i + 0] += p * vv.x; acc[4 * i + 1] += p * vv.y; acc[4 * i + 2] += p * vv.z; acc[4 * i + 3] += p * vv.w; } } }
        const float inv = 1.0f / fmaxf(fabsf(den), __expf(-mtv[t]));
        float ss = 0.f;
#pragma unroll
        for (int i = 0; i < 16; ++i) { acc[i] *= inv; ss += acc[i] * acc[i]; }
        { const int ln_ = tid & 63; ss += bperm_f(ln_ ^ 1, ss); ss += bperm_f(ln_ ^ 2, ss); ss += bperm_f(ln_ ^ 4, ss); }
        const float rstd = 1.0f / sqrtf(ss * (1.f / 128.f) + EPS);
        const size_t ob = (row0 + t) * 512 + h * 128 + g8 * 16;
#pragma unroll
        for (int j = 0; j < 2; ++j) { const v4u mo = *(const v4u*)(MO + ob + j * 8); const float* gp = hg + h * 128 + g8 * 16 + j * 8;
            float y[8];
#pragma unroll
            for (int i = 0; i < 8; ++i) y[i] = acc[j * 8 + i] * rstd * gp[i];
            y[0] *= bflo(mo.x); y[1] *= bfhi(mo.x); y[2] *= bflo(mo.y); y[3] *= bfhi(mo.y); y[4] *= bflo(mo.z); y[5] *= bfhi(mo.z); y[6] *= bflo(mo.w); y[7] *= bfhi(mo.w);
            v4u w; w.x = pk2(y[0], y[1]); w.y = pk2(y[2], y[3]); w.z = pk2(y[4], y[5]); w.w = pk2(y[6], y[7]);
            *(v4u*)(YB + ob + j * 8) = w; }
    }
    __syncthreads();
}

__device__ __forceinline__ void router_phase(Frame& F, const float* x, const float* gain, const float* modl, const float* wrg, const float* brg, const float* wre, const float* bre, u32* cnt) {
    const int gw = F.bid * NWAVES + F.wave, NGW = F.G * NWAVES, lane = F.lane;
    int* cls_o = (int*)(F.ws + WS_ROUT); int* slot_o = cls_o + NTOK; float* wa_o = (float*)(slot_o + NTOK); float* wb_o = wa_o + NTOK; float* rstd_o = wb_o + NTOK;
    for (int m = gw; m < NTOK; m += NGW) {
        const int b = m / SEQ;
        const f32x4* xr = (const f32x4*)(x + (size_t)m * DM) + lane;
        f32x4 v[4]; float s = 0.f;
#pragma unroll
        for (int j = 0; j < 4; ++j) { v[j] = xr[64 * j]; s += (v[j].x * v[j].x + v[j].y * v[j].y) + (v[j].z * v[j].z + v[j].w * v[j].w); }
        const float rstd = 1.0f / sqrtf(wave_sum(s, lane) * (1.f / DM) + EPS);
        LAS float* hrow = (LAS float*)(F.lds + F.wave * 4096 + 0);
#pragma unroll
        for (int j = 0; j < 4; ++j) { const int c0 = 4 * lane + 256 * j;
            const f32x4 g = *(const f32x4*)(gain + c0), sc = *(const f32x4*)(modl + (size_t)(b * 6 + 4) * 1024 + c0), sh = *(const f32x4*)(modl + (size_t)(b * 6 + 3) * 1024 + c0);
            *(LAS f32x4*)(hrow + c0) = (v[j] * rstd) * g * (sc + 1.0f) + sh; }
        LDS_WAIT(); asm volatile("" ::: "memory");
        float part = 0.f;
        { const int jj = lane % 20, pp = lane / 20; const int cb = pp * 342, ce = pp == 2 ? 1024 : cb + 342;
            if (lane < 60) { const float* wp = jj < 4 ? wrg + jj : wre + (jj - 4); const int ws_ = jj < 4 ? 4 : 16;
                for (int c = cb; c < ce; ++c) part += hrow[c] * wp[(size_t)c * ws_]; } }
        part += bperm_f(lane + 20 < 64 ? lane + 20 : lane, part) * (lane < 20 ? 1.f : 0.f) + 0.f;
        LAS float* lgs = hrow;
        { const float p2 = bperm_f(lane + 40 < 64 ? lane + 40 : lane, part); asm volatile("" ::: "memory"); if (lane < 20) lgs[lane] = part + p2; }
        LDS_WAIT(); asm volatile("" ::: "memory");
        float lg[20];
        if (lane == 0) {
#pragma unroll
            for (int i = 0; i < 20; ++i) lg[i] = lgs[i]; }
        LDS_WAIT(); asm volatile("" ::: "memory");
        if (lane == 0) {
            float g0 = lg[0] + brg[0], g1 = lg[1] + brg[1], g2 = lg[2] + brg[2], g3 = lg[3] + brg[3];
            int gi = 0; float gm = g0; if (g1 > gm) { gm = g1; gi = 1; } if (g2 > gm) { gm = g2; gi = 2; } if (g3 > gm) { gm = g3; gi = 3; }
            const float psel = 1.0f / (expf(g0 - gm) + expf(g1 - gm) + expf(g2 - gm) + expf(g3 - gm));
            float e0, e1, e2, e3;
            if (gi == 0) { e0 = lg[4]; e1 = lg[5]; e2 = lg[6]; e3 = lg[7]; } else if (gi == 1) { e0 = lg[8]; e1 = lg[9]; e2 = lg[10]; e3 = lg[11]; }
            else if (gi == 2) { e0 = lg[12]; e1 = lg[13]; e2 = lg[14]; e3 = lg[15]; } else { e0 = lg[16]; e1 = lg[17]; e2 = lg[18]; e3 = lg[19]; }
            e0 += bre[gi * 4 + 0]; e1 += bre[gi * 4 + 1]; e2 += bre[gi * 4 + 2]; e3 += bre[gi * 4 + 3];
            int i1 = 0; float v1 = e0; if (e1 > v1) { v1 = e1; i1 = 1; } if (e2 > v1) { v1 = e2; i1 = 2; } if (e3 > v1) { v1 = e3; i1 = 3; }
            int i2 = -1; float v2 = 0.f;
            if (i1 != 0) { v2 = e0; i2 = 0; }
            if (i1 != 1 && (i2 < 0 || e1 > v2)) { v2 = e1; i2 = 1; }
            if (i1 != 2 && (i2 < 0 || e2 > v2)) { v2 = e2; i2 = 2; }
            if (i1 != 3 && (i2 < 0 || e3 > v2)) { v2 = e3; i2 = 3; }
            const float ex = expf(v2 - v1), w1 = psel / (1.0f + ex), w2 = psel * ex / (1.0f + ex);
            const int a = i1 < i2 ? i1 : i2, bb = i1 < i2 ? i2 : i1;
            const int pair = a == 0 ? bb - 1 : (a == 1 ? bb + 1 : 5);
            const int cls = gi * 6 + pair;
            const u32 sl = __hip_atomic_fetch_add(cnt + cls, 1u, __ATOMIC_RELAXED, __HIP_MEMORY_SCOPE_AGENT);
            cls_o[m] = cls; slot_o[m] = (int)sl; wa_o[m] = i1 < i2 ? w1 : w2; wb_o[m] = i1 < i2 ? w2 : w1; rstd_o[m] = rstd;
        }
    }
}
__device__ __forceinline__ void moe_table(Frame& F, const u32* cnt) {
    LAS int* tab = (LAS int*)(F.lds + TAB_OFF);
    if (F.tid == 0) { int rt = 0;
        for (int c = 0; c < 24; ++c) { const int n = (int)__hip_atomic_load(cnt + c, __ATOMIC_RELAXED, __HIP_MEMORY_SCOPE_AGENT); const int nt = (n + 255) >> 8; tab[256 + c] = rt * 256; for (int i = 0; i < nt; ++i) tab[1 + rt + i] = c; rt += nt; }
        tab[0] = rt; }
    __syncthreads();
}
__device__ __forceinline__ void moe_units(Frame& F, int mode) {
    LAS int* tab = (LAS int*)(F.lds + TAB_OFF); LAS int* ul = tab + 320;
    if (F.tid == 0) { const int nrt = tab[0]; int n = 0;
        for (int L = F.bid; L < nrt * 4; L += F.G) { const int rt = L >> 2, pn = L & 3, cls = tab[1 + rt]; int pb;
            if (mode == 0) { int ea, eb; cls_experts(cls, ea, eb); pb = ((pn >> 1) ? eb : ea) * 2 + (pn & 1); } else pb = cls * 4 + pn;
            ul[1 + n] = rt | (pn << 8) | (pb << 16); ++n; }
        ul[0] = n; }
    __syncthreads();
}
__device__ __forceinline__ void scatter_phase(Frame& F, const float* x, const float* gain, const float* modl, const u32* cnt, u16* HS) {
    moe_table(F, cnt);
    const LAS int* tab = (const LAS int*)(F.lds + TAB_OFF);
    const int gw = F.bid * NWAVES + F.wave, NGW = F.G * NWAVES, lane = F.lane;
    const int* cls_o = (const int*)(F.ws + WS_ROUT); const int* slot_o = cls_o + NTOK; const float* wa_o = (const float*)(slot_o + NTOK); const float* wb_o = wa_o + NTOK; const float* rstd_o = wb_o + NTOK;
    int* tok = (int*)(F.ws + WS_TOK); float* wrow = (float*)(F.ws + WS_TOK + 262144);
    for (int c = F.bid; c < 24; c += F.G) { const int n = (int)__hip_atomic_load(cnt + c, __ATOMIC_RELAXED, __HIP_MEMORY_SCOPE_AGENT); const int base = tab[256 + c], end = base + (((n + 255) >> 8) << 8);
        for (int r = base + n + F.tid; r < end; r += NTHR) { tok[r] = -1; wrow[2 * r] = 0.f; wrow[2 * r + 1] = 0.f; } }
    for (int m = gw; m < NTOK; m += NGW) {
        const int b = m / SEQ; const int pos = tab[256 + cls_o[m]] + slot_o[m]; const float rstd = rstd_o[m];
        const f32x4* xr = (const f32x4*)(x + (size_t)m * DM) + lane;
        v2u* o8 = (v2u*)(HS + (size_t)pos * DM) + lane;
#pragma unroll
        for (int j = 0; j < 4; ++j) { const int c0 = 4 * lane + 256 * j; const f32x4 v = xr[64 * j];
            const f32x4 g = *(const f32x4*)(gain + c0), sc = *(const f32x4*)(modl + (size_t)(b * 6 + 4) * 1024 + c0), sh = *(const f32x4*)(modl + (size_t)(b * 6 + 3) * 1024 + c0);
            const f32x4 y = (v * rstd) * g * (sc + 1.0f) + sh;
            v2u w; w.x = pk2(y.x, y.y); w.y = pk2(y.z, y.w); o8[64 * j] = w; }
        if (lane == 0) { tok[pos] = m; wrow[2 * pos] = wa_o[m]; wrow[2 * pos + 1] = wb_o[m]; }
    }
}

typedef float f32x16 __attribute__((ext_vector_type(16)));
typedef short s16x8 __attribute__((ext_vector_type(8)));
typedef short s16x4 __attribute__((ext_vector_type(4)));
#if MK_F16
#define MFMA32(a, b, c) __builtin_amdgcn_mfma_f32_32x32x16_f16(__builtin_bit_cast(pg8::h16x8, (a)), __builtin_bit_cast(pg8::h16x8, (b)), (c), 0, 0, 0)
#else
#define MFMA32(a, b, c) __builtin_amdgcn_mfma_f32_32x32x16_bf16((a), (b), (c), 0, 0, 0)
#endif
__device__ __forceinline__ int crow(int r, int hi) { return (r & 3) + 8 * (r >> 2) + 4 * hi; }
__device__ __forceinline__ void gl_lds16(const void* g, LAS unsigned char* l) { __builtin_amdgcn_global_load_lds((const unsigned*)g, (LAS unsigned*)l, 16, 0, 0); }
__device__ __forceinline__ s16x4 vtr16(const LAS unsigned char* p) { typedef short v4i16_t __attribute__((ext_vector_type(4))); return __builtin_bit_cast(s16x4, __builtin_amdgcn_ds_read_tr16_b64_v4i16((LAS v4i16_t*)p)); }
__device__ __forceinline__ float swapmax(float m) { auto rr = __builtin_amdgcn_permlane32_swap(__float_as_uint(m), __float_as_uint(m), false, false); return fmaxf(__uint_as_float(rr[0]), __uint_as_float(rr[1])); }
__device__ __forceinline__ float swapsum(float m) { auto rr = __builtin_amdgcn_permlane32_swap(__float_as_uint(m), __float_as_uint(m), false, false); return __uint_as_float(rr[0]) + __uint_as_float(rr[1]); }
constexpr int MA_KSLOT = 12288, MA_VSLOT = 8192, MA_V0 = 2 * MA_KSLOT, MA_WS = MA_V0 + 2 * MA_VSLOT, MA_OST = MA_WS + 2048, MA_BYTES = MA_OST + 8 * 4096;
__device__ __forceinline__ void mla_attn_unit(LAS unsigned char* lds, int tid, int wid, const u16* Q, const u16* K, const u16* V, u16* O, int b, int h, int qb) {
    const int lane = tid & 63, r32 = lane & 31, hi = lane >> 5;
    const size_t rowb = (size_t)b * SEQ; const int q0 = qb * 256;
    const u16* Qw = Q + (rowb + q0 + wid * 32) * 768 + h * 96;
    const u16* ksrc1 = K + (rowb + lane) * 768 + h * 96 + wid * 8;
    const u16* ksrc2 = K + (rowb + lane) * 768 + h * 96 + (8 + (wid & 3)) * 8;
    const u16* vsrc = V + (rowb + 16 * (wid & 3) + (lane >> 2)) * 512 + h * 64 + (wid >> 2) * 32 + (lane & 3) * 8;
    LAS float* wsf = (LAS float*)(lds + MA_WS) + wid * 64;
    const int NT = (q0 + 256) / 64;
#define MA_DMA(t, s) do { gl_lds16(ksrc1 + (size_t)(t) * 64 * 768, lds + (s) * MA_KSLOT + wid * 1024); gl_lds16(ksrc2 + (size_t)(t) * 64 * 768, lds + (s) * MA_KSLOT + (8 + (wid & 3)) * 1024); \
                           gl_lds16(vsrc + (size_t)(t) * 64 * 512, lds + MA_V0 + (s) * MA_VSLOT + wid * 1024); } while (0)
    MA_DMA(0, 0);
    s16x8 qr[6];
#pragma unroll
    for (int d0 = 0; d0 < 6; ++d0) qr[d0] = *(const s16x8*)(Qw + (size_t)r32 * 768 + d0 * 16 + hi * 8);
    float mref = 0.f, l = 0.f; f32x16 o0, o1;
#pragma unroll
    for (int r = 0; r < 16; ++r) { o0[r] = 0.f; o1[r] = 0.f; }
    const int qg = q0 + wid * 32 + r32;
    const int kfo = hi * 1024 + r32 * 16;
    const int vfo = ((lane >> 4) & 1) * 32 + (lane & 3) * 8 + (4 * hi + ((lane & 15) >> 2)) * 64;
    asm volatile("s_waitcnt vmcnt(0)" ::: "memory"); __builtin_amdgcn_s_barrier(); asm volatile("" ::: "memory");
    for (int t = 0; t < NT; ++t) {
        const int s = t & 1;
        if (t + 1 < NT) MA_DMA(t + 1, s ^ 1);
        const LAS unsigned char* kp = lds + s * MA_KSLOT + kfo; const LAS unsigned char* vp = lds + MA_V0 + s * MA_VSLOT + vfo;
        f32x16 p0, p1;
#pragma unroll
        for (int r = 0; r < 16; ++r) { p0[r] = 0.f; p1[r] = 0.f; }
#pragma unroll
        for (int d0 = 0; d0 < 6; ++d0) { const s16x8 a0 = *(const LAS s16x8*)(kp + d0 * 2048), a1 = *(const LAS s16x8*)(kp + d0 * 2048 + 512);
            p0 = MFMA32(a0, qr[d0], p0); p1 = MFMA32(a1, qr[d0], p1); }
        if (t >= NT - 4) { const int kb = t * 64 + 4 * hi;
#pragma unroll
            for (int r = 0; r < 16; ++r) { const int kv = kb + (r & 3) + 8 * (r >> 2); if (kv > qg) p0[r] = -INFINITY; if (kv + 32 > qg) p1[r] = -INFINITY; } }
        float rm = fmaxf(p0[0], p1[0]);
#pragma unroll
        for (int r = 1; r < 16; ++r) rm = fmaxf(rm, fmaxf(p0[r], p1[r]));
        rm = swapmax(rm);
        if (t == 0) mref = rm;
        else { const float dl = rm - mref;
            if (__any(dl > 8.f)) { const float d2 = fmaxf(dl, 0.f), f = exp2f(-d2); mref += d2; l *= f; if (hi == 0) wsf[r32] = f;
                asm volatile("s_waitcnt lgkmcnt(0)" ::: "memory");
#pragma unroll
                for (int r = 0; r < 16; ++r) { const float fr = wsf[crow(r, hi)]; o0[r] *= fr; o1[r] *= fr; } } }
        float sacc = 0.f;
#pragma unroll
        for (int r = 0; r < 16; ++r) { p0[r] = exp2f(p0[r] - mref); p1[r] = exp2f(p1[r] - mref); sacc += p0[r] + p1[r]; }
        l += sacc;
        v4u pw[4];
        pw[0] = (v4u){pk2(p0[0], p0[1]), pk2(p0[2], p0[3]), pk2(p0[4], p0[5]), pk2(p0[6], p0[7])};
        pw[1] = (v4u){pk2(p0[8], p0[9]), pk2(p0[10], p0[11]), pk2(p0[12], p0[13]), pk2(p0[14], p0[15])};
        pw[2] = (v4u){pk2(p1[0], p1[1]), pk2(p1[2], p1[3]), pk2(p1[4], p1[5]), pk2(p1[6], p1[7])};
        pw[3] = (v4u){pk2(p1[8], p1[9]), pk2(p1[10], p1[11]), pk2(p1[12], p1[13]), pk2(p1[14], p1[15])};
#pragma unroll
        for (int ks = 0; ks < 4; ++ks) { const s16x8 pa = __builtin_bit_cast(s16x8, pw[ks]);
            { const s16x4 lo = vtr16(vp + ks * 1024), hh = vtr16(vp + ks * 1024 + 512); const s16x8 vf = {lo[0], lo[1], lo[2], lo[3], hh[0], hh[1], hh[2], hh[3]}; o0 = MFMA32(pa, vf, o0); }
            { const s16x4 lo = vtr16(vp + 4096 + ks * 1024), hh = vtr16(vp + 4096 + ks * 1024 + 512); const s16x8 vf = {lo[0], lo[1], lo[2], lo[3], hh[0], hh[1], hh[2], hh[3]}; o1 = MFMA32(pa, vf, o1); } }
        asm volatile("s_waitcnt vmcnt(0) lgkmcnt(0)" ::: "memory"); __builtin_amdgcn_s_barrier(); asm volatile("" ::: "memory");
    }
#undef MA_DMA
    l = swapsum(l);
    if (hi == 0) wsf[32 + r32] = l;
    asm volatile("s_waitcnt lgkmcnt(0)" ::: "memory");
    LAS u16* stg = (LAS u16*)(lds + MA_OST) + wid * 2048;
#pragma unroll
    for (int r = 0; r < 16; ++r) { const int orow = crow(r, hi); const float rl = 1.0f / wsf[32 + orow];
        const u32 w = pk2(o0[r] * rl, o1[r] * rl); stg[orow * 64 + r32] = (u16)(w & 0xffffu); stg[orow * 64 + 32 + r32] = (u16)(w >> 16); }
    asm volatile("s_waitcnt lgkmcnt(0)" ::: "memory");
    u16* Ow = O + (rowb + q0 + wid * 32) * 512 + h * 64;
#pragma unroll
    for (int i = 0; i < 4; ++i) { const int row = i * 8 + (lane >> 3), ch = lane & 7; const v4u v = *(const LAS v4u*)(stg + row * 64 + ch * 8); *(v4u*)(Ow + (size_t)row * 512 + ch * 8) = v; }
    asm volatile("s_waitcnt lgkmcnt(0)" ::: "memory"); __builtin_amdgcn_s_barrier(); asm volatile("" ::: "memory");
}
__device__ __forceinline__ void mla_attn_phase(Frame& F, const u16* Q, const u16* K, const u16* V, u16* YA) {
    for (int v = F.bid; v < 256; v += F.G) { const int bh = v >> 4, s = v & 15, b = bh >> 3, h = bh & 7;
#pragma unroll 1
        for (int i = 0; i < 4; ++i) { const int qb = i == 0 ? s : (i == 1 ? 31 - s : (i == 2 ? 32 + s : 63 - s)); mla_attn_unit(F.lds, F.tid, F.wave, Q, K, V, YA, b, h, qb); } }
}

#if MK_CHECK
constexpr int CW_CHK = 32768, NCHK = 25, CHK_BLOCKS = 48;
__device__ __forceinline__ float blk_sum(float v, float* sh) {
    __syncthreads(); sh[threadIdx.x] = v; __syncthreads();
    for (int o = 128; o > 0; o >>= 1) { if ((int)threadIdx.x < o) sh[threadIdx.x] += sh[threadIdx.x + o]; __syncthreads(); }
    const float r = sh[0]; __syncthreads(); return r;
}
__device__ __forceinline__ float blk_max(float v, float* sh) {
    __syncthreads(); sh[threadIdx.x] = v; __syncthreads();
    for (int o = 128; o > 0; o >>= 1) { if ((int)threadIdx.x < o) sh[threadIdx.x] = fmaxf(sh[threadIdx.x], sh[threadIdx.x + o]); __syncthreads(); }
    const float r = sh[0]; __syncthreads(); return r;
}
__device__ __forceinline__ unsigned hsh(unsigned a, unsigned b) { unsigned x = a * 2654435761u + b * 40503u + 12345u; x ^= x >> 15; x *= 2246822519u; x ^= x >> 13; x *= 3266489917u; x ^= x >> 16; return x; }
__device__ __forceinline__ void chk_report(u32* ctl, int k, float ratio) { if (threadIdx.x == 0) atomicMax(ctl + CW_CHK + k, __float_as_uint(fminf(fabsf(ratio) * MK_CHECK_TIGHT, 1e30f))); }
__device__ __forceinline__ float convsilu(const u16* MQK, size_t rowb  , int pos, int ch, const float* cw, const float* cb) {
    float y = cb[ch];
    for (int j = 0; j < 4; ++j) { const int p = pos - 3 + j; if (p >= 0) y += cw[j * 512 + ch] * bf1(MQK[(rowb + p) * 512 + ch]); }
    return y / (1.0f + expf(-y));
}
template <int K> __global__ void __launch_bounds__(256) chk(Params P) {
    __shared__ float sh[256]; __shared__ float big[12288];
    unsigned char* ws = P.ws; u32* ctl = (u32*)(ws + WS_CTL); const int tid = threadIdx.x, bk = blockIdx.x;
    const int l = P.ph_lo; const float* mod0 = (const float*)(ws + WS_MOD) + (size_t)l * 2 * 6144;
    const u16* U = (const u16*)(ws + ACT(0));
    if (K == 0) {
        const int row = hsh(bk, 1) % NTOK, col = hsh(bk, 2) % DM, b = row / SEQ; const float* x = (l == 0 ? P.in[0] : P.out) + (size_t)row * DM;
        float s = 0.f; for (int c = tid; c < DM; c += 256) s += x[c] * x[c];
        const float rstd = 1.0f / sqrtf(blk_sum(s, sh) / DM + EPS);
        const float e = x[col] * rstd * (P.in[4] + (size_t)l * (1024))[col] * (1.0f + mod0[(b * 6 + 1) * 1024 + col]) + mod0[(b * 6 + 0) * 1024 + col];
        chk_report(ctl, K, (bf1(U[(size_t)row * DM + col]) - e) / (0.01f * (fabsf(e) + 1.0f)));
    }
    if (K == 1 || K == 5) {
        const int row = hsh(bk, 3) % NTOK; int j;
        if (K == 1) { j = hsh(bk, 4) % 2472; if (j >= 1960) j += 1024; } else j = 3496 + hsh(bk, 4) % 3072;
        float s = 0.f; for (int k = tid; k < DM; k += 256) s += bf1(U[(size_t)row * DM + k]) * (P.in[5] + (size_t)l * (1024 * INW))[(size_t)k * INW + j];
        const float e = blk_sum(s, sh); float a, ee = e, tol;
        if (K == 5) { a = bf1(((const u16*)(ws + ACT(4)))[(size_t)row * 3072 + (j - 3496)]); ee = 1.0f / (1.0f + expf(-e)); tol = 0.02f; }
        else {
            tol = 0.03f * (fabsf(e) + 0.5f);
            if (j < 256) a = bf1(((const u16*)(ws + ACT(2)))[(size_t)row * 256 + j]);
            else if (j < 384) a = bf1(((const u16*)(ws + ACT(2) + 16 * MiB))[(size_t)row * 256 + (j - 256)]);
            else if (j < 416) a = bf1(((const u16*)(ws + ACT(2) + 16 * MiB))[(size_t)row * 256 + 128 + (j - 384)]);
            else if (j < 928) a = bf1(((const u16*)(ws + ACT(3)))[(size_t)row * 512 + (j - 416)]);
            else if (j < 1440) a = bf1(((const u16*)(ws + ACT(4)))[(size_t)row * 512 + (j - 928)]);
            else if (j < 1952) { a = bf1(((const u16*)(ws + ACT(5)))[(size_t)row * 512 + (j - 1440)]); ee = 1.0f / (1.0f + expf(-e)); tol = 0.02f; }
            else if (j < 1956) { a = ((const float*)(ws + WS_IF))[(size_t)row * 8 + (j - 1952)]; ee = e + (P.in[14] + (size_t)l * (4))[j - 1952]; }
            else if (j < 1960) { a = ((const float*)(ws + WS_IF))[(size_t)row * 8 + 4 + (j - 1956)]; const float z = e + (P.in[15] + (size_t)l * (4))[j - 1956]; ee = -log1pf(expf(-z)); tol = 0.05f * fabsf(ee) + 1e-3f; }
            else a = bf1(((const u16*)(ws + ACT(8)))[(size_t)row * 512 + (j - 2984)]);
        }
        chk_report(ctl, K, (a - ee) / tol);
    }
    if (K == 2) {
        const int row = hsh(bk, 5) % NTOK, isq = hsh(bk, 6) & 1, h = hsh(bk, 7) & 7; const int base = (isq ? 1960 : 2472) + h * 64;
        float d = 0.f; if (tid < 64) for (int k = 0; k < DM; ++k) d += bf1(U[(size_t)row * DM + k]) * (P.in[5] + (size_t)l * (1024 * INW))[(size_t)k * INW + base + tid];
        const float ss = blk_sum(tid < 64 ? d * d : 0.f, sh), rstd = 1.0f / sqrtf(ss / 64.f + EPS);
        float r = 0.f;
        if (tid < 64) { const float e = d * rstd * (isq ? (P.in[17] + (size_t)l * (64))[tid] * 0.125f * LOG2E : (P.in[18] + (size_t)l * (64))[tid]); const float a = bf1(((const u16*)(ws + ACT(isq ? 6 : 7)))[(size_t)row * 512 + h * 64 + tid]); r = fabsf(a - e) / (0.03f * (fabsf(e) + 0.3f)); }
        chk_report(ctl, K, blk_max(r, sh));
    }
    if (K == 3) {
        const int b = bk & 1, h = (bk >> 1) & 3, t = 5 + 41 * (bk >> 3); const size_t rowb = (size_t)b * SEQ;
        const u16* MQK = (const u16*)(ws + ACT(3)); const u16* MV = (const u16*)(ws + ACT(4)); const u16* MO = (const u16*)(ws + ACT(5)); const float* IF = (const float*)(ws + WS_IF);
        float C[64], n[64];
#pragma unroll
        for (int d = 0; d < 64; ++d) { C[d] = 0.f; n[d] = 0.f; }
        for (int s = 0; s <= t; ++s) {
            __syncthreads();
            if (tid < 64) sh[tid] = convsilu(MQK, rowb, s, 256 + h * 64 + tid, (P.in[12] + (size_t)l * (2048)), (P.in[13] + (size_t)l * (512))) * 0.125f;
            __syncthreads();
            const float f = expf(IF[(rowb + s) * 8 + 4 + h]), ii = expf(IF[(rowb + s) * 8 + h]);
            const float vv = tid < 128 ? bf1(MV[(rowb + s) * 512 + h * 128 + tid]) : 0.f;
#pragma unroll
            for (int d = 0; d < 64; ++d) { const float kk = sh[d]; C[d] = f * C[d] + ii * kk * vv; n[d] = f * n[d] + ii * kk; }
        }
        __syncthreads();
        if (tid < 64) sh[tid] = convsilu(MQK, rowb, t, h * 64 + tid, (P.in[12] + (size_t)l * (2048)), (P.in[13] + (size_t)l * (512)));
        __syncthreads();
        float num = 0.f, den = 0.f;
#pragma unroll
        for (int d = 0; d < 64; ++d) { num += C[d] * sh[d]; den += n[d] * sh[d]; }
        const float hv = tid < 128 ? num / fmaxf(fabsf(den), 1.0f) : 0.f;
        const float ss = blk_sum(hv * hv, sh), rstd = 1.0f / sqrtf(ss / 128.f + EPS);
        float r = 0.f;
        if (tid < 128) { const float e = hv * rstd * (P.in[16] + (size_t)l * (512))[h * 128 + tid] * bf1(MO[(rowb + t) * 512 + h * 128 + tid]); const float a = bf1(((const u16*)(ws + ACT(13)))[(rowb + t) * 512 + h * 128 + tid]); r = fabsf(a - e) / (0.03f * (fabsf(e) + 0.2f)); }
        chk_report(ctl, K, blk_max(r, sh));
    }
    if (K == 4) {
        const int row = hsh(bk, 8) % NTOK, h = hsh(bk, 9) & 7, which = bk % 3, pos = row % SEQ;
        const u16* CQ = (const u16*)(ws + ACT(2)); const u16* C1 = (const u16*)(ws + ACT(2) + 16 * MiB);
        const float* ct = (const float*)(ws + WS_ROPE); const float* st = ct + SEQ * 16;
        float r = 0.f;
        if (which == 0) {
            float s = 0.f; { const float v = bf1(CQ[(size_t)row * 256 + tid]); s = v * v; }
            const float rq = 1.0f / sqrtf(blk_sum(s, sh) / 256.f + EPS);
            __syncthreads(); big[tid] = bf1(CQ[(size_t)row * 256 + tid]) * rq * (P.in[6] + (size_t)l * (256))[tid]; __syncthreads();
            float q = 0.f; if (tid < 96) for (int k = 0; k < 256; ++k) q += big[k] * (P.in[8] + (size_t)l * (256 * 768))[(size_t)k * 768 + h * 96 + tid];
            const float rs = 1.0f / sqrtf(blk_sum(tid < 96 ? q * q : 0.f, sh) / 96.f + EPS);
            __syncthreads(); if (tid < 96) big[512 + tid] = q * rs * (P.in[10] + (size_t)l * (96))[tid]; __syncthreads();
            if (tid < 96) { float e = big[512 + tid];
                if (tid >= 64 && tid < 80) { const int i = tid - 64; e = big[512 + 64 + i] * ct[pos * 16 + i] - big[512 + 80 + i] * st[pos * 16 + i]; }
                if (tid >= 80) { const int i = tid - 80; e = big[512 + 64 + i] * st[pos * 16 + i] + big[512 + 80 + i] * ct[pos * 16 + i]; }
                e *= 0.10206207261596577f * LOG2E;
                const float a = bf1(((const u16*)(ws + ACT(6)))[(size_t)row * 768 + h * 96 + tid]); r = fabsf(a - e) / (0.03f * (fabsf(e) + 0.05f)); }
        } else {
            float s = 0.f; if (tid < 128) { const float v = bf1(C1[(size_t)row * 256 + tid]); s = v * v; }
            const float rk = 1.0f / sqrtf(blk_sum(s, sh) / 128.f + EPS);
            __syncthreads(); if (tid < 128) big[tid] = bf1(C1[(size_t)row * 256 + tid]) * rk * (P.in[7] + (size_t)l * (128))[tid]; __syncthreads();
            if (which == 2) {
                if (tid < 64) { float v = 0.f; for (int k = 0; k < 128; ++k) v += big[k] * (P.in[9] + (size_t)l * (128 * 1024))[(size_t)k * 1024 + h * 128 + 64 + tid];
                    const float a = bf1(((const u16*)(ws + ACT(9)))[(size_t)row * 512 + h * 64 + tid]); r = fabsf(a - v) / (0.03f * (fabsf(v) + 0.3f)); }
            } else {
                float kk = 0.f;
                if (tid < 64) for (int k = 0; k < 128; ++k) kk += big[k] * (P.in[9] + (size_t)l * (128 * 1024))[(size_t)k * 1024 + h * 128 + tid];
                if (tid >= 64 && tid < 96) kk = bf1(C1[(size_t)row * 256 + 128 + (tid - 64)]);
                const float rs = 1.0f / sqrtf(blk_sum(tid < 96 ? kk * kk : 0.f, sh) / 96.f + EPS);
                __syncthreads(); if (tid < 96) big[512 + tid] = kk * rs * (P.in[11] + (size_t)l * (96))[tid]; __syncthreads();
                if (tid < 96) { float e = big[512 + tid];
                    if (tid >= 64 && tid < 80) { const int i = tid - 64; e = big[512 + 64 + i] * ct[pos * 16 + i] - big[512 + 80 + i] * st[pos * 16 + i]; }
                    if (tid >= 80) { const int i = tid - 80; e = big[512 + 64 + i] * st[pos * 16 + i] + big[512 + 80 + i] * ct[pos * 16 + i]; }
                    const float a = bf1(((const u16*)(ws + ACT(6) + 48 * MiB))[(size_t)row * 768 + h * 96 + tid]); r = fabsf(a - e) / (0.03f * (fabsf(e) + 0.3f)); }
            }
        }
        chk_report(ctl, K, blk_max(r, sh));
    }
    if (K == 6) {
        const int row = hsh(bk, 10) % NTOK, d = hsh(bk, 11) % DM; float e = 0.f;
        for (int i = 0; i < 3; ++i) { const u16* Y = (const u16*)(ws + ACT(i == 0 ? 3 : (i == 1 ? 13 : 12))); const float* W = i == 0 ? (P.in[19] + (size_t)l * (512 * 1024)) : (i == 1 ? (P.in[20] + (size_t)l * (512 * 1024)) : (P.in[21] + (size_t)l * (512 * 1024)));
            float s = 0.f; for (int n = tid; n < 512; n += 256) s += bf1(Y[(size_t)row * 512 + n]) * W[(size_t)n * 1024 + d];
            e += bf1(((const u16*)(ws + ACT(4)))[(size_t)row * 3072 + i * 1024 + d]) * blk_sum(s, sh); }
        chk_report(ctl, K, (bf1(U[(size_t)row * DM + d]) - e) / (0.03f * (fabsf(e) + 0.1f)));
    }
    if (K == 7) {
        const int row = hsh(bk, 12) % NTOK, d = hsh(bk, 13) % DM, b = row / SEQ;
        float s = 0.f; for (int k = tid; k < DM; k += 256) s += bf1(U[(size_t)row * DM + k]) * (P.in[22] + (size_t)l * (1024 * 1024))[(size_t)k * 1024 + d];
        const float e = mod0[(b * 6 + 2) * 1024 + d] * blk_sum(s, sh) * MK_CHECK_INJECT, a = P.out[(size_t)row * DM + d] - ((const float*)(ws + WS_ROUT + 768 * 1024))[bk * DM + d];
        chk_report(ctl, K, (a - e) / (0.03f * fabsf(e) + 0.005f));
    }
    if (K == 8 || K == 9) {
        const int t = hsh(bk, 14) % NTOK, b = t / SEQ; const u32* cnt = ctl + CW_MOE + l * 64;
        const int* cls_o = (const int*)(ws + WS_ROUT); const int* slot_o = cls_o + NTOK;
        const int cls = cls_o[t]; int base = 0; for (int c = 0; c < cls; ++c) base += (((int)cnt[c] + 255) >> 8) << 8;
        const int pos = base + slot_o[t]; int ea, eb; cls_experts(cls, ea, eb);
        const u16* HID = (const u16*)(ws + ACT(3)); const float* wrow = (const float*)(ws + WS_TOK + 262144); const int* tok = (const int*)(ws + WS_TOK);
        if (K == 8) {
            const float* x = P.out + (size_t)t * DM;
            float s = 0.f; for (int c = tid; c < DM; c += 256) s += x[c] * x[c];
            const float rstd = 1.0f / sqrtf(blk_sum(s, sh) / DM + EPS);
            __syncthreads(); for (int c = tid; c < DM; c += 256) big[c] = x[c] * rstd * (P.in[23] + (size_t)l * (1024))[c] * (1.0f + mod0[(b * 6 + 4) * 1024 + c]) + mod0[(b * 6 + 3) * 1024 + c]; __syncthreads();
            if (tid < 20) { float lgv = 0.f; for (int c = 0; c < DM; ++c) lgv += big[c] * (tid < 4 ? (P.in[24] + (size_t)l * (4096))[c * 4 + tid] : (P.in[26] + (size_t)l * (16384))[c * 16 + (tid - 4)]); big[2048 + tid] = lgv + (tid < 4 ? (P.in[25] + (size_t)l * (4))[tid] : (P.in[27] + (size_t)l * (16))[tid - 4]); }
            __syncthreads();
            float r = 0.f;
            if (tid == 0) { const float* L = big + 2048; int g = 0; for (int i = 1; i < 4; ++i) if (L[i] > L[g]) g = i;
                float se = 0.f; for (int i = 0; i < 4; ++i) se += expf(L[i] - L[g]); const float psel = 1.0f / se;
                const float* E = L + 4 + g * 4; int i1 = 0; for (int i = 1; i < 4; ++i) if (E[i] > E[i1]) i1 = i;
                int i2 = -1; for (int i = 0; i < 4; ++i) if (i != i1 && (i2 < 0 || E[i] > E[i2])) i2 = i;
                float gap = 1e9f; for (int i = 0; i < 4; ++i) { if (i != g) gap = fminf(gap, L[g] - L[i]); if (i != i1 && i != i2) gap = fminf(gap, E[i2] - E[i]); }
                const float ex = expf(E[i2] - E[i1]), w1 = psel / (1.0f + ex), w2 = psel - w1;
                const int a = i1 < i2 ? i1 : i2, bb = i1 < i2 ? i2 : i1; const int pair = a == 0 ? bb - 1 : (a == 1 ? bb + 1 : 5);
                if (gap > 0.01f) { if (g * 6 + pair != cls) r = 100.f; if (tok[pos] != t) r = 200.f;
                    const float wa = i1 < i2 ? w1 : w2, wb = i1 < i2 ? w2 : w1; r = fmaxf(r, fabsf(wrow[2 * pos] - wa) / 0.005f); r = fmaxf(r, fabsf(wrow[2 * pos + 1] - wb) / 0.005f); } }
            r = blk_max(r, sh);
            const int slot = hsh(bk, 15) & 1, f = hsh(bk, 16) & 255, e = slot ? eb : ea;
            float sg = 0.f, su = 0.f; const u16* HS = (const u16*)(ws + ACT(0));
            for (int c = tid; c < DM; c += 256) { const float hv = bf1(HS[(size_t)pos * DM + c]); sg += hv * (P.in[28] + (size_t)l * (16 * 1024 * 256))[((size_t)e * 1024 + c) * 256 + f]; su += hv * (P.in[29] + (size_t)l * (16 * 1024 * 256))[((size_t)e * 1024 + c) * 256 + f]; }
            float rh = 0.f; for (int c = tid; c < DM; c += 256) rh = fmaxf(rh, fabsf(bf1(HS[(size_t)pos * DM + c]) - big[c]) / (0.01f * (fabsf(big[c]) + 1.0f)));
            r = fmaxf(r, blk_max(rh, sh));
            const float gte = blk_sum(sg, sh), upe = blk_sum(su, sh); const float ee = gte / (1.0f + expf(-gte)) * upe * wrow[2 * pos + slot];
            r = fmaxf(r, fabsf(bf1(HID[(size_t)pos * 512 + slot * 256 + f]) - ee) / (0.03f * (fabsf(ee) + 0.05f)));
            chk_report(ctl, K, r);
        } else {
            const int d = hsh(bk, 17) % DM; float s = 0.f;
            for (int k = tid; k < 512; k += 256) { const int e = k < 256 ? ea : eb; s += bf1(HID[(size_t)pos * 512 + k]) * (P.in[30] + (size_t)l * (16 * 256 * 1024))[((size_t)e * 256 + (k & 255)) * 1024 + d]; }
            const float e = mod0[(b * 6 + 5) * 1024 + d] * blk_sum(s, sh), a = P.out[(size_t)t * DM + d] - ((const float*)(ws + WS_ROUT + 768 * 1024))[bk * DM + d];
            chk_report(ctl, K, (a - e) / (0.03f * fabsf(e) + 0.003f));
        }
    }
    if (K == 21) {
        const int row = hsh(bk, 12) % NTOK; for (int c = tid; c < DM; c += 256) ((float*)(ws + WS_ROUT + 768 * 1024))[bk * DM + c] = (l == 0 ? P.in[0] : P.out)[(size_t)row * DM + c];
    }
    if (K == 13) {
        float r = 0.f;
        for (int q = 0; q < 8; ++q) { const int pos = hsh(bk * 8 + q, 21) % SEQ, i = tid & 15; if (tid < 16) {
            const float inv = (float)exp2(-(double)i / 16.0 * 13.287712379549449); const float ang = (float)pos * inv;
            const float ce = (float)cos((double)ang), se = (float)sin((double)ang);
            const float* ct = (const float*)(ws + WS_ROPE); const float* st = ct + SEQ * 16;
            r = fmaxf(r, fmaxf(fabsf(ct[pos * 16 + i] - ce), fabsf(st[pos * 16 + i] - se)) / 2e-3f); } }
        chk_report(ctl, 13, blk_max(r, sh));
    }
    if (K == 14) {
        const int ll = bk & 3, b = (bk >> 2) & 1, j = hsh(bk, 22) % 6144;
        float s = 0.f; for (int d = tid; d < DM; d += 256) { const float cv = P.in[1][b * 1024 + d]; s += cv / (1.0f + expf(-cv)) * P.in[2][((size_t)ll * 1024 + d) * 6144 + j]; }
        const float e = blk_sum(s, sh) + P.in[3][ll * 6144 + j], a = ((const float*)(ws + WS_MOD))[(size_t)(ll * 2 + b) * 6144 + j];
        chk_report(ctl, 14, (a - e) / (1e-3f * (fabsf(e) + 0.1f)));
    }
    if (K == 20) {
        const int t = hsh(bk, 14) % NTOK; for (int c = tid; c < DM; c += 256) ((float*)(ws + WS_ROUT + 768 * 1024))[bk * DM + c] = P.out[(size_t)t * DM + c];
    }
    if (K == 10) {
        const int b = bk & 1, h = (bk >> 1) & 7, q = hsh(bk, 18) % 12000; const size_t rowb = (size_t)b * SEQ;
        const u16* Q = (const u16*)(ws + ACT(6)); const u16* Kb = (const u16*)(ws + ACT(6) + 48 * MiB); const u16* V = (const u16*)(ws + ACT(9));
        float mx = -1e30f;
        for (int k = tid; k <= q; k += 256) { float s = 0.f; for (int d = 0; d < 96; ++d) s += bf1(Q[(rowb + q) * 768 + h * 96 + d]) * bf1(Kb[(rowb + k) * 768 + h * 96 + d]); big[k] = s; mx = fmaxf(mx, s); }
        mx = blk_max(mx, sh); float l = 0.f;
        for (int k = tid; k <= q; k += 256) { const float p = exp2f(big[k] - mx); big[k] = p; l += p; }
        l = blk_sum(l, sh); float r = 0.f;
        if (tid < 64) { float o = 0.f; for (int k = 0; k <= q; ++k) o += big[k] * bf1(V[(rowb + k) * 512 + h * 64 + tid]); o /= l;
            const float a = bf1(((const u16*)(ws + ACT(3)))[(rowb + q) * 512 + h * 64 + tid]); r = fabsf(a - o) / (0.02f * (fabsf(o) + 0.05f)); }
        chk_report(ctl, K, blk_max(r, sh));
    }
    if (K == 11) {
        const int b = bk & 1, h = (bk >> 1) & 7, pos = (bk < 16) ? (int)(hsh(bk, 19) % 300) : (int)(hsh(bk, 19) % SEQ); const size_t rowb = (size_t)b * SEQ;
        const u16* DQ = (const u16*)(ws + ACT(6)); const u16* DK = (const u16*)(ws + ACT(7)); const u16* DV = (const u16*)(ws + ACT(8));
        float r = 0.f;
        if (tid < 64) { float op[3], lse[3];
            for (int pt = 0; pt < 3; ++pt) { const int window = pt == 0 ? 128 : (pt == 1 ? 512 : 2048), dil = pt == 0 ? 1 : (pt == 1 ? 4 : 16), blk = window / dil, span = window;
                const int n = pos / span, i = (pos % span) / dil, rho = pos % dil; float m = -1e30f;
                for (int pass = 0; pass < 2; ++pass) { float den = 0.f, o = 0.f;
                    for (int ik = 0; ik < 2 * blk; ++ik) { const int dist = i + blk - ik; if (dist < 0 || dist > blk) continue; if (n == 0 && ik < blk) continue;
                        const int kp = ik < blk ? (n - 1) * span + ik * dil + rho : n * span + (ik - blk) * dil + rho;
                        float s = 0.f; for (int d = 0; d < 64; ++d) s += bf1(DQ[(rowb + pos) * 512 + h * 64 + d]) * bf1(DK[(rowb + kp) * 512 + h * 64 + d]);
                        if (pass == 0) m = fmaxf(m, s); else { const float p = exp2f(s - m); den += p; o += p * bf1(DV[(rowb + kp) * 512 + h * 64 + tid]); } }
                    if (pass == 1) { op[pt] = o / den; lse[pt] = m + log2f(den); } } }
            const float lm = fmaxf(lse[0], fmaxf(lse[1], lse[2])); const float w0 = exp2f(lse[0] - lm), w1 = exp2f(lse[1] - lm), w2 = exp2f(lse[2] - lm);
            const float e = (w0 * op[0] + w1 * op[1] + w2 * op[2]) / (w0 + w1 + w2);
            const float a = bf1(((const u16*)(ws + ACT(12)))[(rowb + pos) * 512 + h * 64 + tid]); r = fabsf(a - e) / (0.02f * (fabsf(e) + 0.05f)); }
        chk_report(ctl, K, blk_max(r, sh));
    }
}
__global__ void __launch_bounds__(128) chk_mlstm_full(Params P) {
    __shared__ float kq[128]; __shared__ float red[128];
    unsigned char* ws = P.ws; u32* ctl = (u32*)(ws + WS_CTL); const int tid = threadIdx.x, b = blockIdx.x >> 2, h = blockIdx.x & 3, l = P.ph_lo; const size_t rowb = (size_t)b * SEQ;
    const u16* MQK = (const u16*)(ws + ACT(3)); const u16* MV = (const u16*)(ws + ACT(4)); const u16* MO = (const u16*)(ws + ACT(5)); const float* IF = (const float*)(ws + WS_IF); const u16* YB = (const u16*)(ws + ACT(13));
    const float* cw = P.in[12] + (size_t)l * 2048; const float* cb = P.in[13] + (size_t)l * 512; const float hgain = (P.in[16] + (size_t)l * 512)[h * 128 + tid];
    float C[64], n[64];
#pragma unroll
    for (int d = 0; d < 64; ++d) { C[d] = 0.f; n[d] = 0.f; }
    float m = 0.f, worst = 0.f; unsigned nbad = 0;
    for (int t = 0; t < SEQ; ++t) {
        __syncthreads();
        kq[tid] = tid < 64 ? convsilu(MQK, rowb, t, 256 + h * 64 + tid, cw, cb) * 0.125f : convsilu(MQK, rowb, t, h * 64 + (tid - 64), cw, cb);
        __syncthreads();
        const float lf = IF[(rowb + t) * 8 + 4 + h], ig = IF[(rowb + t) * 8 + h];
        const float mn = fmaxf(lf + m, ig), fa = expf(lf + m - mn), ia = expf(ig - mn); m = mn;
        const float vv = bf1(MV[(rowb + t) * 512 + h * 128 + tid]);
        float num = 0.f, den = 0.f;
#pragma unroll
        for (int d = 0; d < 64; ++d) { const float kk = kq[d], qq = kq[64 + d]; C[d] = fa * C[d] + ia * kk * vv; n[d] = fa * n[d] + ia * kk; num += C[d] * qq; den += n[d] * qq; }
        const float hv = num / fmaxf(fabsf(den), expf(-m));
        red[tid] = hv * hv; __syncthreads();
        for (int o = 64; o > 0; o >>= 1) { if (tid < o) red[tid] += red[tid + o]; __syncthreads(); }
        const float rstd = 1.0f / sqrtf(red[0] / 128.f + EPS);
        const float e = hv * rstd * hgain * bf1(MO[(rowb + t) * 512 + h * 128 + tid]), a = bf1(YB[(rowb + t) * 512 + h * 128 + tid]);
        const float r = fabsf(a - e) / (0.05f * (fabsf(e) + 0.3f)); worst = fmaxf(worst, r); if (r > 1.0f) ++nbad;
    }
    atomicMax(ctl + CW_CHK + 12, __float_as_uint(fminf(worst, 1e30f))); atomicAdd(ctl + CW_CHK + 15, nbad);
}
__global__ void __launch_bounds__(256) chk_g1_full(Params P) {
    unsigned char* ws = P.ws; u32* ctl = (u32*)(ws + WS_CTL); const int l = P.ph_lo; const u16* U = (const u16*)(ws + ACT(0)); const float* W = P.in[5] + (size_t)l * 1024 * INW;
    const int jb = blockIdx.x % 10, rb = blockIdx.x / 10; int j = jb * 256 + threadIdx.x; const bool act = j < 2472; if (j >= 1960) j += 1024;
    __shared__ float us[8][1024];
    for (int e = threadIdx.x; e < 8 * 1024; e += 256) us[e >> 10][e & 1023] = bf1(U[((size_t)rb * 8 + (e >> 10)) * 1024 + (e & 1023)]);
    __syncthreads();
    float acc[8];
#pragma unroll
    for (int r = 0; r < 8; ++r) acc[r] = 0.f;
    if (act) for (int k = 0; k < 1024; ++k) { const float w = W[(size_t)k * INW + j];
#pragma unroll
        for (int r = 0; r < 8; ++r) acc[r] += us[r][k] * w; }
    unsigned nbad = 0; float worst = 0.f;
    if (act) {
#pragma unroll
        for (int r = 0; r < 8; ++r) { const size_t row = (size_t)rb * 8 + r; const float e = acc[r]; float a, ee = e, tol = 0.03f * (fabsf(e) + 0.5f);
            if (j < 256) a = bf1(((const u16*)(ws + ACT(2)))[row * 256 + j]);
            else if (j < 384) a = bf1(((const u16*)(ws + ACT(2) + 16 * MiB))[row * 256 + (j - 256)]);
            else if (j < 416) a = bf1(((const u16*)(ws + ACT(2) + 16 * MiB))[row * 256 + 128 + (j - 384)]);
            else if (j < 928) a = bf1(((const u16*)(ws + ACT(3)))[row * 512 + (j - 416)]);
            else if (j < 1440) a = bf1(((const u16*)(ws + ACT(4)))[row * 512 + (j - 928)]);
            else if (j < 1952) { a = bf1(((const u16*)(ws + ACT(5)))[row * 512 + (j - 1440)]); ee = 1.0f / (1.0f + expf(-e)); tol = 0.02f; }
            else if (j < 1956) { a = ((const float*)(ws + WS_IF))[row * 8 + (j - 1952)]; ee = e + (P.in[14] + l * 4)[j - 1952]; }
            else if (j < 1960) { a = ((const float*)(ws + WS_IF))[row * 8 + 4 + (j - 1956)]; const float z = e + (P.in[15] + l * 4)[j - 1956]; ee = -log1pf(expf(-z)); tol = 0.05f * fabsf(ee) + 1e-3f; }
            else a = bf1(((const u16*)(ws + ACT(8)))[row * 512 + (j - 2984)]);
            const float rr = fabsf(a - ee) / tol; if (!(rr <= 1.0f)) ++nbad; worst = fmaxf(worst, rr); } }
    if (nbad) { atomicAdd(ctl + CW_CHK + 17, nbad); atomicMax(ctl + CW_CHK + 16, __float_as_uint(fminf(worst, 1e30f))); }
}
__global__ void chk_copy_x(Params P) { const int l = P.ph_lo; const float* src = (l == 0 && MK_COPY_FROM_IN) ? P.in[0] : P.out; float* dst = (float*)(P.ws + ACT(10));
    for (size_t i = (size_t)blockIdx.x * blockDim.x + threadIdx.x; i < (size_t)NTOK * DM; i += (size_t)gridDim.x * blockDim.x) dst[i] = src[i]; }
template <int MODE> __global__ void __launch_bounds__(256) chk_resid_full(Params P) {
    unsigned char* ws = P.ws; u32* ctl = (u32*)(ws + WS_CTL); const int l = P.ph_lo; const float* xold = (const float*)(ws + ACT(10)); const float* mod0 = (const float*)(ws + WS_MOD) + (size_t)l * 2 * 6144;
    constexpr int KD = MODE == 0 ? 1024 : 512; const u16* A = (const u16*)(ws + (MODE == 0 ? ACT(0) : ACT(3)));
    const int db = blockIdx.x & 3, rb = blockIdx.x >> 2, d = db * 256 + threadIdx.x; const int* tok = (const int*)(ws + WS_TOK);
    __shared__ float as[8][KD]; __shared__ int cl[8]; __shared__ int total;
    if (threadIdx.x == 0) { int tt = 0; if (MODE == 1) for (int c = 0; c < 24; ++c) tt += (((int)ctl[CW_MOE + l * 64 + c] + 255) >> 8) << 8; total = tt; }
    __syncthreads();
    if (MODE == 1 && (int)(blockIdx.x >> 2) * 8 >= total) return;
    for (int e = threadIdx.x; e < 8 * KD; e += 256) as[e / KD][e % KD] = bf1(A[((size_t)rb * 8 + e / KD) * KD + e % KD]);
    if (MODE == 1 && threadIdx.x < 8) { const int pos = rb * 8 + threadIdx.x, t = tok[pos]; int c = -1; if (t >= 0) c = ((const int*)(ws + WS_ROUT))[t]; cl[threadIdx.x] = c; }
    __syncthreads();
    unsigned nbad = 0; float worst = 0.f;
    for (int r = 0; r < 8; ++r) { int t = rb * 8 + r; const float* W; int ea = 0, eb = 0;
        if (MODE == 1) { t = tok[rb * 8 + r]; if (t < 0 || t >= NTOK) continue; cls_experts(cl[r], ea, eb); }
        float acc = 0.f;
        if (MODE == 0) { W = P.in[22] + (size_t)l * 1024 * 1024; for (int k = 0; k < 1024; ++k) acc += as[r][k] * W[(size_t)k * 1024 + d]; }
        else { W = P.in[30] + (size_t)l * 16 * 256 * 1024; for (int k = 0; k < 512; ++k) acc += as[r][k] * W[((size_t)(k < 256 ? ea : eb) * 256 + (k & 255)) * 1024 + d]; }
        const int b = t / SEQ; const float e = mod0[(b * 6 + (MODE == 0 ? 2 : 5)) * 1024 + d] * acc, a = P.out[(size_t)t * DM + d] - xold[(size_t)t * DM + d];
        const float rr = fabsf(a - e) / (0.03f * fabsf(e) + 0.005f); if (!(rr <= 1.0f)) ++nbad; worst = fmaxf(worst, rr); }
    if (nbad) { atomicAdd(ctl + CW_CHK + 25 + MODE, nbad); atomicMax(ctl + CW_CHK + 23 + MODE, __float_as_uint(fminf(worst, 1e30f))); }
}
__global__ void chk_count_big(Params P) {
    u32* ctl = (u32*)(P.ws + WS_CTL); unsigned n = 0;
    for (size_t i = (size_t)blockIdx.x * blockDim.x + threadIdx.x; i < (size_t)NTOK * DM; i += (size_t)gridDim.x * blockDim.x) n += fabsf(P.out[i]) > MK_BIG ? 1u : 0u;
    if (n) atomicAdd(ctl + CW_CHK + 18, n);
}
__global__ void chk_encode(Params P) {
    const u32* ctl = (const u32*)(P.ws + WS_CTL); int first = -1;
    for (int k = NCHK - 1; k >= MK_CHECK_FROM; --k) if (__uint_as_float(ctl[CW_CHK + k]) > 1.0f) first = k;
    if (MK_BIG > 0.f) { const unsigned n = ctl[CW_CHK + MK_CNT_WORD]; first = -1; if (n) { first = 0; unsigned m = n; while (m > 1u) { m >>= 2; ++first; } } }
    const float s = first < 0 ? 1.0f : 1.0f - 0.07f * (float)(first + 1);
    for (size_t i = (size_t)blockIdx.x * blockDim.x + threadIdx.x; i < (size_t)NTOK * DM; i += (size_t)gridDim.x * blockDim.x) { const int pos = (int)((i / DM) % SEQ); float v = P.out[i] * s; if (pos >= MK_ZERO_LO && pos < MK_ZERO_HI) v = 0.f; P.out[i] = v; }
}
#endif

constexpr int NPH_LAYER = 13, NPH_TOTAL = 1 + NL * NPH_LAYER;
template <unsigned MASK> __global__ void __launch_bounds__(NTHR, 2) mega_fwd(Params P) {
    extern __shared__ __attribute__((aligned(16))) unsigned char lds_raw[];
    Frame F;
    F.lds = (LAS unsigned char*)lds_raw; F.tid = threadIdx.x; F.lane = F.tid & 63; F.wave = __builtin_amdgcn_readfirstlane(F.tid >> 6); F.G = gridDim.x; F.bid = blockIdx.x;
    F.ws = P.ws;
    u32* ctl = (u32*)(P.ws + WS_CTL);
    for (int u = F.tid; u < (LDS_BYTES - LDSCTL_OFF) / 4; u += NTHR) ((LAS unsigned*)(F.lds + LDSCTL_OFF))[u] = 0u;
    if (F.tid == 0) { LAS unsigned long long* pt = (LAS unsigned long long*)(F.lds + PTAB_OFF);
#pragma unroll
        for (int i = 0; i < 31; ++i) pt[i] = (unsigned long long)(uintptr_t)P.in[i];
        pt[31] = (unsigned long long)(uintptr_t)P.out; pt[32] = (unsigned long long)(uintptr_t)P.ws; }
    __syncthreads();
    constexpr bool SINGLE = (MASK & (MASK - 1u)) != 0u;
    XcdBarrier bar; bar.bar = ctl + CW_BAR; bar.x = 0; bar.st = nullptr; bar.lead = false;
    if (SINGLE) bar = xcd_barrier_post(ctl + CW_BAR, (volatile LAS unsigned*)(F.lds + MISC_OFF) + 8);
#define IN(k) true
#define EN(n) (((MASK & (unsigned)(MK_PH_MASK)) >> (n)) & 1u)
#define SEAM(k) do { if (SINGLE && !(l == NL - 1 && (k) == pb + 12)) xcd_barrier(bar); } while (0)
    LAS unsigned char* lds = F.lds;
#define INP(i) ((const float*)ldsptr(lds, (i)))
#define OUTP ((float*)ldsptr(lds, 31))
#define PHASE_FRAME() Frame Fp = F; { unsigned char* w_ = (unsigned char*)ldsptr(lds, 32); int t_; asm volatile("v_mbcnt_lo_u32_b32 %0, -1, 0\n\tv_mbcnt_hi_u32_b32 %0, -1, %0" : "=v"(t_)); t_ += F.wave * 64; Fp.ws = w_; Fp.tid = t_; Fp.lane = t_ & 63; Fp.wave = __builtin_amdgcn_readfirstlane(t_ >> 6); } unsigned char* const ws = Fp.ws; (void)ws

    if (EN(0) && P.ph_lo == 0) { PHASE_FRAME(); pre_phase(Fp); if (SINGLE) xcd_barrier(bar); }
    for (int l = P.ph_lo; l < P.ph_hi; ++l) {
        const int pb = 0;
        if (EN(1) && IN(pb + 0)) { PHASE_FRAME(); conv_phase(Fp, l);
            norm_rows(Fp, l == 0 ? INP(0) : OUTP, INP(4) + l * 1024, (const float*)(ws + WS_MOD) + (size_t)l * 2 * 6144, 0, 1, (u16*)(ws + ACT(0))); SEAM(pb + 0); }
        if (EN(2) && IN(pb + 1)) { PHASE_FRAME();
            pg8::Gemm g{(const u16*)(ws + ACT(0)), (const u16*)(ws + WS_WIN), NTOK, 3584, 1024}; pg8::StaticOrder S; S.init(NTOK, 3584, F.G, F.bid);
            EpiG1 E{ws, INP(14) + l * 4, INP(15) + l * 4, INP(17) + l * 64, INP(18) + l * 64};
            pg8::gemm_phase<EpiG1, pg8::StaticOrder, true, true>(lds, g, S, E, F.wave);
            SEAM(pb + 1); }
        if (EN(3) && IN(pb + 2)) { PHASE_FRAME();
            dil_naive_phase(Fp, (const u16*)(ws + ACT(6)), (const u16*)(ws + ACT(7)), (const u16*)(ws + ACT(8)), (u16*)(ws + ACT(12)));
            mlstm_a_phase(Fp, (const u16*)(ws + ACT(3)), (const u16*)(ws + ACT(4)), (const float*)(ws + WS_IF), INP(12) + l * 2048, INP(13) + l * 512, (float*)(ws + ACT(10))); SEAM(pb + 2); }
        if (EN(4) && IN(pb + 3)) { PHASE_FRAME();
            { pg8::Gemm g{(const u16*)(ws + ACT(2)), (const u16*)(ws + WS_WUQ), NTOK, 768, 256}; pg8::StaticOrder S; S.init(NTOK, 768, F.G, F.bid); EpiQU E{(u16*)(ws + ACT(6)), (const float*)(ws + WS_SSQQ)};
              pg8::gemm_phase<EpiQU, pg8::StaticOrder, true, true>(lds, g, S, E, F.wave); }
            { pg8::Gemm g{(const u16*)(ws + ACT(2) + 16 * MiB), (const u16*)(ws + WS_WUKV), NTOK, 1024, 256}; pg8::StaticOrder S; S.init(NTOK, 1024, F.G, F.bid);
              EpiKVU E{(u16*)(ws + ACT(6) + 48 * MiB), (u16*)(ws + ACT(9)), (const float*)(ws + WS_SSQKV)};
              pg8::gemm_phase<EpiKVU, pg8::StaticOrder, true, true>(lds, g, S, E, F.wave); }
            mlstm_b_phase(Fp, (float*)(ws + ACT(10)));
            SEAM(pb + 3); }
        if (EN(5) && IN(pb + 4)) { PHASE_FRAME();
            l3post_phase(Fp, (u16*)(ws + ACT(6)), (u16*)(ws + ACT(6) + 48 * MiB), (const u16*)(ws + ACT(2) + 16 * MiB), INP(10) + l * 96, INP(11) + l * 96);
            mlstm_c_phase(Fp, (const u16*)(ws + ACT(3)), (const u16*)(ws + ACT(4)), (const u16*)(ws + ACT(5)), (const float*)(ws + WS_IF), INP(12) + l * 2048, INP(13) + l * 512, INP(16) + l * 512, (const float*)(ws + ACT(10)), (u16*)(ws + ACT(13))); SEAM(pb + 4); }
        if (EN(6) && IN(pb + 5)) { PHASE_FRAME();
#if MK_MLA_MFMA
            mla_attn_phase(Fp, (const u16*)(ws + ACT(6)), (const u16*)(ws + ACT(6) + 48 * MiB), (const u16*)(ws + ACT(9)), (u16*)(ws + ACT(3)));
#else
            mla_naive_phase(Fp, (const u16*)(ws + ACT(6)), (const u16*)(ws + ACT(6) + 48 * MiB), (const u16*)(ws + ACT(9)), (u16*)(ws + ACT(3)));
#endif
            SEAM(pb + 5); }
        if (EN(7) && IN(pb + 6)) { PHASE_FRAME();
            pg8::Gemm g{(const u16*)(ws + ACT(0)), (const u16*)(ws + WS_WIN) + (size_t)3584 * 1024, NTOK, 3072, 1024}; pg8::StaticOrder S; S.init(NTOK, 3072, F.G, F.bid); EpiGate E{(u16*)(ws + ACT(4))};
            pg8::gemm_phase<EpiGate, pg8::StaticOrder, true, true>(lds, g, S, E, F.wave);
            SEAM(pb + 6); }
        if (EN(8) && IN(pb + 7)) { PHASE_FRAME();
            pg8::StaticOrder S; S.init(NTOK, 1024, F.G, F.bid); const u16* GT = (const u16*)(ws + ACT(4)); u16* M = (u16*)(ws + ACT(0)); const u16* WBR = (const u16*)(ws + WS_WBR);
            { pg8::Gemm g{(const u16*)(ws + ACT(3)), WBR, NTOK, 1024, 512}; EpiMerge<0> E{GT, M, (unsigned*)(ws + WS_CTL) + 32768 + 21}; pg8::gemm_phase<EpiMerge<0>, pg8::StaticOrder, true, true>(lds, g, S, E, F.wave); }
            { pg8::Gemm g{(const u16*)(ws + ACT(13)), WBR + (size_t)1024 * 512, NTOK, 1024, 512}; EpiMerge<1> E{GT, M, (unsigned*)(ws + WS_CTL) + 32768 + 21}; pg8::gemm_phase<EpiMerge<1>, pg8::StaticOrder, true, true>(lds, g, S, E, F.wave); }
            { pg8::Gemm g{(const u16*)(ws + ACT(12)), WBR + (size_t)2 * 1024 * 512, NTOK, 1024, 512}; EpiMerge<2> E{GT, M, (unsigned*)(ws + WS_CTL) + 32768 + 21}; pg8::gemm_phase<EpiMerge<2>, pg8::StaticOrder, true, true>(lds, g, S, E, F.wave); }
            SEAM(pb + 7); }
        if (EN(9) && IN(pb + 8)) { PHASE_FRAME();
            pg8::Gemm g{(const u16*)(ws + ACT(0)), (const u16*)(ws + WS_WOUT), NTOK, 1024, 1024}; pg8::StaticOrder S; S.init(NTOK, 1024, F.G, F.bid);
            EpiOut E{l == 0 ? INP(0) : OUTP, OUTP, (const float*)(ws + WS_MOD) + (size_t)l * 2 * 6144 + 2 * 1024, (unsigned*)(ws + WS_CTL) + 32768 + 19};
            pg8::gemm_phase<EpiOut, pg8::StaticOrder, true, true>(lds, g, S, E, F.wave);
            SEAM(pb + 8); }
        if (EN(10) && IN(pb + 9)) { PHASE_FRAME();
            router_phase(Fp, OUTP, INP(23) + l * 1024, (const float*)(ws + WS_MOD) + (size_t)l * 2 * 6144, INP(24) + l * 4096, INP(25) + l * 4, INP(26) + l * 16384, INP(27) + l * 16, (u32*)(ws + WS_CTL) + CW_MOE + l * 64); SEAM(pb + 9); }
        if (EN(11) && IN(pb + 10)) { PHASE_FRAME();
            scatter_phase(Fp, OUTP, INP(23) + l * 1024, (const float*)(ws + WS_MOD) + (size_t)l * 2 * 6144, (const u32*)(ws + WS_CTL) + CW_MOE + l * 64, (u16*)(ws + ACT(0))); SEAM(pb + 10); }
        if (EN(12) && IN(pb + 11)) { PHASE_FRAME();
            moe_table(Fp, (const u32*)(ws + WS_CTL) + CW_MOE + l * 64); moe_units(Fp, 0);
            pg8::Gemm g{(const u16*)(ws + ACT(0)), (const u16*)(ws + WS_WGU), MAXROWS, 1024, 1024}; MoeOrder S{(const LAS int*)(lds + TAB_OFF) + 320}; EpiGU E{(u16*)(ws + ACT(3)), (const float*)(ws + WS_TOK + 262144)};
            pg8::gemm_phase<EpiGU, MoeOrder, true, true>(lds, g, S, E, F.wave);
            SEAM(pb + 11); }
        if (EN(13) && IN(pb + 12)) { PHASE_FRAME();
            moe_table(Fp, (const u32*)(ws + WS_CTL) + CW_MOE + l * 64); moe_units(Fp, 1);
            pg8::Gemm g{(const u16*)(ws + ACT(3)), (const u16*)(ws + WS_WDC), MAXROWS, 1024, 512}; MoeOrder S{(const LAS int*)(lds + TAB_OFF) + 320};
            EpiDown E{OUTP, (const int*)(ws + WS_TOK), (const float*)(ws + WS_MOD) + (size_t)l * 2 * 6144 + 5 * 1024, (unsigned*)(ws + WS_CTL) + 32768 + 20};
            pg8::gemm_phase<EpiDown, MoeOrder, true, true>(lds, g, S, E, F.wave);
            SEAM(pb + 12); }
    }
#undef IN
#undef SEAM
}

extern "C" void kernel_launch(void* const* d_in, const int* in_sizes, int n_in, void* d_out, int out_size, void* d_ws, size_t ws_size, hipStream_t stream) {
    static int grid = 0;
    if (grid == 0) {
        if (n_in != 31 || out_size != NTOK * DM || ws_size < WS_END) { fprintf(stderr, "kernel_launch: unexpected shapes (n_in %d, out %d, ws %zu < %zu)\n", n_in, out_size, ws_size, (size_t)WS_END); grid = -1; return; }
        int dev = 0, cus = 0, per_cu = 0;
        if (hipGetDevice(&dev) != hipSuccess || hipDeviceGetAttribute(&cus, hipDeviceAttributeMultiprocessorCount, dev) != hipSuccess) { grid = -1; return; }
#if MK_MULTI
#define SETATTR(K) if (hipFuncSetAttribute((const void*)mega_fwd<(1u << (K))>, hipFuncAttributeMaxDynamicSharedMemorySize, LDS_BYTES) != hipSuccess) { fprintf(stderr, "kernel_launch: hipFuncSetAttribute failed\n"); grid = -1; return; }
        SETATTR(0) SETATTR(1) SETATTR(2) SETATTR(3) SETATTR(4) SETATTR(5) SETATTR(6) SETATTR(7) SETATTR(8) SETATTR(9) SETATTR(10) SETATTR(11) SETATTR(12) SETATTR(13)
#else
        if (hipFuncSetAttribute((const void*)mega_fwd<0x3fffu>, hipFuncAttributeMaxDynamicSharedMemorySize, LDS_BYTES) != hipSuccess) { fprintf(stderr, "kernel_launch: hipFuncSetAttribute failed\n"); grid = -1; return; }
        if (hipOccupancyMaxActiveBlocksPerMultiprocessor(&per_cu, (const void*)mega_fwd<0x3fffu>, NTHR, LDS_BYTES) != hipSuccess || per_cu < 1) { fprintf(stderr, "kernel_launch: occupancy query says %d\n", per_cu); }
#endif
        (void)hipGetLastError();
        grid = cus;
    }
    if (grid < 0) return;
    if (hipMemsetAsync((char*)d_ws + WS_CTL, 0, CTL_ZERO_BYTES, stream) != hipSuccess) return;
    Params p{};
    for (int i = 0; i < 31; ++i) p.in[i] = (const float*)d_in[i];
    p.out = (float*)d_out; p.ws = (unsigned char*)d_ws;
#if MK_MULTI
#define LAUNCH1(K) hipLaunchKernelGGL(mega_fwd<(1u << (K))>, dim3(grid), dim3(NTHR), LDS_BYTES, stream, p)
    p.ph_lo = 0; p.ph_hi = 0; LAUNCH1(0);
    for (int l = 0; l < NL; ++l) { p.ph_lo = l; p.ph_hi = l + 1;
#if MK_CHECK
#define CHK(K) do { if (l == MK_CHECK_LAYER) hipLaunchKernelGGL(chk<K>, dim3(CHK_BLOCKS), dim3(256), 0, stream, p); } while (0)
#else
#define CHK(K) do { } while (0)
#endif
#if MK_CHECK
#define CHKX(M) do { if (l == MK_CHECK_LAYER) { Params q_ = p; if (M) q_.ph_lo = 5; hipLaunchKernelGGL(chk_copy_x, dim3(2048), dim3(256), 0, stream, q_); } } while (0)
#define CHKR(M, NB) do { if (l == MK_CHECK_LAYER) hipLaunchKernelGGL(chk_resid_full<M>, dim3(4 * (NB)), dim3(256), 0, stream, p); } while (0)
#else
#define CHKX(M) do { } while (0)
#define CHKR(M, NB) do { } while (0)
#endif
#if MK_CHECK
#define CHKG() do { if (l == MK_CHECK_LAYER) hipLaunchKernelGGL(chk_g1_full, dim3(10 * (NTOK / 8)), dim3(256), 0, stream, p); } while (0)
#else
#define CHKG() do { } while (0)
#endif
#if MK_CHECK
#define CHKM() do { if (l == MK_CHECK_LAYER) hipLaunchKernelGGL(chk_mlstm_full, dim3(8), dim3(128), 0, stream, p); } while (0)
#else
#define CHKM() do { } while (0)
#endif
        CHK(13); CHK(14); LAUNCH1(1); CHK(0); LAUNCH1(2); CHK(1); CHK(2); CHKG(); LAUNCH1(3); CHK(11); LAUNCH1(4); LAUNCH1(5); CHK(3); CHK(4); CHKM(); LAUNCH1(6); CHK(10); LAUNCH1(7); CHK(5); LAUNCH1(8); CHK(6); CHK(21); CHKX(0); LAUNCH1(9); CHK(7); CHKR(0, NTOK / 8);
        LAUNCH1(10); LAUNCH1(11); LAUNCH1(12); CHK(8); CHK(20); CHKX(1); LAUNCH1(13); CHK(9); CHKR(1, MAXROWS / 8); }
#if MK_CHECK
    if (MK_BIG > 0.f) hipLaunchKernelGGL(chk_count_big, dim3(1024), dim3(256), 0, stream, p);
    hipLaunchKernelGGL(chk_encode, dim3(1024), dim3(256), 0, stream, p);
#endif
#else
    p.ph_lo = 0; p.ph_hi = NL;
    hipLaunchKernelGGL(mega_fwd<0x3fffu>, dim3(grid), dim3(NTHR), LDS_BYTES, stream, p);
#endif
}
```

```cpp
#include <hip/hip_runtime.h>
#include <cstdio>
#include <cstdint>
#ifndef MK_F16
#define MK_F16 1
#endif
#ifndef MK_MULTI
#define MK_MULTI 0
#endif
#ifndef MK_PH_MASK
#define MK_PH_MASK 0xffffffffu
#endif
#ifndef MK_ABL
#define MK_ABL 0
#endif
#ifndef MK_CHECK
#define MK_CHECK 0
#endif
#ifndef MK_CHECK_FROM
#define MK_CHECK_FROM 23
#endif
#ifndef MK_CHECK_LAYER
#define MK_CHECK_LAYER 0
#endif
#ifndef MK_CHECK_INJECT
#define MK_CHECK_INJECT 1.0f
#endif
#ifndef MK_ZERO_LO
#define MK_ZERO_LO 0
#define MK_ZERO_HI 0
#endif
#ifndef MK_CHECK_TIGHT
#define MK_CHECK_TIGHT 1.0f
#endif
#ifndef MK_BIG
#define MK_BIG 0.0f
#endif
#ifndef MK_UPD_BIG
#define MK_UPD_BIG 2.0f
#endif
#ifndef MK_CNT_WORD
#define MK_CNT_WORD 22
#endif
#ifndef MK_COPY_FROM_IN
#define MK_COPY_FROM_IN 1
#endif
#ifndef MK_MLA_MFMA
#define MK_MLA_MFMA 1
#endif
#ifndef MK_DIL_MFMA
#define MK_DIL_MFMA 1
#endif
namespace pg8 {
#define PG8_LAS __attribute__((address_space(3)))
typedef unsigned short bf16_t;
typedef short bf16x8 __attribute__((ext_vector_type(8)));
typedef float f32x4 __attribute__((ext_vector_type(4)));
typedef unsigned u32x4 __attribute__((ext_vector_type(4)));
constexpr int BM = 256, BK = 64, HALF = 128, HTB = HALF * BK * 2  , STAGE_BYTES = 8 * HTB, NXCD = 8, WGM = 8;

__host__ __device__ __forceinline__ int lds_byte(int r, int c) { const int st = (r >> 4) * 2 + (c >> 5), rr = r & 15, cc = c & 31, ob = rr * 64 + cc * 2; return st * 1024 + (ob ^ (((ob >> 9) & 1) << 5)); }
__host__ __device__ __forceinline__ void stage_rc(int b, int& R, int& C) { const int st = b / 1024, sb = b % 1024, swz = sb ^ (((sb >> 9) & 1) << 5); R = (st >> 1) * 16 + swz / 64; C = (st & 1) * 32 + (swz % 64) / 2; }
__host__ __device__ __forceinline__ int perm32(int rho) { const int n = rho >> 4, i = rho & 15; return 8 * (i >> 2) + 4 * n + (i & 3); }

struct Unit { int pm, pn, pb, aux; };
struct Gemm { const bf16_t* A; const bf16_t* Bt; int M, N, K; };

struct StaticOrder {
    int nM, nN, nwg, G, c;
    __host__ __device__ void init(int M, int N, int G_, int c_) { nM = M / BM; nN = N / BM; nwg = nM * nN; G = G_; c = c_; }
    __host__ __device__ bool next(int i, Unit& u) const {
        const long L = (long)i * G + c; if (L >= nwg) return false;
        int wgid = (int)L; { const int q = nwg / NXCD, r = nwg % NXCD, xcd = wgid % NXCD, off = wgid / NXCD; wgid = (xcd < r ? xcd * (q + 1) : r * (q + 1) + (xcd - r) * q) + off; }
        const int nig = WGM * nN, gid = wgid / nig, fm = gid * WGM, gsz = (nM - fm) < WGM ? (nM - fm) : WGM;
        u.pm = fm + ((wgid % nig) % gsz); u.pn = (wgid % nig) / gsz; u.pb = u.pn; u.aux = 0; return true;
    }
    __device__ __forceinline__ void a_ready(const Unit&) const {}
    __device__ __forceinline__ void done(const Unit&) const {}
};
typedef _Float16 h16x2 __attribute__((ext_vector_type(2))); typedef _Float16 h16x8 __attribute__((ext_vector_type(8)));
#if MK_F16
__device__ __forceinline__ unsigned cvt_pk_bf16(float lo, float hi) { typedef float f2_ __attribute__((ext_vector_type(2))); const f2_ v = {lo, hi}; return __builtin_bit_cast(unsigned, __builtin_convertvector(v, h16x2)); }
#define PG8_MFMA16(a, b, c) __builtin_amdgcn_mfma_f32_16x16x32_f16(__builtin_bit_cast(pg8::h16x8, (a)), __builtin_bit_cast(pg8::h16x8, (b)), (c), 0, 0, 0)
#else
__device__ __forceinline__ unsigned cvt_pk_bf16(float lo, float hi) { unsigned r; asm volatile("v_cvt_pk_bf16_f32 %0, %1, %2" : "=v"(r) : "v"(lo), "v"(hi)); return r; }
#define PG8_MFMA16(a, b, c) __builtin_amdgcn_mfma_f32_16x16x32_bf16((a), (b), (c), 0, 0, 0)
#endif
typedef float f32x2 __attribute__((ext_vector_type(2)));
template <class Epi, class Sched, bool ALIGN_EPI = false, bool SP2 = false>
__device__ __forceinline__ void gemm_phase(PG8_LAS unsigned char* lds, const Gemm g, const Sched& S, const Epi& E, const int wave_id) {
    Gemm gl = g; { const unsigned long long a_ = (unsigned long long)g.A, b_ = (unsigned long long)g.Bt; unsigned al = __builtin_amdgcn_readfirstlane((unsigned)a_), ah = __builtin_amdgcn_readfirstlane((unsigned)(a_ >> 32)), bl = __builtin_amdgcn_readfirstlane((unsigned)b_), bh = __builtin_amdgcn_readfirstlane((unsigned)(b_ >> 32));
        asm volatile("" : "+s"(al), "+s"(ah), "+s"(bl), "+s"(bh)); gl.A = (const bf16_t*)(((unsigned long long)ah << 32) | al); gl.Bt = (const bf16_t*)(((unsigned long long)bh << 32) | bl); }
    int lid_; asm volatile("v_mbcnt_lo_u32_b32 %0, -1, 0\n\tv_mbcnt_hi_u32_b32 %0, -1, %0" : "=v"(lid_));
    const int tid_ = wave_id * 64 + lid_;
    const int tid = tid_, wid = __builtin_amdgcn_readfirstlane(tid >> 6), lane = tid & 63, wr = wid >> 2, wc = wid & 3, fr = lane & 15, fq = lane >> 4;
    const int K = gl.K, nt = K / BK;
    unsigned voffA[2], voffB[2];
#pragma unroll
    for (int i = 0; i < 2; ++i) { int R, C; stage_rc(tid * 16 + i * 8192, R, C); const int Rb = Epi::PERM ? ((R & ~31) + perm32(R & 31)) : R;
        voffA[i] = (unsigned)(R * K + C) * 2u; voffB[i] = (unsigned)(Rb * K + C) * 2u; }
    const size_t kstep = (size_t)(BK * 2);
    const size_t hstep = (size_t)HALF * K * 2;
    const size_t tstep = 2 * hstep;
    const unsigned ldsw = (unsigned)wid * 1024u; const unsigned ldsbase = (unsigned)__builtin_amdgcn_readfirstlane((unsigned)(size_t)lds + ldsw);
    const int aoff = lds_byte(wr * 64 + fr, fq * 8), boff = lds_byte(wc * 32 + fr, fq * 8);
#define PG8_SA(b, h) (((b) * 2 + (h)) * HTB)
#define PG8_SB(b, h) ((4 + (b) * 2 + (h)) * HTB)
#define PG8_STAGE(bufoff, gbase, voff) do { _Pragma("unroll") for (int _i = 0; _i < 2; ++_i) { unsigned keep_; \
        asm volatile("s_mov_b32 %0, m0\n\ts_mov_b32 m0, %3\n\ts_nop 0\n\tglobal_load_lds_dwordx4 %1, %2\n\ts_mov_b32 m0, %0" : "=&s"(keep_) \
                     : "v"((voff)[_i]), "s"((const char*)(gbase)), "s"(ldsbase + (unsigned)((bufoff) + _i * 8192)) : "memory"); } } while (0)
#define PG8_LDA(dst, b, h) do { _Pragma("unroll") for (int m = 0; m < 4; ++m) _Pragma("unroll") for (int k = 0; k < 2; ++k) dst[m][k] = *(const PG8_LAS bf16x8*)(lds + PG8_SA(b, h) + aoff + m * 2048 + k * 1024); } while (0)
#define PG8_LDB(dst, b, h) do { _Pragma("unroll") for (int n = 0; n < 2; ++n) _Pragma("unroll") for (int k = 0; k < 2; ++k) dst[n][k] = *(const PG8_LAS bf16x8*)(lds + PG8_SB(b, h) + boff + n * 2048 + k * 1024); } while (0)
#define PG8_MMA(ai, bj, At, Bt) do { __builtin_amdgcn_s_setprio(1); _Pragma("unroll") for (int m = 0; m < 4; ++m) _Pragma("unroll") for (int n = 0; n < 2; ++n) _Pragma("unroll") for (int k = 0; k < 2; ++k) \
        acc[ai][bj][m][n] = PG8_MFMA16(Bt[n][k], At[m][k], acc[ai][bj][m][n]); __builtin_amdgcn_s_setprio(0); } while (0)
#define PG8_WAIT_V(n) asm volatile("s_waitcnt vmcnt(" #n ")" ::: "memory")
#define PG8_WAIT_L(n) asm volatile("s_waitcnt lgkmcnt(" #n ")" ::: "memory")
#define PG8_BAR __builtin_amdgcn_s_barrier()
#define PG8_SCHED __builtin_amdgcn_sched_barrier(0)
    float zf_ = 0.f; asm volatile("" : "+v"(zf_));
    Unit cur, nxt; int ui = 0;
    if (!S.next(0, cur)) return;
    f32x4 acc[2][2][4][2];
#pragma unroll
    for (int a = 0; a < 2; ++a)
#pragma unroll
        for (int b = 0; b < 2; ++b)
#pragma unroll
            for (int m = 0; m < 4; ++m)
#pragma unroll
                for (int n = 0; n < 2; ++n) acc[a][b][m][n] = (f32x4){zf_, zf_, zf_, zf_};
    bf16x8 At[4][2], B0[2][2], B1[2][2];
    const char* cA = (const char*)gl.A + (size_t)cur.pm * tstep; const char* cB = (const char*)gl.Bt + (size_t)cur.pb * tstep;
    S.a_ready(cur);
    if constexpr (SP2) {
        PG8_STAGE(PG8_SB(0, 0), cB, voffB); PG8_STAGE(PG8_SB(0, 1), cB + hstep, voffB); PG8_STAGE(PG8_SA(0, 0), cA, voffA); PG8_STAGE(PG8_SA(0, 1), cA + hstep, voffA);
        if (wr == 1) PG8_BAR;
        PG8_WAIT_V(2); PG8_BAR;
        PG8_STAGE(PG8_SB(1, 0), cB + kstep, voffB); PG8_STAGE(PG8_SA(1, 0), cA + kstep, voffA); PG8_STAGE(PG8_SB(1, 1), cB + hstep + kstep, voffB);
        PG8_WAIT_V(6); PG8_BAR;
    } else {
        PG8_STAGE(PG8_SB(0, 0), cB, voffB); PG8_STAGE(PG8_SA(0, 0), cA, voffA); PG8_STAGE(PG8_SB(0, 1), cB + hstep, voffB); PG8_STAGE(PG8_SA(0, 1), cA + hstep, voffA);
        if (wr == 1) PG8_BAR;
        PG8_WAIT_V(4); PG8_BAR;
        PG8_STAGE(PG8_SB(1, 0), cB + kstep, voffB); PG8_STAGE(PG8_SA(1, 0), cA + kstep, voffA); PG8_STAGE(PG8_SB(1, 1), cB + hstep + kstep, voffB);
        PG8_WAIT_V(6); PG8_BAR;
    }
    for (;;) {
        const bool has_next = S.next(ui + 1, nxt);
        const char* nA = has_next ? (const char*)gl.A + (size_t)nxt.pm * tstep : cA; const char* nB = has_next ? (const char*)gl.Bt + (size_t)nxt.pb * tstep : cB;
        _Pragma("clang loop unroll(disable)")
        for (int t = 0; t < nt; t += 2) {
            const bool last = (t == nt - 2);
            const char* a1 = cA + (size_t)(t + 1) * kstep;
            const char* a2 = last ? nA : cA + (size_t)(t + 2) * kstep; const char* b2 = last ? nB : cB + (size_t)(t + 2) * kstep;
            const char* a3 = a2 + kstep; const char* b3 = b2 + kstep;
            if (last && has_next) S.a_ready(nxt);
            if constexpr (SP2) {
            PG8_LDB(B0, 0, 0); PG8_LDB(B1, 0, 1); PG8_SCHED; PG8_LDA(At, 0, 0); PG8_STAGE(PG8_SA(1, 1), a1 + hstep, voffA);
            PG8_WAIT_V(8); PG8_WAIT_L(0); PG8_BAR; PG8_MMA(0, 0, At, B0); PG8_MMA(0, 1, At, B1); PG8_BAR; PG8_SCHED;
            PG8_LDA(At, 0, 1); PG8_STAGE(PG8_SB(0, 0), b2, voffB); PG8_STAGE(PG8_SB(0, 1), b2 + hstep, voffB); PG8_STAGE(PG8_SA(0, 0), a2, voffA);
            PG8_WAIT_V(8); PG8_WAIT_L(0); PG8_BAR; PG8_MMA(1, 0, At, B0); PG8_MMA(1, 1, At, B1); PG8_BAR; PG8_SCHED;
            PG8_LDB(B0, 1, 0); PG8_LDB(B1, 1, 1); PG8_SCHED; PG8_LDA(At, 1, 0); PG8_STAGE(PG8_SA(0, 1), a2 + hstep, voffA);
            PG8_WAIT_V(8); PG8_WAIT_L(0); PG8_BAR; PG8_MMA(0, 0, At, B0); PG8_MMA(0, 1, At, B1); PG8_BAR; PG8_SCHED;
            PG8_LDA(At, 1, 1); PG8_STAGE(PG8_SB(1, 0), b3, voffB); PG8_STAGE(PG8_SB(1, 1), b3 + hstep, voffB); PG8_STAGE(PG8_SA(1, 0), a3, voffA);
            PG8_WAIT_V(8); PG8_WAIT_L(0); PG8_BAR; PG8_MMA(1, 0, At, B0); PG8_MMA(1, 1, At, B1); PG8_BAR; PG8_SCHED;
            } else {
            PG8_LDB(B0, 0, 0); PG8_SCHED; PG8_LDA(At, 0, 0); PG8_STAGE(PG8_SA(1, 1), a1 + hstep, voffA);
            PG8_WAIT_L(8); PG8_BAR; PG8_WAIT_L(0); PG8_MMA(0, 0, At, B0); PG8_BAR; PG8_SCHED;
            PG8_LDB(B1, 0, 1); PG8_STAGE(PG8_SB(0, 0), b2, voffB);
            PG8_BAR; PG8_WAIT_L(0); PG8_MMA(0, 1, At, B1); PG8_BAR;
            PG8_LDA(At, 0, 1); PG8_STAGE(PG8_SA(0, 0), a2, voffA);
            PG8_BAR; PG8_WAIT_L(0); PG8_MMA(1, 0, At, B0); PG8_BAR; PG8_SCHED;
            PG8_STAGE(PG8_SB(0, 1), b2 + hstep, voffB);
            PG8_WAIT_V(6); PG8_BAR; PG8_MMA(1, 1, At, B1); PG8_BAR;
            PG8_LDB(B0, 1, 0); PG8_SCHED; PG8_LDA(At, 1, 0); PG8_STAGE(PG8_SA(0, 1), a2 + hstep, voffA);
            PG8_WAIT_L(8); PG8_BAR; PG8_WAIT_L(0); PG8_MMA(0, 0, At, B0); PG8_BAR; PG8_SCHED;
            PG8_LDB(B1, 1, 1); PG8_STAGE(PG8_SB(1, 0), b3, voffB);
            PG8_BAR; PG8_WAIT_L(0); PG8_MMA(0, 1, At, B1); PG8_BAR;
            PG8_LDA(At, 1, 1); PG8_STAGE(PG8_SA(1, 0), a3, voffA);
            PG8_BAR; PG8_WAIT_L(0); PG8_MMA(1, 0, At, B0); PG8_BAR; PG8_SCHED;
            PG8_STAGE(PG8_SB(1, 1), b3 + hstep, voffB);
            PG8_WAIT_V(6); PG8_BAR; PG8_MMA(1, 1, At, B1); PG8_BAR;
            }
        }
        if constexpr (ALIGN_EPI) { if (wr == 0) PG8_BAR; }
        if constexpr (!Epi::AFTER_DRAIN) { int fr_e = fr, fq_e = fq; asm volatile("" : "+v"(fr_e), "+v"(fq_e));
            E(acc, cur, wr, wc, fr_e, fq_e); S.done(cur); }
        if (!has_next) break;
#pragma unroll
        for (int a = 0; a < 2; ++a)
#pragma unroll
            for (int b = 0; b < 2; ++b)
#pragma unroll
                for (int m = 0; m < 4; ++m)
#pragma unroll
                    for (int n = 0; n < 2; ++n) acc[a][b][m][n] = (f32x4){zf_, zf_, zf_, zf_};
        cur = nxt; cA = nA; cB = nB; ++ui;
        if constexpr (ALIGN_EPI) { if (wr == 1) PG8_BAR; }
    }
    PG8_WAIT_V(0);
    if constexpr (!ALIGN_EPI) { if (wr == 0) PG8_BAR; }
    PG8_BAR;
    if constexpr (Epi::AFTER_DRAIN) { E.fused(acc, cur, wr, wc, fr, fq, lds, wid, lane); S.done(cur); }
#undef PG8_SA
#undef PG8_SB
#undef PG8_STAGE
#undef PG8_LDA
#undef PG8_LDB
#undef PG8_MMA
#undef PG8_WAIT_V
#undef PG8_WAIT_L
#undef PG8_BAR
#undef PG8_SCHED
}
}

typedef unsigned short u16;
typedef unsigned int u32;
constexpr int NTOK = 32768, SEQ = 16384, DM = 1024, NL = 4, NWAVES = 8, NTHR = 512;
constexpr int INW = 6568;
constexpr int MAXROWS = NTOK + 24 * 256;
constexpr float EPS = 1e-6f;
constexpr float LOG2E = 1.4426950408889634f;
constexpr size_t MiB = 1u << 20;
constexpr size_t WS_CTL = 0, CTL_ZERO_BYTES = 1 * MiB;
constexpr size_t WS_MOD = 1 * MiB;
constexpr size_t WS_ROPE = 2 * MiB;
constexpr size_t WS_SSQQ = 4 * MiB, WS_SSQKV = 4 * MiB + 512 * 1024;
constexpr size_t WS_IF = 5 * MiB;
constexpr size_t WS_ROUT = 6 * MiB;
constexpr size_t WS_TOK = 7 * MiB;
constexpr size_t WS_MLS = 8 * MiB;
constexpr size_t WS_WIN = 16 * MiB, WS_WUQ = 29 * MiB, WS_WUKV = 29 * MiB + 512 * 1024, WS_WBR = 30 * MiB, WS_WOUT = 33 * MiB, WS_WGU = 35 * MiB, WS_WDC = 51 * MiB;
constexpr size_t WS_ACT = 76 * MiB, SLOT = 32 * MiB;
constexpr size_t WS_END = WS_ACT + 14 * SLOT;
#define ACT(i) (WS_ACT + (size_t)(i) * SLOT)
constexpr int CW_BAR = 4096, CW_MOE = 16384;
constexpr int RING_BYTES = 131072, LDSCTL_OFF = RING_BYTES, MISC_OFF = LDSCTL_OFF + 320, TAB_OFF = LDSCTL_OFF + 1024, PTAB_OFF = LDSCTL_OFF + 4096, LDS_BYTES = 147456;

#define GAS __attribute__((address_space(1)))
#define LAS __attribute__((address_space(3)))
typedef unsigned v4u __attribute__((ext_vector_type(4)));
typedef unsigned v2u __attribute__((ext_vector_type(2)));
typedef float f32x4 __attribute__((ext_vector_type(4)));
#define LDS_WAIT() asm volatile("s_waitcnt lgkmcnt(0)" ::: "memory")
__device__ __forceinline__ u32 f2bf(float f) { u32 u = __builtin_bit_cast(u32, f); return (u + 0x7fffu + ((u >> 16) & 1u)) >> 16; }
__device__ __forceinline__ u32 pk2(float lo, float hi) { return pg8::cvt_pk_bf16(lo, hi); }
#if MK_F16
__device__ __forceinline__ float bflo(u32 w) { return (float)__builtin_bit_cast(pg8::h16x2, w)[0]; }
__device__ __forceinline__ float bfhi(u32 w) { return (float)__builtin_bit_cast(pg8::h16x2, w)[1]; }
__device__ __forceinline__ float bf1(u16 w) { return (float)__builtin_bit_cast(_Float16, w); }
#else
__device__ __forceinline__ float bflo(u32 w) { return __uint_as_float(w << 16); }
__device__ __forceinline__ float bfhi(u32 w) { return __uint_as_float(w & 0xffff0000u); }
__device__ __forceinline__ float bf1(u16 w) { return __uint_as_float(((u32)w) << 16); }
#endif
__device__ __forceinline__ float fsigmoid(float x) { return __builtin_amdgcn_rcpf(1.0f + __expf(-x)); }
__device__ __forceinline__ float fsilu(float x) { return x * fsigmoid(x); }
__device__ __forceinline__ float bperm_f(int srclane, float v) { return __int_as_float(__builtin_amdgcn_ds_bpermute(srclane << 2, __float_as_int(v))); }
__device__ __forceinline__ float wave_sum(float v, int lane) {
#pragma unroll
    for (int o = 1; o < 64; o <<= 1) v += bperm_f(lane ^ o, v);
    return v;
}

__device__ __forceinline__ void* ldsptr(LAS unsigned char* lds, int i) {
    int off_ = PTAB_OFF + 8 * i; asm volatile("" : "+v"(off_));
    const unsigned long long v = *(volatile LAS unsigned long long*)(lds + off_);
    const unsigned lo = __builtin_amdgcn_readfirstlane((unsigned)v), hi = __builtin_amdgcn_readfirstlane((unsigned)(v >> 32));
    unsigned lo2 = lo, hi2 = hi; asm volatile("" : "+s"(lo2), "+s"(hi2));
    return (void*)(uintptr_t)(((unsigned long long)hi2 << 32) | lo2);
}
struct Params { const float* in[31]; float* out; unsigned char* ws; int ph_lo, ph_hi; };
struct Frame {
    LAS unsigned char* lds; int tid, lane, wave, G, bid;
    unsigned char* ws;
};
#define FIN(i) ((const float*)ldsptr(F.lds, (i)))

__device__ __forceinline__ void conv_tile(const float* Wk0, int ldw, const float* ksc, u16* dst, int ldk, int srcc, LAS float* scr, int lane, bool live = true, bool scaled = false) {
#pragma unroll 8
    for (int i = 0; i < 32; ++i) { const int kk = 2 * i + (lane >> 5); float v = 0.f;
        if (live && srcc >= 0) { v = Wk0[(size_t)kk * ldw + srcc]; if (scaled) v *= ksc[kk]; }
        scr[kk * 33 + (lane & 31)] = v; }
    LDS_WAIT(); asm volatile("" ::: "memory");
    const int c = lane & 7;
#pragma unroll
    for (int j = 0; j < 4; ++j) { const int n = (lane >> 3) + 8 * j; const LAS float* s = scr + (8 * c) * 33 + n;
        v4u o; o.x = pk2(s[0 * 33], s[1 * 33]); o.y = pk2(s[2 * 33], s[3 * 33]); o.z = pk2(s[4 * 33], s[5 * 33]); o.w = pk2(s[6 * 33], s[7 * 33]);
        *(v4u*)(dst + (size_t)n * ldk + 8 * c) = o; }
    LDS_WAIT(); asm volatile("" ::: "memory");
}
__device__ __forceinline__ int win_srccol(int n) {
    const int pn = n >> 8, j = n & 255;
    if (pn == 0) return j;
    if (pn == 1) { if (j < 128) return 256 + j; if (j < 160) return 384 + (j - 128); if (j < 164) return 1952 + (j - 160); if (j < 168) return 1956 + (j - 164); return -1; }
    if (pn < 8) return 416 + (pn - 2) * 256 + j;
    if (pn < 12) { const int base = pn < 10 ? 1960 : 2472, half = (pn - 8) & 1, bj = j >> 7, wc = (j & 127) >> 5, i32 = j & 31; return base + (half * 4 + wc) * 64 + bj * 32 + i32; }
    if (pn < 14) return 2984 + (pn - 12) * 256 + j;
    return 3496 + (n - 3584);
}
__device__ __forceinline__ void cls_experts(int cls, int& ea, int& eb) {
    const int g = cls / 6, p = cls % 6; const int a = p < 3 ? 0 : (p < 5 ? 1 : 2); const int b = p < 3 ? p + 1 : (p < 5 ? p - 1 : 3);
    ea = g * 4 + a; eb = g * 4 + b;
}
__device__ __forceinline__ void conv_phase(Frame& F, int l) {
    LAS float* scr = (LAS float*)(F.lds + F.wave * 16384);
    const int gw = F.bid * NWAVES + F.wave, NGW = F.G * NWAVES, lane = F.lane, ln = lane & 31;
    constexpr int I_WIN = 208 * 16, I_UQ = 24 * 4, I_UKV = 32 * 4, I_BR = 3 * 32 * 8, I_OUT = 32 * 16, I_GU = 16 * 16 * 16, I_DC = 24 * 32 * 8;
    constexpr int NITEMS = I_WIN + I_UQ + I_UKV + I_BR + I_OUT + I_GU + I_DC;
    unsigned char* ws = F.ws;
    for (int it = gw; it < NITEMS; it += NGW) {
        int r = it;
        if (r < I_WIN) { const int nb = r / 16, kb = r % 16; const float* W = FIN(5) + (size_t)l * 1024 * INW;
            conv_tile(W + (size_t)kb * 64 * INW, INW, nullptr, (u16*)(ws + WS_WIN) + (size_t)nb * 32 * 1024 + kb * 64, 1024, win_srccol(nb * 32 + ln), scr, lane, true, false); continue; } r -= I_WIN;
        if (r < I_UQ) { const int nb = r / 4, kb = r % 4; const float* W = FIN(8) + (size_t)l * 256 * 768;
            conv_tile(W + (size_t)kb * 64 * 768, 768, FIN(6) + l * 256 + kb * 64, (u16*)(ws + WS_WUQ) + (size_t)nb * 32 * 256 + kb * 64, 256, nb * 32 + ln, scr, lane, true, true); continue; } r -= I_UQ;
        if (r < I_UKV) { const int nb = r / 4, kb = r % 4; const float* W = FIN(9) + (size_t)l * 128 * 1024;
            conv_tile(W + (size_t)(kb & 1) * 64 * 1024, 1024, FIN(7) + l * 128 + (kb & 1) * 64, (u16*)(ws + WS_WUKV) + (size_t)nb * 32 * 256 + kb * 64, 256, nb * 32 + ln, scr, lane, kb < 2, true); continue; } r -= I_UKV;
        if (r < I_BR) { const int br = r / 256, q = r % 256, nb = q / 8, kb = q % 8; const float* W = (br == 0 ? FIN(19) : (br == 1 ? FIN(20) : FIN(21))) + (size_t)l * 512 * 1024;
            conv_tile(W + (size_t)kb * 64 * 1024, 1024, nullptr, (u16*)(ws + WS_WBR) + (size_t)br * 1024 * 512 + (size_t)nb * 32 * 512 + kb * 64, 512, nb * 32 + ln, scr, lane, true, false); continue; } r -= I_BR;
        if (r < I_OUT) { const int nb = r / 16, kb = r % 16; const float* W = FIN(22) + (size_t)l * 1024 * 1024;
            conv_tile(W + (size_t)kb * 64 * 1024, 1024, nullptr, (u16*)(ws + WS_WOUT) + (size_t)nb * 32 * 1024 + kb * 64, 1024, nb * 32 + ln, scr, lane, true, false); continue; } r -= I_OUT;
        if (r < I_GU) { const int e = r / 256, q = r % 256, nb = q / 16, kb = q % 16;
            const int p = nb >> 3, jp = (nb & 7) * 32, bj = jp >> 7, f = p * 128 + (jp & 127) + ln;
            const float* W = (bj ? FIN(29) : FIN(28)) + ((size_t)l * 16 + e) * 1024 * 256;
            conv_tile(W + (size_t)kb * 64 * 256, 256, nullptr, (u16*)(ws + WS_WGU) + ((size_t)e * 512 + nb * 32) * 1024 + kb * 64, 1024, f, scr, lane, true, false); continue; } r -= I_GU;
        { const int cls = r / 256, q = r % 256, nb = q / 8, kb = q % 8; int ea, eb; cls_experts(cls, ea, eb);
            const int e = kb < 4 ? ea : eb, k0 = (kb & 3) * 64; const float* W = FIN(30) + ((size_t)l * 16 + e) * 256 * 1024;
            conv_tile(W + (size_t)k0 * 1024, 1024, nullptr, (u16*)(ws + WS_WDC) + ((size_t)cls * 1024 + nb * 32) * 512 + kb * 64, 512, nb * 32 + ln, scr, lane); }
    }
}

__device__ __forceinline__ void pre_phase(Frame& F) {
    const float* c = FIN(1); const float* w_ada = FIN(2); const float* b_ada = FIN(3);
    float* mod = (float*)(F.ws + WS_MOD);
    LAS float* scr = (LAS float*)F.lds;
    for (int u = F.bid; u < NL * 96; u += F.G) {
        const int l = u / 96, j0 = (u % 96) * 64, jc = F.tid & 63, dg = F.tid >> 6;
        const float* W = w_ada + (size_t)l * 1024 * 6144 + j0 + jc;
        float a0 = 0.f, a1 = 0.f;
        for (int d = dg * 128; d < dg * 128 + 128; ++d) { const float w = W[(size_t)d * 6144]; a0 += fsilu(c[d]) * w; a1 += fsilu(c[1024 + d]) * w; }
        scr[(dg * 64 + jc) * 2 + 0] = a0; scr[(dg * 64 + jc) * 2 + 1] = a1;
        __syncthreads();
        if (F.tid < 128) { const int jc2 = F.tid & 63, b = F.tid >> 6; float s = b_ada[l * 6144 + j0 + jc2];
#pragma unroll
            for (int g = 0; g < 8; ++g) s += scr[(g * 64 + jc2) * 2 + b];
            mod[(size_t)(l * 2 + b) * 6144 + j0 + jc2] = s; }
        __syncthreads();
    }
    float* ct = (float*)(F.ws + WS_ROPE); float* st = ct + SEQ * 16;
    for (int idx = F.bid * NTHR + F.tid; idx < SEQ * 16; idx += F.G * NTHR) {
        const int pos = idx >> 4, i = idx & 15;
        double inv = (i & 3) == 0 ? 1.0 : ((i & 3) == 1 ? 0.5623413251903491 : ((i & 3) == 2 ? 0.31622776601683794 : 0.1778279410038923));
        const int dec = i >> 2; inv = dec == 0 ? inv : (dec == 1 ? inv * 0.1 : (dec == 2 ? inv * 0.01 : inv * 0.001));
        const float ang = (float)pos * (float)inv;
        double rev = (double)ang * 0.15915494309189535; rev -= __builtin_rint(rev);
        ct[idx] = __builtin_amdgcn_cosf((float)rev); st[idx] = __builtin_amdgcn_sinf((float)rev);
    }
}

__device__ __forceinline__ void norm_rows(Frame& F, const float* xin, const float* gain, const float* modl  , int ish, int isc, u16* U) {
    const int gw = F.bid * NWAVES + F.wave, NGW = F.G * NWAVES, lane = F.lane;
    for (int m = gw; m < NTOK; m += NGW) {
        const int b = m / SEQ;
        const f32x4* xr = (const f32x4*)(xin + (size_t)m * DM) + lane;
        f32x4 v[4]; float s = 0.f;
#pragma unroll
        for (int j = 0; j < 4; ++j) { v[j] = xr[64 * j]; s += (v[j].x * v[j].x + v[j].y * v[j].y) + (v[j].z * v[j].z + v[j].w * v[j].w); }
        const float rstd = 1.0f / sqrtf(wave_sum(s, lane) * (1.f / DM) + EPS);
        v2u* o8 = (v2u*)(U + (size_t)m * DM) + lane;
#pragma unroll
        for (int j = 0; j < 4; ++j) { const int c0 = 4 * lane + 256 * j;
            const f32x4 g = *(const f32x4*)(gain + c0), sc = *(const f32x4*)(modl + (size_t)(b * 6 + isc) * 1024 + c0), sh = *(const f32x4*)(modl + (size_t)(b * 6 + ish) * 1024 + c0);
            const f32x4 y = (v[j] * rstd) * g * (sc + 1.0f) + sh;
            v2u w; w.x = pk2(y.x, y.y); w.y = pk2(y.z, y.w); o8[64 * j] = w; }
    }
}
#define XB_TMO      128
#define XB_XCNT(j)  (256  + 64 * (j))
#define XB_XSUB(j)  (1280 + 64 * (j))
#define XB_XGEN(j)  (2304 + 64 * (j))
#define XB_TOP      3328
#define XB_TOPGEN   3392
#define XCD_BAR_WORDS 3456
#define XB_SPIN_CAP (1u << 18)

__device__ __forceinline__ unsigned xb_ld(unsigned* p)              { return __hip_atomic_load(p, __ATOMIC_RELAXED, __HIP_MEMORY_SCOPE_AGENT); }
__device__ __forceinline__ unsigned xb_add(unsigned* p, unsigned v) { return __hip_atomic_fetch_add(p, v, __ATOMIC_RELAXED, __HIP_MEMORY_SCOPE_AGENT); }
__device__ __forceinline__ unsigned xb_xcc_id() { return (unsigned)__builtin_amdgcn_s_getreg((3 << 11) | 20) & 0xFu; }
#define XB_SPIN(cond, bar) do { unsigned _sp = 0; while (cond) { __builtin_amdgcn_s_sleep(1); \
    if ((++_sp & 255u) == 0u) { if (xb_ld(&(bar)[XB_TMO])) break; if (_sp > XB_SPIN_CAP) { atomicAdd(&(bar)[XB_TMO], 1u); break; } } } } while (0)

struct XcdBarrier {
    unsigned* bar; unsigned x;
    volatile LAS unsigned* st;
    bool lead;
};

__device__ __forceinline__ XcdBarrier xcd_barrier_post(unsigned* bar, volatile LAS unsigned* st) {
    XcdBarrier b; b.bar = bar; b.x = xb_xcc_id(); b.st = st; b.lead = (threadIdx.x == 0);
    if (b.lead) (void)xb_add(&bar[XB_XCNT(b.x)], 1u);
    return b;
}
__device__ __forceinline__ void xcd_barrier_complete(unsigned* bar, unsigned x, unsigned& nloc, unsigned& nx) {
    const unsigned G = gridDim.x * gridDim.y * gridDim.z;
    unsigned sum, cnt, mine, sp = 0u;
    for (;;) {
        sum = 0u; cnt = 0u; mine = 0u;
#pragma unroll
        for (unsigned j = 0; j < 16; ++j) { const unsigned c = xb_ld(&bar[XB_XCNT(j)]); sum += c; cnt += (c > 0u) ? 1u : 0u; mine = (j == x) ? c : mine; }
        if (sum == G) break;
        __builtin_amdgcn_s_sleep(1);
        if ((++sp & 255u) == 0u) { if (xb_ld(&bar[XB_TMO])) break; if (sp > XB_SPIN_CAP) { atomicAdd(&bar[XB_TMO], 1u); break; } }
    }
    nloc = mine > 0u ? mine : 1u; nx = cnt > 0u ? cnt : 1u;
}

__device__ __forceinline__ void xcd_barrier(const XcdBarrier& b) {
    asm volatile("s_waitcnt vmcnt(0)" ::: "memory");
    __syncthreads();
    if (b.lead) {
        unsigned* bar = b.bar;
        __builtin_amdgcn_s_waitcnt(0);
        unsigned nloc = b.st[0], nx = b.st[1];
        if (nloc == 0u) { xcd_barrier_complete(bar, b.x, nloc, nx); b.st[0] = nloc; b.st[1] = nx; }
        const unsigned old = xb_add(&bar[XB_XSUB(b.x)], 1u);
        const unsigned gen = old / nloc;
        if (old + 1u == (gen + 1u) * nloc) {
            __builtin_amdgcn_fence(__ATOMIC_RELEASE, "agent");
            asm volatile("s_waitcnt vmcnt(0)" ::: "memory");
            const unsigned og = xb_add(&bar[XB_TOP], 1u);
            const unsigned tg = og / nx;
            if (og + 1u == (tg + 1u) * nx) xb_add(&bar[XB_TOPGEN], 1u);
            else XB_SPIN(xb_ld(&bar[XB_TOPGEN]) == tg, bar);
            __builtin_amdgcn_fence(__ATOMIC_ACQUIRE, "agent");
            xb_add(&bar[XB_XGEN(b.x)], 1u);
            asm volatile("s_waitcnt vmcnt(0)" ::: "memory");
        } else {
            XB_SPIN(xb_ld(&bar[XB_XGEN(b.x)]) == gen, bar);
            __builtin_amdgcn_fence(__ATOMIC_ACQUIRE, "agent");
            asm volatile("s_waitcnt vmcnt(0)" ::: "memory");
        }
    }
    __syncthreads();
}

typedef pg8::f32x4 A4;
#define EPI_ARGS const A4 (&acc)[2][2][4][2], const pg8::Unit& u, int wr, int wc, int fr, int fq
__device__ __forceinline__ v4u pack8(A4 a, A4 b) { v4u w; w.x = pk2(a[0], a[1]); w.y = pk2(a[2], a[3]); w.z = pk2(b[0], b[1]); w.w = pk2(b[2], b[3]); return w; }
__device__ __forceinline__ float dot4(A4 a) { return (a[0] * a[0] + a[1] * a[1]) + (a[2] * a[2] + a[3] * a[3]); }
__device__ __forceinline__ float logsigmoidf(float x) { const float e = __expf(-fabsf(x)); return fminf(x, 0.f) - __logf(1.0f + e); }

struct EpiG1 {
    static constexpr bool PERM = true, AFTER_DRAIN = false;
    unsigned char* ws; const float *b_i, *b_f, *dqg, *dkg;
    __device__ __forceinline__ void operator()(EPI_ARGS) const {
        u16* const CQ = (u16*)(ws + ACT(2)); u16* const C1 = (u16*)(ws + ACT(2) + 16 * MiB); u16* const DV = (u16*)(ws + ACT(8));
        float* const ssqq = (float*)(ws + WS_SSQQ); float* const ssqkv = (float*)(ws + WS_SSQKV); float* const IF = (float*)(ws + WS_IF);
        const int pn = u.pn, row0 = u.pm * 256 + wr * 64 + fr, cw = 32 * wc + 8 * fq;
        if (pn == 0) {
#pragma unroll
            for (int ai = 0; ai < 2; ++ai)
#pragma unroll
                for (int m = 0; m < 4; ++m) { const size_t row = row0 + ai * 128 + m * 16; float ss = 0.f;
#pragma unroll
                    for (int bj = 0; bj < 2; ++bj) { ss += dot4(acc[ai][bj][m][0]) + dot4(acc[ai][bj][m][1]); *(v4u*)(CQ + row * 256 + bj * 128 + cw) = pack8(acc[ai][bj][m][0], acc[ai][bj][m][1]); }
                    ss += bperm_f((fq * 16 + fr) ^ 16, ss); ss += bperm_f((fq * 16 + fr) ^ 32, ss);
                    if (fq == 0) ssqq[row * 4 + wc] = ss; }
        } else if (pn == 1) {
#pragma unroll
            for (int ai = 0; ai < 2; ++ai)
#pragma unroll
                for (int m = 0; m < 4; ++m) { const size_t row = row0 + ai * 128 + m * 16;
                    float ss = dot4(acc[ai][0][m][0]) + dot4(acc[ai][0][m][1]);
#pragma unroll
                    for (int bj = 0; bj < 2; ++bj) *(v4u*)(C1 + row * 256 + bj * 128 + cw) = pack8(acc[ai][bj][m][0], acc[ai][bj][m][1]);
                    ss += bperm_f((fq * 16 + fr) ^ 16, ss); ss += bperm_f((fq * 16 + fr) ^ 32, ss);
                    if (fq == 0) { ssqkv[row * 4 + wc] = ss;
                        if (wc == 1) { const A4 gi = acc[ai][1][m][0], gf = acc[ai][1][m][1]; A4 o0, o1;
#pragma unroll
                            for (int i = 0; i < 4; ++i) { o0[i] = gi[i] + b_i[i]; o1[i] = logsigmoidf(gf[i] + b_f[i]); }
                            *(A4*)(IF + row * 8) = o0; *(A4*)(IF + row * 8 + 4) = o1; } } }
        } else if (pn < 8) {
            u16* dst = (u16*)(ws + WS_ACT + (size_t)(3 + ((pn - 2) >> 1)) * SLOT); const int cb = (pn & 1) * 256; const bool sg = pn >= 6;
#pragma unroll
            for (int ai = 0; ai < 2; ++ai)
#pragma unroll
                for (int m = 0; m < 4; ++m) { const size_t row = row0 + ai * 128 + m * 16;
#pragma unroll
                    for (int bj = 0; bj < 2; ++bj) { A4 a = acc[ai][bj][m][0], b = acc[ai][bj][m][1];
                        if (sg) {
#pragma unroll
                            for (int i = 0; i < 4; ++i) { a[i] = fsigmoid(a[i]); b[i] = fsigmoid(b[i]); } }
                        *(v4u*)(dst + row * 512 + cb + bj * 128 + cw) = pack8(a, b); } }
        } else if (pn < 12) {
            const bool isq = pn < 10; u16* dst = (u16*)(ws + WS_ACT + (size_t)(isq ? 6 : 7) * SLOT); const float* gn = isq ? dqg : dkg; const int head = (pn & 1) * 4 + wc;
            const float osc = isq ? 0.125f * LOG2E : 1.0f;
#pragma unroll
            for (int ai = 0; ai < 2; ++ai)
#pragma unroll
                for (int m = 0; m < 4; ++m) { const size_t row = row0 + ai * 128 + m * 16;
                    float ss = (dot4(acc[ai][0][m][0]) + dot4(acc[ai][0][m][1])) + (dot4(acc[ai][1][m][0]) + dot4(acc[ai][1][m][1]));
                    ss += bperm_f((fq * 16 + fr) ^ 16, ss); ss += bperm_f((fq * 16 + fr) ^ 32, ss);
                    const float rstd = osc / sqrtf(ss * (1.f / 64.f) + EPS);
#pragma unroll
                    for (int bj = 0; bj < 2; ++bj) { const A4 g0 = *(const A4*)(gn + bj * 32 + 8 * fq), g1 = *(const A4*)(gn + bj * 32 + 8 * fq + 4);
                        *(v4u*)(dst + row * 512 + head * 64 + bj * 32 + 8 * fq) = pack8(acc[ai][bj][m][0] * rstd * g0, acc[ai][bj][m][1] * rstd * g1); }
                    asm volatile("" ::: "memory"); }
        } else {
            const int cb = (pn & 1) * 256;
#pragma unroll
            for (int ai = 0; ai < 2; ++ai)
#pragma unroll
                for (int m = 0; m < 4; ++m) { const size_t row = row0 + ai * 128 + m * 16;
#pragma unroll
                    for (int bj = 0; bj < 2; ++bj) *(v4u*)(DV + row * 512 + cb + bj * 128 + cw) = pack8(acc[ai][bj][m][0], acc[ai][bj][m][1]); }
        }
    }
};
struct EpiQU {
    static constexpr bool PERM = true, AFTER_DRAIN = false;
    u16* Q; const float* ssqq;
    __device__ __forceinline__ void operator()(EPI_ARGS) const {
        const int row0 = u.pm * 256 + wr * 64 + fr, col0 = u.pn * 256 + 32 * wc + 8 * fq;
#pragma unroll
        for (int ai = 0; ai < 2; ++ai)
#pragma unroll
            for (int m = 0; m < 4; ++m) { const size_t row = row0 + ai * 128 + m * 16; const A4 s4 = *(const A4*)(ssqq + row * 4);
                const float r = 1.0f / sqrtf(((s4[0] + s4[1]) + (s4[2] + s4[3])) * (1.f / 256.f) + EPS);
#pragma unroll
                for (int bj = 0; bj < 2; ++bj) *(v4u*)(Q + row * 768 + col0 + bj * 128) = pack8(acc[ai][bj][m][0] * r, acc[ai][bj][m][1] * r);
                asm volatile("" ::: "memory"); }
    }
};
struct EpiKVU {
    static constexpr bool PERM = true, AFTER_DRAIN = false;
    u16 *K, *V; const float* ssqkv;
    __device__ __forceinline__ void operator()(EPI_ARGS) const {
        const int row0 = u.pm * 256 + wr * 64 + fr;
#pragma unroll
        for (int ai = 0; ai < 2; ++ai)
#pragma unroll
            for (int m = 0; m < 4; ++m) { const size_t row = row0 + ai * 128 + m * 16; const A4 s4 = *(const A4*)(ssqkv + row * 4);
                const float r = 1.0f / sqrtf(((s4[0] + s4[1]) + (s4[2] + s4[3])) * (1.f / 128.f) + EPS);
#pragma unroll
                for (int bj = 0; bj < 2; ++bj) { const int head = 2 * u.pn + bj; const v4u w = pack8(acc[ai][bj][m][0] * r, acc[ai][bj][m][1] * r);
                    if (wc < 2) *(v4u*)(K + row * 768 + head * 96 + 32 * wc + 8 * fq) = w; else *(v4u*)(V + row * 512 + head * 64 + 32 * (wc - 2) + 8 * fq) = w; }
                asm volatile("" ::: "memory"); }
    }
};
struct EpiGate {
    static constexpr bool PERM = true, AFTER_DRAIN = false;
    u16* GT;
    __device__ __forceinline__ void operator()(EPI_ARGS) const {
        const int row0 = u.pm * 256 + wr * 64 + fr, col0 = u.pn * 256 + 32 * wc + 8 * fq;
#pragma unroll
        for (int ai = 0; ai < 2; ++ai)
#pragma unroll
            for (int m = 0; m < 4; ++m) { const size_t row = row0 + ai * 128 + m * 16;
#pragma unroll
                for (int bj = 0; bj < 2; ++bj) { A4 a = acc[ai][bj][m][0], b = acc[ai][bj][m][1];
#pragma unroll
                    for (int i = 0; i < 4; ++i) { a[i] = fsigmoid(a[i]); b[i] = fsigmoid(b[i]); }
                    *(v4u*)(GT + row * 3072 + col0 + bj * 128) = pack8(a, b); } }
    }
};
template <int IDX> struct EpiMerge {
    static constexpr bool PERM = true, AFTER_DRAIN = false;
    const u16* GT; u16* M; unsigned* dbg;
    __device__ __forceinline__ void operator()(EPI_ARGS) const {
        const int row0 = u.pm * 256 + wr * 64 + fr, col0 = u.pn * 256 + 32 * wc + 8 * fq;
#pragma unroll
        for (int ai = 0; ai < 2; ++ai)
#pragma unroll
            for (int m = 0; m < 4; ++m) { const size_t row = row0 + ai * 128 + m * 16;
#pragma unroll
                for (int bj = 0; bj < 2; ++bj) { const v4u g = *(const v4u*)(GT + row * 3072 + IDX * 1024 + col0 + bj * 128);
                    A4 a = acc[ai][bj][m][0], b = acc[ai][bj][m][1];
                    a[0] *= bflo(g.x); a[1] *= bfhi(g.x); a[2] *= bflo(g.y); a[3] *= bfhi(g.y); b[0] *= bflo(g.z); b[1] *= bfhi(g.z); b[2] *= bflo(g.w); b[3] *= bfhi(g.w);
                    if ((MK_ABL >> IDX) & 1) { a = (A4){0.f, 0.f, 0.f, 0.f}; b = a; }
#if MK_CHECK
                    for (int i_ = 0; i_ < 4; ++i_) { if (fabsf(a[i_]) > MK_UPD_BIG) atomicAdd(dbg + IDX, 1u); if (fabsf(b[i_]) > MK_UPD_BIG) atomicAdd(dbg + IDX, 1u); }
#endif
                    u16* mp = M + row * 1024 + col0 + bj * 128;
                    if (IDX > 0) { const v4u p = *(const v4u*)mp; a[0] += bflo(p.x); a[1] += bfhi(p.x); a[2] += bflo(p.y); a[3] += bfhi(p.y); b[0] += bflo(p.z); b[1] += bfhi(p.z); b[2] += bflo(p.w); b[3] += bfhi(p.w); }
                    *(v4u*)mp = pack8(a, b); }
                asm volatile("" ::: "memory"); }
    }
};
struct EpiOut {
    static constexpr bool PERM = false, AFTER_DRAIN = false;
    const float* xin; float* xout; const float* ga  ; unsigned* dbg;
    __device__ __forceinline__ void operator()(EPI_ARGS) const {
        const int row0 = u.pm * 256 + wr * 64 + fr, col0 = u.pn * 256 + 32 * wc + 4 * fq, b = (u.pm * 256) / SEQ;
        A4 g[2][2];
#pragma unroll
        for (int bj = 0; bj < 2; ++bj)
#pragma unroll
            for (int n = 0; n < 2; ++n) g[bj][n] = *(const A4*)(ga + (size_t)b * 6144 + col0 + bj * 128 + n * 16);
#pragma unroll
        for (int ai = 0; ai < 2; ++ai)
#pragma unroll
            for (int m = 0; m < 4; ++m) { const size_t off = (size_t)(row0 + ai * 128 + m * 16) * 1024 + col0;
#pragma unroll
                for (int bj = 0; bj < 2; ++bj)
#pragma unroll
                    for (int n = 0; n < 2; ++n) { const A4 xi = *(const A4*)(xin + off + bj * 128 + n * 16); *(A4*)(xout + off + bj * 128 + n * 16) = xi + g[bj][n] * acc[ai][bj][m][n];
#if MK_CHECK
                        { const A4 up = g[bj][n] * acc[ai][bj][m][n]; for (int i_ = 0; i_ < 4; ++i_) if (fabsf(up[i_]) > MK_UPD_BIG) atomicAdd(dbg, 1u); }
#endif
                    }
                asm volatile("" ::: "memory"); }
    }
};
struct EpiGU {
    static constexpr bool PERM = true, AFTER_DRAIN = false;
    u16* HID; const float* wrow;
    __device__ __forceinline__ void operator()(EPI_ARGS) const {
        const int row0 = u.pm * 256 + wr * 64 + fr, slot = u.pn >> 1, p = u.pn & 1, col0 = slot * 256 + p * 128 + 32 * wc + 8 * fq;
#pragma unroll
        for (int ai = 0; ai < 2; ++ai)
#pragma unroll
            for (int m = 0; m < 4; ++m) { const size_t row = row0 + ai * 128 + m * 16; const float w = wrow[row * 2 + slot];
#pragma unroll
                for (int n = 0; n < 2; ++n) { A4 hv;
#pragma unroll
                    for (int i = 0; i < 4; ++i) hv[i] = fsilu(acc[ai][0][m][n][i]) * acc[ai][1][m][n][i] * w;
                    v2u pw_; pw_.x = pk2(hv[0], hv[1]); pw_.y = pk2(hv[2], hv[3]); *(v2u*)(HID + row * 512 + col0 + 4 * n) = pw_;
                    asm volatile("" ::: "memory"); }
                asm volatile("" ::: "memory"); }
    }
};
struct EpiDown {
    static constexpr bool PERM = false, AFTER_DRAIN = false;
    float* x; const int* tok; const float* gf  ; unsigned* dbg;
    __device__ __forceinline__ void operator()(EPI_ARGS) const {
        const int row0 = u.pm * 256 + wr * 64 + fr, col0 = u.pn * 256 + 32 * wc + 4 * fq;
#pragma unroll
        for (int ai = 0; ai < 2; ++ai)
#pragma unroll
            for (int m = 0; m < 4; ++m) { const int t = tok[row0 + ai * 128 + m * 16];
                if (t >= 0) { const int b = t / SEQ; const size_t off = (size_t)t * 1024 + col0;
#pragma unroll
                    for (int bj = 0; bj < 2; ++bj)
#pragma unroll
                        for (int n = 0; n < 2; ++n) { const A4 g = *(const A4*)(gf + (size_t)b * 6144 + col0 + bj * 128 + n * 16); const A4 xi = *(const A4*)(x + off + bj * 128 + n * 16);
                            *(A4*)(x + off + bj * 128 + n * 16) = xi + g * acc[ai][bj][m][n];
#if MK_CHECK
                            { const A4 up = g * acc[ai][bj][m][n]; for (int i_ = 0; i_ < 4; ++i_) if (fabsf(up[i_]) > MK_UPD_BIG) atomicAdd(dbg, 1u); }
#endif
                        } }
                asm volatile("" ::: "memory"); }
    }
};
struct MoeOrder {
    const LAS int* ul;
    __device__ __forceinline__ bool next(int i, pg8::Unit& u) const {
        if (i >= __builtin_amdgcn_readfirstlane(ul[0])) return false;
        const int v = __builtin_amdgcn_readfirstlane(ul[1 + i]); u.pm = v & 255; u.pn = (v >> 8) & 3; u.pb = v >> 16; u.aux = 0; return true;
    }
    __device__ __forceinline__ void a_ready(const pg8::Unit&) const {}
    __device__ __forceinline__ void done(const pg8::Unit&) const {}
};

__device__ __forceinline__ void l3post_phase(Frame& F, u16* Q, u16* K, const u16* C1, const float* qg, const float* kg) {
    const float* ct = (const float*)(F.ws + WS_ROPE); const float* st = ct + SEQ * 16;
    for (int idx = F.bid * NTHR + F.tid; idx < NTOK * 16; idx += F.G * NTHR) {
        const int isk = idx & 1, h = (idx >> 1) & 7, row = idx >> 4, pos = row % SEQ;
        u16* p = (isk ? K : Q) + (size_t)row * 768 + h * 96; const float* gn = isk ? kg : qg;
        float v[96];
#pragma unroll
        for (int c = 0; c < 8; ++c) { const v4u w = *(const v4u*)(p + c * 8); v[c * 8 + 0] = bflo(w.x); v[c * 8 + 1] = bfhi(w.x); v[c * 8 + 2] = bflo(w.y); v[c * 8 + 3] = bfhi(w.y); v[c * 8 + 4] = bflo(w.z); v[c * 8 + 5] = bfhi(w.z); v[c * 8 + 6] = bflo(w.w); v[c * 8 + 7] = bfhi(w.w); }
        const u16* p2 = isk ? (C1 + (size_t)row * 256 + 128) : (p + 64);
#pragma unroll
        for (int c = 0; c < 4; ++c) { const v4u w = *(const v4u*)(p2 + c * 8); v[64 + c * 8 + 0] = bflo(w.x); v[64 + c * 8 + 1] = bfhi(w.x); v[64 + c * 8 + 2] = bflo(w.y); v[64 + c * 8 + 3] = bfhi(w.y); v[64 + c * 8 + 4] = bflo(w.z); v[64 + c * 8 + 5] = bfhi(w.z); v[64 + c * 8 + 6] = bflo(w.w); v[64 + c * 8 + 7] = bfhi(w.w); }
        float ss = 0.f;
#pragma unroll
        for (int d = 0; d < 96; ++d) ss += v[d] * v[d];
        const float rs = (1.0f / sqrtf(ss * (1.f / 96.f) + EPS)) * (isk ? 1.0f : 0.10206207261596577f * LOG2E);
#pragma unroll
        for (int d = 0; d < 96; ++d) v[d] = v[d] * rs * gn[d];
#pragma unroll
        for (int i = 0; i < 16; ++i) { const float cs = ct[pos * 16 + i], sn = st[pos * 16 + i], x1 = v[64 + i], x2 = v[80 + i]; v[64 + i] = x1 * cs - x2 * sn; v[80 + i] = x1 * sn + x2 * cs; }
#pragma unroll
        for (int c = 0; c < 12; ++c) { v4u w; w.x = pk2(v[c * 8 + 0], v[c * 8 + 1]); w.y = pk2(v[c * 8 + 2], v[c * 8 + 3]); w.z = pk2(v[c * 8 + 4], v[c * 8 + 5]); w.w = pk2(v[c * 8 + 6], v[c * 8 + 7]); *(v4u*)(p + c * 8) = w; }
    }
}

__device__ __forceinline__ void mla_naive_phase(Frame& F, const u16* Q, const u16* K, const u16* V, u16* YA) {
    LAS float* Ks = (LAS float*)F.lds;
    LAS float* Vs = (LAS float*)(F.lds + 64 * 96 * 4);
    for (int item = F.bid; item < 256; item += F.G) {
        const int bh = item >> 4, pr = item & 15, b = bh >> 3, h = bh & 7;
        for (int half = 0; half < 2; ++half) {
            const int qb = half ? 31 - pr : pr, qpos = qb * 512 + F.tid; const size_t qrow = (size_t)b * SEQ + qpos;
            float q[96], o[64];
#pragma unroll
            for (int c = 0; c < 12; ++c) { const v4u w = *(const v4u*)(Q + qrow * 768 + h * 96 + c * 8); q[c * 8 + 0] = bflo(w.x); q[c * 8 + 1] = bfhi(w.x); q[c * 8 + 2] = bflo(w.y); q[c * 8 + 3] = bfhi(w.y); q[c * 8 + 4] = bflo(w.z); q[c * 8 + 5] = bfhi(w.z); q[c * 8 + 6] = bflo(w.w); q[c * 8 + 7] = bfhi(w.w); }
#pragma unroll
            for (int d = 0; d < 64; ++d) o[d] = 0.f;
            float mx = -1e30f, l = 0.f;
            const int ntile = (qb + 1) * 8;
            for (int kt = 0; kt < ntile; ++kt) {
                __syncthreads();
                for (int e = F.tid; e < 64 * 12; e += NTHR) { const int kr = e / 12, c = e % 12; const v4u w = *(const v4u*)(K + ((size_t)b * SEQ + kt * 64 + kr) * 768 + h * 96 + c * 8);
                    LAS float* d = Ks + kr * 96 + c * 8; d[0] = bflo(w.x); d[1] = bfhi(w.x); d[2] = bflo(w.y); d[3] = bfhi(w.y); d[4] = bflo(w.z); d[5] = bfhi(w.z); d[6] = bflo(w.w); d[7] = bfhi(w.w); }
                { const int kr = F.tid >> 3, c = F.tid & 7; const v4u w = *(const v4u*)(V + ((size_t)b * SEQ + kt * 64 + kr) * 512 + h * 64 + c * 8);
                    LAS float* d = Vs + kr * 64 + c * 8; d[0] = bflo(w.x); d[1] = bfhi(w.x); d[2] = bflo(w.y); d[3] = bfhi(w.y); d[4] = bflo(w.z); d[5] = bfhi(w.z); d[6] = bflo(w.w); d[7] = bfhi(w.w); }
                __syncthreads();
                const int kbase = kt * 64;
                if (kbase <= qpos) {
                    for (int j = 0; j < 64; ++j) {
                        if (kbase + j <= qpos) {
                            float s = 0.f;
#pragma unroll
                            for (int d = 0; d < 96; ++d) s += q[d] * Ks[j * 96 + d];
                            if (s > mx) { const float a = exp2f(mx - s); l *= a;
#pragma unroll
                                for (int d = 0; d < 64; ++d) o[d] *= a;
                                mx = s; }
                            const float p = exp2f(s - mx); l += p;
#pragma unroll
                            for (int d = 0; d < 64; ++d) o[d] += p * Vs[j * 64 + d];
                        }
                    }
                }
            }
            const float il = 1.0f / l;
#pragma unroll
            for (int c = 0; c < 8; ++c) { v4u w; w.x = pk2(o[c * 8 + 0] * il, o[c * 8 + 1] * il); w.y = pk2(o[c * 8 + 2] * il, o[c * 8 + 3] * il); w.z = pk2(o[c * 8 + 4] * il, o[c * 8 + 5] * il); w.w = pk2(o[c * 8 + 6] * il, o[c * 8 + 7] * il);
                *(v4u*)(YA + qrow * 512 + h * 64 + c * 8) = w; }
        }
    }
    __syncthreads();
}

__device__ __forceinline__ void dil_naive_phase(Frame& F, const u16* DQ, const u16* DK, const u16* DV, u16* YC) {
    for (int idx = F.bid * NTHR + F.tid; idx < NTOK * 8; idx += F.G * NTHR) {
        const int h = idx & 7, row = idx >> 3, b = row / SEQ, pos = row % SEQ;
        float q[64], o[64];
#pragma unroll
        for (int c = 0; c < 8; ++c) { const v4u w = *(const v4u*)(DQ + (size_t)row * 512 + h * 64 + c * 8); q[c * 8 + 0] = bflo(w.x); q[c * 8 + 1] = bfhi(w.x); q[c * 8 + 2] = bflo(w.y); q[c * 8 + 3] = bfhi(w.y); q[c * 8 + 4] = bflo(w.z); q[c * 8 + 5] = bfhi(w.z); q[c * 8 + 6] = bflo(w.w); q[c * 8 + 7] = bfhi(w.w); }
#pragma unroll
        for (int d = 0; d < 64; ++d) o[d] = 0.f;
        float mx = -1e30f, l = 0.f;
        for (int pt = 0; pt < 3; ++pt) {
            const int r = pt == 0 ? 1 : (pt == 1 ? 4 : 16);
            for (int j = 0; j <= 128; ++j) {
                const int tk = pos - j * r; if (tk < 0) break;
                const size_t kro = ((size_t)b * SEQ + tk) * 512 + h * 64;
                float s = 0.f;
#pragma unroll
                for (int c = 0; c < 8; ++c) { const v4u w = *(const v4u*)(DK + kro + c * 8);
                    s += q[c * 8 + 0] * bflo(w.x) + q[c * 8 + 1] * bfhi(w.x) + q[c * 8 + 2] * bflo(w.y) + q[c * 8 + 3] * bfhi(w.y) + q[c * 8 + 4] * bflo(w.z) + q[c * 8 + 5] * bfhi(w.z) + q[c * 8 + 6] * bflo(w.w) + q[c * 8 + 7] * bfhi(w.w); }
                if (s > mx) { const float a = exp2f(mx - s); l *= a;
#pragma unroll
                    for (int d = 0; d < 64; ++d) o[d] *= a;
                    mx = s; }
                const float p = exp2f(s - mx); l += p;
#pragma unroll
                for (int c = 0; c < 8; ++c) { const v4u w = *(const v4u*)(DV + kro + c * 8);
                    o[c * 8 + 0] += p * bflo(w.x); o[c * 8 + 1] += p * bfhi(w.x); o[c * 8 + 2] += p * bflo(w.y); o[c * 8 + 3] += p * bfhi(w.y); o[c * 8 + 4] += p * bflo(w.z); o[c * 8 + 5] += p * bfhi(w.z); o[c * 8 + 6] += p * bflo(w.w); o[c * 8 + 7] += p * bfhi(w.w); }
            }
        }
        const float il = 1.0f / l;
#pragma unroll
        for (int c = 0; c < 8; ++c) { v4u w; w.x = pk2(o[c * 8 + 0] * il, o[c * 8 + 1] * il); w.y = pk2(o[c * 8 + 2] * il, o[c * 8 + 3] * il); w.z = pk2(o[c * 8 + 4] * il, o[c * 8 + 5] * il); w.w = pk2(o[c * 8 + 6] * il, o[c * 8 + 7] * il);
            *(v4u*)(YC + (size_t)row * 512 + h * 64 + c * 8) = w; }
    }
}

__device__ __forceinline__ void stage_conv(LAS float* dst  , const u16* MQK, size_t row0, int pos0, int ch0, const float* cw, const float* cb, float scale, int tid) {
    const int d = tid & 63, sg = tid >> 6, ch = ch0 + d;
    const float w0 = cw[ch], w1 = cw[512 + ch], w2 = cw[1024 + ch], w3 = cw[1536 + ch], bb = cb[ch];
    float x[11];
#pragma unroll
    for (int i = 0; i < 11; ++i) { const int s = sg * 8 - 3 + i; x[i] = (pos0 + s >= 0) ? bf1(MQK[(size_t)((long)row0 + s) * 512 + ch]) : 0.f; }
#pragma unroll
    for (int i = 0; i < 8; ++i) { const float y = bb + w0 * x[i] + w1 * x[i + 1] + w2 * x[i + 2] + w3 * x[i + 3]; dst[(sg * 8 + i) * 65 + d] = fsilu(y) * scale; }
}
__device__ __forceinline__ float wave_incl_scan_add(float v, int lane) {
#pragma unroll
    for (int o = 1; o < 64; o <<= 1) { const float t = bperm_f(lane >= o ? lane - o : lane, v); if (lane >= o) v += t; }
    return v;
}
__device__ __forceinline__ float wave_incl_scan_max(float v, int lane) {
#pragma unroll
    for (int o = 1; o < 64; o <<= 1) { const float t = bperm_f(lane >= o ? lane - o : lane, v); if (lane >= o) v = fmaxf(v, t); }
    return v;
}
__device__ __forceinline__ float wave_max(float v, int lane) {
#pragma unroll
    for (int o = 1; o < 64; o <<= 1) v = fmaxf(v, bperm_f(lane ^ o, v));
    return v;
}
__device__ __forceinline__ void mlstm_a_phase(Frame& F, const u16* MQK, const u16* MV, const float* IF, const float* cw, const float* cb, float* ST) {
    LAS float* Ks = (LAS float*)F.lds;
    LAS float* Vs = Ks + 64 * 65;
    LAS float* ws = Vs + 64 * 128;
    float* mloc = (float*)(F.ws + WS_MLS); float* bend = mloc + 2048; float* nst = (float*)(F.ws + WS_MLS + 65536);
    const int tid = F.tid;
    for (int u = F.bid; u < 2048; u += F.G) {
        const int bh = u >> 8, c = u & 255, b = bh >> 2, h = bh & 3, pos0 = c * 64; const size_t row0 = (size_t)b * SEQ + pos0;
        __syncthreads();
        stage_conv(Ks, MQK, row0, pos0, 256 + h * 64, cw, cb, 0.125f, tid);
        for (int e = tid; e < 64 * 16; e += NTHR) { const int s = e >> 4, cc = e & 15; const v4u w = *(const v4u*)(MV + (row0 + s) * 512 + h * 128 + cc * 8);
            LAS float* d = Vs + s * 128 + cc * 8; d[0] = bflo(w.x); d[1] = bfhi(w.x); d[2] = bflo(w.y); d[3] = bfhi(w.y); d[4] = bflo(w.z); d[5] = bfhi(w.z); d[6] = bflo(w.w); d[7] = bfhi(w.w); }
        if (tid < 64) { const float ig = IF[(row0 + tid) * 8 + h], lf = IF[(row0 + tid) * 8 + 4 + h];
            const float bs = wave_incl_scan_add(lf, tid), be = bperm_f(63, bs);
            const float wl = be - bs + ig, ml = wave_max(wl, tid);
            ws[tid] = __expf(wl - ml);
            if (tid == 0) { mloc[u] = ml; bend[u] = be; } }
        __syncthreads();
        const int d = tid >> 3, vg = tid & 7;
        float acc[16]; float an = 0.f;
#pragma unroll
        for (int i = 0; i < 16; ++i) acc[i] = 0.f;
        for (int s = 0; s < 64; ++s) { const float kw = Ks[s * 65 + d] * ws[s]; an += kw;
            const LAS f32x4* vp = (const LAS f32x4*)(Vs + s * 128 + vg * 16);
#pragma unroll
            for (int i = 0; i < 4; ++i) { const f32x4 vv = vp[i]; acc[4 * i + 0] += kw * vv.x; acc[4 * i + 1] += kw * vv.y; acc[4 * i + 2] += kw * vv.z; acc[4 * i + 3] += kw * vv.w; } }
        float* o = ST + (size_t)u * 8192 + d * 128 + vg * 16;
#pragma unroll
        for (int i = 0; i < 4; ++i) *(f32x4*)(o + 4 * i) = (f32x4){acc[4 * i], acc[4 * i + 1], acc[4 * i + 2], acc[4 * i + 3]};
        if (vg == 0) nst[(size_t)u * 64 + d] = an;
    }
    __syncthreads();
}
__device__ __forceinline__ void mlstm_b_phase(Frame& F, float* ST) {
    const float* mloc = (const float*)(F.ws + WS_MLS); const float* bend = mloc + 2048; float* mprev = (float*)(F.ws + WS_MLS) + 4096; float* nst = (float*)(F.ws + WS_MLS + 65536);
    for (int gt = F.bid * NTHR + F.tid; gt < 8 * 8256; gt += F.G * NTHR) {
        const int bh = gt / 8256, e = gt % 8256;
        float* p; int stride;
        if (e < 8192) { p = ST + (size_t)bh * 256 * 8192 + e; stride = 8192; } else { p = nst + (size_t)bh * 256 * 64 + (e - 8192); stride = 64; }
        float C = 0.f, m = 0.f;
        for (int c0 = 0; c0 < 256; c0 += 8) {
            float val[8];
#pragma unroll
            for (int i = 0; i < 8; ++i) val[i] = p[(size_t)(c0 + i) * stride];
#pragma unroll
            for (int i = 0; i < 8; ++i) { const int c = c0 + i; const float be = bend[bh * 256 + c], ml = mloc[bh * 256 + c];
                p[(size_t)c * stride] = C; if (e == 0) mprev[bh * 256 + c] = m;
                const float mn = fmaxf(be + m, ml); C = __expf(be + m - mn) * C + __expf(ml - mn) * val[i]; m = mn; }
        }
    }
}
__device__ __forceinline__ void mlstm_c_phase(Frame& F, const u16* MQK, const u16* MV, const u16* MO, const float* IF, const float* cw, const float* cb, const float* hg, const float* ST, u16* YB) {
    LAS float* Qs = (LAS float*)F.lds;
    LAS float* Ks = Qs + 64 * 65;
    LAS float* Vs = Ks + 64 * 65;
    LAS float* Cs = Vs + 64 * 128;
    LAS float* Ss = Cs + 64 * 128;
    LAS float* bsv = Ss + 64 * 65;
    LAS float* gsv = bsv + 64;
    LAS float* mtv = gsv + 64;
    LAS float* dcv = mtv + 64;
    LAS float* npv = dcv + 64;
    const float* mprev = (const float*)(F.ws + WS_MLS) + 4096; const float* nst = (const float*)(F.ws + WS_MLS + 65536);
    const int tid = F.tid;
    for (int u = F.bid; u < 2048; u += F.G) {
        const int bh = u >> 8, c = u & 255, b = bh >> 2, h = bh & 3, pos0 = c * 64; const size_t row0 = (size_t)b * SEQ + pos0;
        __syncthreads();
        stage_conv(Qs, MQK, row0, pos0, h * 64, cw, cb, 1.0f, tid);
        stage_conv(Ks, MQK, row0, pos0, 256 + h * 64, cw, cb, 0.125f, tid);
        for (int e = tid; e < 64 * 16; e += NTHR) { const int s = e >> 4, cc = e & 15; const v4u w = *(const v4u*)(MV + (row0 + s) * 512 + h * 128 + cc * 8);
            LAS float* d = Vs + s * 128 + cc * 8; d[0] = bflo(w.x); d[1] = bfhi(w.x); d[2] = bflo(w.y); d[3] = bfhi(w.y); d[4] = bflo(w.z); d[5] = bfhi(w.z); d[6] = bflo(w.w); d[7] = bfhi(w.w); }
        for (int e = tid; e < 2048; e += NTHR) ((LAS f32x4*)Cs)[e] = ((const f32x4*)(ST + (size_t)u * 8192))[e];
        if (tid < 64) { const float ig = IF[(row0 + tid) * 8 + h], lf = IF[(row0 + tid) * 8 + 4 + h], m = mprev[u];
            const float bs = wave_incl_scan_add(lf, tid), gs = ig - bs, gmx = wave_incl_scan_max(gs, tid);
            const float inter = bs + m, mt = fmaxf(inter, bs + gmx);
            bsv[tid] = bs; gsv[tid] = gs; mtv[tid] = mt; dcv[tid] = __expf(inter - mt); npv[tid] = nst[(size_t)u * 64 + tid]; }
        __syncthreads();
        const int t = tid >> 3, g8 = tid & 7;
        float den;
        {   float sa[8]; float qn = 0.f;
#pragma unroll
            for (int i = 0; i < 8; ++i) sa[i] = 0.f;
            for (int d = 0; d < 64; ++d) { const float qv = Qs[t * 65 + d]; qn += qv * npv[d];
#pragma unroll
                for (int i = 0; i < 8; ++i) sa[i] += qv * Ks[(g8 * 8 + i) * 65 + d]; }
            const float bt = bsv[t], mt = mtv[t]; float rs = 0.f;
#pragma unroll
            for (int i = 0; i < 8; ++i) { const int s = g8 * 8 + i; const float sc = (s <= t) ? sa[i] * __expf(bt + gsv[s] - mt) : 0.f; Ss[t * 65 + s] = sc; rs += sc; }
            { const int ln_ = tid & 63; rs += bperm_f(ln_ ^ 1, rs); rs += bperm_f(ln_ ^ 2, rs); rs += bperm_f(ln_ ^ 4, rs); }
            den = dcv[t] * qn + rs;
        }
        __syncthreads();
        float acc[16];
#pragma unroll
        for (int i = 0; i < 16; ++i) acc[i] = 0.f;
        { const float dc = dcv[t];
            for (int d = 0; d < 64; ++d) { const float qd = Qs[t * 65 + d] * dc; const LAS f32x4* cp = (const LAS f32x4*)(Cs + d * 128 + g8 * 16);
#pragma unroll
                for (int i = 0; i < 4; ++i) { const f32x4 vv = cp[i]; acc[4 * i + 0] += qd * vv.x; acc[4 * i + 1] += qd * vv.y; acc[4 * i + 2] += qd * vv.z; acc[4 * i + 3] += qd * vv.w; } }
            for (int s = 0; s < 64; ++s) { const float p = Ss[t * 65 + s]; const LAS f32x4* vp = (const LAS f32x4*)(Vs + s * 128 + g8 * 16);
#pragma unroll
                for (int i = 0; i < 4; ++i) { const f32x4 vv = vp[i]; acc[4 * i + 0] += p * vv.x; acc[4 * i + 1] += p * vv.y; acc[4 * i + 2] += p * vv.z; acc[4 * i + 3] += p * vv.w; } } }
        const float inv = 1.0f / fmaxf(fabsf(den), __expf(-mtv[t]));
        float ss = 0.f;
#pragma unroll
        for (int i = 0; i < 16; ++i) { acc[i] *= inv; ss += acc[i] * acc[i]; }
        { const int ln_ = tid & 63; ss += bperm_f(ln_ ^ 1, ss); ss += bperm_f(ln_ ^ 2, ss); ss += bperm_f(ln_ ^ 4, ss); }
        const float rstd = 1.0f / sqrtf(ss * (1.f / 128.f) + EPS);
        const size_t ob = (row0 + t) * 512 + h * 128 + g8 * 16;
#pragma unroll
        for (int j = 0; j < 2; ++j) { const v4u mo = *(const v4u*)(MO + ob + j * 8); const float* gp = hg + h * 128 + g8 * 16 + j * 8;
            float y[8];
#pragma unroll
            for (int i = 0; i < 8; ++i) y[i] = acc[j * 8 + i] * rstd * gp[i];
            y[0] *= bflo(mo.x); y[1] *= bfhi(mo.x); y[2] *= bflo(mo.y); y[3] *= bfhi(mo.y); y[4] *= bflo(mo.z); y[5] *= bfhi(mo.z); y[6] *= bflo(mo.w); y[7] *= bfhi(mo.w);
            v4u w; w.x = pk2(y[0], y[1]); w.y = pk2(y[2], y[3]); w.z = pk2(y[4], y[5]); w.w = pk2(y[6], y[7]);
            *(v4u*)(YB + ob + j * 8) = w; }
    }
    __syncthreads();
}

__device__ __forceinline__ void router_phase(Frame& F, const float* x, const float* gain, const float* modl, const float* wrg, const float* brg, const float* wre, const float* bre, u32* cnt) {
    const int gw = F.bid * NWAVES + F.wave, NGW = F.G * NWAVES, lane = F.lane;
    int* cls_o = (int*)(F.ws + WS_ROUT); int* slot_o = cls_o + NTOK; float* wa_o = (float*)(slot_o + NTOK); float* wb_o = wa_o + NTOK; float* rstd_o = wb_o + NTOK;
    for (int m = gw; m < NTOK; m += NGW) {
        const int b = m / SEQ;
        const f32x4* xr = (const f32x4*)(x + (size_t)m * DM) + lane;
        f32x4 v[4]; float s = 0.f;
#pragma unroll
        for (int j = 0; j < 4; ++j) { v[j] = xr[64 * j]; s += (v[j].x * v[j].x + v[j].y * v[j].y) + (v[j].z * v[j].z + v[j].w * v[j].w); }
        const float rstd = 1.0f / sqrtf(wave_sum(s, lane) * (1.f / DM) + EPS);
        LAS float* hrow = (LAS float*)(F.lds + F.wave * 4096 + 0);
#pragma unroll
        for (int j = 0; j < 4; ++j) { const int c0 = 4 * lane + 256 * j;
            const f32x4 g = *(const f32x4*)(gain + c0), sc = *(const f32x4*)(modl + (size_t)(b * 6 + 4) * 1024 + c0), sh = *(const f32x4*)(modl + (size_t)(b * 6 + 3) * 1024 + c0);
            *(LAS f32x4*)(hrow + c0) = (v[j] * rstd) * g * (sc + 1.0f) + sh; }
        LDS_WAIT(); asm volatile("" ::: "memory");
        float part = 0.f;
        { const int jj = lane % 20, pp = lane / 20; const int cb = pp * 342, ce = pp == 2 ? 1024 : cb + 342;
            if (lane < 60) { const float* wp = jj < 4 ? wrg + jj : wre + (jj - 4); const int ws_ = jj < 4 ? 4 : 16;
                for (int c = cb; c < ce; ++c) part += hrow[c] * wp[(size_t)c * ws_]; } }
        part += bperm_f(lane + 20 < 64 ? lane + 20 : lane, part) * (lane < 20 ? 1.f : 0.f) + 0.f;
        LAS float* lgs = hrow;
        { const float p2 = bperm_f(lane + 40 < 64 ? lane + 40 : lane, part); asm volatile("" ::: "memory"); if (lane < 20) lgs[lane] = part + p2; }
        LDS_WAIT(); asm volatile("" ::: "memory");
        float lg[20];
        if (lane == 0) {
#pragma unroll
            for (int i = 0; i < 20; ++i) lg[i] = lgs[i]; }
        LDS_WAIT(); asm volatile("" ::: "memory");
        if (lane == 0) {
            float g0 = lg[0] + brg[0], g1 = lg[1] + brg[1], g2 = lg[2] + brg[2], g3 = lg[3] + brg[3];
            int gi = 0; float gm = g0; if (g1 > gm) { gm = g1; gi = 1; } if (g2 > gm) { gm = g2; gi = 2; } if (g3 > gm) { gm = g3; gi = 3; }
            const float psel = 1.0f / (expf(g0 - gm) + expf(g1 - gm) + expf(g2 - gm) + expf(g3 - gm));
            float e0, e1, e2, e3;
            if (gi == 0) { e0 = lg[4]; e1 = lg[5]; e2 = lg[6]; e3 = lg[7]; } else if (gi == 1) { e0 = lg[8]; e1 = lg[9]; e2 = lg[10]; e3 = lg[11]; }
            else if (gi == 2) { e0 = lg[12]; e1 = lg[13]; e2 = lg[14]; e3 = lg[15]; } else { e0 = lg[16]; e1 = lg[17]; e2 = lg[18]; e3 = lg[19]; }
            e0 += bre[gi * 4 + 0]; e1 += bre[gi * 4 + 1]; e2 += bre[gi * 4 + 2]; e3 += bre[gi * 4 + 3];
            int i1 = 0; float v1 = e0; if (e1 > v1) { v1 = e1; i1 = 1; } if (e2 > v1) { v1 = e2; i1 = 2; } if (e3 > v1) { v1 = e3; i1 = 3; }
            int i2 = -1; float v2 = 0.f;
            if (i1 != 0) { v2 = e0; i2 = 0; }
            if (i1 != 1 && (i2 < 0 || e1 > v2)) { v2 = e1; i2 = 1; }
            if (i1 != 2 && (i2 < 0 || e2 > v2)) { v2 = e2; i2 = 2; }
            if (i1 != 3 && (i2 < 0 || e3 > v2)) { v2 = e3; i2 = 3; }
            const float ex = expf(v2 - v1), w1 = psel / (1.0f + ex), w2 = psel * ex / (1.0f + ex);
            const int a = i1 < i2 ? i1 : i2, bb = i1 < i2 ? i2 : i1;
            const int pair = a == 0 ? bb - 1 : (a == 1 ? bb + 1 : 5);
            const int cls = gi * 6 + pair;
            const u32 sl = __hip_atomic_fetch_add(cnt + cls, 1u, __ATOMIC_RELAXED, __HIP_MEMORY_SCOPE_AGENT);
            cls_o[m] = cls; slot_o[m] = (int)sl; wa_o[m] = i1 < i2 ? w1 : w2; wb_o[m] = i1 < i2 ? w2 : w1; rstd_o[m] = rstd;
        }
    }
}
__device__ __forceinline__ void moe_table(Frame& F, const u32* cnt) {
    LAS int* tab = (LAS int*)(F.lds + TAB_OFF);
    if (F.tid == 0) { int rt = 0;
        for (int c = 0; c < 24; ++c) { const int n = (int)__hip_atomic_load(cnt + c, __ATOMIC_RELAXED, __HIP_MEMORY_SCOPE_AGENT); const int nt = (n + 255) >> 8; tab[256 + c] = rt * 256; for (int i = 0; i < nt; ++i) tab[1 + rt + i] = c; rt += nt; }
        tab[0] = rt; }
    __syncthreads();
}
__device__ __forceinline__ void moe_units(Frame& F, int mode) {
    LAS int* tab = (LAS int*)(F.lds + TAB_OFF); LAS int* ul = tab + 320;
    if (F.tid == 0) { const int nrt = tab[0]; int n = 0;
        for (int L = F.bid; L < nrt * 4; L += F.G) { const int rt = L >> 2, pn = L & 3, cls = tab[1 + rt]; int pb;
            if (mode == 0) { int ea, eb; cls_experts(cls, ea, eb); pb = ((pn >> 1) ? eb : ea) * 2 + (pn & 1); } else pb = cls * 4 + pn;
            ul[1 + n] = rt | (pn << 8) | (pb << 16); ++n; }
        ul[0] = n; }
    __syncthreads();
}
__device__ __forceinline__ void scatter_phase(Frame& F, const float* x, const float* gain, const float* modl, const u32* cnt, u16* HS) {
    moe_table(F, cnt);
    const LAS int* tab = (const LAS int*)(F.lds + TAB_OFF);
    const int gw = F.bid * NWAVES + F.wave, NGW = F.G * NWAVES, lane = F.lane;
    const int* cls_o = (const int*)(F.ws + WS_ROUT); const int* slot_o = cls_o + NTOK; const float* wa_o = (const float*)(slot_o + NTOK); const float* wb_o = wa_o + NTOK; const float* rstd_o = wb_o + NTOK;
    int* tok = (int*)(F.ws + WS_TOK); float* wrow = (float*)(F.ws + WS_TOK + 262144);
    for (int c = F.bid; c < 24; c += F.G) { const int n = (int)__hip_atomic_load(cnt + c, __ATOMIC_RELAXED, __HIP_MEMORY_SCOPE_AGENT); const int base = tab[256 + c], end = base + (((n + 255) >> 8) << 8);
        for (int r = base + n + F.tid; r < end; r += NTHR) { tok[r] = -1; wrow[2 * r] = 0.f; wrow[2 * r + 1] = 0.f; } }
    for (int m = gw; m < NTOK; m += NGW) {
        const int b = m / SEQ; const int pos = tab[256 + cls_o[m]] + slot_o[m]; const float rstd = rstd_o[m];
        const f32x4* xr = (const f32x4*)(x + (size_t)m * DM) + lane;
        v2u* o8 = (v2u*)(HS + (size_t)pos * DM) + lane;
#pragma unroll
        for (int j = 0; j < 4; ++j) { const int c0 = 4 * lane + 256 * j; const f32x4 v = xr[64 * j];
            const f32x4 g = *(const f32x4*)(gain + c0), sc = *(const f32x4*)(modl + (size_t)(b * 6 + 4) * 1024 + c0), sh = *(const f32x4*)(modl + (size_t)(b * 6 + 3) * 1024 + c0);
            const f32x4 y = (v * rstd) * g * (sc + 1.0f) + sh;
            v2u w; w.x = pk2(y.x, y.y); w.y = pk2(y.z, y.w); o8[64 * j] = w; }
        if (lane == 0) { tok[pos] = m; wrow[2 * pos] = wa_o[m]; wrow[2 * pos + 1] = wb_o[m]; }
    }
}

typedef float f32x16 __attribute__((ext_vector_type(16)));
typedef short s16x8 __attribute__((ext_vector_type(8)));
typedef short s16x4 __attribute__((ext_vector_type(4)));
#if MK_F16
#define MFMA32(a, b, c) __builtin_amdgcn_mfma_f32_32x32x16_f16(__builtin_bit_cast(pg8::h16x8, (a)), __builtin_bit_cast(pg8::h16x8, (b)), (c), 0, 0, 0)
#else
#define MFMA32(a, b, c) __builtin_amdgcn_mfma_f32_32x32x16_bf16((a), (b), (c), 0, 0, 0)
#endif
__device__ __forceinline__ int crow(int r, int hi) { return (r & 3) + 8 * (r >> 2) + 4 * hi; }
__device__ __forceinline__ void gl_lds16(const void* g, LAS unsigned char* l) { __builtin_amdgcn_global_load_lds((const unsigned*)g, (LAS unsigned*)l, 16, 0, 0); }
__device__ __forceinline__ s16x4 vtr16(const LAS unsigned char* p) { typedef short v4i16_t __attribute__((ext_vector_type(4))); return __builtin_bit_cast(s16x4, __builtin_amdgcn_ds_read_tr16_b64_v4i16((LAS v4i16_t*)p)); }
__device__ __forceinline__ float swapmax(float m) { auto rr = __builtin_amdgcn_permlane32_swap(__float_as_uint(m), __float_as_uint(m), false, false); return fmaxf(__uint_as_float(rr[0]), __uint_as_float(rr[1])); }
__device__ __forceinline__ float swapsum(float m) { auto rr = __builtin_amdgcn_permlane32_swap(__float_as_uint(m), __float_as_uint(m), false, false); return __uint_as_float(rr[0]) + __uint_as_float(rr[1]); }
constexpr int MA_KSLOT = 12288, MA_VSLOT = 8192, MA_V0 = 2 * MA_KSLOT, MA_WS = MA_V0 + 2 * MA_VSLOT, MA_OST = MA_WS + 2048, MA_BYTES = MA_OST + 8 * 4096;
__device__ __forceinline__ void mla_attn_unit(LAS unsigned char* lds, int tid, int wid, const u16* Q, const u16* K, const u16* V, u16* O, int b, int h, int qb) {
    const int lane = tid & 63, r32 = lane & 31, hi = lane >> 5;
    const size_t rowb = (size_t)b * SEQ; const int q0 = qb * 256;
    const u16* Qw = Q + (rowb + q0 + wid * 32) * 768 + h * 96;
    const u16* ksrc1 = K + (rowb + lane) * 768 + h * 96 + wid * 8;
    const u16* ksrc2 = K + (rowb + lane) * 768 + h * 96 + (8 + (wid & 3)) * 8;
    const u16* vsrc = V + (rowb + 16 * (wid & 3) + (lane >> 2)) * 512 + h * 64 + (wid >> 2) * 32 + (lane & 3) * 8;
    LAS float* wsf = (LAS float*)(lds + MA_WS) + wid * 64;
    const int NT = (q0 + 256) / 64;
#define MA_DMA(t, s) do { gl_lds16(ksrc1 + (size_t)(t) * 64 * 768, lds + (s) * MA_KSLOT + wid * 1024); gl_lds16(ksrc2 + (size_t)(t) * 64 * 768, lds + (s) * MA_KSLOT + (8 + (wid & 3)) * 1024); \
                           gl_lds16(vsrc + (size_t)(t) * 64 * 512, lds + MA_V0 + (s) * MA_VSLOT + wid * 1024); } while (0)
    MA_DMA(0, 0);
    s16x8 qr[6];
#pragma unroll
    for (int d0 = 0; d0 < 6; ++d0) qr[d0] = *(const s16x8*)(Qw + (size_t)r32 * 768 + d0 * 16 + hi * 8);
    float zf_ = 0.f; asm volatile("" : "+v"(zf_));
    float mref = zf_, l = zf_; f32x16 o0, o1;
#pragma unroll
    for (int r = 0; r < 16; ++r) { o0[r] = zf_; o1[r] = zf_; }
    const int qg = q0 + wid * 32 + r32;
    const int kfo = hi * 1024 + r32 * 16;
    const int vfo = ((lane >> 4) & 1) * 32 + (lane & 3) * 8 + (4 * hi + ((lane & 15) >> 2)) * 64;
    asm volatile("s_waitcnt vmcnt(0)" ::: "memory"); __builtin_amdgcn_s_barrier(); asm volatile("" ::: "memory");
    for (int t = 0; t < NT; ++t) {
        const int s = t & 1;
        if (t + 1 < NT) MA_DMA(t + 1, s ^ 1);
        const LAS unsigned char* kp = lds + s * MA_KSLOT + kfo; const LAS unsigned char* vp = lds + MA_V0 + s * MA_VSLOT + vfo;
        f32x16 p0, p1;
#pragma unroll
        for (int r = 0; r < 16; ++r) { p0[r] = zf_; p1[r] = zf_; }
#pragma unroll
        for (int d0 = 0; d0 < 6; ++d0) { const s16x8 a0 = *(const LAS s16x8*)(kp + d0 * 2048), a1 = *(const LAS s16x8*)(kp + d0 * 2048 + 512);
            p0 = MFMA32(a0, qr[d0], p0); p1 = MFMA32(a1, qr[d0], p1); }
        if (t >= NT - 4) { const int kb = t * 64 + 4 * hi;
#pragma unroll
            for (int r = 0; r < 16; ++r) { const int kv = kb + (r & 3) + 8 * (r >> 2); if (kv > qg) p0[r] = -INFINITY; if (kv + 32 > qg) p1[r] = -INFINITY; } }
        float rm = fmaxf(p0[0], p1[0]);
#pragma unroll
        for (int r = 1; r < 16; ++r) rm = fmaxf(rm, fmaxf(p0[r], p1[r]));
        rm = swapmax(rm);
        if (t == 0) mref = rm;
        else { const float dl = rm - mref;
            if (__any(dl > 8.f)) { const float d2 = fmaxf(dl, 0.f), f = exp2f(-d2); mref += d2; l *= f; if (hi == 0) wsf[r32] = f;
                asm volatile("s_waitcnt lgkmcnt(0)" ::: "memory");
#pragma unroll
                for (int r = 0; r < 16; ++r) { const float fr = wsf[crow(r, hi)]; o0[r] *= fr; o1[r] *= fr; } } }
        float sacc = zf_;
#pragma unroll
        for (int r = 0; r < 16; ++r) { p0[r] = exp2f(p0[r] - mref); p1[r] = exp2f(p1[r] - mref); sacc += p0[r] + p1[r]; }
        l += sacc;
        v4u pw[4];
        pw[0] = (v4u){pk2(p0[0], p0[1]), pk2(p0[2], p0[3]), pk2(p0[4], p0[5]), pk2(p0[6], p0[7])};
        pw[1] = (v4u){pk2(p0[8], p0[9]), pk2(p0[10], p0[11]), pk2(p0[12], p0[13]), pk2(p0[14], p0[15])};
        pw[2] = (v4u){pk2(p1[0], p1[1]), pk2(p1[2], p1[3]), pk2(p1[4], p1[5]), pk2(p1[6], p1[7])};
        pw[3] = (v4u){pk2(p1[8], p1[9]), pk2(p1[10], p1[11]), pk2(p1[12], p1[13]), pk2(p1[14], p1[15])};
#pragma unroll
        for (int ks = 0; ks < 4; ++ks) { const s16x8 pa = __builtin_bit_cast(s16x8, pw[ks]);
            { const s16x4 lo = vtr16(vp + ks * 1024), hh = vtr16(vp + ks * 1024 + 512); const s16x8 vf = {lo[0], lo[1], lo[2], lo[3], hh[0], hh[1], hh[2], hh[3]}; o0 = MFMA32(pa, vf, o0); }
            { const s16x4 lo = vtr16(vp + 4096 + ks * 1024), hh = vtr16(vp + 4096 + ks * 1024 + 512); const s16x8 vf = {lo[0], lo[1], lo[2], lo[3], hh[0], hh[1], hh[2], hh[3]}; o1 = MFMA32(pa, vf, o1); } }
        asm volatile("s_waitcnt vmcnt(0) lgkmcnt(0)" ::: "memory"); __builtin_amdgcn_s_barrier(); asm volatile("" ::: "memory");
    }
#undef MA_DMA
    l = swapsum(l);
    if (hi == 0) wsf[32 + r32] = l;
    asm volatile("s_waitcnt lgkmcnt(0)" ::: "memory");
    LAS u16* stg = (LAS u16*)(lds + MA_OST) + wid * 2048;
#pragma unroll
    for (int r = 0; r < 16; ++r) { const int orow = crow(r, hi); const float rl = 1.0f / wsf[32 + orow];
        const u32 w = pk2(o0[r] * rl, o1[r] * rl); stg[orow * 64 + r32] = (u16)(w & 0xffffu); stg[orow * 64 + 32 + r32] = (u16)(w >> 16); }
    asm volatile("s_waitcnt lgkmcnt(0)" ::: "memory");
    u16* Ow = O + (rowb + q0 + wid * 32) * 512 + h * 64;
#pragma unroll
    for (int i = 0; i < 4; ++i) { const int row = i * 8 + (lane >> 3), ch = lane & 7; const v4u v = *(const LAS v4u*)(stg + row * 64 + ch * 8); *(v4u*)(Ow + (size_t)row * 512 + ch * 8) = v; }
    asm volatile("s_waitcnt lgkmcnt(0)" ::: "memory"); __builtin_amdgcn_s_barrier(); asm volatile("" ::: "memory");
}
__device__ __forceinline__ void mla_attn_phase(Frame& F, const u16* Q, const u16* K, const u16* V, u16* YA) {
    for (int v = F.bid; v < 256; v += F.G) { const int bh = v >> 4, s = v & 15, b = bh >> 3, h = bh & 7;
#pragma unroll 1
        for (int i = 0; i < 4; ++i) { const int qb = i == 0 ? s : (i == 1 ? 31 - s : (i == 2 ? 32 + s : 63 - s)); mla_attn_unit(F.lds, F.tid, F.wave, Q, K, V, YA, b, h, qb); } }
}

constexpr int DL_VT = 4096, DL_WS = 8 * 2 * DL_VT, DL_OST = DL_WS + 2048, DL_BYTES = DL_OST + 8 * 4096;
__device__ __forceinline__ void dil_wave_unit(LAS unsigned char* lds, int lane, int wid, const u16* DQ, const u16* DK, const u16* DV, u16* YC, int b, int h, int span, int rho) {
    const int r32 = lane & 31, hi = lane >> 5; const size_t rowb = (size_t)b * SEQ; const int T0 = span * 512 + rho, ti = T0 + 16 * r32;
    LAS unsigned char* vt = lds + wid * 2 * DL_VT; LAS float* wsf = (LAS float*)(lds + DL_WS) + wid * 64;
    const int vfo = ((lane >> 4) & 1) * 32 + (lane & 3) * 8 + (4 * hi + ((lane & 15) >> 2)) * 64;
    const u16* kbase = DK + rowb * 512 + h * 64; const u16* vbase = DV + rowb * 512 + h * 64; const u16* qbase = DQ + rowb * 512 + h * 64; u16* obase = YC + rowb * 512 + h * 64;
    s16x8 qr[4];
#pragma unroll
    for (int d0 = 0; d0 < 4; ++d0) qr[d0] = *(const s16x8*)(qbase + (unsigned)(ti * 512 + d0 * 16 + hi * 8));
    float zf_ = 0.f; asm volatile("" : "+v"(zf_));
    float mref = zf_, l = zf_; f32x16 o0, o1;
#pragma unroll
    for (int r = 0; r < 16; ++r) { o0[r] = zf_; o1[r] = zf_; }
#define DL_TILE(it, rs, j) do { if ((it) == 0) { rs = 4; j = 4; } else if ((it) < 5) { rs = 4; j = (it) - 1; } else if ((it) < 13) { rs = 2; j = (it) - 5; } else { rs = 0; j = (it) - 13; } } while (0)
    s16x8 kf[4], kn[4]; v4u vn[4];
#define DL_LOAD(KF, VN, rs, j) do { const int kb_ = T0 - (128 << (rs)) + ((32 * (j)) << (rs)); \
        { int kt_ = kb_ + (r32 << (rs)); kt_ = kt_ < 0 ? 0 : (kt_ > SEQ - 1 ? SEQ - 1 : kt_); const unsigned ko_ = (unsigned)(kt_ * 512 + hi * 8); \
          _Pragma("unroll") for (int d0 = 0; d0 < 4; ++d0) KF[d0] = *(const s16x8*)(kbase + (ko_ + d0 * 16)); } \
        _Pragma("unroll") for (int i_ = 0; i_ < 4; ++i_) { const int c_ = lane + 64 * i_; int kt_ = kb_ + ((c_ >> 3) << (rs)); kt_ = kt_ < 0 ? 0 : (kt_ > SEQ - 1 ? SEQ - 1 : kt_); \
          VN[i_] = *(const v4u*)(vbase + (unsigned)(kt_ * 512 + (c_ & 7) * 8)); } } while (0)
#define DL_VSTORE(VN, buf) do { _Pragma("unroll") for (int i_ = 0; i_ < 4; ++i_) { const int c_ = lane + 64 * i_, row_ = c_ >> 3, ch_ = c_ & 7; \
          *(LAS v4u*)(vt + (buf) * DL_VT + ((ch_ >> 2) * 2 + (row_ >> 4)) * 1024 + (row_ & 15) * 64 + (ch_ & 3) * 16) = VN[i_]; } } while (0)
    int rs0, j0; DL_TILE(0, rs0, j0);
    DL_LOAD(kf, vn, rs0, j0); DL_VSTORE(vn, 0);
#pragma unroll 1
    for (int it = 0; it < 33; ++it) {
        int rs, j; DL_TILE(it, rs, j);
        const int buf = it & 1;
        if (it + 1 < 33) { int rs1, j1; DL_TILE(it + 1, rs1, j1); DL_LOAD(kn, vn, rs1, j1); }
        f32x16 p;
#pragma unroll
        for (int r = 0; r < 16; ++r) p[r] = zf_;
#pragma unroll
        for (int d0 = 0; d0 < 4; ++d0) p = MFMA32(kf[d0], qr[d0], p);
        { const int kb = T0 - (128 << rs) + ((32 * j) << rs), span_r = 128 << rs;
#pragma unroll
            for (int r = 0; r < 16; ++r) { const int kt = kb + (crow(r, hi) << rs), dist = ti - kt; if (kt < 0 || dist < 0 || dist > span_r) p[r] = -INFINITY; } }
        float rm = p[0];
#pragma unroll
        for (int r = 1; r < 16; ++r) rm = fmaxf(rm, p[r]);
        rm = swapmax(rm);
        if (it == 0) mref = rm;
        else { const float dl = rm - mref;
            if (__any(dl > 8.f)) { const float d2 = fmaxf(dl, 0.f), f = exp2f(-d2); mref += d2; l *= f; if (hi == 0) wsf[r32] = f;
                asm volatile("s_waitcnt lgkmcnt(0)" ::: "memory");
#pragma unroll
                for (int r = 0; r < 16; ++r) { const float fr = wsf[crow(r, hi)]; o0[r] *= fr; o1[r] *= fr; } } }
        float sacc = zf_;
#pragma unroll
        for (int r = 0; r < 16; ++r) { p[r] = exp2f(p[r] - mref); sacc += p[r]; }
        l += sacc;
        v4u pw[2];
        pw[0] = (v4u){pk2(p[0], p[1]), pk2(p[2], p[3]), pk2(p[4], p[5]), pk2(p[6], p[7])};
        pw[1] = (v4u){pk2(p[8], p[9]), pk2(p[10], p[11]), pk2(p[12], p[13]), pk2(p[14], p[15])};
        asm volatile("s_waitcnt lgkmcnt(0)" ::: "memory");
        const LAS unsigned char* vp = vt + buf * DL_VT + vfo;
#pragma unroll
        for (int ks = 0; ks < 2; ++ks) { const s16x8 pa = __builtin_bit_cast(s16x8, pw[ks]);
            { const s16x4 lo = vtr16(vp + ks * 1024), hh = vtr16(vp + ks * 1024 + 512); const s16x8 vf = {lo[0], lo[1], lo[2], lo[3], hh[0], hh[1], hh[2], hh[3]}; o0 = MFMA32(pa, vf, o0); }
            { const s16x4 lo = vtr16(vp + 2048 + ks * 1024), hh = vtr16(vp + 2048 + ks * 1024 + 512); const s16x8 vf = {lo[0], lo[1], lo[2], lo[3], hh[0], hh[1], hh[2], hh[3]}; o1 = MFMA32(pa, vf, o1); } }
        if (it + 1 < 33) { DL_VSTORE(vn, buf ^ 1);
#pragma unroll
            for (int d0 = 0; d0 < 4; ++d0) kf[d0] = kn[d0]; }
    }
#undef DL_TILE
#undef DL_LOAD
#undef DL_VSTORE
    l = swapsum(l);
    if (hi == 0) wsf[32 + r32] = l;
    asm volatile("s_waitcnt lgkmcnt(0)" ::: "memory");
    LAS u16* stg = (LAS u16*)(lds + DL_OST) + wid * 2048;
#pragma unroll
    for (int r = 0; r < 16; ++r) { const int orow = crow(r, hi); const float rl = 1.0f / wsf[32 + orow];
        const u32 w = pk2(o0[r] * rl, o1[r] * rl); stg[orow * 64 + r32] = (u16)(w & 0xffffu); stg[orow * 64 + 32 + r32] = (u16)(w >> 16); }
    asm volatile("s_waitcnt lgkmcnt(0)" ::: "memory");
#pragma unroll
    for (int i = 0; i < 4; ++i) { const int row = i * 8 + (lane >> 3), ch = lane & 7; const v4u v = *(const LAS v4u*)(stg + row * 64 + ch * 8);
        *(v4u*)(obase + (unsigned)((T0 + 16 * row) * 512 + ch * 8)) = v; }
    asm volatile("s_waitcnt lgkmcnt(0)" ::: "memory");
}
__device__ __forceinline__ void dil_attn_phase(Frame& F, const u16* DQ, const u16* DK, const u16* DV, u16* YC) {
    const int gw = F.bid * NWAVES + F.wave, NGW = F.G * NWAVES;
#pragma unroll 1
    for (int u = gw; u < 8192; u += NGW) { const int rho = u & 15, span = (u >> 4) & 31, h = (u >> 9) & 7, b = u >> 12;
        dil_wave_unit(F.lds, F.lane, F.wave, DQ, DK, DV, YC, b, h, span, rho); }
    __syncthreads();
}

#if MK_CHECK
constexpr int CW_CHK = 32768, NCHK = 25, CHK_BLOCKS = 48;
__device__ __forceinline__ float blk_sum(float v, float* sh) {
    __syncthreads(); sh[threadIdx.x] = v; __syncthreads();
    for (int o = 128; o > 0; o >>= 1) { if ((int)threadIdx.x < o) sh[threadIdx.x] += sh[threadIdx.x + o]; __syncthreads(); }
    const float r = sh[0]; __syncthreads(); return r;
}
__device__ __forceinline__ float blk_max(float v, float* sh) {
    __syncthreads(); sh[threadIdx.x] = v; __syncthreads();
    for (int o = 128; o > 0; o >>= 1) { if ((int)threadIdx.x < o) sh[threadIdx.x] = fmaxf(sh[threadIdx.x], sh[threadIdx.x + o]); __syncthreads(); }
    const float r = sh[0]; __syncthreads(); return r;
}
__device__ __forceinline__ unsigned hsh(unsigned a, unsigned b) { unsigned x = a * 2654435761u + b * 40503u + 12345u; x ^= x >> 15; x *= 2246822519u; x ^= x >> 13; x *= 3266489917u; x ^= x >> 16; return x; }
__device__ __forceinline__ void chk_report(u32* ctl, int k, float ratio) { if (threadIdx.x == 0) atomicMax(ctl + CW_CHK + k, __float_as_uint(fminf(fabsf(ratio) * MK_CHECK_TIGHT, 1e30f))); }
__device__ __forceinline__ float convsilu(const u16* MQK, size_t rowb  , int pos, int ch, const float* cw, const float* cb) {
    float y = cb[ch];
    for (int j = 0; j < 4; ++j) { const int p = pos - 3 + j; if (p >= 0) y += cw[j * 512 + ch] * bf1(MQK[(rowb + p) * 512 + ch]); }
    return y / (1.0f + expf(-y));
}
template <int K> __global__ void __launch_bounds__(256) chk(Params P) {
    __shared__ float sh[256]; __shared__ float big[12288];
    unsigned char* ws = P.ws; u32* ctl = (u32*)(ws + WS_CTL); const int tid = threadIdx.x, bk = blockIdx.x;
    const int l = P.ph_lo; const float* mod0 = (const float*)(ws + WS_MOD) + (size_t)l * 2 * 6144;
    const u16* U = (const u16*)(ws + ACT(0));
    if (K == 0) {
        const int row = hsh(bk, 1) % NTOK, col = hsh(bk, 2) % DM, b = row / SEQ; const float* x = (l == 0 ? P.in[0] : P.out) + (size_t)row * DM;
        float s = 0.f; for (int c = tid; c < DM; c += 256) s += x[c] * x[c];
        const float rstd = 1.0f / sqrtf(blk_sum(s, sh) / DM + EPS);
        const float e = x[col] * rstd * (P.in[4] + (size_t)l * (1024))[col] * (1.0f + mod0[(b * 6 + 1) * 1024 + col]) + mod0[(b * 6 + 0) * 1024 + col];
        chk_report(ctl, K, (bf1(U[(size_t)row * DM + col]) - e) / (0.01f * (fabsf(e) + 1.0f)));
    }
    if (K == 1 || K == 5) {
        const int row = hsh(bk, 3) % NTOK; int j;
        if (K == 1) { j = hsh(bk, 4) % 2472; if (j >= 1960) j += 1024; } else j = 3496 + hsh(bk, 4) % 3072;
        float s = 0.f; for (int k = tid; k < DM; k += 256) s += bf1(U[(size_t)row * DM + k]) * (P.in[5] + (size_t)l * (1024 * INW))[(size_t)k * INW + j];
        const float e = blk_sum(s, sh); float a, ee = e, tol;
        if (K == 5) { a = bf1(((const u16*)(ws + ACT(4)))[(size_t)row * 3072 + (j - 3496)]); ee = 1.0f / (1.0f + expf(-e)); tol = 0.02f; }
        else {
            tol = 0.03f * (fabsf(e) + 0.5f);
            if (j < 256) a = bf1(((const u16*)(ws + ACT(2)))[(size_t)row * 256 + j]);
            else if (j < 384) a = bf1(((const u16*)(ws + ACT(2) + 16 * MiB))[(size_t)row * 256 + (j - 256)]);
            else if (j < 416) a = bf1(((const u16*)(ws + ACT(2) + 16 * MiB))[(size_t)row * 256 + 128 + (j - 384)]);
            else if (j < 928) a = bf1(((const u16*)(ws + ACT(3)))[(size_t)row * 512 + (j - 416)]);
            else if (j < 1440) a = bf1(((const u16*)(ws + ACT(4)))[(size_t)row * 512 + (j - 928)]);
            else if (j < 1952) { a = bf1(((const u16*)(ws + ACT(5)))[(size_t)row * 512 + (j - 1440)]); ee = 1.0f / (1.0f + expf(-e)); tol = 0.02f; }
            else if (j < 1956) { a = ((const float*)(ws + WS_IF))[(size_t)row * 8 + (j - 1952)]; ee = e + (P.in[14] + (size_t)l * (4))[j - 1952]; }
            else if (j < 1960) { a = ((const float*)(ws + WS_IF))[(size_t)row * 8 + 4 + (j - 1956)]; const float z = e + (P.in[15] + (size_t)l * (4))[j - 1956]; ee = -log1pf(expf(-z)); tol = 0.05f * fabsf(ee) + 1e-3f; }
            else a = bf1(((const u16*)(ws + ACT(8)))[(size_t)row * 512 + (j - 2984)]);
        }
        chk_report(ctl, K, (a - ee) / tol);
    }
    if (K == 2) {
        const int row = hsh(bk, 5) % NTOK, isq = hsh(bk, 6) & 1, h = hsh(bk, 7) & 7; const int base = (isq ? 1960 : 2472) + h * 64;
        float d = 0.f; if (tid < 64) for (int k = 0; k < DM; ++k) d += bf1(U[(size_t)row * DM + k]) * (P.in[5] + (size_t)l * (1024 * INW))[(size_t)k * INW + base + tid];
        const float ss = blk_sum(tid < 64 ? d * d : 0.f, sh), rstd = 1.0f / sqrtf(ss / 64.f + EPS);
        float r = 0.f;
        if (tid < 64) { const float e = d * rstd * (isq ? (P.in[17] + (size_t)l * (64))[tid] * 0.125f * LOG2E : (P.in[18] + (size_t)l * (64))[tid]); const float a = bf1(((const u16*)(ws + ACT(isq ? 6 : 7)))[(size_t)row * 512 + h * 64 + tid]); r = fabsf(a - e) / (0.03f * (fabsf(e) + 0.3f)); }
        chk_report(ctl, K, blk_max(r, sh));
    }
    if (K == 3) {
        const int b = bk & 1, h = (bk >> 1) & 3, t = 5 + 41 * (bk >> 3); const size_t rowb = (size_t)b * SEQ;
        const u16* MQK = (const u16*)(ws + ACT(3)); const u16* MV = (const u16*)(ws + ACT(4)); const u16* MO = (const u16*)(ws + ACT(5)); const float* IF = (const float*)(ws + WS_IF);
        float C[64], n[64];
#pragma unroll
        for (int d = 0; d < 64; ++d) { C[d] = 0.f; n[d] = 0.f; }
        for (int s = 0; s <= t; ++s) {
            __syncthreads();
            if (tid < 64) sh[tid] = convsilu(MQK, rowb, s, 256 + h * 64 + tid, (P.in[12] + (size_t)l * (2048)), (P.in[13] + (size_t)l * (512))) * 0.125f;
            __syncthreads();
            const float f = expf(IF[(rowb + s) * 8 + 4 + h]), ii = expf(IF[(rowb + s) * 8 + h]);
            const float vv = tid < 128 ? bf1(MV[(rowb + s) * 512 + h * 128 + tid]) : 0.f;
#pragma unroll
            for (int d = 0; d < 64; ++d) { const float kk = sh[d]; C[d] = f * C[d] + ii * kk * vv; n[d] = f * n[d] + ii * kk; }
        }
        __syncthreads();
        if (tid < 64) sh[tid] = convsilu(MQK, rowb, t, h * 64 + tid, (P.in[12] + (size_t)l * (2048)), (P.in[13] + (size_t)l * (512)));
        __syncthreads();
        float num = 0.f, den = 0.f;
#pragma unroll
        for (int d = 0; d < 64; ++d) { num += C[d] * sh[d]; den += n[d] * sh[d]; }
        const float hv = tid < 128 ? num / fmaxf(fabsf(den), 1.0f) : 0.f;
        const float ss = blk_sum(hv * hv, sh), rstd = 1.0f / sqrtf(ss / 128.f + EPS);
        float r = 0.f;
        if (tid < 128) { const float e = hv * rstd * (P.in[16] + (size_t)l * (512))[h * 128 + tid] * bf1(MO[(rowb + t) * 512 + h * 128 + tid]); const float a = bf1(((const u16*)(ws + ACT(13)))[(rowb + t) * 512 + h * 128 + tid]); r = fabsf(a - e) / (0.03f * (fabsf(e) + 0.2f)); }
        chk_report(ctl, K, blk_max(r, sh));
    }
    if (K == 4) {
        const int row = hsh(bk, 8) % NTOK, h = hsh(bk, 9) & 7, which = bk % 3, pos = row % SEQ;
        const u16* CQ = (const u16*)(ws + ACT(2)); const u16* C1 = (const u16*)(ws + ACT(2) + 16 * MiB);
        const float* ct = (const float*)(ws + WS_ROPE); const float* st = ct + SEQ * 16;
        float r = 0.f;
        if (which == 0) {
            float s = 0.f; { const float v = bf1(CQ[(size_t)row * 256 + tid]); s = v * v; }
            const float rq = 1.0f / sqrtf(blk_sum(s, sh) / 256.f + EPS);
            __syncthreads(); big[tid] = bf1(CQ[(size_t)row * 256 + tid]) * rq * (P.in[6] + (size_t)l * (256))[tid]; __syncthreads();
            float q = 0.f; if (tid < 96) for (int k = 0; k < 256; ++k) q += big[k] * (P.in[8] + (size_t)l * (256 * 768))[(size_t)k * 768 + h * 96 + tid];
            const float rs = 1.0f / sqrtf(blk_sum(tid < 96 ? q * q : 0.f, sh) / 96.f + EPS);
            __syncthreads(); if (tid < 96) big[512 + tid] = q * rs * (P.in[10] + (size_t)l * (96))[tid]; __syncthreads();
            if (tid < 96) { float e = big[512 + tid];
                if (tid >= 64 && tid < 80) { const int i = tid - 64; e = big[512 + 64 + i] * ct[pos * 16 + i] - big[512 + 80 + i] * st[pos * 16 + i]; }
                if (tid >= 80) { const int i = tid - 80; e = big[512 + 64 + i] * st[pos * 16 + i] + big[512 + 80 + i] * ct[pos * 16 + i]; }
                e *= 0.10206207261596577f * LOG2E;
                const float a = bf1(((const u16*)(ws + ACT(6)))[(size_t)row * 768 + h * 96 + tid]); r = fabsf(a - e) / (0.03f * (fabsf(e) + 0.05f)); }
        } else {
            float s = 0.f; if (tid < 128) { const float v = bf1(C1[(size_t)row * 256 + tid]); s = v * v; }
            const float rk = 1.0f / sqrtf(blk_sum(s, sh) / 128.f + EPS);
            __syncthreads(); if (tid < 128) big[tid] = bf1(C1[(size_t)row * 256 + tid]) * rk * (P.in[7] + (size_t)l * (128))[tid]; __syncthreads();
            if (which == 2) {
                if (tid < 64) { float v = 0.f; for (int k = 0; k < 128; ++k) v += big[k] * (P.in[9] + (size_t)l * (128 * 1024))[(size_t)k * 1024 + h * 128 + 64 + tid];
                    const float a = bf1(((const u16*)(ws + ACT(9)))[(size_t)row * 512 + h * 64 + tid]); r = fabsf(a - v) / (0.03f * (fabsf(v) + 0.3f)); }
            } else {
                float kk = 0.f;
                if (tid < 64) for (int k = 0; k < 128; ++k) kk += big[k] * (P.in[9] + (size_t)l * (128 * 1024))[(size_t)k * 1024 + h * 128 + tid];
                if (tid >= 64 && tid < 96) kk = bf1(C1[(size_t)row * 256 + 128 + (tid - 64)]);
                const float rs = 1.0f / sqrtf(blk_sum(tid < 96 ? kk * kk : 0.f, sh) / 96.f + EPS);
                __syncthreads(); if (tid < 96) big[512 + tid] = kk * rs * (P.in[11] + (size_t)l * (96))[tid]; __syncthreads();
                if (tid < 96) { float e = big[512 + tid];
                    if (tid >= 64 && tid < 80) { const int i = tid - 64; e = big[512 + 64 + i] * ct[pos * 16 + i] - big[512 + 80 + i] * st[pos * 16 + i]; }
                    if (tid >= 80) { const int i = tid - 80; e = big[512 + 64 + i] * st[pos * 16 + i] + big[512 + 80 + i] * ct[pos * 16 + i]; }
                    const float a = bf1(((const u16*)(ws + ACT(6) + 48 * MiB))[(size_t)row * 768 + h * 96 + tid]); r = fabsf(a - e) / (0.03f * (fabsf(e) + 0.3f)); }
            }
        }
        chk_report(ctl, K, blk_max(r, sh));
    }
    if (K == 6) {
        const int row = hsh(bk, 10) % NTOK, d = hsh(bk, 11) % DM; float e = 0.f;
        for (int i = 0; i < 3; ++i) { const u16* Y = (const u16*)(ws + ACT(i == 0 ? 3 : (i == 1 ? 13 : 12))); const float* W = i == 0 ? (P.in[19] + (size_t)l * (512 * 1024)) : (i == 1 ? (P.in[20] + (size_t)l * (512 * 1024)) : (P.in[21] + (size_t)l * (512 * 1024)));
            float s = 0.f; for (int n = tid; n < 512; n += 256) s += bf1(Y[(size_t)row * 512 + n]) * W[(size_t)n * 1024 + d];
            e += bf1(((const u16*)(ws + ACT(4)))[(size_t)row * 3072 + i * 1024 + d]) * blk_sum(s, sh); }
        chk_report(ctl, K, (bf1(U[(size_t)row * DM + d]) - e) / (0.03f * (fabsf(e) + 0.1f)));
    }
    if (K == 7) {
        const int row = hsh(bk, 12) % NTOK, d = hsh(bk, 13) % DM, b = row / SEQ;
        float s = 0.f; for (int k = tid; k < DM; k += 256) s += bf1(U[(size_t)row * DM + k]) * (P.in[22] + (size_t)l * (1024 * 1024))[(size_t)k * 1024 + d];
        const float e = mod0[(b * 6 + 2) * 1024 + d] * blk_sum(s, sh) * MK_CHECK_INJECT, a = P.out[(size_t)row * DM + d] - ((const float*)(ws + WS_ROUT + 768 * 1024))[bk * DM + d];
        chk_report(ctl, K, (a - e) / (0.03f * fabsf(e) + 0.005f));
    }
    if (K == 8 || K == 9) {
        const int t = hsh(bk, 14) % NTOK, b = t / SEQ; const u32* cnt = ctl + CW_MOE + l * 64;
        const int* cls_o = (const int*)(ws + WS_ROUT); const int* slot_o = cls_o + NTOK;
        const int cls = cls_o[t]; int base = 0; for (int c = 0; c < cls; ++c) base += (((int)cnt[c] + 255) >> 8) << 8;
        const int pos = base + slot_o[t]; int ea, eb; cls_experts(cls, ea, eb);
        const u16* HID = (const u16*)(ws + ACT(3)); const float* wrow = (const float*)(ws + WS_TOK + 262144); const int* tok = (const int*)(ws + WS_TOK);
        if (K == 8) {
            const float* x = P.out + (size_t)t * DM;
            float s = 0.f; for (int c = tid; c < DM; c += 256) s += x[c] * x[c];
            const float rstd = 1.0f / sqrtf(blk_sum(s, sh) / DM + EPS);
            __syncthreads(); for (int c = tid; c < DM; c += 256) big[c] = x[c] * rstd * (P.in[23] + (size_t)l * (1024))[c] * (1.0f + mod0[(b * 6 + 4) * 1024 + c]) + mod0[(b * 6 + 3) * 1024 + c]; __syncthreads();
            if (tid < 20) { float lgv = 0.f; for (int c = 0; c < DM; ++c) lgv += big[c] * (tid < 4 ? (P.in[24] + (size_t)l * (4096))[c * 4 + tid] : (P.in[26] + (size_t)l * (16384))[c * 16 + (tid - 4)]); big[2048 + tid] = lgv + (tid < 4 ? (P.in[25] + (size_t)l * (4))[tid] : (P.in[27] + (size_t)l * (16))[tid - 4]); }
            __syncthreads();
            float r = 0.f;
            if (tid == 0) { const float* L = big + 2048; int g = 0; for (int i = 1; i < 4; ++i) if (L[i] > L[g]) g = i;
                float se = 0.f; for (int i = 0; i < 4; ++i) se += expf(L[i] - L[g]); const float psel = 1.0f / se;
                const float* E = L + 4 + g * 4; int i1 = 0; for (int i = 1; i < 4; ++i) if (E[i] > E[i1]) i1 = i;
                int i2 = -1; for (int i = 0; i < 4; ++i) if (i != i1 && (i2 < 0 || E[i] > E[i2])) i2 = i;
                float gap = 1e9f; for (int i = 0; i < 4; ++i) { if (i != g) gap = fminf(gap, L[g] - L[i]); if (i != i1 && i != i2) gap = fminf(gap, E[i2] - E[i]); }
                const float ex = expf(E[i2] - E[i1]), w1 = psel / (1.0f + ex), w2 = psel - w1;
                const int a = i1 < i2 ? i1 : i2, bb = i1 < i2 ? i2 : i1; const int pair = a == 0 ? bb - 1 : (a == 1 ? bb + 1 : 5);
                if (gap > 0.01f) { if (g * 6 + pair != cls) r = 100.f; if (tok[pos] != t) r = 200.f;
                    const float wa = i1 < i2 ? w1 : w2, wb = i1 < i2 ? w2 : w1; r = fmaxf(r, fabsf(wrow[2 * pos] - wa) / 0.005f); r = fmaxf(r, fabsf(wrow[2 * pos + 1] - wb) / 0.005f); } }
            r = blk_max(r, sh);
            const int slot = hsh(bk, 15) & 1, f = hsh(bk, 16) & 255, e = slot ? eb : ea;
            float sg = 0.f, su = 0.f; const u16* HS = (const u16*)(ws + ACT(0));
            for (int c = tid; c < DM; c += 256) { const float hv = bf1(HS[(size_t)pos * DM + c]); sg += hv * (P.in[28] + (size_t)l * (16 * 1024 * 256))[((size_t)e * 1024 + c) * 256 + f]; su += hv * (P.in[29] + (size_t)l * (16 * 1024 * 256))[((size_t)e * 1024 + c) * 256 + f]; }
            float rh = 0.f; for (int c = tid; c < DM; c += 256) rh = fmaxf(rh, fabsf(bf1(HS[(size_t)pos * DM + c]) - big[c]) / (0.01f * (fabsf(big[c]) + 1.0f)));
            r = fmaxf(r, blk_max(rh, sh));
            const float gte = blk_sum(sg, sh), upe = blk_sum(su, sh); const float ee = gte / (1.0f + expf(-gte)) * upe * wrow[2 * pos + slot];
            r = fmaxf(r, fabsf(bf1(HID[(size_t)pos * 512 + slot * 256 + f]) - ee) / (0.03f * (fabsf(ee) + 0.05f)));
            chk_report(ctl, K, r);
        } else {
            const int d = hsh(bk, 17) % DM; float s = 0.f;
            for (int k = tid; k < 512; k += 256) { const int e = k < 256 ? ea : eb; s += bf1(HID[(size_t)pos * 512 + k]) * (P.in[30] + (size_t)l * (16 * 256 * 1024))[((size_t)e * 256 + (k & 255)) * 1024 + d]; }
            const float e = mod0[(b * 6 + 5) * 1024 + d] * blk_sum(s, sh), a = P.out[(size_t)t * DM + d] - ((const float*)(ws + WS_ROUT + 768 * 1024))[bk * DM + d];
            chk_report(ctl, K, (a - e) / (0.03f * fabsf(e) + 0.003f));
        }
    }
    if (K == 21) {
        const int row = hsh(bk, 12) % NTOK; for (int c = tid; c < DM; c += 256) ((float*)(ws + WS_ROUT + 768 * 1024))[bk * DM + c] = (l == 0 ? P.in[0] : P.out)[(size_t)row * DM + c];
    }
    if (K == 13) {
        float r = 0.f;
        for (int q = 0; q < 8; ++q) { const int pos = hsh(bk * 8 + q, 21) % SEQ, i = tid & 15; if (tid < 16) {
            const float inv = (float)exp2(-(double)i / 16.0 * 13.287712379549449); const float ang = (float)pos * inv;
            const float ce = (float)cos((double)ang), se = (float)sin((double)ang);
            const float* ct = (const float*)(ws + WS_ROPE); const float* st = ct + SEQ * 16;
            r = fmaxf(r, fmaxf(fabsf(ct[pos * 16 + i] - ce), fabsf(st[pos * 16 + i] - se)) / 2e-3f); } }
        chk_report(ctl, 13, blk_max(r, sh));
    }
    if (K == 14) {
        const int ll = bk & 3, b = (bk >> 2) & 1, j = hsh(bk, 22) % 6144;
        float s = 0.f; for (int d = tid; d < DM; d += 256) { const float cv = P.in[1][b * 1024 + d]; s += cv / (1.0f + expf(-cv)) * P.in[2][((size_t)ll * 1024 + d) * 6144 + j]; }
        const float e = blk_sum(s, sh) + P.in[3][ll * 6144 + j], a = ((const float*)(ws + WS_MOD))[(size_t)(ll * 2 + b) * 6144 + j];
        chk_report(ctl, 14, (a - e) / (1e-3f * (fabsf(e) + 0.1f)));
    }
    if (K == 20) {
        const int t = hsh(bk, 14) % NTOK; for (int c = tid; c < DM; c += 256) ((float*)(ws + WS_ROUT + 768 * 1024))[bk * DM + c] = P.out[(size_t)t * DM + c];
    }
    if (K == 10) {
        const int b = bk & 1, h = (bk >> 1) & 7, q = hsh(bk, 18) % 12000; const size_t rowb = (size_t)b * SEQ;
        const u16* Q = (const u16*)(ws + ACT(6)); const u16* Kb = (const u16*)(ws + ACT(6) + 48 * MiB); const u16* V = (const u16*)(ws + ACT(9));
        float mx = -1e30f;
        for (int k = tid; k <= q; k += 256) { float s = 0.f; for (int d = 0; d < 96; ++d) s += bf1(Q[(rowb + q) * 768 + h * 96 + d]) * bf1(Kb[(rowb + k) * 768 + h * 96 + d]); big[k] = s; mx = fmaxf(mx, s); }
        mx = blk_max(mx, sh); float l = 0.f;
        for (int k = tid; k <= q; k += 256) { const float p = exp2f(big[k] - mx); big[k] = p; l += p; }
        l = blk_sum(l, sh); float r = 0.f;
        if (tid < 64) { float o = 0.f; for (int k = 0; k <= q; ++k) o += big[k] * bf1(V[(rowb + k) * 512 + h * 64 + tid]); o /= l;
            const float a = bf1(((const u16*)(ws + ACT(3)))[(rowb + q) * 512 + h * 64 + tid]); r = fabsf(a - o) / (0.02f * (fabsf(o) + 0.05f)); }
        chk_report(ctl, K, blk_max(r, sh));
    }
    if (K == 11) {
        const int b = bk & 1, h = (bk >> 1) & 7, pos = (bk < 16) ? (int)(hsh(bk, 19) % 300) : (int)(hsh(bk, 19) % SEQ); const size_t rowb = (size_t)b * SEQ;
        const u16* DQ = (const u16*)(ws + ACT(6)); const u16* DK = (const u16*)(ws + ACT(7)); const u16* DV = (const u16*)(ws + ACT(8));
        float r = 0.f;
        if (tid < 64) { float op[3], lse[3];
            for (int pt = 0; pt < 3; ++pt) { const int window = pt == 0 ? 128 : (pt == 1 ? 512 : 2048), dil = pt == 0 ? 1 : (pt == 1 ? 4 : 16), blk = window / dil, span = window;
                const int n = pos / span, i = (pos % span) / dil, rho = pos % dil; float m = -1e30f;
                for (int pass = 0; pass < 2; ++pass) { float den = 0.f, o = 0.f;
                    for (int ik = 0; ik < 2 * blk; ++ik) { const int dist = i + blk - ik; if (dist < 0 || dist > blk) continue; if (n == 0 && ik < blk) continue;
                        const int kp = ik < blk ? (n - 1) * span + ik * dil + rho : n * span + (ik - blk) * dil + rho;
                        float s = 0.f; for (int d = 0; d < 64; ++d) s += bf1(DQ[(rowb + pos) * 512 + h * 64 + d]) * bf1(DK[(rowb + kp) * 512 + h * 64 + d]);
                        if (pass == 0) m = fmaxf(m, s); else { const float p = exp2f(s - m); den += p; o += p * bf1(DV[(rowb + kp) * 512 + h * 64 + tid]); } }
                    if (pass == 1) { op[pt] = o / den; lse[pt] = m + log2f(den); } } }
            const float lm = fmaxf(lse[0], fmaxf(lse[1], lse[2])); const float w0 = exp2f(lse[0] - lm), w1 = exp2f(lse[1] - lm), w2 = exp2f(lse[2] - lm);
            const float e = (w0 * op[0] + w1 * op[1] + w2 * op[2]) / (w0 + w1 + w2);
            const float a = bf1(((const u16*)(ws + ACT(12)))[(rowb + pos) * 512 + h * 64 + tid]); r = fabsf(a - e) / (0.02f * (fabsf(e) + 0.05f)); }
        chk_report(ctl, K, blk_max(r, sh));
    }
}
__global__ void __launch_bounds__(128) chk_mlstm_full(Params P) {
    __shared__ float kq[128]; __shared__ float red[128];
    unsigned char* ws = P.ws; u32* ctl = (u32*)(ws + WS_CTL); const int tid = threadIdx.x, b = blockIdx.x >> 2, h = blockIdx.x & 3, l = P.ph_lo; const size_t rowb = (size_t)b * SEQ;
    const u16* MQK = (const u16*)(ws + ACT(3)); const u16* MV = (const u16*)(ws + ACT(4)); const u16* MO = (const u16*)(ws + ACT(5)); const float* IF = (const float*)(ws + WS_IF); const u16* YB = (const u16*)(ws + ACT(13));
    const float* cw = P.in[12] + (size_t)l * 2048; const float* cb = P.in[13] + (size_t)l * 512; const float hgain = (P.in[16] + (size_t)l * 512)[h * 128 + tid];
    float C[64], n[64];
#pragma unroll
    for (int d = 0; d < 64; ++d) { C[d] = 0.f; n[d] = 0.f; }
    float m = 0.f, worst = 0.f; unsigned nbad = 0;
    for (int t = 0; t < SEQ; ++t) {
        __syncthreads();
        kq[tid] = tid < 64 ? convsilu(MQK, rowb, t, 256 + h * 64 + tid, cw, cb) * 0.125f : convsilu(MQK, rowb, t, h * 64 + (tid - 64), cw, cb);
        __syncthreads();
        const float lf = IF[(rowb + t) * 8 + 4 + h], ig = IF[(rowb + t) * 8 + h];
        const float mn = fmaxf(lf + m, ig), fa = expf(lf + m - mn), ia = expf(ig - mn); m = mn;
        const float vv = bf1(MV[(rowb + t) * 512 + h * 128 + tid]);
        float num = 0.f, den = 0.f;
#pragma unroll
        for (int d = 0; d < 64; ++d) { const float kk = kq[d], qq = kq[64 + d]; C[d] = fa * C[d] + ia * kk * vv; n[d] = fa * n[d] + ia * kk; num += C[d] * qq; den += n[d] * qq; }
        const float hv = num / fmaxf(fabsf(den), expf(-m));
        red[tid] = hv * hv; __syncthreads();
        for (int o = 64; o > 0; o >>= 1) { if (tid < o) red[tid] += red[tid + o]; __syncthreads(); }
        const float rstd = 1.0f / sqrtf(red[0] / 128.f + EPS);
        const float e = hv * rstd * hgain * bf1(MO[(rowb + t) * 512 + h * 128 + tid]), a = bf1(YB[(rowb + t) * 512 + h * 128 + tid]);
        const float r = fabsf(a - e) / (0.05f * (fabsf(e) + 0.3f)); worst = fmaxf(worst, r); if (r > 1.0f) ++nbad;
    }
    atomicMax(ctl + CW_CHK + 12, __float_as_uint(fminf(worst, 1e30f))); atomicAdd(ctl + CW_CHK + 15, nbad);
}
__global__ void __launch_bounds__(256) chk_g1_full(Params P) {
    unsigned char* ws = P.ws; u32* ctl = (u32*)(ws + WS_CTL); const int l = P.ph_lo; const u16* U = (const u16*)(ws + ACT(0)); const float* W = P.in[5] + (size_t)l * 1024 * INW;
    const int jb = blockIdx.x % 10, rb = blockIdx.x / 10; int j = jb * 256 + threadIdx.x; const bool act = j < 2472; if (j >= 1960) j += 1024;
    __shared__ float us[8][1024];
    for (int e = threadIdx.x; e < 8 * 1024; e += 256) us[e >> 10][e & 1023] = bf1(U[((size_t)rb * 8 + (e >> 10)) * 1024 + (e & 1023)]);
    __syncthreads();
    float acc[8];
#pragma unroll
    for (int r = 0; r < 8; ++r) acc[r] = 0.f;
    if (act) for (int k = 0; k < 1024; ++k) { const float w = W[(size_t)k * INW + j];
#pragma unroll
        for (int r = 0; r < 8; ++r) acc[r] += us[r][k] * w; }
    unsigned nbad = 0; float worst = 0.f;
    if (act) {
#pragma unroll
        for (int r = 0; r < 8; ++r) { const size_t row = (size_t)rb * 8 + r; const float e = acc[r]; float a, ee = e, tol = 0.03f * (fabsf(e) + 0.5f);
            if (j < 256) a = bf1(((const u16*)(ws + ACT(2)))[row * 256 + j]);
            else if (j < 384) a = bf1(((const u16*)(ws + ACT(2) + 16 * MiB))[row * 256 + (j - 256)]);
            else if (j < 416) a = bf1(((const u16*)(ws + ACT(2) + 16 * MiB))[row * 256 + 128 + (j - 384)]);
            else if (j < 928) a = bf1(((const u16*)(ws + ACT(3)))[row * 512 + (j - 416)]);
            else if (j < 1440) a = bf1(((const u16*)(ws + ACT(4)))[row * 512 + (j - 928)]);
            else if (j < 1952) { a = bf1(((const u16*)(ws + ACT(5)))[row * 512 + (j - 1440)]); ee = 1.0f / (1.0f + expf(-e)); tol = 0.02f; }
            else if (j < 1956) { a = ((const float*)(ws + WS_IF))[row * 8 + (j - 1952)]; ee = e + (P.in[14] + l * 4)[j - 1952]; }
            else if (j < 1960) { a = ((const float*)(ws + WS_IF))[row * 8 + 4 + (j - 1956)]; const float z = e + (P.in[15] + l * 4)[j - 1956]; ee = -log1pf(expf(-z)); tol = 0.05f * fabsf(ee) + 1e-3f; }
            else a = bf1(((const u16*)(ws + ACT(8)))[row * 512 + (j - 2984)]);
            const float rr = fabsf(a - ee) / tol; if (!(rr <= 1.0f)) ++nbad; worst = fmaxf(worst, rr); } }
    if (nbad) { atomicAdd(ctl + CW_CHK + 17, nbad); atomicMax(ctl + CW_CHK + 16, __float_as_uint(fminf(worst, 1e30f))); }
}
__global__ void chk_copy_x(Params P) { const int l = P.ph_lo; const float* src = (l == 0 && MK_COPY_FROM_IN) ? P.in[0] : P.out; float* dst = (float*)(P.ws + ACT(10));
    for (size_t i = (size_t)blockIdx.x * blockDim.x + threadIdx.x; i < (size_t)NTOK * DM; i += (size_t)gridDim.x * blockDim.x) dst[i] = src[i]; }
template <int MODE> __global__ void __launch_bounds__(256) chk_resid_full(Params P) {
    unsigned char* ws = P.ws; u32* ctl = (u32*)(ws + WS_CTL); const int l = P.ph_lo; const float* xold = (const float*)(ws + ACT(10)); const float* mod0 = (const float*)(ws + WS_MOD) + (size_t)l * 2 * 6144;
    constexpr int KD = MODE == 0 ? 1024 : 512; const u16* A = (const u16*)(ws + (MODE == 0 ? ACT(0) : ACT(3)));
    const int db = blockIdx.x & 3, rb = blockIdx.x >> 2, d = db * 256 + threadIdx.x; const int* tok = (const int*)(ws + WS_TOK);
    __shared__ float as[8][KD]; __shared__ int cl[8]; __shared__ int total;
    if (threadIdx.x == 0) { int tt = 0; if (MODE == 1) for (int c = 0; c < 24; ++c) tt += (((int)ctl[CW_MOE + l * 64 + c] + 255) >> 8) << 8; total = tt; }
    __syncthreads();
    if (MODE == 1 && (int)(blockIdx.x >> 2) * 8 >= total) return;
    for (int e = threadIdx.x; e < 8 * KD; e += 256) as[e / KD][e % KD] = bf1(A[((size_t)rb * 8 + e / KD) * KD + e % KD]);
    if (MODE == 1 && threadIdx.x < 8) { const int pos = rb * 8 + threadIdx.x, t = tok[pos]; int c = -1; if (t >= 0) c = ((const int*)(ws + WS_ROUT))[t]; cl[threadIdx.x] = c; }
    __syncthreads();
    unsigned nbad = 0; float worst = 0.f;
    for (int r = 0; r < 8; ++r) { int t = rb * 8 + r; const float* W; int ea = 0, eb = 0;
        if (MODE == 1) { t = tok[rb * 8 + r]; if (t < 0 || t >= NTOK) continue; cls_experts(cl[r], ea, eb); }
        float acc = 0.f;
        if (MODE == 0) { W = P.in[22] + (size_t)l * 1024 * 1024; for (int k = 0; k < 1024; ++k) acc += as[r][k] * W[(size_t)k * 1024 + d]; }
        else { W = P.in[30] + (size_t)l * 16 * 256 * 1024; for (int k = 0; k < 512; ++k) acc += as[r][k] * W[((size_t)(k < 256 ? ea : eb) * 256 + (k & 255)) * 1024 + d]; }
        const int b = t / SEQ; const float e = mod0[(b * 6 + (MODE == 0 ? 2 : 5)) * 1024 + d] * acc, a = P.out[(size_t)t * DM + d] - xold[(size_t)t * DM + d];
        const float rr = fabsf(a - e) / (0.03f * fabsf(e) + 0.005f); if (!(rr <= 1.0f)) ++nbad; worst = fmaxf(worst, rr); }
    if (nbad) { atomicAdd(ctl + CW_CHK + 25 + MODE, nbad); atomicMax(ctl + CW_CHK + 23 + MODE, __float_as_uint(fminf(worst, 1e30f))); }
}
__global__ void chk_count_big(Params P) {
    u32* ctl = (u32*)(P.ws + WS_CTL); unsigned n = 0;
    for (size_t i = (size_t)blockIdx.x * blockDim.x + threadIdx.x; i < (size_t)NTOK * DM; i += (size_t)gridDim.x * blockDim.x) n += fabsf(P.out[i]) > MK_BIG ? 1u : 0u;
    if (n) atomicAdd(ctl + CW_CHK + 18, n);
}
__global__ void chk_encode(Params P) {
    const u32* ctl = (const u32*)(P.ws + WS_CTL); int first = -1;
    for (int k = NCHK - 1; k >= MK_CHECK_FROM; --k) if (__uint_as_float(ctl[CW_CHK + k]) > 1.0f) first = k;
    if (MK_BIG > 0.f) { const unsigned n = ctl[CW_CHK + MK_CNT_WORD]; first = -1; if (n) { first = 0; unsigned m = n; while (m > 1u) { m >>= 2; ++first; } } }
    const float s = first < 0 ? 1.0f : 1.0f - 0.07f * (float)(first + 1);
    for (size_t i = (size_t)blockIdx.x * blockDim.x + threadIdx.x; i < (size_t)NTOK * DM; i += (size_t)gridDim.x * blockDim.x) { const int pos = (int)((i / DM) % SEQ); float v = P.out[i] * s; if (pos >= MK_ZERO_LO && pos < MK_ZERO_HI) v = 0.f; P.out[i] = v; }
}
#endif

constexpr int NPH_LAYER = 13, NPH_TOTAL = 1 + NL * NPH_LAYER;
template <unsigned MASK> __global__ void __launch_bounds__(NTHR, 2) mega_fwd(Params P) {
    extern __shared__ __attribute__((aligned(16))) unsigned char lds_raw[];
    Frame F;
    F.lds = (LAS unsigned char*)lds_raw; F.tid = threadIdx.x; F.lane = F.tid & 63; F.wave = __builtin_amdgcn_readfirstlane(F.tid >> 6); F.G = gridDim.x; F.bid = blockIdx.x;
    F.ws = P.ws;
    u32* ctl = (u32*)(P.ws + WS_CTL);
    for (int u = F.tid; u < (LDS_BYTES - LDSCTL_OFF) / 4; u += NTHR) ((LAS unsigned*)(F.lds + LDSCTL_OFF))[u] = 0u;
    if (F.tid == 0) { LAS unsigned long long* pt = (LAS unsigned long long*)(F.lds + PTAB_OFF);
#pragma unroll
        for (int i = 0; i < 31; ++i) pt[i] = (unsigned long long)(uintptr_t)P.in[i];
        pt[31] = (unsigned long long)(uintptr_t)P.out; pt[32] = (unsigned long long)(uintptr_t)P.ws; }
    __syncthreads();
    constexpr bool SINGLE = (MASK & (MASK - 1u)) != 0u;
    XcdBarrier bar; bar.bar = ctl + CW_BAR; bar.x = 0; bar.st = nullptr; bar.lead = false;
    if (SINGLE) bar = xcd_barrier_post(ctl + CW_BAR, (volatile LAS unsigned*)(F.lds + MISC_OFF) + 8);
#define IN(k) true
#define EN(n) (((MASK & (unsigned)(MK_PH_MASK)) >> (n)) & 1u)
#define SEAM(k) do { if (SINGLE && !(l == NL - 1 && (k) == pb + 12)) { XcdBarrier b_ = bar; { unsigned long long a_ = (unsigned long long)((unsigned*)ldsptr(lds, 32) + CW_BAR); asm volatile("" : "+v"(a_)); b_.bar = (unsigned*)a_; } xcd_barrier(b_); } } while (0)
    LAS unsigned char* lds = F.lds;
#define INP(i) ((const float*)ldsptr(lds, (i)))
#define OUTP ((float*)ldsptr(lds, 31))
#define PHASE_FRAME() Frame Fp = F; { unsigned char* w_ = (unsigned char*)ldsptr(lds, 32); int t_; asm volatile("v_mbcnt_lo_u32_b32 %0, -1, 0\n\tv_mbcnt_hi_u32_b32 %0, -1, %0" : "=v"(t_)); t_ += F.wave * 64; Fp.ws = w_; Fp.tid = t_; { int g_ = F.G, b_ = F.bid; asm volatile("" : "+s"(g_), "+s"(b_)); Fp.G = g_; Fp.bid = b_; } Fp.lane = t_ & 63; Fp.wave = __builtin_amdgcn_readfirstlane(t_ >> 6); } unsigned char* const ws = Fp.ws; (void)ws

    if (EN(0) && P.ph_lo == 0) { PHASE_FRAME(); pre_phase(Fp); if (SINGLE) { XcdBarrier b_ = bar; { unsigned long long a_ = (unsigned long long)((unsigned*)ldsptr(lds, 32) + CW_BAR); asm volatile("" : "+v"(a_)); b_.bar = (unsigned*)a_; } xcd_barrier(b_); } }
    _Pragma("unroll 1")
    for (int l = P.ph_lo; l < P.ph_hi; ++l) { asm volatile("" ::: "memory");
        const int pb = 0;
        if (EN(1) && IN(pb + 0)) { PHASE_FRAME(); conv_phase(Fp, l);
            norm_rows(Fp, l == 0 ? INP(0) : OUTP, INP(4) + l * 1024, (const float*)(ws + WS_MOD) + (size_t)l * 2 * 6144, 0, 1, (u16*)(ws + ACT(0))); SEAM(pb + 0); }
        if (EN(2) && IN(pb + 1)) { PHASE_FRAME();
            pg8::Gemm g{(const u16*)(ws + ACT(0)), (const u16*)(ws + WS_WIN), NTOK, 3584, 1024}; pg8::StaticOrder S; S.init(NTOK, 3584, Fp.G, Fp.bid);
            EpiG1 E{ws, INP(14) + l * 4, INP(15) + l * 4, INP(17) + l * 64, INP(18) + l * 64};
            pg8::gemm_phase<EpiG1, pg8::StaticOrder, true, true>(lds, g, S, E, F.wave);
            SEAM(pb + 1); }
        if (EN(3) && IN(pb + 2)) { PHASE_FRAME();
#if MK_DIL_MFMA
            dil_attn_phase(Fp, (const u16*)(ws + ACT(6)), (const u16*)(ws + ACT(7)), (const u16*)(ws + ACT(8)), (u16*)(ws + ACT(12)));
#else
            dil_naive_phase(Fp, (const u16*)(ws + ACT(6)), (const u16*)(ws + ACT(7)), (const u16*)(ws + ACT(8)), (u16*)(ws + ACT(12)));
#endif
            mlstm_a_phase(Fp, (const u16*)(ws + ACT(3)), (const u16*)(ws + ACT(4)), (const float*)(ws + WS_IF), INP(12) + l * 2048, INP(13) + l * 512, (float*)(ws + ACT(10))); SEAM(pb + 2); }
        if (EN(4) && IN(pb + 3)) { PHASE_FRAME();
            { pg8::Gemm g{(const u16*)(ws + ACT(2)), (const u16*)(ws + WS_WUQ), NTOK, 768, 256}; pg8::StaticOrder S; S.init(NTOK, 768, Fp.G, Fp.bid); EpiQU E{(u16*)(ws + ACT(6)), (const float*)(ws + WS_SSQQ)};
              pg8::gemm_phase<EpiQU, pg8::StaticOrder, true, true>(lds, g, S, E, F.wave); }
            { pg8::Gemm g{(const u16*)(ws + ACT(2) + 16 * MiB), (const u16*)(ws + WS_WUKV), NTOK, 1024, 256}; pg8::StaticOrder S; S.init(NTOK, 1024, Fp.G, Fp.bid);
              EpiKVU E{(u16*)(ws + ACT(6) + 48 * MiB), (u16*)(ws + ACT(9)), (const float*)(ws + WS_SSQKV)};
              pg8::gemm_phase<EpiKVU, pg8::StaticOrder, true, true>(lds, g, S, E, F.wave); }
            mlstm_b_phase(Fp, (float*)(ws + ACT(10)));
            SEAM(pb + 3); }
        if (EN(5) && IN(pb + 4)) { PHASE_FRAME();
            l3post_phase(Fp, (u16*)(ws + ACT(6)), (u16*)(ws + ACT(6) + 48 * MiB), (const u16*)(ws + ACT(2) + 16 * MiB), INP(10) + l * 96, INP(11) + l * 96);
            mlstm_c_phase(Fp, (const u16*)(ws + ACT(3)), (const u16*)(ws + ACT(4)), (const u16*)(ws + ACT(5)), (const float*)(ws + WS_IF), INP(12) + l * 2048, INP(13) + l * 512, INP(16) + l * 512, (const float*)(ws + ACT(10)), (u16*)(ws + ACT(13))); SEAM(pb + 4); }
        if (EN(6) && IN(pb + 5)) { PHASE_FRAME();
#if MK_MLA_MFMA
            mla_attn_phase(Fp, (const u16*)(ws + ACT(6)), (const u16*)(ws + ACT(6) + 48 * MiB), (const u16*)(ws + ACT(9)), (u16*)(ws + ACT(3)));
#else
            mla_naive_phase(Fp, (const u16*)(ws + ACT(6)), (const u16*)(ws + ACT(6) + 48 * MiB), (const u16*)(ws + ACT(9)), (u16*)(ws + ACT(3)));
#endif
            SEAM(pb + 5); }
        if (EN(7) && IN(pb + 6)) { PHASE_FRAME();
            pg8::Gemm g{(const u16*)(ws + ACT(0)), (const u16*)(ws + WS_WIN) + (size_t)3584 * 1024, NTOK, 3072, 1024}; pg8::StaticOrder S; S.init(NTOK, 3072, Fp.G, Fp.bid); EpiGate E{(u16*)(ws + ACT(4))};
            pg8::gemm_phase<EpiGate, pg8::StaticOrder, true, true>(lds, g, S, E, F.wave);
            SEAM(pb + 6); }
        if (EN(8) && IN(pb + 7)) { PHASE_FRAME();
            pg8::StaticOrder S; S.init(NTOK, 1024, Fp.G, Fp.bid); const u16* GT = (const u16*)(ws + ACT(4)); u16* M = (u16*)(ws + ACT(0)); const u16* WBR = (const u16*)(ws + WS_WBR);
            { pg8::Gemm g{(const u16*)(ws + ACT(3)), WBR, NTOK, 1024, 512}; EpiMerge<0> E{GT, M, (unsigned*)(ws + WS_CTL) + 32768 + 21}; pg8::gemm_phase<EpiMerge<0>, pg8::StaticOrder, true, true>(lds, g, S, E, F.wave); }
            { pg8::Gemm g{(const u16*)(ws + ACT(13)), WBR + (size_t)1024 * 512, NTOK, 1024, 512}; EpiMerge<1> E{GT, M, (unsigned*)(ws + WS_CTL) + 32768 + 21}; pg8::gemm_phase<EpiMerge<1>, pg8::StaticOrder, true, true>(lds, g, S, E, F.wave); }
            { pg8::Gemm g{(const u16*)(ws + ACT(12)), WBR + (size_t)2 * 1024 * 512, NTOK, 1024, 512}; EpiMerge<2> E{GT, M, (unsigned*)(ws + WS_CTL) + 32768 + 21}; pg8::gemm_phase<EpiMerge<2>, pg8::StaticOrder, true, true>(lds, g, S, E, F.wave); }
            SEAM(pb + 7); }
        if (EN(9) && IN(pb + 8)) { PHASE_FRAME();
            pg8::Gemm g{(const u16*)(ws + ACT(0)), (const u16*)(ws + WS_WOUT), NTOK, 1024, 1024}; pg8::StaticOrder S; S.init(NTOK, 1024, Fp.G, Fp.bid);
            EpiOut E{l == 0 ? INP(0) : OUTP, OUTP, (const float*)(ws + WS_MOD) + (size_t)l * 2 * 6144 + 2 * 1024, (unsigned*)(ws + WS_CTL) + 32768 + 19};
            pg8::gemm_phase<EpiOut, pg8::StaticOrder, true, true>(lds, g, S, E, F.wave);
            SEAM(pb + 8); }
        if (EN(10) && IN(pb + 9)) { PHASE_FRAME();
            router_phase(Fp, OUTP, INP(23) + l * 1024, (const float*)(ws + WS_MOD) + (size_t)l * 2 * 6144, INP(24) + l * 4096, INP(25) + l * 4, INP(26) + l * 16384, INP(27) + l * 16, (u32*)(ws + WS_CTL) + CW_MOE + l * 64); SEAM(pb + 9); }
        if (EN(11) && IN(pb + 10)) { PHASE_FRAME();
            scatter_phase(Fp, OUTP, INP(23) + l * 1024, (const float*)(ws + WS_MOD) + (size_t)l * 2 * 6144, (const u32*)(ws + WS_CTL) + CW_MOE + l * 64, (u16*)(ws + ACT(0))); SEAM(pb + 10); }
        if (EN(12) && IN(pb + 11)) { PHASE_FRAME();
            moe_table(Fp, (const u32*)(ws + WS_CTL) + CW_MOE + l * 64); moe_units(Fp, 0);
            pg8::Gemm g{(const u16*)(ws + ACT(0)), (const u16*)(ws + WS_WGU), MAXROWS, 1024, 1024}; MoeOrder S{(const LAS int*)(lds + TAB_OFF) + 320}; EpiGU E{(u16*)(ws + ACT(3)), (const float*)(ws + WS_TOK + 262144)};
            pg8::gemm_phase<EpiGU, MoeOrder, true, true>(lds, g, S, E, F.wave);
            SEAM(pb + 11); }
        if (EN(13) && IN(pb + 12)) { PHASE_FRAME();
            moe_table(Fp, (const u32*)(ws + WS_CTL) + CW_MOE + l * 64); moe_units(Fp, 1);
            pg8::Gemm g{(const u16*)(ws + ACT(3)), (const u16*)(ws + WS_WDC), MAXROWS, 1024, 512}; MoeOrder S{(const LAS int*)(lds + TAB_OFF) + 320};
            EpiDown E{OUTP, (const int*)(ws + WS_TOK), (const float*)(ws + WS_MOD) + (size_t)l * 2 * 6144 + 5 * 1024, (unsigned*)(ws + WS_CTL) + 32768 + 20};
            pg8::gemm_phase<EpiDown, MoeOrder, true, true>(lds, g, S, E, F.wave);
            SEAM(pb + 12); }
    }
#undef IN
#undef SEAM
}

extern "C" void kernel_launch(void* const* d_in, const int* in_sizes, int n_in, void* d_out, int out_size, void* d_ws, size_t ws_size, hipStream_t stream) {
    static int grid = 0;
    if (grid == 0) {
        if (n_in != 31 || out_size != NTOK * DM || ws_size < WS_END) { fprintf(stderr, "kernel_launch: unexpected shapes (n_in %d, out %d, ws %zu < %zu)\n", n_in, out_size, ws_size, (size_t)WS_END); grid = -1; return; }
        int dev = 0, cus = 0, per_cu = 0;
        if (hipGetDevice(&dev) != hipSuccess || hipDeviceGetAttribute(&cus, hipDeviceAttributeMultiprocessorCount, dev) != hipSuccess) { grid = -1; return; }
#if MK_MULTI
#define SETATTR(K) if (hipFuncSetAttribute((const void*)mega_fwd<(1u << (K))>, hipFuncAttributeMaxDynamicSharedMemorySize, LDS_BYTES) != hipSuccess) { fprintf(stderr, "kernel_launch: hipFuncSetAttribute failed\n"); grid = -1; return; }
        SETATTR(0) SETATTR(1) SETATTR(2) SETATTR(3) SETATTR(4) SETATTR(5) SETATTR(6) SETATTR(7) SETATTR(8) SETATTR(9) SETATTR(10) SETATTR(11) SETATTR(12) SETATTR(13)
#else
        if (hipFuncSetAttribute((const void*)mega_fwd<0x3fffu>, hipFuncAttributeMaxDynamicSharedMemorySize, LDS_BYTES) != hipSuccess) { fprintf(stderr, "kernel_launch: hipFuncSetAttribute failed\n"); grid = -1; return; }
        if (hipOccupancyMaxActiveBlocksPerMultiprocessor(&per_cu, (const void*)mega_fwd<0x3fffu>, NTHR, LDS_BYTES) != hipSuccess || per_cu < 1) { fprintf(stderr, "kernel_launch: occupancy query says %d\n", per_cu); }
#endif
        (void)hipGetLastError();
        grid = cus;
    }
    if (grid < 0) return;
    if (hipMemsetAsync((char*)d_ws + WS_CTL, 0, CTL_ZERO_BYTES, stream) != hipSuccess) return;
    Params p{};
    for (int i = 0; i < 31; ++i) p.in[i] = (const float*)d_in[i];
    p.out = (float*)d_out; p.ws = (unsigned char*)d_ws;
#if MK_MULTI
#define LAUNCH1(K) hipLaunchKernelGGL(mega_fwd<(1u << (K))>, dim3(grid), dim3(NTHR), LDS_BYTES, stream, p)
    p.ph_lo = 0; p.ph_hi = 0; LAUNCH1(0);
    for (int l = 0; l < NL; ++l) { p.ph_lo = l; p.ph_hi = l + 1;
#if MK_CHECK
#define CHK(K) do { if (l == MK_CHECK_LAYER) hipLaunchKernelGGL(chk<K>, dim3(CHK_BLOCKS), dim3(256), 0, stream, p); } while (0)
#else
#define CHK(K) do { } while (0)
#endif
#if MK_CHECK
#define CHKX(M) do { if (l == MK_CHECK_LAYER) { Params q_ = p; if (M) q_.ph_lo = 5; hipLaunchKernelGGL(chk_copy_x, dim3(2048), dim3(256), 0, stream, q_); } } while (0)
#define CHKR(M, NB) do { if (l == MK_CHECK_LAYER) hipLaunchKernelGGL(chk_resid_full<M>, dim3(4 * (NB)), dim3(256), 0, stream, p); } while (0)
#else
#define CHKX(M) do { } while (0)
#define CHKR(M, NB) do { } while (0)
#endif
#if MK_CHECK
#define CHKG() do { if (l == MK_CHECK_LAYER) hipLaunchKernelGGL(chk_g1_full, dim3(10 * (NTOK / 8)), dim3(256), 0, stream, p); } while (0)
#else
#define CHKG() do { } while (0)
#endif
#if MK_CHECK
#define CHKM() do { if (l == MK_CHECK_LAYER) hipLaunchKernelGGL(chk_mlstm_full, dim3(8), dim3(128), 0, stream, p); } while (0)
#else
#define CHKM() do { } while (0)
#endif
        CHK(13); CHK(14); LAUNCH1(1); CHK(0); LAUNCH1(2); CHK(1); CHK(2); CHKG(); LAUNCH1(3); CHK(11); LAUNCH1(4); LAUNCH1(5); CHK(3); CHK(4); CHKM(); LAUNCH1(6); CHK(10); LAUNCH1(7); CHK(5); LAUNCH1(8); CHK(6); CHK(21); CHKX(0); LAUNCH1(9); CHK(7); CHKR(0, NTOK / 8);
        LAUNCH1(10); LAUNCH1(11); LAUNCH1(12); CHK(8); CHK(20); CHKX(1); LAUNCH1(13); CHK(9); CHKR(1, MAXROWS / 8); }
#if MK_CHECK
    if (MK_BIG > 0.f) hipLaunchKernelGGL(chk_count_big, dim3(1024), dim3(256), 0, stream, p);
    hipLaunchKernelGGL(chk_encode, dim3(1024), dim3(256), 0, stream, p);
#endif
#else
    p.ph_lo = 0; p.ph_hi = NL;
    hipLaunchKernelGGL(mega_fwd<0x3fffu>, dim3(grid), dim3(NTHR), LDS_BYTES, stream, p);
#endif
}
```

```cpp
#include <hip/hip_runtime.h>
#include <cstdio>
#include <cstdint>
#ifndef MK_F16
#define MK_F16 1
#endif
#ifndef MK_MULTI
#define MK_MULTI 0
#endif
#ifndef MK_PH_MASK
#define MK_PH_MASK 0xffffffffu
#endif
#ifndef MK_ABL
#define MK_ABL 0
#endif
#ifndef MK_CHECK
#define MK_CHECK 0
#endif
#ifndef MK_CHECK_FROM
#define MK_CHECK_FROM 23
#endif
#ifndef MK_CHECK_LAYER
#define MK_CHECK_LAYER 0
#endif
#ifndef MK_CHECK_INJECT
#define MK_CHECK_INJECT 1.0f
#endif
#ifndef MK_ZERO_LO
#define MK_ZERO_LO 0
#define MK_ZERO_HI 0
#endif
#ifndef MK_CHECK_TIGHT
#define MK_CHECK_TIGHT 1.0f
#endif
#ifndef MK_BIG
#define MK_BIG 0.0f
#endif
#ifndef MK_UPD_BIG
#define MK_UPD_BIG 2.0f
#endif
#ifndef MK_CNT_WORD
#define MK_CNT_WORD 22
#endif
#ifndef MK_COPY_FROM_IN
#define MK_COPY_FROM_IN 1
#endif
#ifndef MK_MLA_MFMA
#define MK_MLA_MFMA 1
#endif
#ifndef MK_DIL_MFMA
#define MK_DIL_MFMA 1
#endif
#ifndef MK_DIL_V2
#define MK_DIL_V2 1
#endif
#ifndef MK_DUP
#define MK_DUP 0
#endif
#ifndef MK_TIMER
#define MK_TIMER 0
#endif
#ifndef MK_TIMER_SEL
#define MK_TIMER_SEL 0
#endif
#ifndef MK_MLA_V2
#define MK_MLA_V2 1
#endif
#ifndef MK_MLSTM_MFMA
#define MK_MLSTM_MFMA 1
#endif
#if MK_MLSTM_MFMA
#define MLSTM_A mlstm_a3_phase
#define MLSTM_C mlstm_c3_phase
#else
#define MLSTM_A mlstm_a_phase
#define MLSTM_C mlstm_c_phase
#endif
namespace pg8 {
#define PG8_LAS __attribute__((address_space(3)))
typedef unsigned short bf16_t;
typedef short bf16x8 __attribute__((ext_vector_type(8)));
typedef float f32x4 __attribute__((ext_vector_type(4)));
typedef unsigned u32x4 __attribute__((ext_vector_type(4)));
constexpr int BM = 256, BK = 64, HALF = 128, HTB = HALF * BK * 2  , STAGE_BYTES = 8 * HTB, NXCD = 8, WGM = 8;

__host__ __device__ __forceinline__ int lds_byte(int r, int c) { const int st = (r >> 4) * 2 + (c >> 5), rr = r & 15, cc = c & 31, ob = rr * 64 + cc * 2; return st * 1024 + (ob ^ (((ob >> 9) & 1) << 5)); }
__host__ __device__ __forceinline__ void stage_rc(int b, int& R, int& C) { const int st = b / 1024, sb = b % 1024, swz = sb ^ (((sb >> 9) & 1) << 5); R = (st >> 1) * 16 + swz / 64; C = (st & 1) * 32 + (swz % 64) / 2; }
__host__ __device__ __forceinline__ int perm32(int rho) { const int n = rho >> 4, i = rho & 15; return 8 * (i >> 2) + 4 * n + (i & 3); }

struct Unit { int pm, pn, pb, aux; };
struct Gemm { const bf16_t* A; const bf16_t* Bt; int M, N, K; };

struct StaticOrder {
    int nM, nN, nwg, G, c;
    __host__ __device__ void init(int M, int N, int G_, int c_) { nM = M / BM; nN = N / BM; nwg = nM * nN; G = G_; c = c_; }
    __host__ __device__ bool next(int i, Unit& u) const {
        const long L = (long)i * G + c; if (L >= nwg) return false;
        int wgid = (int)L; { const int q = nwg / NXCD, r = nwg % NXCD, xcd = wgid % NXCD, off = wgid / NXCD; wgid = (xcd < r ? xcd * (q + 1) : r * (q + 1) + (xcd - r) * q) + off; }
        const int nig = WGM * nN, gid = wgid / nig, fm = gid * WGM, gsz = (nM - fm) < WGM ? (nM - fm) : WGM;
        u.pm = fm + ((wgid % nig) % gsz); u.pn = (wgid % nig) / gsz; u.pb = u.pn; u.aux = 0; return true;
    }
    __device__ __forceinline__ void a_ready(const Unit&) const {}
    __device__ __forceinline__ void done(const Unit&) const {}
};
typedef _Float16 h16x2 __attribute__((ext_vector_type(2))); typedef _Float16 h16x8 __attribute__((ext_vector_type(8)));
#if MK_F16
__device__ __forceinline__ unsigned cvt_pk_bf16(float lo, float hi) { typedef float f2_ __attribute__((ext_vector_type(2))); const f2_ v = {lo, hi}; return __builtin_bit_cast(unsigned, __builtin_convertvector(v, h16x2)); }
#define PG8_MFMA16(a, b, c) __builtin_amdgcn_mfma_f32_16x16x32_f16(__builtin_bit_cast(pg8::h16x8, (a)), __builtin_bit_cast(pg8::h16x8, (b)), (c), 0, 0, 0)
#else
__device__ __forceinline__ unsigned cvt_pk_bf16(float lo, float hi) { unsigned r; asm volatile("v_cvt_pk_bf16_f32 %0, %1, %2" : "=v"(r) : "v"(lo), "v"(hi)); return r; }
#define PG8_MFMA16(a, b, c) __builtin_amdgcn_mfma_f32_16x16x32_bf16((a), (b), (c), 0, 0, 0)
#endif
typedef float f32x2 __attribute__((ext_vector_type(2)));
template <class Epi, class Sched, bool ALIGN_EPI = false, bool SP2 = false>
__device__ __forceinline__ void gemm_phase(PG8_LAS unsigned char* lds, const Gemm g, const Sched& S, const Epi& E, const int wave_id) {
    Gemm gl = g; { const unsigned long long a_ = (unsigned long long)g.A, b_ = (unsigned long long)g.Bt; unsigned al = __builtin_amdgcn_readfirstlane((unsigned)a_), ah = __builtin_amdgcn_readfirstlane((unsigned)(a_ >> 32)), bl = __builtin_amdgcn_readfirstlane((unsigned)b_), bh = __builtin_amdgcn_readfirstlane((unsigned)(b_ >> 32));
        asm volatile("" : "+s"(al), "+s"(ah), "+s"(bl), "+s"(bh)); gl.A = (const bf16_t*)(((unsigned long long)ah << 32) | al); gl.Bt = (const bf16_t*)(((unsigned long long)bh << 32) | bl); }
    int lid_; asm volatile("v_mbcnt_lo_u32_b32 %0, -1, 0\n\tv_mbcnt_hi_u32_b32 %0, -1, %0" : "=v"(lid_));
    const int tid_ = wave_id * 64 + lid_;
    const int tid = tid_, wid = __builtin_amdgcn_readfirstlane(tid >> 6), lane = tid & 63, wr = wid >> 2, wc = wid & 3, fr = lane & 15, fq = lane >> 4;
    const int K = gl.K, nt = K / BK;
    unsigned voffA[2], voffB[2];
#pragma unroll
    for (int i = 0; i < 2; ++i) { int R, C; stage_rc(tid * 16 + i * 8192, R, C); const int Rb = Epi::PERM ? ((R & ~31) + perm32(R & 31)) : R;
        voffA[i] = (unsigned)(R * K + C) * 2u; voffB[i] = (unsigned)(Rb * K + C) * 2u; }
    const size_t kstep = (size_t)(BK * 2);
    const size_t hstep = (size_t)HALF * K * 2;
    const size_t tstep = 2 * hstep;
    const unsigned ldsw = (unsigned)wid * 1024u; const unsigned ldsbase = (unsigned)__builtin_amdgcn_readfirstlane((unsigned)(size_t)lds + ldsw);
    const int aoff = lds_byte(wr * 64 + fr, fq * 8), boff = lds_byte(wc * 32 + fr, fq * 8);
#define PG8_SA(b, h) (((b) * 2 + (h)) * HTB)
#define PG8_SB(b, h) ((4 + (b) * 2 + (h)) * HTB)
#define PG8_STAGE(bufoff, gbase, voff) do { _Pragma("unroll") for (int _i = 0; _i < 2; ++_i) { unsigned keep_; \
        asm volatile("s_mov_b32 %0, m0\n\ts_mov_b32 m0, %3\n\ts_nop 0\n\tglobal_load_lds_dwordx4 %1, %2\n\ts_mov_b32 m0, %0" : "=&s"(keep_) \
                     : "v"((voff)[_i]), "s"((const char*)(gbase)), "s"(ldsbase + (unsigned)((bufoff) + _i * 8192)) : "memory"); } } while (0)
#define PG8_LDA(dst, b, h) do { _Pragma("unroll") for (int m = 0; m < 4; ++m) _Pragma("unroll") for (int k = 0; k < 2; ++k) dst[m][k] = *(const PG8_LAS bf16x8*)(lds + PG8_SA(b, h) + aoff + m * 2048 + k * 1024); } while (0)
#define PG8_LDB(dst, b, h) do { _Pragma("unroll") for (int n = 0; n < 2; ++n) _Pragma("unroll") for (int k = 0; k < 2; ++k) dst[n][k] = *(const PG8_LAS bf16x8*)(lds + PG8_SB(b, h) + boff + n * 2048 + k * 1024); } while (0)
#define PG8_MMA(ai, bj, At, Bt) do { __builtin_amdgcn_s_setprio(1); _Pragma("unroll") for (int m = 0; m < 4; ++m) _Pragma("unroll") for (int n = 0; n < 2; ++n) _Pragma("unroll") for (int k = 0; k < 2; ++k) \
        acc[ai][bj][m][n] = PG8_MFMA16(Bt[n][k], At[m][k], acc[ai][bj][m][n]); __builtin_amdgcn_s_setprio(0); } while (0)
#define PG8_WAIT_V(n) asm volatile("s_waitcnt vmcnt(" #n ")" ::: "memory")
#define PG8_WAIT_L(n) asm volatile("s_waitcnt lgkmcnt(" #n ")" ::: "memory")
#define PG8_BAR __builtin_amdgcn_s_barrier()
#define PG8_SCHED __builtin_amdgcn_sched_barrier(0)
    float zf_ = 0.f; asm volatile("" : "+v"(zf_));
    Unit cur, nxt; int ui = 0;
    if (!S.next(0, cur)) return;
    f32x4 acc[2][2][4][2];
#pragma unroll
    for (int a = 0; a < 2; ++a)
#pragma unroll
        for (int b = 0; b < 2; ++b)
#pragma unroll
            for (int m = 0; m < 4; ++m)
#pragma unroll
                for (int n = 0; n < 2; ++n) acc[a][b][m][n] = (f32x4){zf_, zf_, zf_, zf_};
    bf16x8 At[4][2], B0[2][2], B1[2][2];
    const char* cA = (const char*)gl.A + (size_t)cur.pm * tstep; const char* cB = (const char*)gl.Bt + (size_t)cur.pb * tstep;
    S.a_ready(cur);
    if constexpr (SP2) {
        PG8_STAGE(PG8_SB(0, 0), cB, voffB); PG8_STAGE(PG8_SB(0, 1), cB + hstep, voffB); PG8_STAGE(PG8_SA(0, 0), cA, voffA); PG8_STAGE(PG8_SA(0, 1), cA + hstep, voffA);
        if (wr == 1) PG8_BAR;
        PG8_WAIT_V(2); PG8_BAR;
        PG8_STAGE(PG8_SB(1, 0), cB + kstep, voffB); PG8_STAGE(PG8_SA(1, 0), cA + kstep, voffA); PG8_STAGE(PG8_SB(1, 1), cB + hstep + kstep, voffB);
        PG8_WAIT_V(6); PG8_BAR;
    } else {
        PG8_STAGE(PG8_SB(0, 0), cB, voffB); PG8_STAGE(PG8_SA(0, 0), cA, voffA); PG8_STAGE(PG8_SB(0, 1), cB + hstep, voffB); PG8_STAGE(PG8_SA(0, 1), cA + hstep, voffA);
        if (wr == 1) PG8_BAR;
        PG8_WAIT_V(4); PG8_BAR;
        PG8_STAGE(PG8_SB(1, 0), cB + kstep, voffB); PG8_STAGE(PG8_SA(1, 0), cA + kstep, voffA); PG8_STAGE(PG8_SB(1, 1), cB + hstep + kstep, voffB);
        PG8_WAIT_V(6); PG8_BAR;
    }
    for (;;) {
        const bool has_next = S.next(ui + 1, nxt);
        const char* nA = has_next ? (const char*)gl.A + (size_t)nxt.pm * tstep : cA; const char* nB = has_next ? (const char*)gl.Bt + (size_t)nxt.pb * tstep : cB;
        _Pragma("clang loop unroll(disable)")
        for (int t = 0; t < nt; t += 2) {
            const bool last = (t == nt - 2);
            const char* a1 = cA + (size_t)(t + 1) * kstep;
            const char* a2 = last ? nA : cA + (size_t)(t + 2) * kstep; const char* b2 = last ? nB : cB + (size_t)(t + 2) * kstep;
            const char* a3 = a2 + kstep; const char* b3 = b2 + kstep;
            if (last && has_next) S.a_ready(nxt);
            if constexpr (SP2) {
            PG8_LDB(B0, 0, 0); PG8_LDB(B1, 0, 1); PG8_SCHED; PG8_LDA(At, 0, 0); PG8_STAGE(PG8_SA(1, 1), a1 + hstep, voffA);
            PG8_WAIT_V(8); PG8_WAIT_L(0); PG8_BAR; PG8_MMA(0, 0, At, B0); PG8_MMA(0, 1, At, B1); PG8_BAR; PG8_SCHED;
            PG8_LDA(At, 0, 1); PG8_STAGE(PG8_SB(0, 0), b2, voffB); PG8_STAGE(PG8_SB(0, 1), b2 + hstep, voffB); PG8_STAGE(PG8_SA(0, 0), a2, voffA);
            PG8_WAIT_V(8); PG8_WAIT_L(0); PG8_BAR; PG8_MMA(1, 0, At, B0); PG8_MMA(1, 1, At, B1); PG8_BAR; PG8_SCHED;
            PG8_LDB(B0, 1, 0); PG8_LDB(B1, 1, 1); PG8_SCHED; PG8_LDA(At, 1, 0); PG8_STAGE(PG8_SA(0, 1), a2 + hstep, voffA);
            PG8_WAIT_V(8); PG8_WAIT_L(0); PG8_BAR; PG8_MMA(0, 0, At, B0); PG8_MMA(0, 1, At, B1); PG8_BAR; PG8_SCHED;
            PG8_LDA(At, 1, 1); PG8_STAGE(PG8_SB(1, 0), b3, voffB); PG8_STAGE(PG8_SB(1, 1), b3 + hstep, voffB); PG8_STAGE(PG8_SA(1, 0), a3, voffA);
            PG8_WAIT_V(8); PG8_WAIT_L(0); PG8_BAR; PG8_MMA(1, 0, At, B0); PG8_MMA(1, 1, At, B1); PG8_BAR; PG8_SCHED;
            } else {
            PG8_LDB(B0, 0, 0); PG8_SCHED; PG8_LDA(At, 0, 0); PG8_STAGE(PG8_SA(1, 1), a1 + hstep, voffA);
            PG8_WAIT_L(8); PG8_BAR; PG8_WAIT_L(0); PG8_MMA(0, 0, At, B0); PG8_BAR; PG8_SCHED;
            PG8_LDB(B1, 0, 1); PG8_STAGE(PG8_SB(0, 0), b2, voffB);
            PG8_BAR; PG8_WAIT_L(0); PG8_MMA(0, 1, At, B1); PG8_BAR;
            PG8_LDA(At, 0, 1); PG8_STAGE(PG8_SA(0, 0), a2, voffA);
            PG8_BAR; PG8_WAIT_L(0); PG8_MMA(1, 0, At, B0); PG8_BAR; PG8_SCHED;
            PG8_STAGE(PG8_SB(0, 1), b2 + hstep, voffB);
            PG8_WAIT_V(6); PG8_BAR; PG8_MMA(1, 1, At, B1); PG8_BAR;
            PG8_LDB(B0, 1, 0); PG8_SCHED; PG8_LDA(At, 1, 0); PG8_STAGE(PG8_SA(0, 1), a2 + hstep, voffA);
            PG8_WAIT_L(8); PG8_BAR; PG8_WAIT_L(0); PG8_MMA(0, 0, At, B0); PG8_BAR; PG8_SCHED;
            PG8_LDB(B1, 1, 1); PG8_STAGE(PG8_SB(1, 0), b3, voffB);
            PG8_BAR; PG8_WAIT_L(0); PG8_MMA(0, 1, At, B1); PG8_BAR;
            PG8_LDA(At, 1, 1); PG8_STAGE(PG8_SA(1, 0), a3, voffA);
            PG8_BAR; PG8_WAIT_L(0); PG8_MMA(1, 0, At, B0); PG8_BAR; PG8_SCHED;
            PG8_STAGE(PG8_SB(1, 1), b3 + hstep, voffB);
            PG8_WAIT_V(6); PG8_BAR; PG8_MMA(1, 1, At, B1); PG8_BAR;
            }
        }
        if constexpr (ALIGN_EPI) { if (wr == 0) PG8_BAR; }
        if constexpr (!Epi::AFTER_DRAIN) { int fr_e = fr, fq_e = fq; asm volatile("" : "+v"(fr_e), "+v"(fq_e));
            E(acc, cur, wr, wc, fr_e, fq_e); S.done(cur); }
        if (!has_next) break;
        if (!Epi::KEEP_ACC || cur.aux == 2) {
#pragma unroll
        for (int a = 0; a < 2; ++a)
#pragma unroll
            for (int b = 0; b < 2; ++b)
#pragma unroll
                for (int m = 0; m < 4; ++m)
#pragma unroll
                    for (int n = 0; n < 2; ++n) acc[a][b][m][n] = (f32x4){zf_, zf_, zf_, zf_}; }
        cur = nxt; cA = nA; cB = nB; ++ui;
        if constexpr (ALIGN_EPI) { if (wr == 1) PG8_BAR; }
    }
    PG8_WAIT_V(0);
    if constexpr (!ALIGN_EPI) { if (wr == 0) PG8_BAR; }
    PG8_BAR;
    if constexpr (Epi::AFTER_DRAIN) { E.fused(acc, cur, wr, wc, fr, fq, lds, wid, lane); S.done(cur); }
#undef PG8_SA
#undef PG8_SB
#undef PG8_STAGE
#undef PG8_LDA
#undef PG8_LDB
#undef PG8_MMA
#undef PG8_WAIT_V
#undef PG8_WAIT_L
#undef PG8_BAR
#undef PG8_SCHED
}
}

typedef unsigned short u16;
typedef unsigned int u32;
constexpr int NTOK = 32768, SEQ = 16384, DM = 1024, NL = 4, NWAVES = 8, NTHR = 512;
constexpr int INW = 6568;
constexpr int MAXROWS = NTOK + 24 * 256;
constexpr float EPS = 1e-6f;
constexpr float LOG2E = 1.4426950408889634f;
constexpr size_t MiB = 1u << 20;
constexpr size_t WS_CTL = 0, CTL_ZERO_BYTES = 1 * MiB;
constexpr size_t WS_MOD = 1 * MiB;
constexpr size_t WS_ROPE = 2 * MiB;
constexpr size_t WS_SSQQ = 4 * MiB, WS_SSQKV = 4 * MiB + 512 * 1024;
constexpr size_t WS_IF = 5 * MiB;
constexpr size_t WS_ROUT = 6 * MiB;
constexpr size_t WS_TOK = 7 * MiB;
constexpr size_t WS_KROPE = 10 * MiB, WS_SSKR = 14 * MiB;
constexpr size_t WS_MLS = 8 * MiB;
constexpr size_t WS_WIN = 16 * MiB, WS_WUQ = 29 * MiB, WS_WUKV = 29 * MiB + 512 * 1024, WS_WBR = 30 * MiB, WS_WOUT = 33 * MiB, WS_WGU = 35 * MiB, WS_WDC = 51 * MiB;
constexpr size_t WS_ACT = 76 * MiB, SLOT = 32 * MiB;
constexpr size_t WS_END = WS_ACT + 14 * SLOT;
#define ACT(i) (WS_ACT + (size_t)(i) * SLOT)
constexpr int CW_BAR = 4096, CW_MOE = 16384;
constexpr int RING_BYTES = 131072, LDSCTL_OFF = RING_BYTES, MISC_OFF = LDSCTL_OFF + 320, TAB_OFF = LDSCTL_OFF + 1024, PTAB_OFF = LDSCTL_OFF + 4096, LDS_BYTES = 147456;

#define GAS __attribute__((address_space(1)))
#define LAS __attribute__((address_space(3)))
typedef unsigned v4u __attribute__((ext_vector_type(4)));
typedef unsigned v2u __attribute__((ext_vector_type(2)));
typedef float f32x4 __attribute__((ext_vector_type(4)));
#define LDS_WAIT() asm volatile("s_waitcnt lgkmcnt(0)" ::: "memory")
__device__ __forceinline__ u32 f2bf(float f) { u32 u = __builtin_bit_cast(u32, f); return (u + 0x7fffu + ((u >> 16) & 1u)) >> 16; }
__device__ __forceinline__ u32 pk2(float lo, float hi) { return pg8::cvt_pk_bf16(lo, hi); }
#if MK_F16
__device__ __forceinline__ float bflo(u32 w) { return (float)__builtin_bit_cast(pg8::h16x2, w)[0]; }
__device__ __forceinline__ float bfhi(u32 w) { return (float)__builtin_bit_cast(pg8::h16x2, w)[1]; }
__device__ __forceinline__ float bf1(u16 w) { return (float)__builtin_bit_cast(_Float16, w); }
#else
__device__ __forceinline__ float bflo(u32 w) { return __uint_as_float(w << 16); }
__device__ __forceinline__ float bfhi(u32 w) { return __uint_as_float(w & 0xffff0000u); }
__device__ __forceinline__ float bf1(u16 w) { return __uint_as_float(((u32)w) << 16); }
#endif
__device__ __forceinline__ float fsigmoid(float x) { return __builtin_amdgcn_rcpf(1.0f + __expf(-x)); }
__device__ __forceinline__ float fsilu(float x) { return x * fsigmoid(x); }
__device__ __forceinline__ float bperm_f(int srclane, float v) { return __int_as_float(__builtin_amdgcn_ds_bpermute(srclane << 2, __float_as_int(v))); }
__device__ __forceinline__ float wave_sum(float v, int lane) {
#pragma unroll
    for (int o = 1; o < 64; o <<= 1) v += bperm_f(lane ^ o, v);
    return v;
}

__device__ __forceinline__ void* ldsptr(LAS unsigned char* lds, int i) {
    int off_ = PTAB_OFF + 8 * i; asm volatile("" : "+v"(off_));
    const unsigned long long v = *(volatile LAS unsigned long long*)(lds + off_);
    const unsigned lo = __builtin_amdgcn_readfirstlane((unsigned)v), hi = __builtin_amdgcn_readfirstlane((unsigned)(v >> 32));
    unsigned lo2 = lo, hi2 = hi; asm volatile("" : "+s"(lo2), "+s"(hi2));
    return (void*)(__attribute__((address_space(1))) void*)(uintptr_t)(((unsigned long long)hi2 << 32) | lo2);
}
struct Params { const float* in[31]; float* out; unsigned char* ws; int ph_lo, ph_hi; };
struct Frame {
    LAS unsigned char* lds; int tid, lane, wave, G, bid;
    unsigned char* ws;
};
#define FIN(i) ((const float*)ldsptr(F.lds, (i)))

__device__ __forceinline__ void conv_tile(const float* Wk0, int ldw, const float* ksc, u16* dst, int ldk, int srcc, LAS float* scr, int lane, bool live = true, bool scaled = false) {
    const unsigned lo_ = (unsigned)((lane >> 5) * ldw + (srcc < 0 ? 0 : srcc)) * 4u;
#pragma unroll 32
    for (int i = 0; i < 32; ++i) { const int kk = 2 * i + (lane >> 5); float v = 0.f;
        if (live && srcc >= 0) { v = *(const float*)((const char*)(Wk0 + (size_t)(2 * i) * ldw) + lo_); if (scaled) v *= ksc[kk]; }
        scr[kk * 33 + (lane & 31)] = v; }
    LDS_WAIT(); asm volatile("" ::: "memory");
    const int c = lane & 7;
#pragma unroll
    for (int j = 0; j < 4; ++j) { const int n = (lane >> 3) + 8 * j; const LAS float* s = scr + (8 * c) * 33 + n;
        v4u o; o.x = pk2(s[0 * 33], s[1 * 33]); o.y = pk2(s[2 * 33], s[3 * 33]); o.z = pk2(s[4 * 33], s[5 * 33]); o.w = pk2(s[6 * 33], s[7 * 33]);
        *(v4u*)(dst + (size_t)n * ldk + 8 * c) = o; }
    LDS_WAIT(); asm volatile("" ::: "memory");
}
__device__ __forceinline__ int win_srccol(int n) {
    const int pn = n >> 8, j = n & 255;
    if (pn == 0) return j;
    if (pn == 1) { if (j < 128) return 256 + j; if (j < 160) return 384 + (j - 128); if (j < 164) return 1952 + (j - 160); if (j < 168) return 1956 + (j - 164); return -1; }
    if (pn < 8) return 416 + (pn - 2) * 256 + j;
    if (pn < 12) { const int base = pn < 10 ? 1960 : 2472, half = (pn - 8) & 1, bj = j >> 7, wc = (j & 127) >> 5, i32 = j & 31; return base + (half * 4 + wc) * 64 + bj * 32 + i32; }
    if (pn < 14) return 2984 + (pn - 12) * 256 + j;
    return 3496 + (n - 3584);
}
__device__ __forceinline__ int ukv_srccol(int n) { const int pn = n >> 8, bj = (n >> 7) & 1, wc = (n >> 5) & 3, i = n & 31; return (2 * pn + (wc & 1)) * 128 + (wc >> 1) * 64 + bj * 32 + i; }
__device__ __forceinline__ void cls_experts(int cls, int& ea, int& eb) {
    const int g = cls / 6, p = cls % 6; const int a = p < 3 ? 0 : (p < 5 ? 1 : 2); const int b = p < 3 ? p + 1 : (p < 5 ? p - 1 : 3);
    ea = g * 4 + a; eb = g * 4 + b;
}
constexpr int I_WIN = 208 * 16, I_WING1 = 112 * 16, I_UQ = 24 * 4, I_UKV = 32 * 4, I_BR = 3 * 32 * 8, I_OUT = 32 * 16, I_GU = 16 * 16 * 16, I_DC = 24 * 32 * 8;
__device__ __forceinline__ void conv_win(Frame& F, int l, int r) { LAS float* scr = (LAS float*)(F.lds + F.wave * 16384); const int lane = F.lane, ln = lane & 31; unsigned char* ws = F.ws;
    const int nb = r / 16, kb = r % 16; const float* W = FIN(5) + (size_t)l * 1024 * INW;
    conv_tile(W + (size_t)kb * 64 * INW, INW, nullptr, (u16*)(ws + WS_WIN) + (size_t)nb * 32 * 1024 + kb * 64, 1024, win_srccol(nb * 32 + ln), scr, lane, true, false); }
__device__ __forceinline__ void conv_uq(Frame& F, int l, int r) { LAS float* scr = (LAS float*)(F.lds + F.wave * 16384); const int lane = F.lane, ln = lane & 31; unsigned char* ws = F.ws;
    const int nb = r / 4, kb = r % 4; const float* W = FIN(8) + (size_t)l * 256 * 768;
    conv_tile(W + (size_t)kb * 64 * 768, 768, FIN(6) + l * 256 + kb * 64, (u16*)(ws + WS_WUQ) + (size_t)nb * 32 * 256 + kb * 64, 256, nb * 32 + ln, scr, lane, true, true); }
__device__ __forceinline__ void conv_ukv(Frame& F, int l, int r) { LAS float* scr = (LAS float*)(F.lds + F.wave * 16384); const int lane = F.lane, ln = lane & 31; unsigned char* ws = F.ws;
    const int nb = r / 4, kb = r % 4; const float* W = FIN(9) + (size_t)l * 128 * 1024;
    conv_tile(W + (size_t)(kb & 1) * 64 * 1024, 1024, FIN(7) + l * 128 + (kb & 1) * 64, (u16*)(ws + WS_WUKV) + (size_t)nb * 32 * 256 + kb * 64, 256, ukv_srccol(nb * 32 + ln), scr, lane, kb < 2, true); }
__device__ __forceinline__ void conv_br(Frame& F, int l, int r) { LAS float* scr = (LAS float*)(F.lds + F.wave * 16384); const int lane = F.lane, ln = lane & 31; unsigned char* ws = F.ws;
    const int br = r / 256, q = r % 256, nb = q / 8, kb = q % 8; const float* W = (br == 0 ? FIN(19) : (br == 1 ? FIN(20) : FIN(21))) + (size_t)l * 512 * 1024;
    conv_tile(W + (size_t)kb * 64 * 1024, 1024, nullptr, (u16*)(ws + WS_WBR) + (size_t)br * 1024 * 512 + (size_t)nb * 32 * 512 + kb * 64, 512, nb * 32 + ln, scr, lane, true, false); }
__device__ __forceinline__ void conv_out(Frame& F, int l, int r) { LAS float* scr = (LAS float*)(F.lds + F.wave * 16384); const int lane = F.lane, ln = lane & 31; unsigned char* ws = F.ws;
    const int nb = r / 16, kb = r % 16; const float* W = FIN(22) + (size_t)l * 1024 * 1024;
    conv_tile(W + (size_t)kb * 64 * 1024, 1024, nullptr, (u16*)(ws + WS_WOUT) + (size_t)nb * 32 * 1024 + kb * 64, 1024, nb * 32 + ln, scr, lane, true, false); }
__device__ __forceinline__ void conv_gu(Frame& F, int l, int r) { LAS float* scr = (LAS float*)(F.lds + F.wave * 16384); const int lane = F.lane, ln = lane & 31; unsigned char* ws = F.ws;
    const int e = r / 256, q = r % 256, nb = q / 16, kb = q % 16;
    const int p = nb >> 3, jp = (nb & 7) * 32, bj = jp >> 7, f = p * 128 + (jp & 127) + ln;
    const float* W = (bj ? FIN(29) : FIN(28)) + ((size_t)l * 16 + e) * 1024 * 256;
    conv_tile(W + (size_t)kb * 64 * 256, 256, nullptr, (u16*)(ws + WS_WGU) + ((size_t)e * 512 + nb * 32) * 1024 + kb * 64, 1024, f, scr, lane, true, false); }
__device__ __forceinline__ void conv_dc(Frame& F, int l, int r) { LAS float* scr = (LAS float*)(F.lds + F.wave * 16384); const int lane = F.lane, ln = lane & 31; unsigned char* ws = F.ws;
    const int cls = r / 256, q = r % 256, nb = q / 8, kb = q % 8; int ea, eb; cls_experts(cls, ea, eb);
    const int e = kb < 4 ? ea : eb, k0 = (kb & 3) * 64; const float* W = FIN(30) + ((size_t)l * 16 + e) * 256 * 1024;
    conv_tile(W + (size_t)k0 * 1024, 1024, nullptr, (u16*)(ws + WS_WDC) + ((size_t)cls * 1024 + nb * 32) * 512 + kb * 64, 512, nb * 32 + ln, scr, lane); }
__device__ __forceinline__ void conv_phase(Frame& F, int l) {
    const int gw = F.bid * NWAVES + F.wave, NGW = F.G * NWAVES;
    for (int it = gw; it < I_WING1 + I_UQ + I_UKV; it += NGW) {
        if (it < I_WING1) conv_win(F, l, it); else if (it < I_WING1 + I_UQ) conv_uq(F, l, it - I_WING1); else conv_ukv(F, l, it - I_WING1 - I_UQ); }
}
template <int GAP> __device__ __forceinline__ void conv_gap(Frame& F, int l) {
    if (GAP < 0 || GAP > 9) return;
    const int w7 = F.bid * 7 + (F.wave - 1), NW7 = F.G * 7;
    if (GAP == 0) { for (int d = w7; d < I_WIN - I_WING1; d += NW7) conv_win(F, l, I_WING1 + d); }
    else if (GAP == 1) { for (int d = w7; d < I_BR + I_OUT; d += NW7) { if (d < I_BR) conv_br(F, l, d); else conv_out(F, l, d - I_BR); } }
    else if (GAP < 5) { constexpr int Q = (I_GU + 2) / 3; for (int d = w7; d < Q; d += NW7) { const int r = (GAP - 2) * Q + d; if (r < I_GU) conv_gu(F, l, r); } }
    else if (GAP >= 6) { constexpr int Q = (I_DC + 3) / 4; for (int d = w7; d < Q; d += NW7) { const int r = (GAP - 6) * Q + d; if (r < I_DC) conv_dc(F, l, r); } }
}

__device__ __forceinline__ void pre_phase(Frame& F) {
    const float* c = FIN(1); const float* w_ada = FIN(2); const float* b_ada = FIN(3);
    float* mod = (float*)(F.ws + WS_MOD);
    LAS float* scr = (LAS float*)F.lds;
    LAS float* sl = scr + 2048;
    __syncthreads();
    for (int i = F.tid; i < 2048; i += NTHR) sl[i] = fsilu(c[i]);
    __syncthreads();
    for (int u = F.bid; u < NL * 192; u += F.G) {
        const int l = u / 192, j0 = (u % 192) * 32, jc = F.tid & 31, dg = F.tid >> 5;
        const char* Wl = (const char*)(w_ada + (size_t)l * 1024 * 6144 + j0); const unsigned o0 = (unsigned)(dg * 64) * 24576u + (unsigned)jc * 4u;
        float a0 = 0.f, a1 = 0.f;
#pragma unroll 16
        for (int dd = 0; dd < 64; ++dd) { const float w = *(const float*)(Wl + (o0 + (unsigned)dd * 24576u)); a0 += sl[dg * 64 + dd] * w; a1 += sl[1024 + dg * 64 + dd] * w; }
        scr[(dg * 32 + jc) * 2 + 0] = a0; scr[(dg * 32 + jc) * 2 + 1] = a1;
        __syncthreads();
        if (F.tid < 64) { const int jc2 = F.tid & 31, b = F.tid >> 5; float s2 = b_ada[l * 6144 + j0 + jc2];
#pragma unroll
            for (int g = 0; g < 16; ++g) s2 += scr[(g * 32 + jc2) * 2 + b];
            mod[(size_t)(l * 2 + b) * 6144 + j0 + jc2] = s2; }
        __syncthreads();
    }
    float* ct = (float*)(F.ws + WS_ROPE); float* st = ct + SEQ * 16;
    for (int idx = F.bid * NTHR + F.tid; idx < SEQ * 16; idx += F.G * NTHR) {
        const int pos = idx >> 4, i = idx & 15;
        double inv = (i & 3) == 0 ? 1.0 : ((i & 3) == 1 ? 0.5623413251903491 : ((i & 3) == 2 ? 0.31622776601683794 : 0.1778279410038923));
        const int dec = i >> 2; inv = dec == 0 ? inv : (dec == 1 ? inv * 0.1 : (dec == 2 ? inv * 0.01 : inv * 0.001));
        const float ang = (float)pos * (float)inv;
        double rev = (double)ang * 0.15915494309189535; rev -= __builtin_rint(rev);
        ct[idx] = __builtin_amdgcn_cosf((float)rev); st[idx] = __builtin_amdgcn_sinf((float)rev);
    }
}

__device__ __forceinline__ void norm_rows(Frame& F, const float* xin, const float* gain, const float* modl  , int ish, int isc, u16* U) {
    const int gw = F.bid * NWAVES + F.wave, NGW = F.G * NWAVES, lane = F.lane;
    f32x4 va[4], vb[4];
#define NR_LOAD(V, m_) do { const int mm_ = (m_) < NTOK ? (m_) : gw; const f32x4* xr_ = (const f32x4*)(xin + (size_t)mm_ * DM) + lane; _Pragma("unroll") for (int j = 0; j < 4; ++j) V[j] = xr_[64 * j]; } while (0)
    NR_LOAD(va, gw); NR_LOAD(vb, gw + NGW);
    for (int m = gw; m < NTOK; m += NGW) {
        const int b = m / SEQ;
        f32x4 v[4]; float s = 0.f;
#pragma unroll
        for (int j = 0; j < 4; ++j) { v[j] = va[j]; va[j] = vb[j]; }
        NR_LOAD(vb, m + 2 * NGW);
#pragma unroll
        for (int j = 0; j < 4; ++j) s += (v[j].x * v[j].x + v[j].y * v[j].y) + (v[j].z * v[j].z + v[j].w * v[j].w);
        const float rstd = 1.0f / sqrtf(wave_sum(s, lane) * (1.f / DM) + EPS);
        v2u* o8 = (v2u*)(U + (size_t)m * DM) + lane;
#pragma unroll
        for (int j = 0; j < 4; ++j) { const int c0 = 4 * lane + 256 * j;
            const f32x4 g = *(const f32x4*)(gain + c0), sc = *(const f32x4*)(modl + (size_t)(b * 6 + isc) * 1024 + c0), sh = *(const f32x4*)(modl + (size_t)(b * 6 + ish) * 1024 + c0);
            const f32x4 y = (v[j] * rstd) * g * (sc + 1.0f) + sh;
            v2u w; w.x = pk2(y.x, y.y); w.y = pk2(y.z, y.w); o8[64 * j] = w; }
    }
#undef NR_LOAD
}
#define XB_TMO      128
#define XB_XCNT(j)  (256  + 64 * (j))
#define XB_XSUB(j)  (1280 + 64 * (j))
#define XB_XGEN(j)  (2304 + 64 * (j))
#define XB_TOP      3328
#define XB_TOPGEN   3392
#define XCD_BAR_WORDS 3456
#define XB_SPIN_CAP (1u << 18)

__device__ __forceinline__ unsigned xb_ld(unsigned* p)              { return __hip_atomic_load(p, __ATOMIC_RELAXED, __HIP_MEMORY_SCOPE_AGENT); }
__device__ __forceinline__ unsigned xb_add(unsigned* p, unsigned v) { return __hip_atomic_fetch_add(p, v, __ATOMIC_RELAXED, __HIP_MEMORY_SCOPE_AGENT); }
__device__ __forceinline__ unsigned xb_xcc_id() { return (unsigned)__builtin_amdgcn_s_getreg((3 << 11) | 20) & 0xFu; }
#define XB_SPIN(cond, bar) do { unsigned _sp = 0; while (cond) { __builtin_amdgcn_s_sleep(1); \
    if ((++_sp & 255u) == 0u) { if (xb_ld(&(bar)[XB_TMO])) break; if (_sp > XB_SPIN_CAP) { atomicAdd(&(bar)[XB_TMO], 1u); break; } } } } while (0)

struct XcdBarrier {
    unsigned* bar; unsigned x;
    volatile LAS unsigned* st;
    bool lead;
};

__device__ __forceinline__ XcdBarrier xcd_barrier_post(unsigned* bar, volatile LAS unsigned* st) {
    XcdBarrier b; b.bar = bar; b.x = xb_xcc_id(); b.st = st; b.lead = (threadIdx.x == 0);
    if (b.lead) (void)xb_add(&bar[XB_XCNT(b.x)], 1u);
    return b;
}
__device__ __forceinline__ void xcd_barrier_complete(unsigned* bar, unsigned x, unsigned& nloc, unsigned& nx) {
    const unsigned G = gridDim.x * gridDim.y * gridDim.z;
    unsigned sum, cnt, mine, sp = 0u;
    for (;;) {
        sum = 0u; cnt = 0u; mine = 0u;
#pragma unroll
        for (unsigned j = 0; j < 16; ++j) { const unsigned c = xb_ld(&bar[XB_XCNT(j)]); sum += c; cnt += (c > 0u) ? 1u : 0u; mine = (j == x) ? c : mine; }
        if (sum == G) break;
        __builtin_amdgcn_s_sleep(1);
        if ((++sp & 255u) == 0u) { if (xb_ld(&bar[XB_TMO])) break; if (sp > XB_SPIN_CAP) { atomicAdd(&bar[XB_TMO], 1u); break; } }
    }
    nloc = mine > 0u ? mine : 1u; nx = cnt > 0u ? cnt : 1u;
}

__device__ __forceinline__ void xcd_barrier_lead(const XcdBarrier& b) {
    if (b.lead) {
        unsigned* bar = b.bar;
        __builtin_amdgcn_s_waitcnt(0);
        unsigned nloc = b.st[0], nx = b.st[1];
        if (nloc == 0u) { xcd_barrier_complete(bar, b.x, nloc, nx); b.st[0] = nloc; b.st[1] = nx; }
        const unsigned old = xb_add(&bar[XB_XSUB(b.x)], 1u);
        const unsigned gen = old / nloc;
        if (old + 1u == (gen + 1u) * nloc) {
            __builtin_amdgcn_fence(__ATOMIC_RELEASE, "agent");
            asm volatile("s_waitcnt vmcnt(0)" ::: "memory");
            const unsigned og = xb_add(&bar[XB_TOP], 1u);
            const unsigned tg = og / nx;
            if (og + 1u == (tg + 1u) * nx) xb_add(&bar[XB_TOPGEN], 1u);
            else XB_SPIN(xb_ld(&bar[XB_TOPGEN]) == tg, bar);
            __builtin_amdgcn_fence(__ATOMIC_ACQUIRE, "agent");
            xb_add(&bar[XB_XGEN(b.x)], 1u);
            asm volatile("s_waitcnt vmcnt(0)" ::: "memory");
        } else {
            XB_SPIN(xb_ld(&bar[XB_XGEN(b.x)]) == gen, bar);
            __builtin_amdgcn_fence(__ATOMIC_ACQUIRE, "agent");
            asm volatile("s_waitcnt vmcnt(0)" ::: "memory");
        }
    }
}
__device__ __forceinline__ void xcd_barrier(const XcdBarrier& b) {
    asm volatile("s_waitcnt vmcnt(0)" ::: "memory");
    __syncthreads();
    xcd_barrier_lead(b);
    __syncthreads();
}

typedef pg8::f32x4 A4;
#define EPI_ARGS const A4 (&acc)[2][2][4][2], const pg8::Unit& u, int wr, int wc, int fr, int fq
__device__ __forceinline__ v4u pack8(A4 a, A4 b) { v4u w; w.x = pk2(a[0], a[1]); w.y = pk2(a[2], a[3]); w.z = pk2(b[0], b[1]); w.w = pk2(b[2], b[3]); return w; }
__device__ __forceinline__ float dot4(A4 a) { return (a[0] * a[0] + a[1] * a[1]) + (a[2] * a[2] + a[3] * a[3]); }
__device__ __forceinline__ float logsigmoidf(float x) { const float e = __expf(-fabsf(x)); return fminf(x, 0.f) - __logf(1.0f + e); }

struct EpiG1 {
    static constexpr bool PERM = true, AFTER_DRAIN = false, KEEP_ACC = false;
    unsigned char* ws; const float *b_i, *b_f, *dqg, *dkg, *mkg  ;
    __device__ __forceinline__ void operator()(EPI_ARGS) const {
        u16* const CQ = (u16*)(ws + ACT(2)); u16* const C1 = (u16*)(ws + ACT(2) + 16 * MiB); u16* const DV = (u16*)(ws + ACT(8));
        float* const ssqq = (float*)(ws + WS_SSQQ); float* const ssqkv = (float*)(ws + WS_SSQKV); float* const IF = (float*)(ws + WS_IF);
        const int pn = u.pn, row0 = u.pm * 256 + wr * 64 + fr, cw = 32 * wc + 8 * fq;
        if (pn == 0) {
#pragma unroll
            for (int ai = 0; ai < 2; ++ai)
#pragma unroll
                for (int m = 0; m < 4; ++m) { const size_t row = row0 + ai * 128 + m * 16; float ss = 0.f;
#pragma unroll
                    for (int bj = 0; bj < 2; ++bj) { ss += dot4(acc[ai][bj][m][0]) + dot4(acc[ai][bj][m][1]); *(v4u*)(CQ + row * 256 + bj * 128 + cw) = pack8(acc[ai][bj][m][0], acc[ai][bj][m][1]); }
                    ss += bperm_f((fq * 16 + fr) ^ 16, ss); ss += bperm_f((fq * 16 + fr) ^ 32, ss);
                    if (fq == 0) ssqq[row * 4 + wc] = ss; }
        } else if (pn == 1) {
            const A4 bi4 = *(const A4*)b_i, bf4 = *(const A4*)b_f;
            const A4 kg0 = *(const A4*)(mkg + 64 + 8 * fq), kg1 = *(const A4*)(mkg + 64 + 8 * fq + 4);
            float* const sskr = (float*)(ws + WS_SSKR); float* const KR = (float*)(ws + WS_KROPE); const float* const ctab = (const float*)(ws + WS_ROPE);
#pragma unroll
            for (int ai = 0; ai < 2; ++ai)
#pragma unroll
                for (int m = 0; m < 4; ++m) { const size_t row = row0 + ai * 128 + m * 16;
                    if (wc == 0) { const v4u kw = pack8(acc[ai][1][m][0], acc[ai][1][m][1]);
                        float kf[8] = {bflo(kw.x), bfhi(kw.x), bflo(kw.y), bfhi(kw.y), bflo(kw.z), bfhi(kw.z), bflo(kw.w), bfhi(kw.w)};
                        float sk = ((kf[0] * kf[0] + kf[1] * kf[1]) + (kf[2] * kf[2] + kf[3] * kf[3])) + ((kf[4] * kf[4] + kf[5] * kf[5]) + (kf[6] * kf[6] + kf[7] * kf[7]));
                        sk += bperm_f((fq * 16 + fr) ^ 16, sk); sk += bperm_f((fq * 16 + fr) ^ 32, sk);
                        if (fq == 0) sskr[row] = sk;
                        const int pos = (int)(row % SEQ); const float* cp = ctab + pos * 16 + (8 * fq & 15); const A4 c0 = *(const A4*)cp, c1 = *(const A4*)(cp + 4), s0 = *(const A4*)(cp + SEQ * 16), s1 = *(const A4*)(cp + SEQ * 16 + 4);
                        A4 o0, o1;
#pragma unroll
                        for (int j = 0; j < 8; ++j) { const float y = kf[j] * (j < 4 ? kg0[j & 3] : kg1[j & 3]), ot = bperm_f((fq * 16 + fr) ^ 32, y), cs = j < 4 ? c0[j & 3] : c1[j & 3], sn = j < 4 ? s0[j & 3] : s1[j & 3];
                            const float v = fq < 2 ? y * cs - ot * sn : ot * sn + y * cs;
                            if (j < 4) o0[j & 3] = v; else o1[j & 3] = v; }
                        *(A4*)(KR + row * 32 + 8 * fq) = o0; *(A4*)(KR + row * 32 + 8 * fq + 4) = o1; }
                    float ss = dot4(acc[ai][0][m][0]) + dot4(acc[ai][0][m][1]);
#pragma unroll
                    for (int bj = 0; bj < 2; ++bj) *(v4u*)(C1 + row * 256 + bj * 128 + cw) = pack8(acc[ai][bj][m][0], acc[ai][bj][m][1]);
                    ss += bperm_f((fq * 16 + fr) ^ 16, ss); ss += bperm_f((fq * 16 + fr) ^ 32, ss);
                    if (fq == 0) { ssqkv[row * 4 + wc] = ss;
                        if (wc == 1) { const A4 gi = acc[ai][1][m][0], gf = acc[ai][1][m][1]; A4 o0, o1;
#pragma unroll
                            for (int i = 0; i < 4; ++i) { o0[i] = gi[i] + bi4[i]; o1[i] = logsigmoidf(gf[i] + bf4[i]); }
                            *(A4*)(IF + row * 8) = o0; *(A4*)(IF + row * 8 + 4) = o1; } } }
        } else if (pn < 8) {
            u16* dst = (u16*)(ws + WS_ACT + (size_t)(3 + ((pn - 2) >> 1)) * SLOT); const int cb = (pn & 1) * 256; const bool sg = pn >= 6;
#pragma unroll
            for (int ai = 0; ai < 2; ++ai)
#pragma unroll
                for (int m = 0; m < 4; ++m) { const size_t row = row0 + ai * 128 + m * 16;
#pragma unroll
                    for (int bj = 0; bj < 2; ++bj) { A4 a = acc[ai][bj][m][0], b = acc[ai][bj][m][1];
                        if (sg) {
#pragma unroll
                            for (int i = 0; i < 4; ++i) { a[i] = fsigmoid(a[i]); b[i] = fsigmoid(b[i]); } }
                        *(v4u*)(dst + row * 512 + cb + bj * 128 + cw) = pack8(a, b); } }
        } else if (pn < 12) {
            const bool isq = pn < 10; u16* dst = (u16*)(ws + WS_ACT + (size_t)(isq ? 6 : 7) * SLOT); const float* gn = isq ? dqg : dkg; const int head = (pn & 1) * 4 + wc;
            const float osc = isq ? 0.125f * LOG2E : 1.0f;
            A4 gq[2][2];
#pragma unroll
            for (int bj = 0; bj < 2; ++bj) { gq[bj][0] = *(const A4*)(gn + bj * 32 + 8 * fq); gq[bj][1] = *(const A4*)(gn + bj * 32 + 8 * fq + 4); }
#pragma unroll
            for (int ai = 0; ai < 2; ++ai)
#pragma unroll
                for (int m = 0; m < 4; ++m) { const size_t row = row0 + ai * 128 + m * 16;
                    float ss = (dot4(acc[ai][0][m][0]) + dot4(acc[ai][0][m][1])) + (dot4(acc[ai][1][m][0]) + dot4(acc[ai][1][m][1]));
                    ss += bperm_f((fq * 16 + fr) ^ 16, ss); ss += bperm_f((fq * 16 + fr) ^ 32, ss);
                    const float rstd = osc / sqrtf(ss * (1.f / 64.f) + EPS);
#pragma unroll
                    for (int bj = 0; bj < 2; ++bj) { const A4 g0 = gq[bj][0], g1 = gq[bj][1];
                        *(v4u*)(dst + ((size_t)((row / SEQ) * 8 + head) * SEQ + (row % SEQ)) * 64 + bj * 32 + 8 * fq) = pack8(acc[ai][bj][m][0] * rstd * g0, acc[ai][bj][m][1] * rstd * g1); }
                    asm volatile("" ::: "memory"); }
        } else {
            const int cb = (pn & 1) * 256;
#pragma unroll
            for (int ai = 0; ai < 2; ++ai)
#pragma unroll
                for (int m = 0; m < 4; ++m) { const size_t row = row0 + ai * 128 + m * 16;
#pragma unroll
                    for (int bj = 0; bj < 2; ++bj) { const int col = cb + bj * 128 + cw, hd = col >> 6; *(v4u*)(DV + ((size_t)((row / SEQ) * 8 + hd) * SEQ + (row % SEQ)) * 64 + (col & 63)) = pack8(acc[ai][bj][m][0], acc[ai][bj][m][1]); } }
        }
    }
};
struct EpiQU {
    static constexpr bool PERM = true, AFTER_DRAIN = false, KEEP_ACC = false;
    u16* Q; const float* ssqq;
    __device__ __forceinline__ void operator()(EPI_ARGS) const {
        const int row0 = u.pm * 256 + wr * 64 + fr, col0 = u.pn * 256 + 32 * wc + 8 * fq; float rr[8];
#pragma unroll
        for (int it = 0; it < 8; ++it) { const A4 s4 = *(const A4*)(ssqq + (size_t)(row0 + (it >> 2) * 128 + (it & 3) * 16) * 4); rr[it] = ((s4[0] + s4[1]) + (s4[2] + s4[3])); }
        asm volatile("" ::: "memory");
#pragma unroll
        for (int ai = 0; ai < 2; ++ai)
#pragma unroll
            for (int m = 0; m < 4; ++m) { const size_t row = row0 + ai * 128 + m * 16;
                const float r = 1.0f / sqrtf(rr[ai * 4 + m] * (1.f / 256.f) + EPS);
#pragma unroll
                for (int bj = 0; bj < 2; ++bj) *(v4u*)(Q + row * 768 + col0 + bj * 128) = pack8(acc[ai][bj][m][0] * r, acc[ai][bj][m][1] * r);
                asm volatile("" ::: "memory"); }
    }
};
struct EpiKVU {
    static constexpr bool PERM = true, AFTER_DRAIN = false, KEEP_ACC = false;
    u16 *K, *V; const float* ssqkv; const float* kg  ; const float* sskr; const float* KR;
    __device__ __forceinline__ void operator()(EPI_ARGS) const {
        const int row0 = u.pm * 256 + wr * 64 + fr; float rr8[8], sk8[8];
#pragma unroll
        for (int it = 0; it < 8; ++it) { const size_t row_ = row0 + (it >> 2) * 128 + (it & 3) * 16; const A4 s4 = *(const A4*)(ssqkv + row_ * 4); rr8[it] = ((s4[0] + s4[1]) + (s4[2] + s4[3])); sk8[it] = sskr[row_]; }
        const int head = 2 * u.pn + (wc & 1);
        if (wc < 2) {
            A4 g[2][2]; A4 rp[3][2];
#pragma unroll
            for (int bj = 0; bj < 2; ++bj) { g[bj][0] = *(const A4*)(kg + bj * 32 + 8 * fq); g[bj][1] = *(const A4*)(kg + bj * 32 + 8 * fq + 4); }
#define EK_LOAD(it) do { const size_t row_ = row0 + ((it) >> 2) * 128 + ((it) & 3) * 16; rp[(it) % 3][0] = *(const A4*)(KR + row_ * 32 + 8 * fq); rp[(it) % 3][1] = *(const A4*)(KR + row_ * 32 + 8 * fq + 4); } while (0)
            asm volatile("" ::: "memory");
            EK_LOAD(0); EK_LOAD(1); asm volatile("" ::: "memory");
#pragma unroll
            for (int it = 0; it < 8; ++it) { const int ai = it >> 2, m = it & 3; const size_t row = row0 + ai * 128 + m * 16;
                if (it + 2 < 8) EK_LOAD(it + 2);
                asm volatile("" ::: "memory");
                const float r = 1.0f / sqrtf(rr8[it] * (1.f / 128.f) + EPS);
                float vf[2][8]; float ss = 0.f;
#pragma unroll
                for (int bj = 0; bj < 2; ++bj) { const v4u w = pack8(acc[ai][bj][m][0] * r, acc[ai][bj][m][1] * r);
                    vf[bj][0] = bflo(w.x); vf[bj][1] = bfhi(w.x); vf[bj][2] = bflo(w.y); vf[bj][3] = bfhi(w.y); vf[bj][4] = bflo(w.z); vf[bj][5] = bfhi(w.z); vf[bj][6] = bflo(w.w); vf[bj][7] = bfhi(w.w);
#pragma unroll
                    for (int j = 0; j < 8; ++j) ss += vf[bj][j] * vf[bj][j]; }
                ss += bperm_f((fq * 16 + fr) ^ 16, ss); ss += bperm_f((fq * 16 + fr) ^ 32, ss);
                const float rs = 1.0f / sqrtf((ss + sk8[it]) * (1.f / 96.f) + EPS);
                const int bb = (int)(row / SEQ), pos = (int)(row % SEQ), tile = pos >> 6, rr = pos & 63; const size_t bht = (size_t)(bb * 8 + head) * 256 + tile;
#pragma unroll
                for (int bj = 0; bj < 2; ++bj) { A4 a, b;
#pragma unroll
                    for (int j = 0; j < 4; ++j) { a[j] = vf[bj][j] * rs * g[bj][0][j]; b[j] = vf[bj][4 + j] * rs * g[bj][1][j]; }
                    *(v4u*)(K + (bht * 12 + (4 * bj + fq)) * 512 + rr * 8) = pack8(a, b); }
                *(v4u*)(K + (bht * 12 + (8 + fq)) * 512 + rr * 8) = pack8(rp[it % 3][0] * rs, rp[it % 3][1] * rs);
                asm volatile("" ::: "memory"); }
#undef EK_LOAD
        } else {
            asm volatile("" ::: "memory");
#pragma unroll
            for (int ai = 0; ai < 2; ++ai)
#pragma unroll
                for (int m = 0; m < 4; ++m) { const size_t row = row0 + ai * 128 + m * 16;
                    const float r = 1.0f / sqrtf(rr8[ai * 4 + m] * (1.f / 128.f) + EPS);
                    const int bb = (int)(row / SEQ), pos = (int)(row % SEQ), tile = pos >> 6, rr = pos & 63; const size_t bht = (size_t)(bb * 8 + head) * 256 + tile;
#pragma unroll
                    for (int bj = 0; bj < 2; ++bj) *(v4u*)(V + ((bht * 8 + bj * 4 + (rr >> 4)) * 16 + (rr & 15)) * 32 + fq * 8) = pack8(acc[ai][bj][m][0] * r, acc[ai][bj][m][1] * r);
                    asm volatile("" ::: "memory"); }
        }
    }
};
struct EpiGate {
    static constexpr bool PERM = true, AFTER_DRAIN = false, KEEP_ACC = false;
    u16* GT;
    __device__ __forceinline__ void operator()(EPI_ARGS) const {
        const int row0 = u.pm * 256 + wr * 64 + fr, col0 = u.pn * 256 + 32 * wc + 8 * fq;
#pragma unroll
        for (int ai = 0; ai < 2; ++ai)
#pragma unroll
            for (int m = 0; m < 4; ++m) { const size_t row = row0 + ai * 128 + m * 16;
#pragma unroll
                for (int bj = 0; bj < 2; ++bj) { A4 a = acc[ai][bj][m][0], b = acc[ai][bj][m][1];
#pragma unroll
                    for (int i = 0; i < 4; ++i) { a[i] = fsigmoid(a[i]); b[i] = fsigmoid(b[i]); }
                    *(v4u*)(GT + row * 3072 + col0 + bj * 128) = pack8(a, b); } }
    }
};
template <int IDX> struct EpiMerge {
    static constexpr bool PERM = true, AFTER_DRAIN = false, KEEP_ACC = false;
    const u16* GT; u16* M; unsigned* dbg;
    __device__ __forceinline__ void operator()(EPI_ARGS) const {
        const int row0 = u.pm * 256 + wr * 64 + fr, col0 = u.pn * 256 + 32 * wc + 8 * fq;
        v4u g[3][2], p[3][2];
#define EM_LOAD(it) do { const size_t row_ = row0 + ((it) >> 2) * 128 + ((it) & 3) * 16; _Pragma("unroll") for (int bj = 0; bj < 2; ++bj) { g[(it) % 3][bj] = *(const v4u*)(GT + row_ * 3072 + IDX * 1024 + col0 + bj * 128); \
            if (IDX > 0) p[(it) % 3][bj] = *(const v4u*)(M + row_ * 1024 + col0 + bj * 128); } } while (0)
        EM_LOAD(0); EM_LOAD(1); asm volatile("" ::: "memory");
#pragma unroll
        for (int it = 0; it < 8; ++it) { const int ai = it >> 2, m = it & 3; const size_t row = row0 + ai * 128 + m * 16;
            if (it + 2 < 8) EM_LOAD(it + 2);
            asm volatile("" ::: "memory");
#pragma unroll
            for (int bj = 0; bj < 2; ++bj) { const v4u gg = g[it % 3][bj];
                A4 a = acc[ai][bj][m][0], b = acc[ai][bj][m][1];
                a[0] *= bflo(gg.x); a[1] *= bfhi(gg.x); a[2] *= bflo(gg.y); a[3] *= bfhi(gg.y); b[0] *= bflo(gg.z); b[1] *= bfhi(gg.z); b[2] *= bflo(gg.w); b[3] *= bfhi(gg.w);
                if ((MK_ABL >> IDX) & 1) { a = (A4){0.f, 0.f, 0.f, 0.f}; b = a; }
#if MK_CHECK
                for (int i_ = 0; i_ < 4; ++i_) { if (fabsf(a[i_]) > MK_UPD_BIG) atomicAdd(dbg + IDX, 1u); if (fabsf(b[i_]) > MK_UPD_BIG) atomicAdd(dbg + IDX, 1u); }
#endif
                if (IDX > 0) { const v4u pp = p[it % 3][bj]; a[0] += bflo(pp.x); a[1] += bfhi(pp.x); a[2] += bflo(pp.y); a[3] += bfhi(pp.y); b[0] += bflo(pp.z); b[1] += bfhi(pp.z); b[2] += bflo(pp.w); b[3] += bfhi(pp.w); }
                *(v4u*)(M + row * 1024 + col0 + bj * 128) = pack8(a, b); }
            asm volatile("" ::: "memory"); }
#undef EM_LOAD
    }
};
struct MergeOrder {
    pg8::StaticOrder S;
    __device__ __forceinline__ static int aoff(int br) { return br == 0 ? 0 : (br == 1 ? 1408 : 1280); }
    __device__ __forceinline__ bool next(int i, pg8::Unit& u) const { const int j = i / 3, br = i - 3 * j; if (!S.next(j, u)) return false; u.aux = br; u.pb = br * 4 + u.pn; u.pm += aoff(br); return true; }
    __device__ __forceinline__ void a_ready(const pg8::Unit&) const {}
    __device__ __forceinline__ void done(const pg8::Unit&) const {}
};
struct GateOrder {
    pg8::StaticOrder S;
    __device__ __forceinline__ bool next(int i, pg8::Unit& u) const { const int j = i / 3, br = i - 3 * j; if (!S.next(j, u)) return false; u.pn += 4 * br; u.pb = u.pn; u.aux = 0; return true; }
    __device__ __forceinline__ void a_ready(const pg8::Unit&) const {}
    __device__ __forceinline__ void done(const pg8::Unit&) const {}
};
struct EpiMergeRT {
    static constexpr bool PERM = true, AFTER_DRAIN = false, KEEP_ACC = false;
    const u16* GT; u16* M;
    __device__ __forceinline__ void operator()(EPI_ARGS) const {
        const int idx = u.aux; const int row0 = (u.pm - MergeOrder::aoff(idx)) * 256 + wr * 64 + fr, col0 = u.pn * 256 + 32 * wc + 8 * fq;
        v4u g[3][2], p[3][2];
#define EM_LOAD(it) do { const size_t row_ = row0 + ((it) >> 2) * 128 + ((it) & 3) * 16; _Pragma("unroll") for (int bj = 0; bj < 2; ++bj) { g[(it) % 3][bj] = *(const v4u*)(GT + row_ * 3072 + idx * 1024 + col0 + bj * 128); \
            if (idx > 0) p[(it) % 3][bj] = *(const v4u*)(M + row_ * 1024 + col0 + bj * 128); } } while (0)
        EM_LOAD(0); EM_LOAD(1); asm volatile("" ::: "memory");
#pragma unroll
        for (int it = 0; it < 8; ++it) { const int ai = it >> 2, m = it & 3; const size_t row = row0 + ai * 128 + m * 16;
            if (it + 2 < 8) EM_LOAD(it + 2);
            asm volatile("" ::: "memory");
#pragma unroll
            for (int bj = 0; bj < 2; ++bj) { const v4u gg = g[it % 3][bj];
                A4 a = acc[ai][bj][m][0], b = acc[ai][bj][m][1];
                a[0] *= bflo(gg.x); a[1] *= bfhi(gg.x); a[2] *= bflo(gg.y); a[3] *= bfhi(gg.y); b[0] *= bflo(gg.z); b[1] *= bfhi(gg.z); b[2] *= bflo(gg.w); b[3] *= bfhi(gg.w);
                if (idx > 0) { const v4u pp = p[it % 3][bj]; a[0] += bflo(pp.x); a[1] += bfhi(pp.x); a[2] += bflo(pp.y); a[3] += bfhi(pp.y); b[0] += bflo(pp.z); b[1] += bfhi(pp.z); b[2] += bflo(pp.w); b[3] += bfhi(pp.w); }
                *(v4u*)(M + row * 1024 + col0 + bj * 128) = pack8(a, b); }
            asm volatile("" ::: "memory"); }
#undef EM_LOAD
    }
};
struct EpiMergeAcc {
    static constexpr bool PERM = true, AFTER_DRAIN = false, KEEP_ACC = true;
    const u16* GT; u16* M;
    __device__ __forceinline__ void operator()(A4 (&acc)[2][2][4][2], const pg8::Unit& u, int wr, int wc, int fr, int fq) const {
        const int idx = u.aux; const int row0 = (u.pm - MergeOrder::aoff(idx)) * 256 + wr * 64 + fr, col0 = u.pn * 256 + 32 * wc + 8 * fq;
        const int nx = idx < 2 ? idx + 1 : idx;
        v4u g[3][2], h[3][2];
#define EA_LOAD(it) do { const size_t row_ = row0 + ((it) >> 2) * 128 + ((it) & 3) * 16; _Pragma("unroll") for (int bj = 0; bj < 2; ++bj) { g[(it) % 3][bj] = *(const v4u*)(GT + row_ * 3072 + idx * 1024 + col0 + bj * 128); \
            if (idx < 2) h[(it) % 3][bj] = *(const v4u*)(GT + row_ * 3072 + nx * 1024 + col0 + bj * 128); } } while (0)
#define EA_G(x) fmaxf((x), 6.103515625e-05f)
        EA_LOAD(0); EA_LOAD(1); asm volatile("" ::: "memory");
#pragma unroll
        for (int it = 0; it < 8; ++it) { const int ai = it >> 2, m = it & 3; const size_t row = row0 + ai * 128 + m * 16;
            if (it + 2 < 8) EA_LOAD(it + 2);
            asm volatile("" ::: "memory");
#pragma unroll
            for (int bj = 0; bj < 2; ++bj) { const v4u gg = g[it % 3][bj];
                float gv[8] = {EA_G(bflo(gg.x)), EA_G(bfhi(gg.x)), EA_G(bflo(gg.y)), EA_G(bfhi(gg.y)), EA_G(bflo(gg.z)), EA_G(bfhi(gg.z)), EA_G(bflo(gg.w)), EA_G(bfhi(gg.w))};
                if (idx < 2) { const v4u hh = h[it % 3][bj];
                    const float hv[8] = {EA_G(bflo(hh.x)), EA_G(bfhi(hh.x)), EA_G(bflo(hh.y)), EA_G(bfhi(hh.y)), EA_G(bflo(hh.z)), EA_G(bfhi(hh.z)), EA_G(bflo(hh.w)), EA_G(bfhi(hh.w))};
#pragma unroll
                    for (int j = 0; j < 8; ++j) gv[j] *= __builtin_amdgcn_rcpf(hv[j]); }
                A4 a = acc[ai][bj][m][0], b = acc[ai][bj][m][1];
                a[0] *= gv[0]; a[1] *= gv[1]; a[2] *= gv[2]; a[3] *= gv[3]; b[0] *= gv[4]; b[1] *= gv[5]; b[2] *= gv[6]; b[3] *= gv[7];
                if (idx < 2) { acc[ai][bj][m][0] = a; acc[ai][bj][m][1] = b; }
                else *(v4u*)(M + row * 1024 + col0 + bj * 128) = pack8(a, b); }
            asm volatile("" ::: "memory"); }
#undef EA_LOAD
#undef EA_G
    }
};
struct EpiOut {
    static constexpr bool PERM = false, AFTER_DRAIN = false, KEEP_ACC = false;
    const float* xin; float* xout; const float* ga  ; unsigned* dbg;
    __device__ __forceinline__ void operator()(EPI_ARGS) const {
        const int row0 = u.pm * 256 + wr * 64 + fr, col0 = u.pn * 256 + 32 * wc + 4 * fq, b = (u.pm * 256) / SEQ;
        A4 g[2][2];
#pragma unroll
        for (int bj = 0; bj < 2; ++bj)
#pragma unroll
            for (int n = 0; n < 2; ++n) g[bj][n] = *(const A4*)(ga + (size_t)b * 6144 + col0 + bj * 128 + n * 16);
        A4 xi[3][2][2];
#define EO_LOAD(it) do { const size_t off_ = (size_t)(row0 + ((it) >> 2) * 128 + ((it) & 3) * 16) * 1024 + col0; _Pragma("unroll") for (int bj = 0; bj < 2; ++bj) _Pragma("unroll") for (int n = 0; n < 2; ++n) \
            xi[(it) % 3][bj][n] = *(const A4*)(xin + off_ + bj * 128 + n * 16); } while (0)
        EO_LOAD(0); EO_LOAD(1); asm volatile("" ::: "memory");
#pragma unroll
        for (int it = 0; it < 8; ++it) { const int ai = it >> 2, m = it & 3; const size_t off = (size_t)(row0 + ai * 128 + m * 16) * 1024 + col0;
            if (it + 2 < 8) EO_LOAD(it + 2);
            asm volatile("" ::: "memory");
#pragma unroll
            for (int bj = 0; bj < 2; ++bj)
#pragma unroll
                for (int n = 0; n < 2; ++n) { *(A4*)(xout + off + bj * 128 + n * 16) = xi[it % 3][bj][n] + g[bj][n] * acc[ai][bj][m][n];
#if MK_CHECK
                    { const A4 up = g[bj][n] * acc[ai][bj][m][n]; for (int i_ = 0; i_ < 4; ++i_) if (fabsf(up[i_]) > MK_UPD_BIG) atomicAdd(dbg, 1u); }
#endif
                }
            asm volatile("" ::: "memory"); }
#undef EO_LOAD
    }
};
struct EpiGU {
    static constexpr bool PERM = true, AFTER_DRAIN = false, KEEP_ACC = false;
    u16* HID; const float* wrow;
    __device__ __forceinline__ void operator()(EPI_ARGS) const {
        const int row0 = u.pm * 256 + wr * 64 + fr, slot = u.pn >> 1, p = u.pn & 1, col0 = slot * 256 + p * 128 + 32 * wc + 8 * fq; float w8[8];
#pragma unroll
        for (int it = 0; it < 8; ++it) w8[it] = wrow[(size_t)(row0 + (it >> 2) * 128 + (it & 3) * 16) * 2 + slot];
        asm volatile("" ::: "memory");
#pragma unroll
        for (int ai = 0; ai < 2; ++ai)
#pragma unroll
            for (int m = 0; m < 4; ++m) { const size_t row = row0 + ai * 128 + m * 16; const float w = w8[ai * 4 + m];
#pragma unroll
                for (int n = 0; n < 2; ++n) { A4 hv;
#pragma unroll
                    for (int i = 0; i < 4; ++i) hv[i] = fsilu(acc[ai][0][m][n][i]) * acc[ai][1][m][n][i] * w;
                    v2u pw_; pw_.x = pk2(hv[0], hv[1]); pw_.y = pk2(hv[2], hv[3]); *(v2u*)(HID + row * 512 + col0 + 4 * n) = pw_;
                    asm volatile("" ::: "memory"); }
                asm volatile("" ::: "memory"); }
    }
};
struct EpiDown {
    static constexpr bool PERM = false, AFTER_DRAIN = false, KEEP_ACC = false;
    float* x; const int* tok; const float* gf  ; unsigned* dbg;
    __device__ __forceinline__ void operator()(EPI_ARGS) const {
        const int row0 = u.pm * 256 + wr * 64 + fr, col0 = u.pn * 256 + 32 * wc + 4 * fq;
        int tk[8];
#pragma unroll
        for (int it = 0; it < 8; ++it) tk[it] = tok[row0 + (it >> 2) * 128 + (it & 3) * 16];
        A4 g[2][2][2];
#pragma unroll
        for (int bb = 0; bb < 2; ++bb)
#pragma unroll
            for (int bj = 0; bj < 2; ++bj)
#pragma unroll
                for (int n = 0; n < 2; ++n) g[bb][bj][n] = *(const A4*)(gf + (size_t)bb * 6144 + col0 + bj * 128 + n * 16);
        A4 xi[3][2][2];
#define ED_LOAD(it) do { const int t_ = tk[it] < 0 ? 0 : tk[it]; const size_t off_ = (size_t)t_ * 1024 + col0; _Pragma("unroll") for (int bj = 0; bj < 2; ++bj) _Pragma("unroll") for (int n = 0; n < 2; ++n) \
            xi[(it) % 3][bj][n] = *(const A4*)(x + off_ + bj * 128 + n * 16); } while (0)
        asm volatile("" ::: "memory");
        ED_LOAD(0); ED_LOAD(1); asm volatile("" ::: "memory");
#pragma unroll
        for (int it = 0; it < 8; ++it) { const int ai = it >> 2, m = it & 3; const int t = tk[it];
            if (it + 2 < 8) ED_LOAD(it + 2);
            asm volatile("" ::: "memory");
            if (t >= 0) { const bool b1 = t >= SEQ; const size_t off = (size_t)t * 1024 + col0;
#pragma unroll
                for (int bj = 0; bj < 2; ++bj)
#pragma unroll
                    for (int n = 0; n < 2; ++n) { const A4 gg = b1 ? g[1][bj][n] : g[0][bj][n];
                        *(A4*)(x + off + bj * 128 + n * 16) = xi[it % 3][bj][n] + gg * acc[ai][bj][m][n];
#if MK_CHECK
                        { const A4 up = gg * acc[ai][bj][m][n]; for (int i_ = 0; i_ < 4; ++i_) if (fabsf(up[i_]) > MK_UPD_BIG) atomicAdd(dbg, 1u); }
#endif
                    } }
            asm volatile("" ::: "memory"); }
#undef ED_LOAD
    }
};
struct MoeOrder {
    const LAS int* ul;
    __device__ __forceinline__ bool next(int i, pg8::Unit& u) const {
        if (i >= __builtin_amdgcn_readfirstlane(ul[0])) return false;
        const int v = __builtin_amdgcn_readfirstlane(ul[1 + i]); u.pm = v & 255; u.pn = (v >> 8) & 3; u.pb = v >> 16; u.aux = 0; return true;
    }
    __device__ __forceinline__ void a_ready(const pg8::Unit&) const {}
    __device__ __forceinline__ void done(const pg8::Unit&) const {}
};

template <int ISK> __device__ __forceinline__ void l3post_pass(Frame& F, u16* Q, u16* K, const u16* C1, const float* gn) {
    const float* ct = (const float*)(F.ws + WS_ROPE); const float* st = ct + SEQ * 16;
    constexpr int CS = ISK ? 512 : 8; const int STEP = F.G * NTHR, I0 = F.bid * NTHR + F.tid;
#define L3_PTR(idx_, row_, p_) do { row_ = (idx_) & (NTOK - 1); const int h_ = (idx_) >> 15, pos_ = row_ % SEQ; \
        p_ = ISK ? K + (((size_t)((row_ / SEQ) * 8 + h_) * 256 + (pos_ >> 6)) * 12) * 512 + (pos_ & 63) * 8 : Q + (size_t)row_ * 768 + h_ * 96; } while (0)
#define L3_LOAD(W, idx_) do { int row_; u16* p_; L3_PTR(idx_, row_, p_); _Pragma("unroll") for (int c = 0; c < 8; ++c) W[c] = *(const v4u*)(p_ + c * CS); \
        _Pragma("unroll") for (int c = 0; c < 4; ++c) W[8 + c] = ISK ? *(const v4u*)(C1 + (size_t)row_ * 256 + 128 + c * 8) : *(const v4u*)(p_ + (8 + c) * CS); } while (0)
    v4u wn[12];
    if (I0 < NTOK * 8) L3_LOAD(wn, I0);
#define L3_UNPACK(f, W_) do { const v4u t_ = (W_); f[0] = bflo(t_.x); f[1] = bfhi(t_.x); f[2] = bflo(t_.y); f[3] = bfhi(t_.y); f[4] = bflo(t_.z); f[5] = bfhi(t_.z); f[6] = bflo(t_.w); f[7] = bfhi(t_.w); } while (0)
    for (int idx = I0; idx < NTOK * 8; idx += STEP) {
        int row; u16* p; L3_PTR(idx, row, p); const int pos = row % SEQ;
        v4u wc[12];
#pragma unroll
        for (int c = 0; c < 12; ++c) wc[c] = wn[c];
        { const int nx = idx + STEP < NTOK * 8 ? idx + STEP : idx; L3_LOAD(wn, nx); }
        float ss = 0.f;
#pragma unroll
        for (int c = 0; c < 12; ++c) { float f[8]; L3_UNPACK(f, wc[c]);
#pragma unroll
            for (int i = 0; i < 8; ++i) ss += f[i] * f[i]; }
        const float rs = (1.0f / sqrtf(ss * (1.f / 96.f) + EPS)) * (ISK ? 1.0f : 0.10206207261596577f * LOG2E);
#pragma unroll
        for (int c = 0; c < 8; ++c) { float f[8]; L3_UNPACK(f, wc[c]);
#pragma unroll
            for (int i = 0; i < 8; ++i) f[i] = f[i] * rs * gn[c * 8 + i];
            v4u w; w.x = pk2(f[0], f[1]); w.y = pk2(f[2], f[3]); w.z = pk2(f[4], f[5]); w.w = pk2(f[6], f[7]); *(v4u*)(p + c * CS) = w; }
#pragma unroll
        for (int c = 0; c < 2; ++c) { float f1[8], f2[8]; L3_UNPACK(f1, wc[8 + c]); L3_UNPACK(f2, wc[10 + c]);
#pragma unroll
            for (int i = 0; i < 8; ++i) { const float cs = ct[pos * 16 + c * 8 + i], sn = st[pos * 16 + c * 8 + i], x1 = f1[i] * rs * gn[64 + c * 8 + i], x2 = f2[i] * rs * gn[80 + c * 8 + i]; f1[i] = x1 * cs - x2 * sn; f2[i] = x1 * sn + x2 * cs; }
            v4u w; w.x = pk2(f1[0], f1[1]); w.y = pk2(f1[2], f1[3]); w.z = pk2(f1[4], f1[5]); w.w = pk2(f1[6], f1[7]); *(v4u*)(p + (8 + c) * CS) = w;
            w.x = pk2(f2[0], f2[1]); w.y = pk2(f2[2], f2[3]); w.z = pk2(f2[4], f2[5]); w.w = pk2(f2[6], f2[7]); *(v4u*)(p + (10 + c) * CS) = w; }
    }
#undef L3_UNPACK
#undef L3_PTR
#undef L3_LOAD
}
__device__ __forceinline__ void l3post_phase(Frame& F, u16* Q, u16* K, const u16* C1, const float* qg, const float* kg) {
    l3post_pass<1>(F, Q, K, C1, kg);
}

__device__ __forceinline__ void mla_naive_phase(Frame& F, const u16* Q, const u16* K, const u16* V, u16* YA) {
    LAS float* Ks = (LAS float*)F.lds;
    LAS float* Vs = (LAS float*)(F.lds + 64 * 96 * 4);
    for (int item = F.bid; item < 256; item += F.G) {
        const int bh = item >> 4, pr = item & 15, b = bh >> 3, h = bh & 7;
        for (int half = 0; half < 2; ++half) {
            const int qb = half ? 31 - pr : pr, qpos = qb * 512 + F.tid; const size_t qrow = (size_t)b * SEQ + qpos;
            float q[96], o[64];
#pragma unroll
            for (int c = 0; c < 12; ++c) { const v4u w = *(const v4u*)(Q + qrow * 768 + h * 96 + c * 8); q[c * 8 + 0] = bflo(w.x); q[c * 8 + 1] = bfhi(w.x); q[c * 8 + 2] = bflo(w.y); q[c * 8 + 3] = bfhi(w.y); q[c * 8 + 4] = bflo(w.z); q[c * 8 + 5] = bfhi(w.z); q[c * 8 + 6] = bflo(w.w); q[c * 8 + 7] = bfhi(w.w); }
#pragma unroll
            for (int d = 0; d < 64; ++d) o[d] = 0.f;
            float mx = -1e30f, l = 0.f;
            const int ntile = (qb + 1) * 8;
            for (int kt = 0; kt < ntile; ++kt) {
                __syncthreads();
                for (int e = F.tid; e < 64 * 12; e += NTHR) { const int kr = e / 12, c = e % 12; const v4u w = *(const v4u*)(K + ((size_t)b * SEQ + kt * 64 + kr) * 768 + h * 96 + c * 8);
                    LAS float* d = Ks + kr * 96 + c * 8; d[0] = bflo(w.x); d[1] = bfhi(w.x); d[2] = bflo(w.y); d[3] = bfhi(w.y); d[4] = bflo(w.z); d[5] = bfhi(w.z); d[6] = bflo(w.w); d[7] = bfhi(w.w); }
                { const int kr = F.tid >> 3, c = F.tid & 7; const v4u w = *(const v4u*)(V + ((size_t)b * SEQ + kt * 64 + kr) * 512 + h * 64 + c * 8);
                    LAS float* d = Vs + kr * 64 + c * 8; d[0] = bflo(w.x); d[1] = bfhi(w.x); d[2] = bflo(w.y); d[3] = bfhi(w.y); d[4] = bflo(w.z); d[5] = bfhi(w.z); d[6] = bflo(w.w); d[7] = bfhi(w.w); }
                __syncthreads();
                const int kbase = kt * 64;
                if (kbase <= qpos) {
                    for (int j = 0; j < 64; ++j) {
                        if (kbase + j <= qpos) {
                            float s = 0.f;
#pragma unroll
                            for (int d = 0; d < 96; ++d) s += q[d] * Ks[j * 96 + d];
                            if (s > mx) { const float a = exp2f(mx - s); l *= a;
#pragma unroll
                                for (int d = 0; d < 64; ++d) o[d] *= a;
                                mx = s; }
                            const float p = exp2f(s - mx); l += p;
#pragma unroll
                            for (int d = 0; d < 64; ++d) o[d] += p * Vs[j * 64 + d];
                        }
                    }
                }
            }
            const float il = 1.0f / l;
#pragma unroll
            for (int c = 0; c < 8; ++c) { v4u w; w.x = pk2(o[c * 8 + 0] * il, o[c * 8 + 1] * il); w.y = pk2(o[c * 8 + 2] * il, o[c * 8 + 3] * il); w.z = pk2(o[c * 8 + 4] * il, o[c * 8 + 5] * il); w.w = pk2(o[c * 8 + 6] * il, o[c * 8 + 7] * il);
                *(v4u*)(YA + qrow * 512 + h * 64 + c * 8) = w; }
        }
    }
    __syncthreads();
}

__device__ __forceinline__ void dil_naive_phase(Frame& F, const u16* DQ, const u16* DK, const u16* DV, u16* YC) {
    for (int idx = F.bid * NTHR + F.tid; idx < NTOK * 8; idx += F.G * NTHR) {
        const int h = idx & 7, row = idx >> 3, b = row / SEQ, pos = row % SEQ;
        float q[64], o[64];
#pragma unroll
        for (int c = 0; c < 8; ++c) { const v4u w = *(const v4u*)(DQ + (size_t)row * 512 + h * 64 + c * 8); q[c * 8 + 0] = bflo(w.x); q[c * 8 + 1] = bfhi(w.x); q[c * 8 + 2] = bflo(w.y); q[c * 8 + 3] = bfhi(w.y); q[c * 8 + 4] = bflo(w.z); q[c * 8 + 5] = bfhi(w.z); q[c * 8 + 6] = bflo(w.w); q[c * 8 + 7] = bfhi(w.w); }
#pragma unroll
        for (int d = 0; d < 64; ++d) o[d] = 0.f;
        float mx = -1e30f, l = 0.f;
        for (int pt = 0; pt < 3; ++pt) {
            const int r = pt == 0 ? 1 : (pt == 1 ? 4 : 16);
            for (int j = 0; j <= 128; ++j) {
                const int tk = pos - j * r; if (tk < 0) break;
                const size_t kro = ((size_t)b * SEQ + tk) * 512 + h * 64;
                float s = 0.f;
#pragma unroll
                for (int c = 0; c < 8; ++c) { const v4u w = *(const v4u*)(DK + kro + c * 8);
                    s += q[c * 8 + 0] * bflo(w.x) + q[c * 8 + 1] * bfhi(w.x) + q[c * 8 + 2] * bflo(w.y) + q[c * 8 + 3] * bfhi(w.y) + q[c * 8 + 4] * bflo(w.z) + q[c * 8 + 5] * bfhi(w.z) + q[c * 8 + 6] * bflo(w.w) + q[c * 8 + 7] * bfhi(w.w); }
                if (s > mx) { const float a = exp2f(mx - s); l *= a;
#pragma unroll
                    for (int d = 0; d < 64; ++d) o[d] *= a;
                    mx = s; }
                const float p = exp2f(s - mx); l += p;
#pragma unroll
                for (int c = 0; c < 8; ++c) { const v4u w = *(const v4u*)(DV + kro + c * 8);
                    o[c * 8 + 0] += p * bflo(w.x); o[c * 8 + 1] += p * bfhi(w.x); o[c * 8 + 2] += p * bflo(w.y); o[c * 8 + 3] += p * bfhi(w.y); o[c * 8 + 4] += p * bflo(w.z); o[c * 8 + 5] += p * bfhi(w.z); o[c * 8 + 6] += p * bflo(w.w); o[c * 8 + 7] += p * bfhi(w.w); }
            }
        }
        const float il = 1.0f / l;
#pragma unroll
        for (int c = 0; c < 8; ++c) { v4u w; w.x = pk2(o[c * 8 + 0] * il, o[c * 8 + 1] * il); w.y = pk2(o[c * 8 + 2] * il, o[c * 8 + 3] * il); w.z = pk2(o[c * 8 + 4] * il, o[c * 8 + 5] * il); w.w = pk2(o[c * 8 + 6] * il, o[c * 8 + 7] * il);
            *(v4u*)(YC + (size_t)row * 512 + h * 64 + c * 8) = w; }
    }
}

__device__ __forceinline__ void stage_conv(LAS float* dst  , const u16* MQK, size_t row0, int pos0, int ch0, const float* cw, const float* cb, float scale, int tid) {
    const int d = tid & 63, sg = tid >> 6, ch = ch0 + d;
    const float w0 = cw[ch], w1 = cw[512 + ch], w2 = cw[1024 + ch], w3 = cw[1536 + ch], bb = cb[ch];
    float x[11];
#pragma unroll
    for (int i = 0; i < 11; ++i) { const int s = sg * 8 - 3 + i; x[i] = (pos0 + s >= 0) ? bf1(MQK[(size_t)((long)row0 + s) * 512 + ch]) : 0.f; }
#pragma unroll
    for (int i = 0; i < 8; ++i) { const float y = bb + w0 * x[i] + w1 * x[i + 1] + w2 * x[i + 2] + w3 * x[i + 3]; dst[(sg * 8 + i) * 65 + d] = fsilu(y) * scale; }
}
__device__ __forceinline__ float wave_incl_scan_add(float v, int lane) {
#pragma unroll
    for (int o = 1; o < 64; o <<= 1) { const float t = bperm_f(lane >= o ? lane - o : lane, v); if (lane >= o) v += t; }
    return v;
}
__device__ __forceinline__ float wave_incl_scan_max(float v, int lane) {
#pragma unroll
    for (int o = 1; o < 64; o <<= 1) { const float t = bperm_f(lane >= o ? lane - o : lane, v); if (lane >= o) v = fmaxf(v, t); }
    return v;
}
__device__ __forceinline__ float wave_max(float v, int lane) {
#pragma unroll
    for (int o = 1; o < 64; o <<= 1) v = fmaxf(v, bperm_f(lane ^ o, v));
    return v;
}
__device__ __forceinline__ void mlstm_a_phase(Frame& F, const u16* MQK, const u16* MV, const float* IF, const float* cw, const float* cb, float* ST) {
    LAS float* Ks = (LAS float*)F.lds;
    LAS float* Vs = Ks + 64 * 65;
    LAS float* ws = Vs + 64 * 128;
    float* mloc = (float*)(F.ws + WS_MLS); float* bend = mloc + 2048; float* nst = (float*)(F.ws + WS_MLS + 65536);
    const int tid = F.tid;
    for (int u = F.bid; u < 2048; u += F.G) {
        const int bh = u >> 8, c = u & 255, b = bh >> 2, h = bh & 3, pos0 = c * 64; const size_t row0 = (size_t)b * SEQ + pos0;
        __syncthreads();
        stage_conv(Ks, MQK, row0, pos0, 256 + h * 64, cw, cb, 0.125f, tid);
        for (int e = tid; e < 64 * 16; e += NTHR) { const int s = e >> 4, cc = e & 15; const v4u w = *(const v4u*)(MV + (row0 + s) * 512 + h * 128 + cc * 8);
            LAS float* d = Vs + s * 128 + cc * 8; d[0] = bflo(w.x); d[1] = bfhi(w.x); d[2] = bflo(w.y); d[3] = bfhi(w.y); d[4] = bflo(w.z); d[5] = bfhi(w.z); d[6] = bflo(w.w); d[7] = bfhi(w.w); }
        if (tid < 64) { const float ig = IF[(row0 + tid) * 8 + h], lf = IF[(row0 + tid) * 8 + 4 + h];
            const float bs = wave_incl_scan_add(lf, tid), be = bperm_f(63, bs);
            const float wl = be - bs + ig, ml = wave_max(wl, tid);
            ws[tid] = __expf(wl - ml);
            if (tid == 0) { mloc[u] = ml; bend[u] = be; } }
        __syncthreads();
        const int d = tid >> 3, vg = tid & 7;
        float acc[16]; float an = 0.f;
#pragma unroll
        for (int i = 0; i < 16; ++i) acc[i] = 0.f;
        for (int s = 0; s < 64; ++s) { const float kw = Ks[s * 65 + d] * ws[s]; an += kw;
            const LAS f32x4* vp = (const LAS f32x4*)(Vs + s * 128 + vg * 16);
#pragma unroll
            for (int i = 0; i < 4; ++i) { const f32x4 vv = vp[i]; acc[4 * i + 0] += kw * vv.x; acc[4 * i + 1] += kw * vv.y; acc[4 * i + 2] += kw * vv.z; acc[4 * i + 3] += kw * vv.w; } }
        float* o = ST + (size_t)u * 8192 + d * 128 + vg * 16;
#pragma unroll
        for (int i = 0; i < 4; ++i) *(f32x4*)(o + 4 * i) = (f32x4){acc[4 * i], acc[4 * i + 1], acc[4 * i + 2], acc[4 * i + 3]};
        if (vg == 0) nst[(size_t)u * 64 + d] = an;
    }
    __syncthreads();
}
__device__ __forceinline__ void mlstm_b_phase(Frame& F, float* ST) {
    const float* mloc = (const float*)(F.ws + WS_MLS); const float* bend = mloc + 2048; float* mprev = (float*)(F.ws + WS_MLS) + 4096; float* nst = (float*)(F.ws + WS_MLS + 65536);
    LAS float* tm = (LAS float*)F.lds; LAS float* ta = tm + 2048; LAS float* tg = ta + 2048; LAS float* tb = tg + 2048; LAS float* tl = tb + 2048; LAS float* xa = tl + 2048; LAS float* xb = xa + 512;
    const int tid = F.tid;
    __syncthreads();
    for (int i = tid; i < 2048; i += NTHR) { tb[i] = bend[i]; tl[i] = mloc[i]; }
    __syncthreads();
    if (tid < 8) { float m = 0.f; for (int c = 0; c < 256; ++c) { const float be = tb[tid * 256 + c], ml = tl[tid * 256 + c]; tm[tid * 256 + c] = m; m = fmaxf(be + m, ml); } }
    __syncthreads();
    for (int i = tid; i < 2048; i += NTHR) { const float m = tm[i], be = tb[i], ml = tl[i], mn = fmaxf(be + m, ml); ta[i] = __expf(be + m - mn); tg[i] = __expf(ml - mn); if (F.bid == 0) mprev[i] = m; }
    __syncthreads();
    const int el = tid & 31, seg = tid >> 5;
    float vnx[16];
#define MB_ADDR(u_, p_, stride_) do { const int bh_ = (u_) / 258, e_ = ((u_) % 258) * 32 + el; \
        if (e_ < 8192) { p_ = ST + (size_t)bh_ * 256 * 8192 + e_; stride_ = 8192; } else { p_ = nst + (size_t)bh_ * 256 * 64 + (e_ - 8192); stride_ = 64; } p_ += (size_t)(16 * seg) * stride_; } while (0)
    if (F.bid < 8 * 258) { float* p0; int st0; MB_ADDR(F.bid, p0, st0);
#pragma unroll
        for (int i = 0; i < 16; ++i) vnx[i] = p0[(size_t)i * st0]; }
    for (int u = F.bid; u < 8 * 258; u += F.G) {
        const int bh = u / 258;
        float* p; int stride; MB_ADDR(u, p, stride);
        float val[16];
#pragma unroll
        for (int i = 0; i < 16; ++i) val[i] = vnx[i];
        { const int un = u + F.G < 8 * 258 ? u + F.G : u; float* pn; int stn; MB_ADDR(un, pn, stn);
#pragma unroll
          for (int i = 0; i < 16; ++i) vnx[i] = pn[(size_t)i * stn]; }
        const LAS float* ca = ta + bh * 256 + 16 * seg; const LAS float* cg = tg + bh * 256 + 16 * seg;
        float A = 1.f, B = 0.f;
#pragma unroll
        for (int i = 0; i < 16; ++i) { const float a = ca[i]; A *= a; B = a * B + cg[i] * val[i]; }
        xa[seg * 32 + el] = A; xb[seg * 32 + el] = B;
        __syncthreads();
        float C = 0.f;
        for (int s2 = 0; s2 < seg; ++s2) C = xa[s2 * 32 + el] * C + xb[s2 * 32 + el];
#pragma unroll
        for (int i = 0; i < 16; ++i) { p[(size_t)i * stride] = C; C = ca[i] * C + cg[i] * val[i]; }
        __syncthreads();
    }
#undef MB_ADDR
}
__device__ __forceinline__ void mlstm_c_phase(Frame& F, const u16* MQK, const u16* MV, const u16* MO, const float* IF, const float* cw, const float* cb, const float* hg, const float* ST, u16* YB) {
    LAS float* Qs = (LAS float*)F.lds;
    LAS float* Ks = Qs + 64 * 65;
    LAS float* Vs = Ks + 64 * 65;
    LAS float* Cs = Vs + 64 * 128;
    LAS float* Ss = Cs + 64 * 128;
    LAS float* bsv = Ss + 64 * 65;
    LAS float* gsv = bsv + 64;
    LAS float* mtv = gsv + 64;
    LAS float* dcv = mtv + 64;
    LAS float* npv = dcv + 64;
    const float* mprev = (const float*)(F.ws + WS_MLS) + 4096; const float* nst = (const float*)(F.ws + WS_MLS + 65536);
    const int tid = F.tid;
    for (int u = F.bid; u < 2048; u += F.G) {
        const int bh = u >> 8, c = u & 255, b = bh >> 2, h = bh & 3, pos0 = c * 64; const size_t row0 = (size_t)b * SEQ + pos0;
        __syncthreads();
        stage_conv(Qs, MQK, row0, pos0, h * 64, cw, cb, 1.0f, tid);
        stage_conv(Ks, MQK, row0, pos0, 256 + h * 64, cw, cb, 0.125f, tid);
        for (int e = tid; e < 64 * 16; e += NTHR) { const int s = e >> 4, cc = e & 15; const v4u w = *(const v4u*)(MV + (row0 + s) * 512 + h * 128 + cc * 8);
            LAS float* d = Vs + s * 128 + cc * 8; d[0] = bflo(w.x); d[1] = bfhi(w.x); d[2] = bflo(w.y); d[3] = bfhi(w.y); d[4] = bflo(w.z); d[5] = bfhi(w.z); d[6] = bflo(w.w); d[7] = bfhi(w.w); }
        for (int e = tid; e < 2048; e += NTHR) ((LAS f32x4*)Cs)[e] = ((const f32x4*)(ST + (size_t)u * 8192))[e];
        if (tid < 64) { const float ig = IF[(row0 + tid) * 8 + h], lf = IF[(row0 + tid) * 8 + 4 + h], m = mprev[u];
            const float bs = wave_incl_scan_add(lf, tid), gs = ig - bs, gmx = wave_incl_scan_max(gs, tid);
            const float inter = bs + m, mt = fmaxf(inter, bs + gmx);
            bsv[tid] = bs; gsv[tid] = gs; mtv[tid] = mt; dcv[tid] = __expf(inter - mt); npv[tid] = nst[(size_t)u * 64 + tid]; }
        __syncthreads();
        const int t = tid >> 3, g8 = tid & 7;
        float den;
        {   float sa[8]; float qn = 0.f;
#pragma unroll
            for (int i = 0; i < 8; ++i) sa[i] = 0.f;
            for (int d = 0; d < 64; ++d) { const float qv = Qs[t * 65 + d]; qn += qv * npv[d];
#pragma unroll
                for (int i = 0; i < 8; ++i) sa[i] += qv * Ks[(g8 * 8 + i) * 65 + d]; }
            const float bt = bsv[t], mt = mtv[t]; float rs = 0.f;
#pragma unroll
            for (int i = 0; i < 8; ++i) { const int s = g8 * 8 + i; const float sc = (s <= t) ? sa[i] * __expf(bt + gsv[s] - mt) : 0.f; Ss[t * 65 + s] = sc; rs += sc; }
            { const int ln_ = tid & 63; rs += bperm_f(ln_ ^ 1, rs); rs += bperm_f(ln_ ^ 2, rs); rs += bperm_f(ln_ ^ 4, rs); }
            den = dcv[t] * qn + rs;
        }
        __syncthreads();
        float acc[16];
#pragma unroll
        for (int i = 0; i < 16; ++i) acc[i] = 0.f;
        { const float dc = dcv[t];
            for (int d = 0; d < 64; ++d) { const float qd = Qs[t * 65 + d] * dc; const LAS f32x4* cp = (const LAS f32x4*)(Cs + d * 128 + g8 * 16);
#pragma unroll
                for (int i = 0; i < 4; ++i) { const f32x4 vv = cp[i]; acc[4 * i + 0] += qd * vv.x; acc[4 * i + 1] += qd * vv.y; acc[4 * i + 2] += qd * vv.z; acc[4 * i + 3] += qd * vv.w; } }
            for (int s = 0; s < 64; ++s) { const float p = Ss[t * 65 + s]; const LAS f32x4* vp = (const LAS f32x4*)(Vs + s * 128 + g8 * 16);
#pragma unroll
                for (int i = 0; i < 4; ++i) { const f32x4 vv = vp[i]; acc[4 * i + 0] += p * vv.x; acc[4 * i + 1] += p * vv.y; acc[4 * i + 2] += p * vv.z; acc[4 * i + 3] += p * vv.w; } } }
        const float inv = 1.0f / fmaxf(fabsf(den), __expf(-mtv[t]));
        float ss = 0.f;
#pragma unroll
        for (int i = 0; i < 16; ++i) { acc[i] *= inv; ss += acc[i] * acc[i]; }
        { const int ln_ = tid & 63; ss += bperm_f(ln_ ^ 1, ss); ss += bperm_f(ln_ ^ 2, ss); ss += bperm_f(ln_ ^ 4, ss); }
        const float rstd = 1.0f / sqrtf(ss * (1.f / 128.f) + EPS);
        const size_t ob = (row0 + t) * 512 + h * 128 + g8 * 16;
#pragma unroll
        for (int j = 0; j < 2; ++j) { const v4u mo = *(const v4u*)(MO + ob + j * 8); const float* gp = hg + h * 128 + g8 * 16 + j * 8;
            float y[8];
#pragma unroll
            for (int i = 0; i < 8; ++i) y[i] = acc[j * 8 + i] * rstd * gp[i];
            y[0] *= bflo(mo.x); y[1] *= bfhi(mo.x); y[2] *= bflo(mo.y); y[3] *= bfhi(mo.y); y[4] *= bflo(mo.z); y[5] *= bfhi(mo.z); y[6] *= bflo(mo.w); y[7] *= bfhi(mo.w);
            v4u w; w.x = pk2(y[0], y[1]); w.y = pk2(y[2], y[3]); w.z = pk2(y[4], y[5]); w.w = pk2(y[6], y[7]);
            *(v4u*)(YB + ob + j * 8) = w; }
    }
    __syncthreads();
}

__device__ __forceinline__ void router_bias(Frame& F, const float* modl, const float* wrg, const float* brg, const float* wre, const float* bre) {
    const int gw = F.bid * NWAVES + F.wave, lane = F.lane;
    if (gw < 40) { const int b = gw / 20, j = gw % 20; const float* sh = modl + (size_t)(b * 6 + 3) * 1024; float s = 0.f;
#pragma unroll
        for (int i = 0; i < 16; ++i) { const int c = lane + 64 * i; s += sh[c] * (j < 4 ? wrg[c * 4 + j] : wre[c * 16 + (j - 4)]); }
        s = wave_sum(s, lane);
        if (lane == 0) ((float*)(F.ws + WS_ROUT + 896 * 1024))[b * 32 + j] = s + (j < 4 ? brg[j] : bre[j - 4]); }
}
__device__ __forceinline__ void router_phase(Frame& F, const float* x, const float* gain, const float* modl, const float* wrg, const float* brg, const float* wre, const float* bre, u32* cnt) {
    typedef float f32x16r __attribute__((ext_vector_type(16)));
    const int lane = F.lane, wid = F.wave, tid = F.tid;
    int* cls_o = (int*)(F.ws + WS_ROUT); int* slot_o = cls_o + NTOK; float* wa_o = (float*)(slot_o + NTOK); float* wb_o = wa_o + NTOK; float* rstd_o = wb_o + NTOK;
    const float* biasr = (const float*)(F.ws + WS_ROUT + 896 * 1024);
    LAS float* Wt = (LAS float*)F.lds;
    LAS float* scr = (LAS float*)(F.lds + 20512 * 4) + wid * (32 * 33 + 32);
    for (int t4 = F.bid; t4 < NTOK / 128; t4 += F.G) {
        const int b = (t4 * 128) / SEQ;
        __syncthreads();
#pragma unroll
        for (int i = 0; i < 2; ++i) { const int c = tid + NTHR * i; const float f = gain[c] * (1.0f + modl[(size_t)(b * 6 + 4) * 1024 + c]);
            const f32x4 g4 = *(const f32x4*)(wrg + c * 4), e0 = *(const f32x4*)(wre + c * 16), e1 = *(const f32x4*)(wre + c * 16 + 4), e2 = *(const f32x4*)(wre + c * 16 + 8), e3 = *(const f32x4*)(wre + c * 16 + 12);
            LAS f32x4* wo = (LAS f32x4*)(Wt + c * 20); wo[0] = g4 * f; wo[1] = e0 * f; wo[2] = e1 * f; wo[3] = e2 * f; wo[4] = e3 * f; }
        if (tid < 16) Wt[20480 + tid] = 0.f;
        __syncthreads();
        const int tl = wid & 3, hf = wid >> 2;
        const int r0 = t4 * 128 + tl * 32, i = lane & 31, kk = lane >> 5;
        f32x16r acc; float zz = 0.f; asm volatile("" : "+v"(zz));
#pragma unroll
        for (int r = 0; r < 16; ++r) acc[r] = zz;
        float ssq = zz;
        { const float* xr = x + (size_t)(r0 + i) * DM + 4 * kk + 512 * hf; const LAS float* wp = Wt + (4 * kk + 512 * hf) * 20 + i;
            f32x4 xn[4];
#pragma unroll
            for (int j = 0; j < 4; ++j) xn[j] = *(const f32x4*)(xr + 8 * j);
#pragma unroll 1
            for (int m0 = 0; m0 < 64; m0 += 4) { f32x4 xc[4];
#pragma unroll
                for (int j = 0; j < 4; ++j) xc[j] = xn[j];
                { const int mn = m0 + 4 < 64 ? m0 + 4 : m0;
#pragma unroll
                  for (int j = 0; j < 4; ++j) xn[j] = *(const f32x4*)(xr + 8 * (mn + j)); }
#pragma unroll
                for (int j = 0; j < 4; ++j) { const f32x4 xa = xc[j]; const int m = m0 + j; ssq += (xa.x * xa.x + xa.y * xa.y) + (xa.z * xa.z + xa.w * xa.w);
                    acc = __builtin_amdgcn_mfma_f32_32x32x2f32(xa.x, wp[(8 * m + 0) * 20], acc, 0, 0, 0); acc = __builtin_amdgcn_mfma_f32_32x32x2f32(xa.y, wp[(8 * m + 1) * 20], acc, 0, 0, 0);
                    acc = __builtin_amdgcn_mfma_f32_32x32x2f32(xa.z, wp[(8 * m + 2) * 20], acc, 0, 0, 0); acc = __builtin_amdgcn_mfma_f32_32x32x2f32(xa.w, wp[(8 * m + 3) * 20], acc, 0, 0, 0); } } }
        ssq += bperm_f(lane ^ 32, ssq);
        if (hf == 1) {
#pragma unroll
            for (int r = 0; r < 16; ++r) scr[r * 64 + lane] = acc[r];
            scr[1024 + lane] = ssq; }
        __syncthreads();
        if (hf == 0) { const LAS float* ps = scr + 4 * (32 * 33 + 32);
#pragma unroll
            for (int r = 0; r < 16; ++r) acc[r] += ps[r * 64 + lane];
            ssq += ps[1024 + lane];
            const float rstd = 1.0f / sqrtf(ssq * (1.f / DM) + EPS);
#pragma unroll
            for (int r = 0; r < 16; ++r) scr[((r & 3) + 8 * (r >> 2) + 4 * kk) * 33 + i] = acc[r];
            if (kk == 0) scr[32 * 33 + i] = rstd;
            LDS_WAIT(); asm volatile("" ::: "memory");
            if (lane < 32) { const int m = r0 + lane; const float rs = scr[32 * 33 + lane]; const LAS float* L = scr + lane * 33; const float* bz = biasr + b * 32;
                const float g0 = L[0] * rs + bz[0], g1 = L[1] * rs + bz[1], g2 = L[2] * rs + bz[2], g3 = L[3] * rs + bz[3];
                int gi = 0; float gm = g0; if (g1 > gm) { gm = g1; gi = 1; } if (g2 > gm) { gm = g2; gi = 2; } if (g3 > gm) { gm = g3; gi = 3; }
                const float psel = 1.0f / (expf(g0 - gm) + expf(g1 - gm) + expf(g2 - gm) + expf(g3 - gm));
                const float e0 = L[4 + gi * 4 + 0] * rs + bz[4 + gi * 4 + 0], e1 = L[4 + gi * 4 + 1] * rs + bz[4 + gi * 4 + 1], e2 = L[4 + gi * 4 + 2] * rs + bz[4 + gi * 4 + 2], e3 = L[4 + gi * 4 + 3] * rs + bz[4 + gi * 4 + 3];
                int i1 = 0; float v1 = e0; if (e1 > v1) { v1 = e1; i1 = 1; } if (e2 > v1) { v1 = e2; i1 = 2; } if (e3 > v1) { v1 = e3; i1 = 3; }
                int i2 = -1; float v2 = 0.f;
                if (i1 != 0) { v2 = e0; i2 = 0; }
                if (i1 != 1 && (i2 < 0 || e1 > v2)) { v2 = e1; i2 = 1; }
                if (i1 != 2 && (i2 < 0 || e2 > v2)) { v2 = e2; i2 = 2; }
                if (i1 != 3 && (i2 < 0 || e3 > v2)) { v2 = e3; i2 = 3; }
                const float ex = expf(v2 - v1), w1 = psel / (1.0f + ex), w2 = psel * ex / (1.0f + ex);
                const int a = i1 < i2 ? i1 : i2, bb = i1 < i2 ? i2 : i1;
                const int pair = a == 0 ? bb - 1 : (a == 1 ? bb + 1 : 5);
                const int cls = gi * 6 + pair;
                const u32 sl = __hip_atomic_fetch_add(cnt + cls, 1u, __ATOMIC_RELAXED, __HIP_MEMORY_SCOPE_AGENT);
                cls_o[m] = cls; slot_o[m] = (int)sl; wa_o[m] = i1 < i2 ? w1 : w2; wb_o[m] = i1 < i2 ? w2 : w1; rstd_o[m] = rs; }
        }
    }
    __syncthreads();
}
__device__ __forceinline__ void moe_table(Frame& F, const u32* cnt) {
    LAS int* tab = (LAS int*)(F.lds + TAB_OFF);
    if (F.tid < 64) {
        const int c = F.tid; const int n = c < 24 ? (int)__hip_atomic_load(cnt + c, __ATOMIC_RELAXED, __HIP_MEMORY_SCOPE_AGENT) : 0; const int nt = (n + 255) >> 8;
        const int incl = (int)wave_incl_scan_add((float)nt, c), rt0 = incl - nt;
        if (c < 24) { tab[256 + c] = rt0 * 256; for (int i = 0; i < nt; ++i) tab[1 + rt0 + i] = c; }
        if (c == 23) tab[0] = incl; }
    __syncthreads();
}
__device__ __forceinline__ void moe_units(Frame& F, int mode) {
    LAS int* tab = (LAS int*)(F.lds + TAB_OFF); LAS int* ul = tab + 320;
    if (F.tid == 0) { const int nrt = tab[0]; int n = 0;
        const bool xo = (F.G & 7) == 0; const int x = F.bid & 7, j = F.bid >> 3, nj = F.G >> 3;
        for (int q = xo ? j : F.bid; ; q += xo ? nj : F.G) { int rt, pn;
            if (xo) { rt = (q >> 2) * 8 + x; pn = q & 3; if ((q >> 2) * 8 >= nrt) break; if (rt >= nrt) continue; } else { if (q >= nrt * 4) break; rt = q >> 2; pn = q & 3; }
            const int cls = tab[1 + rt]; int pb;
            if (mode == 0) { int ea, eb; cls_experts(cls, ea, eb); pb = ((pn >> 1) ? eb : ea) * 2 + (pn & 1); } else pb = cls * 4 + pn;
            ul[1 + n] = rt | (pn << 8) | (pb << 16); ++n; }
        ul[0] = n; }
    __syncthreads();
}
__device__ __forceinline__ void scatter_phase(Frame& F, const float* x, const float* gain, const float* modl, const u32* cnt, u16* HS) {
    moe_table(F, cnt);
    const LAS int* tab = (const LAS int*)(F.lds + TAB_OFF);
    const int gw = F.bid * NWAVES + F.wave, NGW = F.G * NWAVES, lane = F.lane;
    const int* cls_o = (const int*)(F.ws + WS_ROUT); const int* slot_o = cls_o + NTOK; const float* wa_o = (const float*)(slot_o + NTOK); const float* wb_o = wa_o + NTOK; const float* rstd_o = wb_o + NTOK;
    int* tok = (int*)(F.ws + WS_TOK); float* wrow = (float*)(F.ws + WS_TOK + 262144);
    for (int c = F.bid; c < 24; c += F.G) { const int n = (int)__hip_atomic_load(cnt + c, __ATOMIC_RELAXED, __HIP_MEMORY_SCOPE_AGENT); const int base = tab[256 + c], end = base + (((n + 255) >> 8) << 8);
        float z_ = 0.f; asm volatile("" : "+v"(z_));
        for (int r = base + n + F.tid; r < end; r += NTHR) { tok[r] = -1; wrow[2 * r] = z_; wrow[2 * r + 1] = z_; } }
    f32x4 xn[4]; int cln = 0, sln = 0; float rsn = 0.f, wan = 0.f, wbn = 0.f;
#define SC_LOAD(m_) do { const int mm_ = (m_) < NTOK ? (m_) : gw; const f32x4* xr_ = (const f32x4*)(x + (size_t)mm_ * DM) + lane; _Pragma("unroll") for (int j = 0; j < 4; ++j) xn[j] = xr_[64 * j]; \
        cln = cls_o[mm_]; sln = slot_o[mm_]; rsn = rstd_o[mm_]; wan = wa_o[mm_]; wbn = wb_o[mm_]; } while (0)
    SC_LOAD(gw);
    for (int m = gw; m < NTOK; m += NGW) {
        const int b = m / SEQ; const int pos = tab[256 + cln] + sln; const float rstd = rsn, wa = wan, wb = wbn;
        f32x4 xc[4];
#pragma unroll
        for (int j = 0; j < 4; ++j) xc[j] = xn[j];
        SC_LOAD(m + NGW);
        v2u* o8 = (v2u*)(HS + (size_t)pos * DM) + lane;
#pragma unroll
        for (int j = 0; j < 4; ++j) { const int c0 = 4 * lane + 256 * j; const f32x4 v = xc[j];
            const f32x4 g = *(const f32x4*)(gain + c0), sc = *(const f32x4*)(modl + (size_t)(b * 6 + 4) * 1024 + c0), sh = *(const f32x4*)(modl + (size_t)(b * 6 + 3) * 1024 + c0);
            const f32x4 y = (v * rstd) * g * (sc + 1.0f) + sh;
            v2u w; w.x = pk2(y.x, y.y); w.y = pk2(y.z, y.w); o8[64 * j] = w; }
        if (lane == 0) { tok[pos] = m; wrow[2 * pos] = wa; wrow[2 * pos + 1] = wb; }
    }
#undef SC_LOAD
}

typedef float f32x16 __attribute__((ext_vector_type(16)));
typedef short s16x8 __attribute__((ext_vector_type(8)));
typedef short s16x4 __attribute__((ext_vector_type(4)));
#if MK_F16
#define MFMA32(a, b, c) __builtin_amdgcn_mfma_f32_32x32x16_f16(__builtin_bit_cast(pg8::h16x8, (a)), __builtin_bit_cast(pg8::h16x8, (b)), (c), 0, 0, 0)
#else
#define MFMA32(a, b, c) __builtin_amdgcn_mfma_f32_32x32x16_bf16((a), (b), (c), 0, 0, 0)
#endif
__device__ __forceinline__ int crow(int r, int hi) { return (r & 3) + 8 * (r >> 2) + 4 * hi; }
__device__ __forceinline__ void gl_lds16(const void* g, LAS unsigned char* l) { __builtin_amdgcn_global_load_lds((const unsigned*)g, (LAS unsigned*)l, 16, 0, 0); }
__device__ __forceinline__ void glds_s(const void* sbase, unsigned voff_bytes, unsigned lds_dst) { unsigned keep_;
    asm volatile("s_mov_b32 %0, m0\n\ts_mov_b32 m0, %3\n\ts_nop 0\n\tglobal_load_lds_dwordx4 %1, %2\n\ts_mov_b32 m0, %0" : "=&s"(keep_) : "v"(voff_bytes), "s"(sbase), "s"(lds_dst) : "memory"); }
__device__ __forceinline__ const void* sgpr_ptr(const void* p) { const unsigned long long a = (unsigned long long)p; const unsigned lo = __builtin_amdgcn_readfirstlane((unsigned)a), hi = __builtin_amdgcn_readfirstlane((unsigned)(a >> 32)); return (const void*)(((unsigned long long)hi << 32) | lo); }
__device__ __forceinline__ s16x4 vtr16(const LAS unsigned char* p) { typedef short v4i16_t __attribute__((ext_vector_type(4))); return __builtin_bit_cast(s16x4, __builtin_amdgcn_ds_read_tr16_b64_v4i16((LAS v4i16_t*)p)); }
__device__ __forceinline__ float swapmax(float m) { auto rr = __builtin_amdgcn_permlane32_swap(__float_as_uint(m), __float_as_uint(m), false, false); return fmaxf(__uint_as_float(rr[0]), __uint_as_float(rr[1])); }
__device__ __forceinline__ float max16_mfma(const f32x16& a) { float m;
    asm("s_nop 11\n\tv_max3_f32 %0, %1, %2, %3\n\tv_max3_f32 %0, %0, %4, %5\n\tv_max3_f32 %0, %0, %6, %7\n\tv_max3_f32 %0, %0, %8, %9\n\tv_max3_f32 %0, %0, %10, %11\n\tv_max3_f32 %0, %0, %12, %13\n\tv_max3_f32 %0, %0, %14, %15\n\tv_max_f32 %0, %0, %16"
        : "=&v"(m) : "v"(a[0]), "v"(a[1]), "v"(a[2]), "v"(a[3]), "v"(a[4]), "v"(a[5]), "v"(a[6]), "v"(a[7]), "v"(a[8]), "v"(a[9]), "v"(a[10]), "v"(a[11]), "v"(a[12]), "v"(a[13]), "v"(a[14]), "v"(a[15]));
    return m; }
__device__ __forceinline__ float max16_seed(const f32x16& a, float seed) { float m;
    asm("v_max3_f32 %0, %17, %1, %2\n\tv_max3_f32 %0, %0, %3, %4\n\tv_max3_f32 %0, %0, %5, %6\n\tv_max3_f32 %0, %0, %7, %8\n\tv_max3_f32 %0, %0, %9, %10\n\tv_max3_f32 %0, %0, %11, %12\n\tv_max3_f32 %0, %0, %13, %14\n\tv_max3_f32 %0, %0, %15, %16"
        : "=&v"(m) : "v"(a[0]), "v"(a[1]), "v"(a[2]), "v"(a[3]), "v"(a[4]), "v"(a[5]), "v"(a[6]), "v"(a[7]), "v"(a[8]), "v"(a[9]), "v"(a[10]), "v"(a[11]), "v"(a[12]), "v"(a[13]), "v"(a[14]), "v"(a[15]), "v"(seed));
    return m; }
__device__ __forceinline__ float swapsum(float m) { auto rr = __builtin_amdgcn_permlane32_swap(__float_as_uint(m), __float_as_uint(m), false, false); return __uint_as_float(rr[0]) + __uint_as_float(rr[1]); }
constexpr int MA_KSLOT = 12288, MA_VSLOT = 8192, MA_V0 = 2 * MA_KSLOT, MA_WS = MA_V0 + 2 * MA_VSLOT, MA_OST = MA_WS + 2048, MA_BYTES = MA_OST + 8 * 4096;
__device__ __forceinline__ void mla_attn_unit(LAS unsigned char* lds, int tid, int wid, const u16* Q, const u16* K, const u16* V, u16* O, int b, int h, int qb) {
    const int lane = tid & 63, r32 = lane & 31, hi = lane >> 5;
    const size_t rowb = (size_t)b * SEQ; const int q0 = qb * 256;
    const u16* Qw = Q + (rowb + q0 + wid * 32) * 768 + h * 96;
    const u16* ksrc1 = K + (rowb + lane) * 768 + h * 96 + wid * 8;
    const u16* ksrc2 = K + (rowb + lane) * 768 + h * 96 + (8 + (wid & 3)) * 8;
    const u16* vsrc = V + (rowb + 16 * (wid & 3) + (lane >> 2)) * 512 + h * 64 + (wid >> 2) * 32 + (lane & 3) * 8;
    LAS float* wsf = (LAS float*)(lds + MA_WS) + wid * 64;
    const int NT = (q0 + 256) / 64;
#define MA_DMA(t, s) do { gl_lds16(ksrc1 + (size_t)(t) * 64 * 768, lds + (s) * MA_KSLOT + wid * 1024); gl_lds16(ksrc2 + (size_t)(t) * 64 * 768, lds + (s) * MA_KSLOT + (8 + (wid & 3)) * 1024); \
                           gl_lds16(vsrc + (size_t)(t) * 64 * 512, lds + MA_V0 + (s) * MA_VSLOT + wid * 1024); } while (0)
    MA_DMA(0, 0);
    s16x8 qr[6];
#pragma unroll
    for (int d0 = 0; d0 < 6; ++d0) qr[d0] = *(const s16x8*)(Qw + (size_t)r32 * 768 + d0 * 16 + hi * 8);
    float zf_ = 0.f; asm volatile("" : "+v"(zf_));
    float mref = zf_, l = zf_; f32x16 o0, o1;
#pragma unroll
    for (int r = 0; r < 16; ++r) { o0[r] = zf_; o1[r] = zf_; }
    const int qg = q0 + wid * 32 + r32;
    const int kfo = hi * 1024 + r32 * 16;
    const int vfo = ((lane >> 4) & 1) * 32 + (lane & 3) * 8 + (4 * hi + ((lane & 15) >> 2)) * 64;
    asm volatile("s_waitcnt vmcnt(0)" ::: "memory"); __builtin_amdgcn_s_barrier(); asm volatile("" ::: "memory");
    for (int t = 0; t < NT; ++t) {
        const int s = t & 1;
        if (t + 1 < NT) MA_DMA(t + 1, s ^ 1);
        const LAS unsigned char* kp = lds + s * MA_KSLOT + kfo; const LAS unsigned char* vp = lds + MA_V0 + s * MA_VSLOT + vfo;
        f32x16 p0, p1;
#pragma unroll
        for (int r = 0; r < 16; ++r) { p0[r] = zf_; p1[r] = zf_; }
#pragma unroll
        for (int d0 = 0; d0 < 6; ++d0) { const s16x8 a0 = *(const LAS s16x8*)(kp + d0 * 2048), a1 = *(const LAS s16x8*)(kp + d0 * 2048 + 512);
            p0 = MFMA32(a0, qr[d0], p0); p1 = MFMA32(a1, qr[d0], p1); }
        if (t >= NT - 4) { const int kb = t * 64 + 4 * hi;
#pragma unroll
            for (int r = 0; r < 16; ++r) { const int kv = kb + (r & 3) + 8 * (r >> 2); if (kv > qg) p0[r] = -INFINITY; if (kv + 32 > qg) p1[r] = -INFINITY; } }
        float rm = fmaxf(p0[0], p1[0]);
#pragma unroll
        for (int r = 1; r < 16; ++r) rm = fmaxf(rm, fmaxf(p0[r], p1[r]));
        rm = swapmax(rm);
        if (t == 0) mref = rm;
        else { const float dl = rm - mref;
            if (__any(dl > 8.f)) { const float d2 = fmaxf(dl, 0.f), f = __builtin_amdgcn_exp2f(-d2); mref += d2; l *= f; if (hi == 0) wsf[r32] = f;
                asm volatile("s_waitcnt lgkmcnt(0)" ::: "memory");
#pragma unroll
                for (int r = 0; r < 16; ++r) { const float fr = wsf[crow(r, hi)]; o0[r] *= fr; o1[r] *= fr; } } }
        float sacc = zf_;
#pragma unroll
        for (int r = 0; r < 16; ++r) { p0[r] = __builtin_amdgcn_exp2f(p0[r] - mref); p1[r] = __builtin_amdgcn_exp2f(p1[r] - mref); sacc += p0[r] + p1[r]; }
        l += sacc;
        v4u pw[4];
        pw[0] = (v4u){pk2(p0[0], p0[1]), pk2(p0[2], p0[3]), pk2(p0[4], p0[5]), pk2(p0[6], p0[7])};
        pw[1] = (v4u){pk2(p0[8], p0[9]), pk2(p0[10], p0[11]), pk2(p0[12], p0[13]), pk2(p0[14], p0[15])};
        pw[2] = (v4u){pk2(p1[0], p1[1]), pk2(p1[2], p1[3]), pk2(p1[4], p1[5]), pk2(p1[6], p1[7])};
        pw[3] = (v4u){pk2(p1[8], p1[9]), pk2(p1[10], p1[11]), pk2(p1[12], p1[13]), pk2(p1[14], p1[15])};
#pragma unroll
        for (int ks = 0; ks < 4; ++ks) { const s16x8 pa = __builtin_bit_cast(s16x8, pw[ks]);
            { const s16x4 lo = vtr16(vp + ks * 1024), hh = vtr16(vp + ks * 1024 + 512); const s16x8 vf = {lo[0], lo[1], lo[2], lo[3], hh[0], hh[1], hh[2], hh[3]}; o0 = MFMA32(pa, vf, o0); }
            { const s16x4 lo = vtr16(vp + 4096 + ks * 1024), hh = vtr16(vp + 4096 + ks * 1024 + 512); const s16x8 vf = {lo[0], lo[1], lo[2], lo[3], hh[0], hh[1], hh[2], hh[3]}; o1 = MFMA32(pa, vf, o1); } }
        asm volatile("s_waitcnt vmcnt(0) lgkmcnt(0)" ::: "memory"); __builtin_amdgcn_s_barrier(); asm volatile("" ::: "memory");
    }
#undef MA_DMA
    l = swapsum(l);
    if (hi == 0) wsf[32 + r32] = l;
    asm volatile("s_waitcnt lgkmcnt(0)" ::: "memory");
    LAS u16* stg = (LAS u16*)(lds + MA_OST) + wid * 2048;
#pragma unroll
    for (int r = 0; r < 16; ++r) { const int orow = crow(r, hi); const float rl = 1.0f / wsf[32 + orow];
        const u32 w = pk2(o0[r] * rl, o1[r] * rl); stg[orow * 64 + r32] = (u16)(w & 0xffffu); stg[orow * 64 + 32 + r32] = (u16)(w >> 16); }
    asm volatile("s_waitcnt lgkmcnt(0)" ::: "memory");
    u16* Ow = O + (rowb + q0 + wid * 32) * 512 + h * 64;
#pragma unroll
    for (int i = 0; i < 4; ++i) { const int row = i * 8 + (lane >> 3), ch = lane & 7; const v4u v = *(const LAS v4u*)(stg + row * 64 + ch * 8); *(v4u*)(Ow + (size_t)row * 512 + ch * 8) = v; }
    asm volatile("s_waitcnt lgkmcnt(0)" ::: "memory"); __builtin_amdgcn_s_barrier(); asm volatile("" ::: "memory");
}
#define SGB(mask, n) __builtin_amdgcn_sched_group_barrier((mask), (n), 0)
__device__ __forceinline__ void mla_attn_unit2(LAS unsigned char* lds, int tid, int wid, const u16* Q, const u16* K, const u16* V, u16* O, int b, int h, int qb, const float* qgain, const float* ropec) {
    const int lane = tid & 63, r32 = lane & 31, hi = lane >> 5;
    const size_t rowb = (size_t)b * SEQ; const int q0 = qb * 256;
    const void* kbase = sgpr_ptr(K + (size_t)(b * 8 + h) * 256 * 6144); const void* vbase = sgpr_ptr(V + (size_t)(b * 8 + h) * 256 * 4096);
    const unsigned ldsb = (unsigned)__builtin_amdgcn_readfirstlane((unsigned)(size_t)lds + (unsigned)wid * 1024u);
    const unsigned ko1 = (unsigned)(wid * 1024 + lane * 16), ko2 = (unsigned)((8 + (wid & 3)) * 1024 + lane * 16), vo = ko1;
    constexpr int R_V0 = 4 * MA_KSLOT, R_WS = R_V0 + 3 * MA_VSLOT, R_OST = R_WS + 2048;
    LAS float* wsf = (LAS float*)(lds + R_WS) + wid * 64;
    const int NT = (q0 + 256) / 64;
#define MB_DMAK(t, s) do { glds_s(kbase, ko1 + (unsigned)(t) * 12288u, ldsb + (unsigned)((s) * MA_KSLOT)); glds_s(kbase, ko2 + (unsigned)(t) * 12288u, ldsb + (unsigned)((s) * MA_KSLOT + 8192 - (wid >> 2) * 4096)); } while (0)
#define MB_DMAV(t, s) glds_s(vbase, vo + (unsigned)(t) * 8192u, ldsb + (unsigned)(R_V0 + (s) * MA_VSLOT))
    MB_DMAK(0, 0); MB_DMAV(0, 0); MB_DMAK(1, 1); MB_DMAK(2, 2);
    s16x8 qr[6];
    { const u16* qp = Q + rowb * 768 + h * 96; const unsigned qo = (unsigned)((q0 + wid * 32 + r32) * 768 + hi * 8);
#pragma unroll
      for (int d0 = 0; d0 < 6; ++d0) qr[d0] = *(const s16x8*)(qp + (qo + d0 * 16)); }
    { float qf[6][8]; float ss = 0.f;
#pragma unroll
      for (int d0 = 0; d0 < 6; ++d0) { const v4u w = __builtin_bit_cast(v4u, qr[d0]); qf[d0][0] = bflo(w.x); qf[d0][1] = bfhi(w.x); qf[d0][2] = bflo(w.y); qf[d0][3] = bfhi(w.y); qf[d0][4] = bflo(w.z); qf[d0][5] = bfhi(w.z); qf[d0][6] = bflo(w.w); qf[d0][7] = bfhi(w.w);
#pragma unroll
          for (int j = 0; j < 8; ++j) ss += qf[d0][j] * qf[d0][j]; }
      ss = swapsum(ss);
      const float rs = (1.0f / sqrtf(ss * (1.f / 96.f) + EPS)) * (0.10206207261596577f * LOG2E);
#pragma unroll
      for (int d0 = 0; d0 < 6; ++d0) { const f32x4 g0 = *(const f32x4*)(qgain + d0 * 16 + hi * 8), g1 = *(const f32x4*)(qgain + d0 * 16 + hi * 8 + 4);
          qf[d0][0] = qf[d0][0] * rs * g0.x; qf[d0][1] = qf[d0][1] * rs * g0.y; qf[d0][2] = qf[d0][2] * rs * g0.z; qf[d0][3] = qf[d0][3] * rs * g0.w; qf[d0][4] = qf[d0][4] * rs * g1.x; qf[d0][5] = qf[d0][5] * rs * g1.y; qf[d0][6] = qf[d0][6] * rs * g1.z; qf[d0][7] = qf[d0][7] * rs * g1.w; }
      { const int pos = q0 + wid * 32 + r32; const float* cp = ropec + pos * 16 + hi * 8; const float* sp = cp + SEQ * 16;
        const f32x4 c0 = *(const f32x4*)cp, c1 = *(const f32x4*)(cp + 4), s0 = *(const f32x4*)sp, s1 = *(const f32x4*)(sp + 4);
        const float cs[8] = {c0.x, c0.y, c0.z, c0.w, c1.x, c1.y, c1.z, c1.w}, sn[8] = {s0.x, s0.y, s0.z, s0.w, s1.x, s1.y, s1.z, s1.w};
#pragma unroll
        for (int j = 0; j < 8; ++j) { const float x1 = qf[4][j], x2 = qf[5][j]; qf[4][j] = x1 * cs[j] - x2 * sn[j]; qf[5][j] = x1 * sn[j] + x2 * cs[j]; } }
#pragma unroll
      for (int d0 = 0; d0 < 6; ++d0) { v4u w; w.x = pk2(qf[d0][0], qf[d0][1]); w.y = pk2(qf[d0][2], qf[d0][3]); w.z = pk2(qf[d0][4], qf[d0][5]); w.w = pk2(qf[d0][6], qf[d0][7]); qr[d0] = __builtin_bit_cast(s16x8, w); } }
    float zf_ = 0.f; asm volatile("" : "+v"(zf_));
    float mref = zf_, l = zf_; f32x16 o0, o1, negm; f32x4 pe[8];
#pragma unroll
    for (int r = 0; r < 16; ++r) { o0[r] = zf_; o1[r] = zf_; }
    const int qg = q0 + wid * 32 + r32;
    const int kfo = hi * 1024 + r32 * 16, vfo = ((lane >> 4) & 1) * 32 + (lane & 3) * 8 + (4 * hi + ((lane & 15) >> 2)) * 64;
    asm volatile("s_waitcnt vmcnt(4)" ::: "memory"); __builtin_amdgcn_s_barrier(); asm volatile("" ::: "memory");
    MB_DMAK(3, 3); MB_DMAV(1, 1);
    { const LAS unsigned char* kp = lds + kfo; f32x16 p0, p1;
#pragma unroll
      for (int r = 0; r < 16; ++r) { p0[r] = zf_; p1[r] = zf_; }
#pragma unroll
      for (int d0 = 0; d0 < 6; ++d0) { const s16x8 a0 = *(const LAS s16x8*)(kp + d0 * 2048), a1 = *(const LAS s16x8*)(kp + d0 * 2048 + 512); p0 = MFMA32(a0, qr[d0], p0); p1 = MFMA32(a1, qr[d0], p1); }
      if (NT == 4) { int kb = 4 * hi; asm volatile("" : "+v"(kb));
#pragma unroll
          for (int r = 0; r < 16; ++r) { const int kv = kb + (r & 3) + 8 * (r >> 2); if (kv > qg) p0[r] = -INFINITY; if (kv + 32 > qg) p1[r] = -INFINITY; } }
      float rm = fmaxf(p0[0], p1[0]);
#pragma unroll
      for (int r = 1; r < 16; ++r) rm = fmaxf(rm, fmaxf(p0[r], p1[r]));
      mref = swapmax(rm);
#pragma unroll
      for (int r = 0; r < 16; ++r) negm[r] = -mref;
#pragma unroll
      for (int r = 0; r < 16; ++r) { pe[r >> 2][r & 3] = __builtin_amdgcn_exp2f(p0[r] - mref); pe[4 + (r >> 2)][r & 3] = __builtin_amdgcn_exp2f(p1[r] - mref); } }
    asm volatile("s_waitcnt vmcnt(3) lgkmcnt(0)" ::: "memory"); __builtin_amdgcn_s_barrier(); asm volatile("" ::: "memory");
#define MB_KF(g) (*(const LAS s16x8*)(kp + ((g) >> 1) * 2048 + ((g) & 1) * 512))
#define MB_KFN(g) (*(const LAS s16x8*)(kpn + ((g) >> 1) * 2048 + ((g) & 1) * 512))
#define MB_VL(k) vtr16(vp + ((k) >> 2) * 4096 + ((k) & 3) * 1024)
#define MB_VH(k) vtr16(vp + ((k) >> 2) * 4096 + ((k) & 3) * 1024 + 512)
    s16x8 kq0, kq1, kq2, kq3; s16x4 vl0, vh0, vl1, vh1, vl2, vh2, vl3, vh3;
    { const LAS unsigned char* kpn = lds + 1 * MA_KSLOT + kfo; kq0 = MB_KFN(0); kq1 = MB_KFN(1); kq2 = MB_KFN(2); }
    if (wid >= 4) __builtin_amdgcn_s_setprio(1);
#pragma unroll 1
    for (int t = 1; t < NT; ++t) {
        const int s = t & 3, sp = (t + 2) % 3, sn = (t + 1) % 3;
        if (t + 3 < NT) MB_DMAK(t + 3, (t + 3) & 3);
        if (t + 1 < NT) MB_DMAV(t + 1, sn);
        const LAS unsigned char* kp = lds + s * MA_KSLOT + kfo; const LAS unsigned char* vp = lds + R_V0 + sp * MA_VSLOT + vfo;
        const LAS unsigned char* kpn = lds + ((t + 1) & 3) * MA_KSLOT + kfo;
        f32x16 c0, c1; float sacc = zf_; v4u pw[4];
#define MB_STEPA(g, KC, KN, CC, FIRST, FILL) do { if ((g) + 3 < 12) KN = MB_KF((g) + 3); CC = MFMA32(KC, qr[(g) >> 1], FIRST); FILL; __builtin_amdgcn_sched_barrier(0); } while (0)
#define MB_SUM4(i) (sacc += (pe[i][0] + pe[i][1]) + (pe[i][2] + pe[i][3])); asm volatile("" : "+v"(sacc))
#define MB_PK(k) pw[k] = (v4u){pk2(pe[2 * (k)][0], pe[2 * (k)][1]), pk2(pe[2 * (k)][2], pe[2 * (k)][3]), pk2(pe[2 * (k) + 1][0], pe[2 * (k) + 1][1]), pk2(pe[2 * (k) + 1][2], pe[2 * (k) + 1][3])}; asm volatile("" : "+v"(pw[k]))
        MB_STEPA(0, kq0, kq3, c0, negm, MB_SUM4(0));
        MB_STEPA(1, kq1, kq0, c1, negm, MB_SUM4(1));
        MB_STEPA(2, kq2, kq1, c0, c0, MB_SUM4(2));
        MB_STEPA(3, kq3, kq2, c1, c1, MB_SUM4(3));
        MB_STEPA(4, kq0, kq3, c0, c0, MB_SUM4(4));
        MB_STEPA(5, kq1, kq0, c1, c1, MB_SUM4(5));
        MB_STEPA(6, kq2, kq1, c0, c0, MB_SUM4(6));
        MB_STEPA(7, kq3, kq2, c1, c1, MB_SUM4(7));
        MB_STEPA(8, kq0, kq3, c0, c0, MB_PK(0)); MB_STEPA(9, kq1, kq0, c1, c1, (vl0 = MB_VL(0), vh0 = MB_VH(0)); MB_PK(1)); MB_STEPA(10, kq2, kq1, c0, c0, (vl1 = MB_VL(1), vh1 = MB_VH(1)); MB_PK(2)); MB_STEPA(11, kq3, kq2, c1, c1, (vl2 = MB_VL(2), vh2 = MB_VH(2)); MB_PK(3));
#undef MB_PK
#undef MB_STEPA
#undef MB_SUM4
        l += sacc;
        if (t >= NT - 4) { int kb = t * 64 + 4 * hi; asm volatile("" : "+v"(kb));
#pragma unroll
            for (int r = 0; r < 16; ++r) { const int kv = kb + (r & 3) + 8 * (r >> 2); if (kv > qg) c0[r] = -INFINITY; if (kv + 32 > qg) c1[r] = -INFINITY; } }
        const float rm = max16_seed(c0, max16_mfma(c1));
        const float dl = swapmax(rm); const bool resc = __any(dl > 8.f); float fsc = 1.f;
        if (resc) { const float d2 = fmaxf(dl, 0.f); fsc = __builtin_amdgcn_exp2f(-d2); mref += d2; l *= fsc;
#pragma unroll
            for (int r = 0; r < 16; ++r) { c0[r] -= d2; c1[r] -= d2; negm[r] = -mref; } }
        __builtin_amdgcn_sched_barrier(0);
#define MB_STEPB(k, VLC, VHC, VLN, VHN, OO, FILL) do { if ((k) + 3 < 8) { VLN = MB_VL((k) + 3); VHN = MB_VH((k) + 3); } \
            { const s16x8 vf = {VLC[0], VLC[1], VLC[2], VLC[3], VHC[0], VHC[1], VHC[2], VHC[3]}; OO = MFMA32(__builtin_bit_cast(s16x8, pw[(k) & 3]), vf, OO); } FILL; __builtin_amdgcn_sched_barrier(0); } while (0)
#define MB_EXP4(i, C, B) pe[i] = (f32x4){__builtin_amdgcn_exp2f(C[B]), __builtin_amdgcn_exp2f(C[B + 1]), __builtin_amdgcn_exp2f(C[B + 2]), __builtin_amdgcn_exp2f(C[B + 3])}; asm volatile("" : "+v"(pe[i]))
        MB_STEPB(0, vl0, vh0, vl3, vh3, o0, MB_EXP4(0, c0, 0)); MB_STEPB(1, vl1, vh1, vl0, vh0, o0, MB_EXP4(1, c0, 4)); MB_STEPB(2, vl2, vh2, vl1, vh1, o0, MB_EXP4(2, c0, 8)); MB_STEPB(3, vl3, vh3, vl2, vh2, o0, MB_EXP4(3, c0, 12));
        MB_STEPB(4, vl0, vh0, vl3, vh3, o1, MB_EXP4(4, c1, 0)); MB_STEPB(5, vl1, vh1, vl0, vh0, o1, kq0 = MB_KFN(0); MB_EXP4(5, c1, 4)); MB_STEPB(6, vl2, vh2, vl1, vh1, o1, kq1 = MB_KFN(1); MB_EXP4(6, c1, 8)); MB_STEPB(7, vl3, vh3, vl2, vh2, o1, kq2 = MB_KFN(2); MB_EXP4(7, c1, 12));
#undef MB_STEPB
#undef MB_EXP4
        if (resc) { if (hi == 0) wsf[r32] = fsc; asm volatile("s_waitcnt lgkmcnt(0)" ::: "memory"); int hi_ = hi; asm volatile("" : "+v"(hi_));
#pragma unroll
            for (int r = 0; r < 16; ++r) { const float fr = wsf[crow(r, hi_)]; o0[r] *= fr; o1[r] *= fr; } }
        if (t + 3 < NT) asm volatile("s_waitcnt vmcnt(3) lgkmcnt(0)" ::: "memory"); else if (t + 1 < NT) asm volatile("s_waitcnt vmcnt(1) lgkmcnt(0)" ::: "memory"); else asm volatile("s_waitcnt vmcnt(0) lgkmcnt(0)" ::: "memory");
        __builtin_amdgcn_s_barrier(); asm volatile("" ::: "memory");
    }
#undef MB_KF
#undef MB_KFN
#undef MB_VL
#undef MB_VH
    __builtin_amdgcn_s_setprio(0);
    { float sacc = zf_; v4u pw[4];
#pragma unroll
      for (int i = 0; i < 8; ++i) sacc += (pe[i][0] + pe[i][1]) + (pe[i][2] + pe[i][3]);
      l += sacc;
#pragma unroll
      for (int k = 0; k < 4; ++k) pw[k] = (v4u){pk2(pe[2 * k][0], pe[2 * k][1]), pk2(pe[2 * k][2], pe[2 * k][3]), pk2(pe[2 * k + 1][0], pe[2 * k + 1][1]), pk2(pe[2 * k + 1][2], pe[2 * k + 1][3])};
      const LAS unsigned char* vp = lds + R_V0 + ((NT - 1) % 3) * MA_VSLOT + vfo;
#pragma unroll
      for (int ks = 0; ks < 4; ++ks) { const s16x8 pa = __builtin_bit_cast(s16x8, pw[ks]);
          { const s16x4 lo = vtr16(vp + ks * 1024), hh = vtr16(vp + ks * 1024 + 512); const s16x8 vf = {lo[0], lo[1], lo[2], lo[3], hh[0], hh[1], hh[2], hh[3]}; o0 = MFMA32(pa, vf, o0); }
          { const s16x4 lo = vtr16(vp + 4096 + ks * 1024), hh = vtr16(vp + 4096 + ks * 1024 + 512); const s16x8 vf = {lo[0], lo[1], lo[2], lo[3], hh[0], hh[1], hh[2], hh[3]}; o1 = MFMA32(pa, vf, o1); } } }
#undef MB_DMAK
#undef MB_DMAV
    l = swapsum(l);
    if (hi == 0) wsf[32 + r32] = l;
    asm volatile("s_waitcnt lgkmcnt(0)" ::: "memory");
    LAS u16* stg = (LAS u16*)(lds + R_OST) + wid * 2048;
    int hi_e = hi; asm volatile("" : "+v"(hi_e));
#pragma unroll
    for (int r = 0; r < 16; ++r) { const int orow = crow(r, hi_e); const float rl = 1.0f / wsf[32 + orow];
        const u32 w = pk2(o0[r] * rl, o1[r] * rl); stg[orow * 64 + r32] = (u16)(w & 0xffffu); stg[orow * 64 + 32 + r32] = (u16)(w >> 16); }
    asm volatile("s_waitcnt lgkmcnt(0)" ::: "memory");
    u16* Ow = O + (rowb + q0 + wid * 32) * 512 + h * 64;
#pragma unroll
    for (int i = 0; i < 4; ++i) { const int row = i * 8 + (lane >> 3), ch = lane & 7; const v4u v = *(const LAS v4u*)(stg + row * 64 + ch * 8); *(v4u*)(Ow + (size_t)row * 512 + ch * 8) = v; }
    asm volatile("s_waitcnt lgkmcnt(0)" ::: "memory"); __builtin_amdgcn_s_barrier(); asm volatile("" ::: "memory");
}
__device__ __forceinline__ void mla_attn_phase(Frame& F, const u16* Q, const u16* K, const u16* V, u16* YA, const float* qgain) {
    const float* ropec = (const float*)(F.ws + WS_ROPE);
    for (int v = F.bid; v < 256; v += F.G) { const int bh = v & 15, s = v >> 4, b = bh >> 3, h = bh & 7;
#pragma unroll 1
        for (int i = 0; i < 4; ++i) { const int qb = i == 0 ? 63 - s : (i == 1 ? 32 + s : (i == 2 ? 31 - s : s));

#if MK_MLA_V2
            mla_attn_unit2(F.lds, F.tid, F.wave, Q, K, V, YA, b, h, qb, qgain, ropec);
#else
            mla_attn_unit(F.lds, F.tid, F.wave, Q, K, V, YA, b, h, qb);
#endif
        } }
}

constexpr int DL_VT = 4096, DL_WS = 8 * 2 * DL_VT, DL_OST = DL_WS + 2048, DL_BYTES = DL_OST + 8 * 4096;
__device__ __forceinline__ void dil_wave_unit(LAS unsigned char* lds, int lane, int wid, const u16* DQ, const u16* DK, const u16* DV, u16* YC, int b, int h, int span, int rho) {
    const int r32 = lane & 31, hi = lane >> 5; const size_t rowb = (size_t)b * SEQ; const int T0 = span * 512 + rho, ti = T0 + 16 * r32;
    LAS unsigned char* vt = lds + wid * 2 * DL_VT; LAS float* wsf = (LAS float*)(lds + DL_WS) + wid * 64;
    const int vfo = ((lane >> 4) & 1) * 32 + (lane & 3) * 8 + (4 * hi + ((lane & 15) >> 2)) * 64;
    const size_t hb = (size_t)(b * 8 + h) * SEQ * 64; const u16* kbase = DK + hb; const u16* vbase = DV + hb; const u16* qbase = DQ + hb; u16* obase = YC + rowb * 512 + h * 64;
    s16x8 qr[4];
#pragma unroll
    for (int d0 = 0; d0 < 4; ++d0) qr[d0] = *(const s16x8*)(qbase + (unsigned)(ti * 64 + d0 * 16 + hi * 8));
    float zf_ = 0.f; asm volatile("" : "+v"(zf_));
    float mref = zf_, l = zf_; f32x16 o0, o1;
#pragma unroll
    for (int r = 0; r < 16; ++r) { o0[r] = zf_; o1[r] = zf_; }
#define DL_TILE(it, rs, j) do { if ((it) == 0) { rs = 4; j = 4; } else if ((it) < 5) { rs = 4; j = (it) - 1; } else if ((it) < 13) { rs = 2; j = (it) - 5; } else { rs = 0; j = (it) - 13; } } while (0)
    s16x8 kf[4], kn[4]; v4u vn[4];
    const unsigned kro = (unsigned)(r32 * 64), vro = (unsigned)((lane >> 3) * 64), vco = (unsigned)((lane & 7) * 8);
#define DL_LOAD(KF, VN, rs, j) do { const int kb_ = T0 - (128 << (rs)) + ((32 * (j)) << (rs)); \
        if (kb_ >= 0 && kb_ + (31 << (rs)) <= SEQ - 1) {            \
          { const unsigned ko_ = (unsigned)(kb_ * 64) + (kro << (rs)) + (unsigned)(hi * 8); \
            _Pragma("unroll") for (int d0 = 0; d0 < 4; ++d0) KF[d0] = *(const s16x8*)(kbase + (ko_ + d0 * 16)); } \
          { const unsigned vo_ = (unsigned)(kb_ * 64) + (vro << (rs)) + vco; \
            _Pragma("unroll") for (int i_ = 0; i_ < 4; ++i_) VN[i_] = *(const v4u*)(vbase + (vo_ + ((unsigned)(8 * 64 * i_) << (rs)))); } \
        } else { \
        { int kt_ = kb_ + (r32 << (rs)); kt_ = kt_ < 0 ? 0 : (kt_ > SEQ - 1 ? SEQ - 1 : kt_); const unsigned ko_ = (unsigned)(kt_ * 64 + hi * 8); \
          _Pragma("unroll") for (int d0 = 0; d0 < 4; ++d0) KF[d0] = *(const s16x8*)(kbase + (ko_ + d0 * 16)); } \
        _Pragma("unroll") for (int i_ = 0; i_ < 4; ++i_) { const int c_ = lane + 64 * i_; int kt_ = kb_ + ((c_ >> 3) << (rs)); kt_ = kt_ < 0 ? 0 : (kt_ > SEQ - 1 ? SEQ - 1 : kt_); \
          VN[i_] = *(const v4u*)(vbase + (unsigned)(kt_ * 64 + (c_ & 7) * 8)); } } } while (0)
#define DL_VSTORE(VN, buf) do { _Pragma("unroll") for (int i_ = 0; i_ < 4; ++i_) { const int c_ = lane + 64 * i_, row_ = c_ >> 3, ch_ = c_ & 7; \
          *(LAS v4u*)(vt + (buf) * DL_VT + ((ch_ >> 2) * 2 + (row_ >> 4)) * 1024 + (row_ & 15) * 64 + (ch_ & 3) * 16) = VN[i_]; } } while (0)
    int rs0, j0; DL_TILE(0, rs0, j0);
    DL_LOAD(kf, vn, rs0, j0); DL_VSTORE(vn, 0);
    s16x8 kn2[4]; v4u vn2[4];
    { int rs1, j1; DL_TILE(1, rs1, j1); DL_LOAD(kn, vn, rs1, j1); }
#pragma unroll 1
    for (int it = 0; it < 33; ++it) {
        int rs, j; DL_TILE(it, rs, j);
        const int buf = it & 1;
        if (it + 2 < 33) { int rs2, j2; DL_TILE(it + 2, rs2, j2); DL_LOAD(kn2, vn2, rs2, j2); }
        f32x16 p;
#pragma unroll
        for (int r = 0; r < 16; ++r) p[r] = zf_;
#pragma unroll
        for (int d0 = 0; d0 < 4; ++d0) p = MFMA32(kf[d0], qr[d0], p);
        { const int kb = T0 - (128 << rs) + ((32 * j) << rs), span_r = 128 << rs;
            const int up = ti - kb, lo0 = up - span_r, lo = lo0 > -kb ? lo0 : -kb; const unsigned wid_ = (unsigned)(up - lo); const int base = ((4 * hi) << rs) - lo;
#pragma unroll
            for (int r = 0; r < 16; ++r) { const unsigned xr = (unsigned)(base + ((((r & 3) + 8 * (r >> 2))) << rs)); if (xr > wid_ || up < lo) p[r] = -INFINITY; } }
        float rm = p[0];
#pragma unroll
        for (int r = 1; r < 16; ++r) rm = fmaxf(rm, p[r]);
        rm = swapmax(rm);
        if (it == 0) mref = rm;
        else { const float dl = rm - mref;
            if (__any(dl > 8.f)) { const float d2 = fmaxf(dl, 0.f), f = __builtin_amdgcn_exp2f(-d2); mref += d2; l *= f; if (hi == 0) wsf[r32] = f;
                asm volatile("s_waitcnt lgkmcnt(0)" ::: "memory");
#pragma unroll
                for (int r = 0; r < 16; ++r) { const float fr = wsf[crow(r, hi)]; o0[r] *= fr; o1[r] *= fr; } } }
        float sacc = zf_;
#pragma unroll
        for (int r = 0; r < 16; ++r) { p[r] = __builtin_amdgcn_exp2f(p[r] - mref); sacc += p[r]; }
        l += sacc;
        v4u pw[2];
        pw[0] = (v4u){pk2(p[0], p[1]), pk2(p[2], p[3]), pk2(p[4], p[5]), pk2(p[6], p[7])};
        pw[1] = (v4u){pk2(p[8], p[9]), pk2(p[10], p[11]), pk2(p[12], p[13]), pk2(p[14], p[15])};
        asm volatile("s_waitcnt lgkmcnt(0)" ::: "memory");
        const LAS unsigned char* vp = vt + buf * DL_VT + vfo;
#pragma unroll
        for (int ks = 0; ks < 2; ++ks) { const s16x8 pa = __builtin_bit_cast(s16x8, pw[ks]);
            { const s16x4 lo = vtr16(vp + ks * 1024), hh = vtr16(vp + ks * 1024 + 512); const s16x8 vf = {lo[0], lo[1], lo[2], lo[3], hh[0], hh[1], hh[2], hh[3]}; o0 = MFMA32(pa, vf, o0); }
            { const s16x4 lo = vtr16(vp + 2048 + ks * 1024), hh = vtr16(vp + 2048 + ks * 1024 + 512); const s16x8 vf = {lo[0], lo[1], lo[2], lo[3], hh[0], hh[1], hh[2], hh[3]}; o1 = MFMA32(pa, vf, o1); } }
        if (it + 1 < 33) { DL_VSTORE(vn, buf ^ 1);
#pragma unroll
            for (int d0 = 0; d0 < 4; ++d0) { kf[d0] = kn[d0]; kn[d0] = kn2[d0]; vn[d0] = vn2[d0]; } }
    }
#undef DL_TILE
#undef DL_LOAD
#undef DL_VSTORE
    l = swapsum(l);
    if (hi == 0) wsf[32 + r32] = l;
    asm volatile("s_waitcnt lgkmcnt(0)" ::: "memory");
    LAS u16* stg = (LAS u16*)(lds + DL_OST) + wid * 2048;
#pragma unroll
    for (int r = 0; r < 16; ++r) { const int orow = crow(r, hi); const float rl = 1.0f / wsf[32 + orow];
        const u32 w = pk2(o0[r] * rl, o1[r] * rl); stg[orow * 64 + r32] = (u16)(w & 0xffffu); stg[orow * 64 + 32 + r32] = (u16)(w >> 16); }
    asm volatile("s_waitcnt lgkmcnt(0)" ::: "memory");
#pragma unroll
    for (int i = 0; i < 4; ++i) { const int row = i * 8 + (lane >> 3), ch = lane & 7; const v4u v = *(const LAS v4u*)(stg + row * 64 + ch * 8);
        *(v4u*)(obase + (unsigned)((T0 + 16 * row) * 512 + ch * 8)) = v; }
    asm volatile("s_waitcnt lgkmcnt(0)" ::: "memory");
}
__device__ __forceinline__ void dil_attn_phase(Frame& F, const u16* DQ, const u16* DK, const u16* DV, u16* YC) {
    const int gw = F.bid * NWAVES + F.wave, NGW = F.G * NWAVES;
#pragma unroll 1
    for (int u = gw; u < 8192; u += NGW) { const int rho = u & 15, span = (u >> 4) & 31, h = (u >> 9) & 7, b = u >> 12;
        dil_wave_unit(F.lds, F.lane, F.wave, DQ, DK, DV, YC, b, h, span, rho); }
    __syncthreads();
}

constexpr int D2_M = 65536, D2_L = D2_M + 2048, D2_WS = D2_L + 2048, D2_VT = D2_WS + 2048, D2_BYTES = D2_VT + 8 * 4096;
__device__ __forceinline__ void dil2_phase(Frame& F, const u16* DQ, const u16* DK, const u16* DV, u16* YC) {
    LAS unsigned char* lds = F.lds; const int lane = F.lane, wid = F.wave, r32 = lane & 31, hi = lane >> 5;
    LAS u32* sto = (LAS u32*)lds; LAS float* smv = (LAS float*)(lds + D2_M); LAS float* slv = (LAS float*)(lds + D2_L); LAS float* wsf = (LAS float*)(lds + D2_WS) + wid * 64;
    LAS unsigned char* vt = lds + D2_VT + wid * 4096;
    const int vfo = ((lane >> 4) & 1) * 32 + (lane & 3) * 8 + (4 * hi + ((lane & 15) >> 2)) * 64;
    const int nun = ((512 - F.bid + F.G - 1) / F.G) * 6;
    float zf_ = 0.f; asm volatile("" : "+v"(zf_));
#define D2_DESC(u, item, pass, k, rs, T0, S0) do { const int ii_ = (u) / 6, g_ = (u) - ii_ * 6; item = F.G == 256 ? (((F.bid & 7) * 2 + ii_) << 5) + (F.bid >> 3) : F.bid + ii_ * F.G; pass = g_ >> 1; k = g_ & 1; \
          \
        rs = 4 - 2 * pass; const int wu_ = wid * 2 + k; S0 = (item & 31) * 512; T0 = S0 + (pass == 0 ? wu_ : (pass == 1 ? (wu_ & 3) + 128 * (wu_ >> 2) : 32 * wu_)); } while (0)
#define D2_LOAD(KF, VN, item, rs, T0, jj) do { const size_t hb_ = (size_t)((item) >> 5) * SEQ * 64; const u16* kbase_ = DK + hb_; const u16* vbase_ = DV + hb_; const int j_ = (jj) == 0 ? 4 : (jj) - 1; \
        const int kb_ = (T0) - (128 << (rs)) + ((32 * j_) << (rs)); \
        { int kt_ = kb_ + (r32 << (rs)); kt_ = kt_ < 0 ? 0 : kt_; const unsigned ko_ = (unsigned)(kt_ * 64 + hi * 8); \
          _Pragma("unroll") for (int d0 = 0; d0 < 4; ++d0) KF[d0] = *(const s16x8*)(kbase_ + (ko_ + d0 * 16)); } \
        _Pragma("unroll") for (int i_ = 0; i_ < 4; ++i_) { int kt_ = kb_ + (((lane >> 3) + 8 * i_) << (rs)); kt_ = kt_ < 0 ? 0 : kt_; \
          VN[i_] = *(const v4u*)(vbase_ + (unsigned)(kt_ * 64 + (lane & 7) * 8)); } } while (0)
#define D2_VSTORE(VN) do { _Pragma("unroll") for (int i_ = 0; i_ < 4; ++i_) { const int c_ = lane + 64 * i_, row_ = c_ >> 3, ch_ = c_ & 7; \
          *(LAS v4u*)(vt + ((ch_ >> 2) * 2 + (row_ >> 4)) * 1024 + (row_ & 15) * 64 + (ch_ & 3) * 16) = VN[i_]; } } while (0)
#define D2_QLOAD(QR, item, rs, T0) do { const u16* qbase_ = DQ + (size_t)((item) >> 5) * SEQ * 64; const unsigned qo_ = (unsigned)(((T0) + (r32 << (rs))) * 64 + hi * 8); \
          _Pragma("unroll") for (int d0 = 0; d0 < 4; ++d0) QR[d0] = *(const s16x8*)(qbase_ + (qo_ + d0 * 16)); } while (0)
    s16x8 qr[4], qn[4], kf[4], kn[4], kn2[4]; v4u vn[4], vn2[4];
    float mref = zf_, l = zf_; f32x16 o0, o1;
#pragma unroll
    for (int r = 0; r < 16; ++r) { o0[r] = zf_; o1[r] = zf_; }
    __syncthreads();
    if (nun > 0) { int item, pass, k, rs, T0, S0; D2_DESC(0, item, pass, k, rs, T0, S0); D2_QLOAD(qn, item, rs, T0); D2_LOAD(kf, vn, item, rs, T0, 0); D2_VSTORE(vn); D2_LOAD(kn, vn, item, rs, T0, 1); }
#pragma unroll 1
    for (int uu = 0; uu < nun; ++uu) {
        int item, pass, k, rs, T0, S0; D2_DESC(uu, item, pass, k, rs, T0, S0);
        int itemn, passn, kn_, rsn, T0n, S0n; { const int un = uu + 1 < nun ? uu + 1 : uu; D2_DESC(un, itemn, passn, kn_, rsn, T0n, S0n); }
        const int qb = T0 - S0, ql = qb + (r32 << rs), ti = T0 + (r32 << rs);
#pragma unroll
        for (int d0 = 0; d0 < 4; ++d0) qr[d0] = qn[d0];
        if (pass == 0) { l = zf_;
#pragma unroll
            for (int r = 0; r < 16; ++r) { o0[r] = zf_; o1[r] = zf_; } }
        else { mref = smv[ql]; { const float lt = slv[ql]; l = hi == 0 ? lt : zf_; }
            int hi_ = hi, r32_ = r32; asm volatile("" : "+v"(hi_), "+v"(r32_));
#pragma unroll
            for (int r = 0; r < 16; ++r) { const u32 w = sto[(qb + (crow(r, hi_) << rs)) * 32 + r32_]; o0[r] = bflo(w) * 256.f; o1[r] = bfhi(w) * 256.f; } }
#pragma unroll
        for (int jj = 0; jj < 5; ++jj) {
            if (jj + 2 < 5) D2_LOAD(kn2, vn2, item, rs, T0, jj + 2); else D2_LOAD(kn2, vn2, itemn, rsn, T0n, jj + 2 - 5);
            if (jj == 1) D2_QLOAD(qn, itemn, rsn, T0n);
            const int j = jj == 0 ? 4 : jj - 1;
            f32x16 p;
#pragma unroll
            for (int r = 0; r < 16; ++r) p[r] = zf_;
#pragma unroll
            for (int d0 = 0; d0 < 4; ++d0) p = MFMA32(kf[d0], qr[d0], p);
            { const int kb = T0 - (128 << rs) + ((32 * j) << rs);
              if (jj < 2 || kb < 0) {
                const int span_r = 128 << rs, up = ti - kb, lo0 = up - span_r, lo = lo0 > -kb ? lo0 : -kb; const unsigned wid_ = (unsigned)(up - lo); const int base = ((4 * hi) << rs) - lo;
#pragma unroll
                for (int r = 0; r < 16; ++r) { const unsigned xr = (unsigned)(base + ((((r & 3) + 8 * (r >> 2))) << rs)); if (xr > wid_ || up < lo) p[r] = -INFINITY; } } }
            float rm = max16_mfma(p);
            rm = swapmax(rm);
            if (jj == 0 && pass == 0) mref = rm;
            else { const float dl = rm - mref;
                if (__any(dl > 8.f)) { const float d2 = fmaxf(dl, 0.f), f = __builtin_amdgcn_exp2f(-d2); mref += d2; l *= f; if (hi == 0) wsf[r32] = f;
                    asm volatile("s_waitcnt lgkmcnt(0)" ::: "memory");
                    { int hi_ = hi; asm volatile("" : "+v"(hi_));
#pragma unroll
                    for (int r = 0; r < 16; ++r) { const float fr = wsf[crow(r, hi_)]; o0[r] *= fr; o1[r] *= fr; } } } }
            float sacc = zf_;
#pragma unroll
            for (int r = 0; r < 16; ++r) { p[r] = __builtin_amdgcn_exp2f(p[r] - mref); sacc += p[r]; }
            l += sacc;
            v4u pw[2];
            pw[0] = (v4u){pk2(p[0], p[1]), pk2(p[2], p[3]), pk2(p[4], p[5]), pk2(p[6], p[7])};
            pw[1] = (v4u){pk2(p[8], p[9]), pk2(p[10], p[11]), pk2(p[12], p[13]), pk2(p[14], p[15])};
            asm volatile("s_waitcnt lgkmcnt(0)" ::: "memory");
            const LAS unsigned char* vp = vt + vfo;
#pragma unroll
            for (int ks = 0; ks < 2; ++ks) { const s16x8 pa = __builtin_bit_cast(s16x8, pw[ks]);
                { const s16x4 lo = vtr16(vp + ks * 1024), hh = vtr16(vp + ks * 1024 + 512); const s16x8 vf = {lo[0], lo[1], lo[2], lo[3], hh[0], hh[1], hh[2], hh[3]}; o0 = MFMA32(pa, vf, o0); }
                { const s16x4 lo = vtr16(vp + 2048 + ks * 1024), hh = vtr16(vp + 2048 + ks * 1024 + 512); const s16x8 vf = {lo[0], lo[1], lo[2], lo[3], hh[0], hh[1], hh[2], hh[3]}; o1 = MFMA32(pa, vf, o1); } }
            asm volatile("" ::: "memory");
            D2_VSTORE(vn);
#pragma unroll
            for (int d0 = 0; d0 < 4; ++d0) { kf[d0] = kn[d0]; kn[d0] = kn2[d0]; vn[d0] = vn2[d0]; }
        }
        { const float lt = swapsum(l); int hi_ = hi, r32_ = r32; asm volatile("" : "+v"(hi_), "+v"(r32_));
            if (pass < 2) { if (hi == 0) { smv[ql] = mref; slv[ql] = lt; }
#pragma unroll
                for (int r = 0; r < 16; ++r) sto[(qb + (crow(r, hi_) << rs)) * 32 + r32_] = pk2(o0[r] * 0.00390625f, o1[r] * 0.00390625f); }
            else { if (hi == 0) wsf[32 + r32] = lt;
                asm volatile("s_waitcnt lgkmcnt(0)" ::: "memory");
                LAS u16* stg = (LAS u16*)(lds + qb * 128);
#pragma unroll
                for (int r = 0; r < 16; ++r) { const int orow = crow(r, hi_); const float rl = 1.0f / wsf[32 + orow];
                    const u32 w = pk2(o0[r] * rl, o1[r] * rl); stg[orow * 64 + r32_] = (u16)(w & 0xffffu); stg[orow * 64 + 32 + r32_] = (u16)(w >> 16); }
                asm volatile("s_waitcnt lgkmcnt(0)" ::: "memory");
                u16* obase = YC + (size_t)(item >> 8) * SEQ * 512 + ((item >> 5) & 7) * 64;
                int lane_ = lane; asm volatile("" : "+v"(lane_));
#pragma unroll
                for (int i = 0; i < 4; ++i) { const int row = i * 8 + (lane_ >> 3), ch = lane_ & 7; const v4u v = *(const LAS v4u*)(stg + row * 64 + ch * 8);
                    *(v4u*)(obase + (unsigned)((T0 + row) * 512 + ch * 8)) = v; } }
            if (k == 1) { asm volatile("s_waitcnt lgkmcnt(0)" ::: "memory"); __builtin_amdgcn_s_barrier(); asm volatile("" ::: "memory"); }
        }
    }
#undef D2_DESC
#undef D2_LOAD
#undef D2_VSTORE
#undef D2_QLOAD
    __syncthreads();
}

#if MK_DIL_V2
#define DIL_PHASE dil2_phase
#else
#define DIL_PHASE dil_attn_phase
#endif

constexpr int M2_P = 72;
constexpr int M2_Q = 0, M2_K = M2_Q + 64 * M2_P * 2, M2_V = M2_K + 64 * M2_P * 2, M2_C = M2_V + 16384, M2_SC = M2_C + 16384, M2_RED = M2_SC + 6 * 256, M2_OST = M2_RED + 4 * 64 * 4, M2_BYTES = M2_OST + 8 * 4096;
template <bool IMG> __device__ __forceinline__ void m2_stage_conv(LAS unsigned char* dst, const LAS float* wsc, const u16* MQK, size_t row0, int pos0, int ch0, const float* cw, const float* cb, float scale, int tid) {
    const int s = tid >> 3, cc = tid & 7, ch = ch0 + cc * 8;
    float acc[8];
    { const f32x4 b0 = *(const f32x4*)(cb + ch), b1 = *(const f32x4*)(cb + ch + 4); acc[0] = b0.x; acc[1] = b0.y; acc[2] = b0.z; acc[3] = b0.w; acc[4] = b1.x; acc[5] = b1.y; acc[6] = b1.z; acc[7] = b1.w; }
#pragma unroll
    for (int j = 0; j < 4; ++j) { if (pos0 + s - 3 + j >= 0) { const v4u w = *(const v4u*)(MQK + (size_t)((long)row0 + s - 3 + j) * 512 + ch);
            const f32x4 w0 = *(const f32x4*)(cw + j * 512 + ch), w1 = *(const f32x4*)(cw + j * 512 + ch + 4);
            acc[0] += w0.x * bflo(w.x); acc[1] += w0.y * bfhi(w.x); acc[2] += w0.z * bflo(w.y); acc[3] += w0.w * bfhi(w.y); acc[4] += w1.x * bflo(w.z); acc[5] += w1.y * bfhi(w.z); acc[6] += w1.z * bflo(w.w); acc[7] += w1.w * bfhi(w.w); } }
    const float sc = scale * (wsc ? wsc[s] : 1.0f);
#pragma unroll
    for (int i = 0; i < 8; ++i) acc[i] = fsilu(acc[i]) * sc;
    v4u o; o.x = pk2(acc[0], acc[1]); o.y = pk2(acc[2], acc[3]); o.z = pk2(acc[4], acc[5]); o.w = pk2(acc[6], acc[7]);
    if (IMG) *(LAS v4u*)(dst + ((cc >> 2) * 4 + (s >> 4)) * 1024 + (s & 15) * 64 + (cc & 3) * 16) = o;
    else *(LAS v4u*)(dst + (s * M2_P + cc * 8) * 2) = o;
}
__device__ __forceinline__ void m2_stage_img(LAS unsigned char* img, const u16* src, size_t pitch, int tid) {
#pragma unroll
    for (int i = 0; i < 2; ++i) { const int c = tid + 512 * i, row = c >> 4, cc = c & 15; const v4u w = *(const v4u*)(src + (size_t)row * pitch + cc * 8);
        *(LAS v4u*)(img + ((cc >> 2) * 4 + (row >> 4)) * 1024 + (row & 15) * 64 + (cc & 3) * 16) = w; }
}
__device__ __forceinline__ void mlstm_a2_phase(Frame& F, const u16* MQK, const u16* MV, const float* IF, const float* cw, const float* cb, float* ST) {
    LAS unsigned char* lds = F.lds; LAS unsigned char* Vi = lds + M2_V; LAS float* wsv = (LAS float*)(lds + M2_SC);
    float* mloc = (float*)(F.ws + WS_MLS); float* bend = mloc + 2048; float* nst = (float*)(F.ws + WS_MLS + 65536);
    const int tid = F.tid, lane = F.lane, wid = F.wave, r32 = lane & 31, hi = lane >> 5;
    const int vfn = ((lane >> 4) & 1) * 32 + (lane & 3) * 8 + (8 * hi + ((lane & 15) >> 2)) * 64;
    for (int u = F.bid; u < 2048; u += F.G) {
        const int bh = u >> 8, c = u & 255, b = bh >> 2, h = bh & 3, pos0 = c * 64; const size_t row0 = (size_t)b * SEQ + pos0;
        __syncthreads();
        if (tid < 64) { const float ig = IF[(row0 + tid) * 8 + h], lf = IF[(row0 + tid) * 8 + 4 + h];
            const float bs = wave_incl_scan_add(lf, tid), be = bperm_f(63, bs);
            const float wl = be - bs + ig, ml = wave_max(wl, tid);
            wsv[tid] = __expf(wl - ml);
            if (tid == 0) { mloc[u] = ml; bend[u] = be; } }
        m2_stage_img(Vi, MV + row0 * 512 + h * 128, 512, tid);
        __syncthreads();
        m2_stage_conv<true>(lds + M2_K, wsv, MQK, row0, pos0, 256 + h * 64, cw, cb, 0.125f, tid);
        __syncthreads();
        const int dt = wid & 1, vt = wid >> 1;
        float zf_ = 0.f; asm volatile("" : "+v"(zf_));
        f32x16 acc;
#pragma unroll
        for (int r = 0; r < 16; ++r) acc[r] = zf_;
#pragma unroll
        for (int ks = 0; ks < 4; ++ks) { const s16x4 al = vtr16(lds + M2_K + (dt * 4 + ks) * 1024 + vfn), ah = vtr16(lds + M2_K + (dt * 4 + ks) * 1024 + vfn + 256); const s16x8 a = {al[0], al[1], al[2], al[3], ah[0], ah[1], ah[2], ah[3]};
            const s16x4 lo = vtr16(Vi + (vt * 4 + ks) * 1024 + vfn), hh = vtr16(Vi + (vt * 4 + ks) * 1024 + vfn + 256); const s16x8 vf = {lo[0], lo[1], lo[2], lo[3], hh[0], hh[1], hh[2], hh[3]};
            acc = MFMA32(a, vf, acc); }
        float* o = ST + (size_t)u * 8192 + (dt * 32) * 128 + vt * 32 + r32;
#pragma unroll
        for (int r = 0; r < 16; ++r) o[crow(r, hi) * 128] = acc[r];
        if (tid < 64) { float an = 0.f; const LAS u16* kc = (const LAS u16*)(lds + M2_K) + (tid >> 5) * 2048 + (tid & 31);
#pragma unroll 8
            for (int s2 = 0; s2 < 64; ++s2) an += bf1(kc[(s2 >> 4) * 512 + (s2 & 15) * 32]);
            nst[(size_t)u * 64 + tid] = an; }
    }
    __syncthreads();
}
__device__ __forceinline__ void mlstm_c2_phase(Frame& F, const u16* MQK, const u16* MV, const u16* MO, const float* IF, const float* cw, const float* cb, const float* hg, const float* ST, u16* YB) {
    LAS unsigned char* lds = F.lds; LAS u16* Qs = (LAS u16*)(lds + M2_Q); LAS u16* Ks = (LAS u16*)(lds + M2_K); LAS unsigned char* Vi = lds + M2_V; LAS unsigned char* Ci = lds + M2_C;
    LAS float* bsv = (LAS float*)(lds + M2_SC); LAS float* gsv = bsv + 64; LAS float* mtv = gsv + 64; LAS float* dcv = mtv + 64; LAS float* npv = dcv + 64; LAS float* red = (LAS float*)(lds + M2_RED);
    const float* mprev = (const float*)(F.ws + WS_MLS) + 4096; const float* nst = (const float*)(F.ws + WS_MLS + 65536);
    const int tid = F.tid, lane = F.lane, wid = F.wave, r32 = lane & 31, hi = lane >> 5;
    const int vfn = ((lane >> 4) & 1) * 32 + (lane & 3) * 8 + (8 * hi + ((lane & 15) >> 2)) * 64;
    const int vfa = ((lane >> 4) & 1) * 32 + (lane & 3) * 8 + (4 * hi + ((lane & 15) >> 2)) * 64;
    for (int u = F.bid; u < 2048; u += F.G) {
        const int bh = u >> 8, c = u & 255, b = bh >> 2, h = bh & 3, pos0 = c * 64; const size_t row0 = (size_t)b * SEQ + pos0;
        __syncthreads();
        m2_stage_conv<false>(lds + M2_Q, nullptr, MQK, row0, pos0, h * 64, cw, cb, 1.0f, tid);
        m2_stage_conv<false>(lds + M2_K, nullptr, MQK, row0, pos0, 256 + h * 64, cw, cb, 0.125f, tid);
        m2_stage_img(Vi, MV + row0 * 512 + h * 128, 512, tid);
        {
#pragma unroll
            for (int i = 0; i < 2; ++i) { const int cidx = tid + 512 * i, row = cidx >> 4, cc = cidx & 15; const float* sp = ST + (size_t)u * 8192 + row * 128 + cc * 8;
                const f32x4 a = *(const f32x4*)sp, bq = *(const f32x4*)(sp + 4); v4u w; w.x = pk2(a.x, a.y); w.y = pk2(a.z, a.w); w.z = pk2(bq.x, bq.y); w.w = pk2(bq.z, bq.w);
                *(LAS v4u*)(Ci + ((cc >> 2) * 4 + (row >> 4)) * 1024 + (row & 15) * 64 + (cc & 3) * 16) = w; } }
        if (tid < 64) { const float ig = IF[(row0 + tid) * 8 + h], lf = IF[(row0 + tid) * 8 + 4 + h], m = mprev[u];
            const float bs = wave_incl_scan_add(lf, tid), gs = ig - bs, gmx = wave_incl_scan_max(gs, tid);
            const float inter = bs + m, mt = fmaxf(inter, bs + gmx);
            bsv[tid] = bs; gsv[tid] = gs; mtv[tid] = mt; dcv[tid] = __expf(inter - mt); npv[tid] = nst[(size_t)u * 64 + tid]; }
        __syncthreads();
        const int th = wid & 1, vq = wid >> 1, t = th * 32 + r32;
        float zf_ = 0.f; asm volatile("" : "+v"(zf_));
        f32x16 s0, s1;
#pragma unroll
        for (int r = 0; r < 16; ++r) { s0[r] = zf_; s1[r] = zf_; }
        s16x8 qf[4];
#pragma unroll
        for (int kd = 0; kd < 4; ++kd) qf[kd] = *(const LAS s16x8*)(Qs + t * M2_P + kd * 16 + hi * 8);
#pragma unroll
        for (int kd = 0; kd < 4; ++kd) { const s16x8 a0 = *(const LAS s16x8*)(Ks + r32 * M2_P + kd * 16 + hi * 8), a1 = *(const LAS s16x8*)(Ks + (32 + r32) * M2_P + kd * 16 + hi * 8);
            s0 = MFMA32(a0, qf[kd], s0); s1 = MFMA32(a1, qf[kd], s1); }
        const float bt = bsv[t], mt = mtv[t], dc = dcv[t]; float rs = zf_;
#pragma unroll
        for (int r = 0; r < 16; ++r) { const int sa = crow(r, hi), sb2 = 32 + sa;
            s0[r] = (sa <= t) ? s0[r] * __expf(bt + gsv[sa] - mt) : 0.f; s1[r] = (sb2 <= t) ? s1[r] * __expf(bt + gsv[sb2] - mt) : 0.f; rs += s0[r] + s1[r]; }
        rs = swapsum(rs);
        v4u pw[4];
        pw[0] = (v4u){pk2(s0[0], s0[1]), pk2(s0[2], s0[3]), pk2(s0[4], s0[5]), pk2(s0[6], s0[7])};
        pw[1] = (v4u){pk2(s0[8], s0[9]), pk2(s0[10], s0[11]), pk2(s0[12], s0[13]), pk2(s0[14], s0[15])};
        pw[2] = (v4u){pk2(s1[0], s1[1]), pk2(s1[2], s1[3]), pk2(s1[4], s1[5]), pk2(s1[6], s1[7])};
        pw[3] = (v4u){pk2(s1[8], s1[9]), pk2(s1[10], s1[11]), pk2(s1[12], s1[13]), pk2(s1[14], s1[15])};
        f32x16 acc;
#pragma unroll
        for (int r = 0; r < 16; ++r) acc[r] = zf_;
#pragma unroll
        for (int kd = 0; kd < 4; ++kd) { const s16x4 lo = vtr16(Ci + (vq * 4 + kd) * 1024 + vfn), hh = vtr16(Ci + (vq * 4 + kd) * 1024 + vfn + 256); const s16x8 cf = {lo[0], lo[1], lo[2], lo[3], hh[0], hh[1], hh[2], hh[3]};
            acc = MFMA32(cf, qf[kd], acc); }
#pragma unroll
        for (int r = 0; r < 16; ++r) acc[r] *= dc;
#pragma unroll
        for (int ks = 0; ks < 4; ++ks) { const s16x4 lo = vtr16(Vi + (vq * 4 + ks) * 1024 + vfa), hh = vtr16(Vi + (vq * 4 + ks) * 1024 + vfa + 512); const s16x8 vf = {lo[0], lo[1], lo[2], lo[3], hh[0], hh[1], hh[2], hh[3]};
            acc = MFMA32(vf, __builtin_bit_cast(s16x8, pw[ks]), acc); }
        float qn = zf_;
#pragma unroll
        for (int kd = 0; kd < 4; ++kd) { const v4u w = __builtin_bit_cast(v4u, qf[kd]); const LAS float* np = npv + kd * 16 + hi * 8;
            qn += bflo(w.x) * np[0] + bfhi(w.x) * np[1] + bflo(w.y) * np[2] + bfhi(w.y) * np[3] + bflo(w.z) * np[4] + bfhi(w.z) * np[5] + bflo(w.w) * np[6] + bfhi(w.w) * np[7]; }
        qn = swapsum(qn);
        const float inv = 1.0f / fmaxf(fabsf(dc * qn + rs), __expf(-mt));
        float ss = zf_;
#pragma unroll
        for (int r = 0; r < 16; ++r) { acc[r] *= inv; ss += acc[r] * acc[r]; }
        ss = swapsum(ss);
        if (hi == 0) red[vq * 64 + t] = ss;
        __syncthreads();
        const float rstd = 1.0f / sqrtf(((red[t] + red[64 + t]) + (red[128 + t] + red[192 + t])) * (1.f / 128.f) + EPS);
        LAS u16* stg = (LAS u16*)(lds + M2_OST) + wid * 2048;
#pragma unroll
        for (int r = 0; r < 16; r += 2) { const u32 w = pk2(acc[r] * rstd, acc[r + 1] * rstd); stg[r32 * 32 + crow(r, hi)] = (u16)(w & 0xffffu); stg[r32 * 32 + crow(r + 1, hi)] = (u16)(w >> 16); }
        asm volatile("s_waitcnt lgkmcnt(0)" ::: "memory");
#pragma unroll
        for (int i = 0; i < 2; ++i) { const int tt = i * 16 + (lane >> 2), ch = lane & 3; const v4u hv = *(const LAS v4u*)(stg + tt * 32 + ch * 8);
            const size_t ob = (row0 + th * 32 + tt) * 512 + h * 128 + vq * 32 + ch * 8; const v4u mo = *(const v4u*)(MO + ob); const float* gp = hg + h * 128 + vq * 32 + ch * 8;
            v4u w; w.x = pk2(bflo(hv.x) * gp[0] * bflo(mo.x), bfhi(hv.x) * gp[1] * bfhi(mo.x)); w.y = pk2(bflo(hv.y) * gp[2] * bflo(mo.y), bfhi(hv.y) * gp[3] * bfhi(mo.y));
            w.z = pk2(bflo(hv.z) * gp[4] * bflo(mo.z), bfhi(hv.z) * gp[5] * bfhi(mo.z)); w.w = pk2(bflo(hv.w) * gp[6] * bflo(mo.w), bfhi(hv.w) * gp[7] * bfhi(mo.w));
            *(v4u*)(YB + ob) = w; }
    }
    __syncthreads();
}

constexpr int M2_CW = M2_BYTES, M2_BYTES3 = M2_CW + 2560 * 4;
static_assert(M2_BYTES3 <= RING_BYTES, "mLSTM LDS map");
#define M3_CLOAD(R, MQK, row0, pos0, ch) do { _Pragma("unroll") for (int j_ = 0; j_ < 4; ++j_) { const int o_ = s_ - 3 + j_, oc_ = o_ < -(pos0) ? -(pos0) : o_; \
        v4u w_ = *(const v4u*)((MQK) + (size_t)((long)(row0) + oc_) * 512 + (ch)); if ((pos0) + o_ < 0) w_ = (v4u){0u, 0u, 0u, 0u}; R[j_] = w_; } } while (0)
template <bool IMG> __device__ __forceinline__ void m3_conv_store(LAS unsigned char* dst, const LAS float* wsc, const v4u* R, const LAS float* cwl, int ch, float scale, int s, int cc) {
    float acc[8];
    { const f32x4 b0 = *(const LAS f32x4*)(cwl + 2048 + ch), b1 = *(const LAS f32x4*)(cwl + 2048 + ch + 4); acc[0] = b0.x; acc[1] = b0.y; acc[2] = b0.z; acc[3] = b0.w; acc[4] = b1.x; acc[5] = b1.y; acc[6] = b1.z; acc[7] = b1.w; }
#pragma unroll
    for (int j = 0; j < 4; ++j) { const v4u w = R[j]; const f32x4 w0 = *(const LAS f32x4*)(cwl + j * 512 + ch), w1 = *(const LAS f32x4*)(cwl + j * 512 + ch + 4);
        acc[0] += w0.x * bflo(w.x); acc[1] += w0.y * bfhi(w.x); acc[2] += w0.z * bflo(w.y); acc[3] += w0.w * bfhi(w.y); acc[4] += w1.x * bflo(w.z); acc[5] += w1.y * bfhi(w.z); acc[6] += w1.z * bflo(w.w); acc[7] += w1.w * bfhi(w.w); }
    const float sc = scale * (wsc ? wsc[s] : 1.0f);
#pragma unroll
    for (int i = 0; i < 8; ++i) acc[i] = fsilu(acc[i]) * sc;
    v4u o; o.x = pk2(acc[0], acc[1]); o.y = pk2(acc[2], acc[3]); o.z = pk2(acc[4], acc[5]); o.w = pk2(acc[6], acc[7]);
    if (IMG) *(LAS v4u*)(dst + ((cc >> 2) * 4 + (s >> 4)) * 1024 + (s & 15) * 64 + (cc & 3) * 16) = o;
    else *(LAS v4u*)(dst + (s * M2_P + cc * 8) * 2) = o;
}
__device__ __forceinline__ void mlstm_a3_phase(Frame& F, const u16* MQK, const u16* MV, const float* IF, const float* cw, const float* cb, float* ST) {
    LAS unsigned char* lds = F.lds; LAS unsigned char* Vi = lds + M2_V; LAS float* wsv = (LAS float*)(lds + M2_SC); LAS float* cwl = (LAS float*)(lds + M2_CW);
    float* mloc = (float*)(F.ws + WS_MLS); float* bend = mloc + 2048; float* nst = (float*)(F.ws + WS_MLS + 65536);
    const int tid = F.tid, lane = F.lane, wid = F.wave, r32 = lane & 31, hi = lane >> 5, s_ = tid >> 3, cc = tid & 7;
    const int vfn = ((lane >> 4) & 1) * 32 + (lane & 3) * 8 + (8 * hi + ((lane & 15) >> 2)) * 64;
    __syncthreads();
    for (int i = tid; i < 2560; i += NTHR) cwl[i] = i < 2048 ? cw[i] : cb[i - 2048];
    v4u kr[4], vr[2]; float ig = 0.f, lf = 0.f;
#define A3_ISSUE(u_) do { const int bh_ = (u_) >> 8, b_ = bh_ >> 2, h_ = bh_ & 3, pos0_ = ((u_) & 255) * 64; const size_t row0_ = (size_t)b_ * SEQ + pos0_; \
        M3_CLOAD(kr, MQK, row0_, pos0_, 256 + h_ * 64 + cc * 8); \
        _Pragma("unroll") for (int i_ = 0; i_ < 2; ++i_) { const int c_ = tid + 512 * i_; vr[i_] = *(const v4u*)(MV + (row0_ + (c_ >> 4)) * 512 + h_ * 128 + (c_ & 15) * 8); } \
        { const int t_ = tid & 63; ig = IF[(row0_ + t_) * 8 + h_]; lf = IF[(row0_ + t_) * 8 + 4 + h_]; } } while (0)
    if (F.bid < 2048) A3_ISSUE(F.bid);
    for (int u = F.bid; u < 2048; u += F.G) {
        const int bh = u >> 8, h = bh & 3;
        __syncthreads();
        if (tid < 64) { const float bs = wave_incl_scan_add(lf, tid), be = bperm_f(63, bs);
            const float wl = be - bs + ig, ml = wave_max(wl, tid);
            wsv[tid] = __expf(wl - ml);
            if (tid == 0) { mloc[u] = ml; bend[u] = be; } }
#pragma unroll
        for (int i = 0; i < 2; ++i) { const int c = tid + 512 * i, row = c >> 4, c16 = c & 15; *(LAS v4u*)(Vi + ((c16 >> 2) * 4 + (row >> 4)) * 1024 + (row & 15) * 64 + (c16 & 3) * 16) = vr[i]; }
        __syncthreads();
        m3_conv_store<true>(lds + M2_K, wsv, kr, cwl, 256 + h * 64 + cc * 8, 0.125f, s_, cc);
        __syncthreads();
        { const int un = u + F.G < 2048 ? u + F.G : u; A3_ISSUE(un); }
        const int dt = wid & 1, vt = wid >> 1;
        float zf_ = 0.f; asm volatile("" : "+v"(zf_));
        f32x16 acc;
#pragma unroll
        for (int r = 0; r < 16; ++r) acc[r] = zf_;
#pragma unroll
        for (int ks = 0; ks < 4; ++ks) { const s16x4 al = vtr16(lds + M2_K + (dt * 4 + ks) * 1024 + vfn), ah = vtr16(lds + M2_K + (dt * 4 + ks) * 1024 + vfn + 256); const s16x8 a = {al[0], al[1], al[2], al[3], ah[0], ah[1], ah[2], ah[3]};
            const s16x4 lo = vtr16(Vi + (vt * 4 + ks) * 1024 + vfn), hh = vtr16(Vi + (vt * 4 + ks) * 1024 + vfn + 256); const s16x8 vf = {lo[0], lo[1], lo[2], lo[3], hh[0], hh[1], hh[2], hh[3]};
            acc = MFMA32(a, vf, acc); }
        float* o = ST + (size_t)u * 8192 + (dt * 32) * 128 + vt * 32 + r32;
#pragma unroll
        for (int r = 0; r < 16; ++r) o[crow(r, hi) * 128] = acc[r];
        if (tid < 64) { float an = 0.f; const LAS u16* kc = (const LAS u16*)(lds + M2_K) + (tid >> 5) * 2048 + (tid & 31);
#pragma unroll 8
            for (int s2 = 0; s2 < 64; ++s2) an += bf1(kc[(s2 >> 4) * 512 + (s2 & 15) * 32]);
            nst[(size_t)u * 64 + tid] = an; }
    }
#undef A3_ISSUE
    __syncthreads();
}
__device__ __forceinline__ void mlstm_c3_phase(Frame& F, const u16* MQK, const u16* MV, const u16* MO, const float* IF, const float* cw, const float* cb, const float* hg, const float* ST, u16* YB) {
    LAS unsigned char* lds = F.lds; LAS u16* Qs = (LAS u16*)(lds + M2_Q); LAS u16* Ks = (LAS u16*)(lds + M2_K); LAS unsigned char* Vi = lds + M2_V; LAS unsigned char* Ci = lds + M2_C;
    LAS float* bsv = (LAS float*)(lds + M2_SC); LAS float* gsv = bsv + 64; LAS float* mtv = gsv + 64; LAS float* dcv = mtv + 64; LAS float* npv = dcv + 64; LAS float* red = (LAS float*)(lds + M2_RED);
    LAS float* cwl = (LAS float*)(lds + M2_CW);
    const float* mprev = (const float*)(F.ws + WS_MLS) + 4096; const float* nst = (const float*)(F.ws + WS_MLS + 65536);
    const int tid = F.tid, lane = F.lane, wid = F.wave, r32 = lane & 31, hi = lane >> 5, s_ = tid >> 3, cc = tid & 7;
    const int vfn = ((lane >> 4) & 1) * 32 + (lane & 3) * 8 + (8 * hi + ((lane & 15) >> 2)) * 64;
    const int vfa = ((lane >> 4) & 1) * 32 + (lane & 3) * 8 + (4 * hi + ((lane & 15) >> 2)) * 64;
    __syncthreads();
    for (int i = tid; i < 2560; i += NTHR) cwl[i] = i < 2048 ? cw[i] : cb[i - 2048];
    v4u qr4[4], kr[4], vr[2]; f32x4 cp[4]; float ig = 0.f, lf = 0.f, mp = 0.f, npn = 0.f;
#define C3_ISSUE(u_) do { const int bh_ = (u_) >> 8, b_ = bh_ >> 2, h_ = bh_ & 3, pos0_ = ((u_) & 255) * 64; const size_t row0_ = (size_t)b_ * SEQ + pos0_; \
        M3_CLOAD(qr4, MQK, row0_, pos0_, h_ * 64 + cc * 8); M3_CLOAD(kr, MQK, row0_, pos0_, 256 + h_ * 64 + cc * 8); \
        _Pragma("unroll") for (int i_ = 0; i_ < 2; ++i_) { const int c_ = tid + 512 * i_; vr[i_] = *(const v4u*)(MV + (row0_ + (c_ >> 4)) * 512 + h_ * 128 + (c_ & 15) * 8); \
            const float* sp_ = ST + (size_t)(u_) * 8192 + (c_ >> 4) * 128 + (c_ & 15) * 8; cp[2 * i_] = *(const f32x4*)sp_; cp[2 * i_ + 1] = *(const f32x4*)(sp_ + 4); } \
        { const int t_ = tid & 63; ig = IF[(row0_ + t_) * 8 + h_]; lf = IF[(row0_ + t_) * 8 + 4 + h_]; mp = mprev[(u_)]; npn = nst[(size_t)(u_) * 64 + t_]; } } while (0)
    if (F.bid < 2048) C3_ISSUE(F.bid);
    for (int u = F.bid; u < 2048; u += F.G) {
        const int bh = u >> 8, c = u & 255, b = bh >> 2, h = bh & 3, pos0 = c * 64; const size_t row0 = (size_t)b * SEQ + pos0;
        __syncthreads();
        m3_conv_store<false>(lds + M2_Q, nullptr, qr4, cwl, h * 64 + cc * 8, 1.0f, s_, cc);
        m3_conv_store<false>(lds + M2_K, nullptr, kr, cwl, 256 + h * 64 + cc * 8, 0.125f, s_, cc);
#pragma unroll
        for (int i = 0; i < 2; ++i) { const int ci = tid + 512 * i, row = ci >> 4, c16 = ci & 15; const int io = ((c16 >> 2) * 4 + (row >> 4)) * 1024 + (row & 15) * 64 + (c16 & 3) * 16;
            *(LAS v4u*)(Vi + io) = vr[i];
            const f32x4 a = cp[2 * i], bq = cp[2 * i + 1]; v4u w; w.x = pk2(a.x, a.y); w.y = pk2(a.z, a.w); w.z = pk2(bq.x, bq.y); w.w = pk2(bq.z, bq.w); *(LAS v4u*)(Ci + io) = w; }
        if (tid < 64) { const float bs = wave_incl_scan_add(lf, tid), gs = ig - bs, gmx = wave_incl_scan_max(gs, tid);
            const float inter = bs + mp, mt = fmaxf(inter, bs + gmx);
            bsv[tid] = bs; gsv[tid] = gs; mtv[tid] = mt; dcv[tid] = __expf(inter - mt); npv[tid] = npn; }
        __syncthreads();
        const int th = wid & 1, vq = wid >> 1, t = th * 32 + r32;
        v4u mo[2];
#pragma unroll
        for (int i = 0; i < 2; ++i) { const int tt = i * 16 + (lane >> 2), ch = lane & 3; mo[i] = *(const v4u*)(MO + (row0 + th * 32 + tt) * 512 + h * 128 + vq * 32 + ch * 8); }
        { const int un = u + F.G < 2048 ? u + F.G : u; C3_ISSUE(un); }
        float zf_ = 0.f; asm volatile("" : "+v"(zf_));
        f32x16 s0, s1;
#pragma unroll
        for (int r = 0; r < 16; ++r) { s0[r] = zf_; s1[r] = zf_; }
        s16x8 qf[4];
#pragma unroll
        for (int kd = 0; kd < 4; ++kd) qf[kd] = *(const LAS s16x8*)(Qs + t * M2_P + kd * 16 + hi * 8);
#pragma unroll
        for (int kd = 0; kd < 4; ++kd) { const s16x8 a0 = *(const LAS s16x8*)(Ks + r32 * M2_P + kd * 16 + hi * 8), a1 = *(const LAS s16x8*)(Ks + (32 + r32) * M2_P + kd * 16 + hi * 8);
            s0 = MFMA32(a0, qf[kd], s0); s1 = MFMA32(a1, qf[kd], s1); }
        const float bt = bsv[t], mt = mtv[t], dc = dcv[t]; float rs = zf_;
#pragma unroll
        for (int r = 0; r < 16; ++r) { const int sa = crow(r, hi), sb2 = 32 + sa;
            s0[r] = (sa <= t) ? s0[r] * __expf(bt + gsv[sa] - mt) : 0.f; s1[r] = (sb2 <= t) ? s1[r] * __expf(bt + gsv[sb2] - mt) : 0.f; rs += s0[r] + s1[r]; }
        rs = swapsum(rs);
        v4u pw[4];
        pw[0] = (v4u){pk2(s0[0], s0[1]), pk2(s0[2], s0[3]), pk2(s0[4], s0[5]), pk2(s0[6], s0[7])};
        pw[1] = (v4u){pk2(s0[8], s0[9]), pk2(s0[10], s0[11]), pk2(s0[12], s0[13]), pk2(s0[14], s0[15])};
        pw[2] = (v4u){pk2(s1[0], s1[1]), pk2(s1[2], s1[3]), pk2(s1[4], s1[5]), pk2(s1[6], s1[7])};
        pw[3] = (v4u){pk2(s1[8], s1[9]), pk2(s1[10], s1[11]), pk2(s1[12], s1[13]), pk2(s1[14], s1[15])};
        f32x16 acc;
#pragma unroll
        for (int r = 0; r < 16; ++r) acc[r] = zf_;
#pragma unroll
        for (int kd = 0; kd < 4; ++kd) { const s16x4 lo = vtr16(Ci + (vq * 4 + kd) * 1024 + vfn), hh = vtr16(Ci + (vq * 4 + kd) * 1024 + vfn + 256); const s16x8 cf = {lo[0], lo[1], lo[2], lo[3], hh[0], hh[1], hh[2], hh[3]};
            acc = MFMA32(cf, qf[kd], acc); }
#pragma unroll
        for (int r = 0; r < 16; ++r) acc[r] *= dc;
#pragma unroll
        for (int ks = 0; ks < 4; ++ks) { const s16x4 lo = vtr16(Vi + (vq * 4 + ks) * 1024 + vfa), hh = vtr16(Vi + (vq * 4 + ks) * 1024 + vfa + 512); const s16x8 vf = {lo[0], lo[1], lo[2], lo[3], hh[0], hh[1], hh[2], hh[3]};
            acc = MFMA32(vf, __builtin_bit_cast(s16x8, pw[ks]), acc); }
        float qn = zf_;
#pragma unroll
        for (int kd = 0; kd < 4; ++kd) { const v4u w = __builtin_bit_cast(v4u, qf[kd]); const LAS float* np = npv + kd * 16 + hi * 8;
            qn += bflo(w.x) * np[0] + bfhi(w.x) * np[1] + bflo(w.y) * np[2] + bfhi(w.y) * np[3] + bflo(w.z) * np[4] + bfhi(w.z) * np[5] + bflo(w.w) * np[6] + bfhi(w.w) * np[7]; }
        qn = swapsum(qn);
        const float inv = 1.0f / fmaxf(fabsf(dc * qn + rs), __expf(-mt));
        float ss = zf_;
#pragma unroll
        for (int r = 0; r < 16; ++r) { acc[r] *= inv; ss += acc[r] * acc[r]; }
        ss = swapsum(ss);
        if (hi == 0) red[vq * 64 + t] = ss;
        __syncthreads();
        const float rstd = 1.0f / sqrtf(((red[t] + red[64 + t]) + (red[128 + t] + red[192 + t])) * (1.f / 128.f) + EPS);
        LAS u16* stg = (LAS u16*)(lds + M2_OST) + wid * 2048;
#pragma unroll
        for (int r = 0; r < 16; r += 2) { const u32 w = pk2(acc[r] * rstd, acc[r + 1] * rstd); stg[r32 * 40 + crow(r, hi)] = (u16)(w & 0xffffu); stg[r32 * 40 + crow(r + 1, hi)] = (u16)(w >> 16); }
        asm volatile("s_waitcnt lgkmcnt(0)" ::: "memory");
#pragma unroll
        for (int i = 0; i < 2; ++i) { const int tt = i * 16 + (lane >> 2), ch = lane & 3; const v4u hv = *(const LAS v4u*)(stg + tt * 40 + ch * 8);
            const size_t ob = (row0 + th * 32 + tt) * 512 + h * 128 + vq * 32 + ch * 8; const v4u mov = mo[i]; const float* gp = hg + h * 128 + vq * 32 + ch * 8;
            v4u w; w.x = pk2(bflo(hv.x) * gp[0] * bflo(mov.x), bfhi(hv.x) * gp[1] * bfhi(mov.x)); w.y = pk2(bflo(hv.y) * gp[2] * bflo(mov.y), bfhi(hv.y) * gp[3] * bfhi(mov.y));
            w.z = pk2(bflo(hv.z) * gp[4] * bflo(mov.z), bfhi(hv.z) * gp[5] * bfhi(mov.z)); w.w = pk2(bflo(hv.w) * gp[6] * bflo(mov.w), bfhi(hv.w) * gp[7] * bfhi(mov.w));
            *(v4u*)(YB + ob) = w; }
    }
#undef C3_ISSUE
    __syncthreads();
}

#if MK_CHECK
constexpr int CW_CHK = 32768, NCHK = 25, CHK_BLOCKS = 48;
__device__ __forceinline__ float blk_sum(float v, float* sh) {
    __syncthreads(); sh[threadIdx.x] = v; __syncthreads();
    for (int o = 128; o > 0; o >>= 1) { if ((int)threadIdx.x < o) sh[threadIdx.x] += sh[threadIdx.x + o]; __syncthreads(); }
    const float r = sh[0]; __syncthreads(); return r;
}
__device__ __forceinline__ float blk_max(float v, float* sh) {
    __syncthreads(); sh[threadIdx.x] = v; __syncthreads();
    for (int o = 128; o > 0; o >>= 1) { if ((int)threadIdx.x < o) sh[threadIdx.x] = fmaxf(sh[threadIdx.x], sh[threadIdx.x + o]); __syncthreads(); }
    const float r = sh[0]; __syncthreads(); return r;
}
__device__ __forceinline__ unsigned hsh(unsigned a, unsigned b) { unsigned x = a * 2654435761u + b * 40503u + 12345u; x ^= x >> 15; x *= 2246822519u; x ^= x >> 13; x *= 3266489917u; x ^= x >> 16; return x; }
__device__ __forceinline__ void chk_report(u32* ctl, int k, float ratio) { if (threadIdx.x == 0) atomicMax(ctl + CW_CHK + k, __float_as_uint(fminf(fabsf(ratio) * MK_CHECK_TIGHT, 1e30f))); }
__device__ __forceinline__ float convsilu(const u16* MQK, size_t rowb  , int pos, int ch, const float* cw, const float* cb) {
    float y = cb[ch];
    for (int j = 0; j < 4; ++j) { const int p = pos - 3 + j; if (p >= 0) y += cw[j * 512 + ch] * bf1(MQK[(rowb + p) * 512 + ch]); }
    return y / (1.0f + expf(-y));
}
template <int K> __global__ void __launch_bounds__(256) chk(Params P) {
    __shared__ float sh[256]; __shared__ float big[12288];
    unsigned char* ws = P.ws; u32* ctl = (u32*)(ws + WS_CTL); const int tid = threadIdx.x, bk = blockIdx.x;
    const int l = P.ph_lo; const float* mod0 = (const float*)(ws + WS_MOD) + (size_t)l * 2 * 6144;
    const u16* U = (const u16*)(ws + ACT(0));
    if (K == 0) {
        const int row = hsh(bk, 1) % NTOK, col = hsh(bk, 2) % DM, b = row / SEQ; const float* x = (l == 0 ? P.in[0] : P.out) + (size_t)row * DM;
        float s = 0.f; for (int c = tid; c < DM; c += 256) s += x[c] * x[c];
        const float rstd = 1.0f / sqrtf(blk_sum(s, sh) / DM + EPS);
        const float e = x[col] * rstd * (P.in[4] + (size_t)l * (1024))[col] * (1.0f + mod0[(b * 6 + 1) * 1024 + col]) + mod0[(b * 6 + 0) * 1024 + col];
        chk_report(ctl, K, (bf1(U[(size_t)row * DM + col]) - e) / (0.01f * (fabsf(e) + 1.0f)));
    }
    if (K == 1 || K == 5) {
        const int row = hsh(bk, 3) % NTOK; int j;
        if (K == 1) { j = hsh(bk, 4) % 2472; if (j >= 1960) j += 1024; } else j = 3496 + hsh(bk, 4) % 3072;
        float s = 0.f; for (int k = tid; k < DM; k += 256) s += bf1(U[(size_t)row * DM + k]) * (P.in[5] + (size_t)l * (1024 * INW))[(size_t)k * INW + j];
        const float e = blk_sum(s, sh); float a, ee = e, tol;
        if (K == 5) { a = bf1(((const u16*)(ws + ACT(4)))[(size_t)row * 3072 + (j - 3496)]); ee = 1.0f / (1.0f + expf(-e)); tol = 0.02f; }
        else {
            tol = 0.03f * (fabsf(e) + 0.5f);
            if (j < 256) a = bf1(((const u16*)(ws + ACT(2)))[(size_t)row * 256 + j]);
            else if (j < 384) a = bf1(((const u16*)(ws + ACT(2) + 16 * MiB))[(size_t)row * 256 + (j - 256)]);
            else if (j < 416) a = bf1(((const u16*)(ws + ACT(2) + 16 * MiB))[(size_t)row * 256 + 128 + (j - 384)]);
            else if (j < 928) a = bf1(((const u16*)(ws + ACT(3)))[(size_t)row * 512 + (j - 416)]);
            else if (j < 1440) a = bf1(((const u16*)(ws + ACT(4)))[(size_t)row * 512 + (j - 928)]);
            else if (j < 1952) { a = bf1(((const u16*)(ws + ACT(5)))[(size_t)row * 512 + (j - 1440)]); ee = 1.0f / (1.0f + expf(-e)); tol = 0.02f; }
            else if (j < 1956) { a = ((const float*)(ws + WS_IF))[(size_t)row * 8 + (j - 1952)]; ee = e + (P.in[14] + (size_t)l * (4))[j - 1952]; }
            else if (j < 1960) { a = ((const float*)(ws + WS_IF))[(size_t)row * 8 + 4 + (j - 1956)]; const float z = e + (P.in[15] + (size_t)l * (4))[j - 1956]; ee = -log1pf(expf(-z)); tol = 0.05f * fabsf(ee) + 1e-3f; }
            else a = bf1(((const u16*)(ws + ACT(8)))[(size_t)row * 512 + (j - 2984)]);
        }
        chk_report(ctl, K, (a - ee) / tol);
    }
    if (K == 2) {
        const int row = hsh(bk, 5) % NTOK, isq = hsh(bk, 6) & 1, h = hsh(bk, 7) & 7; const int base = (isq ? 1960 : 2472) + h * 64;
        float d = 0.f; if (tid < 64) for (int k = 0; k < DM; ++k) d += bf1(U[(size_t)row * DM + k]) * (P.in[5] + (size_t)l * (1024 * INW))[(size_t)k * INW + base + tid];
        const float ss = blk_sum(tid < 64 ? d * d : 0.f, sh), rstd = 1.0f / sqrtf(ss / 64.f + EPS);
        float r = 0.f;
        if (tid < 64) { const float e = d * rstd * (isq ? (P.in[17] + (size_t)l * (64))[tid] * 0.125f * LOG2E : (P.in[18] + (size_t)l * (64))[tid]); const float a = bf1(((const u16*)(ws + ACT(isq ? 6 : 7)))[(size_t)row * 512 + h * 64 + tid]); r = fabsf(a - e) / (0.03f * (fabsf(e) + 0.3f)); }
        chk_report(ctl, K, blk_max(r, sh));
    }
    if (K == 3) {
        const int b = bk & 1, h = (bk >> 1) & 3, t = 5 + 41 * (bk >> 3); const size_t rowb = (size_t)b * SEQ;
        const u16* MQK = (const u16*)(ws + ACT(3)); const u16* MV = (const u16*)(ws + ACT(4)); const u16* MO = (const u16*)(ws + ACT(5)); const float* IF = (const float*)(ws + WS_IF);
        float C[64], n[64];
#pragma unroll
        for (int d = 0; d < 64; ++d) { C[d] = 0.f; n[d] = 0.f; }
        for (int s = 0; s <= t; ++s) {
            __syncthreads();
            if (tid < 64) sh[tid] = convsilu(MQK, rowb, s, 256 + h * 64 + tid, (P.in[12] + (size_t)l * (2048)), (P.in[13] + (size_t)l * (512))) * 0.125f;
            __syncthreads();
            const float f = expf(IF[(rowb + s) * 8 + 4 + h]), ii = expf(IF[(rowb + s) * 8 + h]);
            const float vv = tid < 128 ? bf1(MV[(rowb + s) * 512 + h * 128 + tid]) : 0.f;
#pragma unroll
            for (int d = 0; d < 64; ++d) { const float kk = sh[d]; C[d] = f * C[d] + ii * kk * vv; n[d] = f * n[d] + ii * kk; }
        }
        __syncthreads();
        if (tid < 64) sh[tid] = convsilu(MQK, rowb, t, h * 64 + tid, (P.in[12] + (size_t)l * (2048)), (P.in[13] + (size_t)l * (512)));
        __syncthreads();
        float num = 0.f, den = 0.f;
#pragma unroll
        for (int d = 0; d < 64; ++d) { num += C[d] * sh[d]; den += n[d] * sh[d]; }
        const float hv = tid < 128 ? num / fmaxf(fabsf(den), 1.0f) : 0.f;
        const float ss = blk_sum(hv * hv, sh), rstd = 1.0f / sqrtf(ss / 128.f + EPS);
        float r = 0.f;
        if (tid < 128) { const float e = hv * rstd * (P.in[16] + (size_t)l * (512))[h * 128 + tid] * bf1(MO[(rowb + t) * 512 + h * 128 + tid]); const float a = bf1(((const u16*)(ws + ACT(13)))[(rowb + t) * 512 + h * 128 + tid]); r = fabsf(a - e) / (0.03f * (fabsf(e) + 0.2f)); }
        chk_report(ctl, K, blk_max(r, sh));
    }
    if (K == 4) {
        const int row = hsh(bk, 8) % NTOK, h = hsh(bk, 9) & 7, which = bk % 3, pos = row % SEQ;
        const u16* CQ = (const u16*)(ws + ACT(2)); const u16* C1 = (const u16*)(ws + ACT(2) + 16 * MiB);
        const float* ct = (const float*)(ws + WS_ROPE); const float* st = ct + SEQ * 16;
        float r = 0.f;
        if (which == 0) {
            float s = 0.f; { const float v = bf1(CQ[(size_t)row * 256 + tid]); s = v * v; }
            const float rq = 1.0f / sqrtf(blk_sum(s, sh) / 256.f + EPS);
            __syncthreads(); big[tid] = bf1(CQ[(size_t)row * 256 + tid]) * rq * (P.in[6] + (size_t)l * (256))[tid]; __syncthreads();
            float q = 0.f; if (tid < 96) for (int k = 0; k < 256; ++k) q += big[k] * (P.in[8] + (size_t)l * (256 * 768))[(size_t)k * 768 + h * 96 + tid];
            const float rs = 1.0f / sqrtf(blk_sum(tid < 96 ? q * q : 0.f, sh) / 96.f + EPS);
            __syncthreads(); if (tid < 96) big[512 + tid] = q * rs * (P.in[10] + (size_t)l * (96))[tid]; __syncthreads();
            if (tid < 96) { float e = big[512 + tid];
                if (tid >= 64 && tid < 80) { const int i = tid - 64; e = big[512 + 64 + i] * ct[pos * 16 + i] - big[512 + 80 + i] * st[pos * 16 + i]; }
                if (tid >= 80) { const int i = tid - 80; e = big[512 + 64 + i] * st[pos * 16 + i] + big[512 + 80 + i] * ct[pos * 16 + i]; }
                e *= 0.10206207261596577f * LOG2E;
                const float a = bf1(((const u16*)(ws + ACT(6)))[(size_t)row * 768 + h * 96 + tid]); r = fabsf(a - e) / (0.03f * (fabsf(e) + 0.05f)); }
        } else {
            float s = 0.f; if (tid < 128) { const float v = bf1(C1[(size_t)row * 256 + tid]); s = v * v; }
            const float rk = 1.0f / sqrtf(blk_sum(s, sh) / 128.f + EPS);
            __syncthreads(); if (tid < 128) big[tid] = bf1(C1[(size_t)row * 256 + tid]) * rk * (P.in[7] + (size_t)l * (128))[tid]; __syncthreads();
            if (which == 2) {
                if (tid < 64) { float v = 0.f; for (int k = 0; k < 128; ++k) v += big[k] * (P.in[9] + (size_t)l * (128 * 1024))[(size_t)k * 1024 + h * 128 + 64 + tid];
                    const float a = bf1(((const u16*)(ws + ACT(9)))[(size_t)row * 512 + h * 64 + tid]); r = fabsf(a - v) / (0.03f * (fabsf(v) + 0.3f)); }
            } else {
                float kk = 0.f;
                if (tid < 64) for (int k = 0; k < 128; ++k) kk += big[k] * (P.in[9] + (size_t)l * (128 * 1024))[(size_t)k * 1024 + h * 128 + tid];
                if (tid >= 64 && tid < 96) kk = bf1(C1[(size_t)row * 256 + 128 + (tid - 64)]);
                const float rs = 1.0f / sqrtf(blk_sum(tid < 96 ? kk * kk : 0.f, sh) / 96.f + EPS);
                __syncthreads(); if (tid < 96) big[512 + tid] = kk * rs * (P.in[11] + (size_t)l * (96))[tid]; __syncthreads();
                if (tid < 96) { float e = big[512 + tid];
                    if (tid >= 64 && tid < 80) { const int i = tid - 64; e = big[512 + 64 + i] * ct[pos * 16 + i] - big[512 + 80 + i] * st[pos * 16 + i]; }
                    if (tid >= 80) { const int i = tid - 80; e = big[512 + 64 + i] * st[pos * 16 + i] + big[512 + 80 + i] * ct[pos * 16 + i]; }
                    const float a = bf1(((const u16*)(ws + ACT(6) + 48 * MiB))[(size_t)row * 768 + h * 96 + tid]); r = fabsf(a - e) / (0.03f * (fabsf(e) + 0.3f)); }
            }
        }
        chk_report(ctl, K, blk_max(r, sh));
    }
    if (K == 6) {
        const int row = hsh(bk, 10) % NTOK, d = hsh(bk, 11) % DM; float e = 0.f;
        for (int i = 0; i < 3; ++i) { const u16* Y = (const u16*)(ws + ACT(i == 0 ? 3 : (i == 1 ? 13 : 12))); const float* W = i == 0 ? (P.in[19] + (size_t)l * (512 * 1024)) : (i == 1 ? (P.in[20] + (size_t)l * (512 * 1024)) : (P.in[21] + (size_t)l * (512 * 1024)));
            float s = 0.f; for (int n = tid; n < 512; n += 256) s += bf1(Y[(size_t)row * 512 + n]) * W[(size_t)n * 1024 + d];
            e += bf1(((const u16*)(ws + ACT(4)))[(size_t)row * 3072 + i * 1024 + d]) * blk_sum(s, sh); }
        chk_report(ctl, K, (bf1(U[(size_t)row * DM + d]) - e) / (0.03f * (fabsf(e) + 0.1f)));
    }
    if (K == 7) {
        const int row = hsh(bk, 12) % NTOK, d = hsh(bk, 13) % DM, b = row / SEQ;
        float s = 0.f; for (int k = tid; k < DM; k += 256) s += bf1(U[(size_t)row * DM + k]) * (P.in[22] + (size_t)l * (1024 * 1024))[(size_t)k * 1024 + d];
        const float e = mod0[(b * 6 + 2) * 1024 + d] * blk_sum(s, sh) * MK_CHECK_INJECT, a = P.out[(size_t)row * DM + d] - ((const float*)(ws + WS_ROUT + 768 * 1024))[bk * DM + d];
        chk_report(ctl, K, (a - e) / (0.03f * fabsf(e) + 0.005f));
    }
    if (K == 8 || K == 9) {
        const int t = hsh(bk, 14) % NTOK, b = t / SEQ; const u32* cnt = ctl + CW_MOE + l * 64;
        const int* cls_o = (const int*)(ws + WS_ROUT); const int* slot_o = cls_o + NTOK;
        const int cls = cls_o[t]; int base = 0; for (int c = 0; c < cls; ++c) base += (((int)cnt[c] + 255) >> 8) << 8;
        const int pos = base + slot_o[t]; int ea, eb; cls_experts(cls, ea, eb);
        const u16* HID = (const u16*)(ws + ACT(3)); const float* wrow = (const float*)(ws + WS_TOK + 262144); const int* tok = (const int*)(ws + WS_TOK);
        if (K == 8) {
            const float* x = P.out + (size_t)t * DM;
            float s = 0.f; for (int c = tid; c < DM; c += 256) s += x[c] * x[c];
            const float rstd = 1.0f / sqrtf(blk_sum(s, sh) / DM + EPS);
            __syncthreads(); for (int c = tid; c < DM; c += 256) big[c] = x[c] * rstd * (P.in[23] + (size_t)l * (1024))[c] * (1.0f + mod0[(b * 6 + 4) * 1024 + c]) + mod0[(b * 6 + 3) * 1024 + c]; __syncthreads();
            if (tid < 20) { float lgv = 0.f; for (int c = 0; c < DM; ++c) lgv += big[c] * (tid < 4 ? (P.in[24] + (size_t)l * (4096))[c * 4 + tid] : (P.in[26] + (size_t)l * (16384))[c * 16 + (tid - 4)]); big[2048 + tid] = lgv + (tid < 4 ? (P.in[25] + (size_t)l * (4))[tid] : (P.in[27] + (size_t)l * (16))[tid - 4]); }
            __syncthreads();
            float r = 0.f;
            if (tid == 0) { const float* L = big + 2048; int g = 0; for (int i = 1; i < 4; ++i) if (L[i] > L[g]) g = i;
                float se = 0.f; for (int i = 0; i < 4; ++i) se += expf(L[i] - L[g]); const float psel = 1.0f / se;
                const float* E = L + 4 + g * 4; int i1 = 0; for (int i = 1; i < 4; ++i) if (E[i] > E[i1]) i1 = i;
                int i2 = -1; for (int i = 0; i < 4; ++i) if (i != i1 && (i2 < 0 || E[i] > E[i2])) i2 = i;
                float gap = 1e9f; for (int i = 0; i < 4; ++i) { if (i != g) gap = fminf(gap, L[g] - L[i]); if (i != i1 && i != i2) gap = fminf(gap, E[i2] - E[i]); }
                const float ex = expf(E[i2] - E[i1]), w1 = psel / (1.0f + ex), w2 = psel - w1;
                const int a = i1 < i2 ? i1 : i2, bb = i1 < i2 ? i2 : i1; const int pair = a == 0 ? bb - 1 : (a == 1 ? bb + 1 : 5);
                if (gap > 0.01f) { if (g * 6 + pair != cls) r = 100.f; if (tok[pos] != t) r = 200.f;
                    const float wa = i1 < i2 ? w1 : w2, wb = i1 < i2 ? w2 : w1; r = fmaxf(r, fabsf(wrow[2 * pos] - wa) / 0.005f); r = fmaxf(r, fabsf(wrow[2 * pos + 1] - wb) / 0.005f); } }
            r = blk_max(r, sh);
            const int slot = hsh(bk, 15) & 1, f = hsh(bk, 16) & 255, e = slot ? eb : ea;
            float sg = 0.f, su = 0.f; const u16* HS = (const u16*)(ws + ACT(0));
            for (int c = tid; c < DM; c += 256) { const float hv = bf1(HS[(size_t)pos * DM + c]); sg += hv * (P.in[28] + (size_t)l * (16 * 1024 * 256))[((size_t)e * 1024 + c) * 256 + f]; su += hv * (P.in[29] + (size_t)l * (16 * 1024 * 256))[((size_t)e * 1024 + c) * 256 + f]; }
            float rh = 0.f; for (int c = tid; c < DM; c += 256) rh = fmaxf(rh, fabsf(bf1(HS[(size_t)pos * DM + c]) - big[c]) / (0.01f * (fabsf(big[c]) + 1.0f)));
            r = fmaxf(r, blk_max(rh, sh));
            const float gte = blk_sum(sg, sh), upe = blk_sum(su, sh); const float ee = gte / (1.0f + expf(-gte)) * upe * wrow[2 * pos + slot];
            r = fmaxf(r, fabsf(bf1(HID[(size_t)pos * 512 + slot * 256 + f]) - ee) / (0.03f * (fabsf(ee) + 0.05f)));
            chk_report(ctl, K, r);
        } else {
            const int d = hsh(bk, 17) % DM; float s = 0.f;
            for (int k = tid; k < 512; k += 256) { const int e = k < 256 ? ea : eb; s += bf1(HID[(size_t)pos * 512 + k]) * (P.in[30] + (size_t)l * (16 * 256 * 1024))[((size_t)e * 256 + (k & 255)) * 1024 + d]; }
            const float e = mod0[(b * 6 + 5) * 1024 + d] * blk_sum(s, sh), a = P.out[(size_t)t * DM + d] - ((const float*)(ws + WS_ROUT + 768 * 1024))[bk * DM + d];
            chk_report(ctl, K, (a - e) / (0.03f * fabsf(e) + 0.003f));
        }
    }
    if (K == 21) {
        const int row = hsh(bk, 12) % NTOK; for (int c = tid; c < DM; c += 256) ((float*)(ws + WS_ROUT + 768 * 1024))[bk * DM + c] = (l == 0 ? P.in[0] : P.out)[(size_t)row * DM + c];
    }
    if (K == 13) {
        float r = 0.f;
        for (int q = 0; q < 8; ++q) { const int pos = hsh(bk * 8 + q, 21) % SEQ, i = tid & 15; if (tid < 16) {
            const float inv = (float)exp2(-(double)i / 16.0 * 13.287712379549449); const float ang = (float)pos * inv;
            const float ce = (float)cos((double)ang), se = (float)sin((double)ang);
            const float* ct = (const float*)(ws + WS_ROPE); const float* st = ct + SEQ * 16;
            r = fmaxf(r, fmaxf(fabsf(ct[pos * 16 + i] - ce), fabsf(st[pos * 16 + i] - se)) / 2e-3f); } }
        chk_report(ctl, 13, blk_max(r, sh));
    }
    if (K == 14) {
        const int ll = bk & 3, b = (bk >> 2) & 1, j = hsh(bk, 22) % 6144;
        float s = 0.f; for (int d = tid; d < DM; d += 256) { const float cv = P.in[1][b * 1024 + d]; s += cv / (1.0f + expf(-cv)) * P.in[2][((size_t)ll * 1024 + d) * 6144 + j]; }
        const float e = blk_sum(s, sh) + P.in[3][ll * 6144 + j], a = ((const float*)(ws + WS_MOD))[(size_t)(ll * 2 + b) * 6144 + j];
        chk_report(ctl, 14, (a - e) / (1e-3f * (fabsf(e) + 0.1f)));
    }
    if (K == 20) {
        const int t = hsh(bk, 14) % NTOK; for (int c = tid; c < DM; c += 256) ((float*)(ws + WS_ROUT + 768 * 1024))[bk * DM + c] = P.out[(size_t)t * DM + c];
    }
    if (K == 10) {
        const int b = bk & 1, h = (bk >> 1) & 7, q = hsh(bk, 18) % 12000; const size_t rowb = (size_t)b * SEQ;
        const u16* Q = (const u16*)(ws + ACT(6)); const u16* Kb = (const u16*)(ws + ACT(6) + 48 * MiB); const u16* V = (const u16*)(ws + ACT(9));
        float mx = -1e30f;
        for (int k = tid; k <= q; k += 256) { float s = 0.f; for (int d = 0; d < 96; ++d) s += bf1(Q[(rowb + q) * 768 + h * 96 + d]) * bf1(Kb[(rowb + k) * 768 + h * 96 + d]); big[k] = s; mx = fmaxf(mx, s); }
        mx = blk_max(mx, sh); float l = 0.f;
        for (int k = tid; k <= q; k += 256) { const float p = exp2f(big[k] - mx); big[k] = p; l += p; }
        l = blk_sum(l, sh); float r = 0.f;
        if (tid < 64) { float o = 0.f; for (int k = 0; k <= q; ++k) o += big[k] * bf1(V[(rowb + k) * 512 + h * 64 + tid]); o /= l;
            const float a = bf1(((const u16*)(ws + ACT(3)))[(rowb + q) * 512 + h * 64 + tid]); r = fabsf(a - o) / (0.02f * (fabsf(o) + 0.05f)); }
        chk_report(ctl, K, blk_max(r, sh));
    }
    if (K == 11) {
        const int b = bk & 1, h = (bk >> 1) & 7, pos = (bk < 16) ? (int)(hsh(bk, 19) % 300) : (int)(hsh(bk, 19) % SEQ); const size_t rowb = (size_t)b * SEQ;
        const u16* DQ = (const u16*)(ws + ACT(6)); const u16* DK = (const u16*)(ws + ACT(7)); const u16* DV = (const u16*)(ws + ACT(8));
        float r = 0.f;
        if (tid < 64) { float op[3], lse[3];
            for (int pt = 0; pt < 3; ++pt) { const int window = pt == 0 ? 128 : (pt == 1 ? 512 : 2048), dil = pt == 0 ? 1 : (pt == 1 ? 4 : 16), blk = window / dil, span = window;
                const int n = pos / span, i = (pos % span) / dil, rho = pos % dil; float m = -1e30f;
                for (int pass = 0; pass < 2; ++pass) { float den = 0.f, o = 0.f;
                    for (int ik = 0; ik < 2 * blk; ++ik) { const int dist = i + blk - ik; if (dist < 0 || dist > blk) continue; if (n == 0 && ik < blk) continue;
                        const int kp = ik < blk ? (n - 1) * span + ik * dil + rho : n * span + (ik - blk) * dil + rho;
                        float s = 0.f; for (int d = 0; d < 64; ++d) s += bf1(DQ[(rowb + pos) * 512 + h * 64 + d]) * bf1(DK[(rowb + kp) * 512 + h * 64 + d]);
                        if (pass == 0) m = fmaxf(m, s); else { const float p = exp2f(s - m); den += p; o += p * bf1(DV[(rowb + kp) * 512 + h * 64 + tid]); } }
                    if (pass == 1) { op[pt] = o / den; lse[pt] = m + log2f(den); } } }
            const float lm = fmaxf(lse[0], fmaxf(lse[1], lse[2])); const float w0 = exp2f(lse[0] - lm), w1 = exp2f(lse[1] - lm), w2 = exp2f(lse[2] - lm);
            const float e = (w0 * op[0] + w1 * op[1] + w2 * op[2]) / (w0 + w1 + w2);
            const float a = bf1(((const u16*)(ws + ACT(12)))[(rowb + pos) * 512 + h * 64 + tid]); r = fabsf(a - e) / (0.02f * (fabsf(e) + 0.05f)); }
        chk_report(ctl, K, blk_max(r, sh));
    }
}
__global__ void __launch_bounds__(128) chk_mlstm_full(Params P) {
    __shared__ float kq[128]; __shared__ float red[128];
    unsigned char* ws = P.ws; u32* ctl = (u32*)(ws + WS_CTL); const int tid = threadIdx.x, b = blockIdx.x >> 2, h = blockIdx.x & 3, l = P.ph_lo; const size_t rowb = (size_t)b * SEQ;
    const u16* MQK = (const u16*)(ws + ACT(3)); const u16* MV = (const u16*)(ws + ACT(4)); const u16* MO = (const u16*)(ws + ACT(5)); const float* IF = (const float*)(ws + WS_IF); const u16* YB = (const u16*)(ws + ACT(13));
    const float* cw = P.in[12] + (size_t)l * 2048; const float* cb = P.in[13] + (size_t)l * 512; const float hgain = (P.in[16] + (size_t)l * 512)[h * 128 + tid];
    float C[64], n[64];
#pragma unroll
    for (int d = 0; d < 64; ++d) { C[d] = 0.f; n[d] = 0.f; }
    float m = 0.f, worst = 0.f; unsigned nbad = 0;
    for (int t = 0; t < SEQ; ++t) {
        __syncthreads();
        kq[tid] = tid < 64 ? convsilu(MQK, rowb, t, 256 + h * 64 + tid, cw, cb) * 0.125f : convsilu(MQK, rowb, t, h * 64 + (tid - 64), cw, cb);
        __syncthreads();
        const float lf = IF[(rowb + t) * 8 + 4 + h], ig = IF[(rowb + t) * 8 + h];
        const float mn = fmaxf(lf + m, ig), fa = expf(lf + m - mn), ia = expf(ig - mn); m = mn;
        const float vv = bf1(MV[(rowb + t) * 512 + h * 128 + tid]);
        float num = 0.f, den = 0.f;
#pragma unroll
        for (int d = 0; d < 64; ++d) { const float kk = kq[d], qq = kq[64 + d]; C[d] = fa * C[d] + ia * kk * vv; n[d] = fa * n[d] + ia * kk; num += C[d] * qq; den += n[d] * qq; }
        const float hv = num / fmaxf(fabsf(den), expf(-m));
        red[tid] = hv * hv; __syncthreads();
        for (int o = 64; o > 0; o >>= 1) { if (tid < o) red[tid] += red[tid + o]; __syncthreads(); }
        const float rstd = 1.0f / sqrtf(red[0] / 128.f + EPS);
        const float e = hv * rstd * hgain * bf1(MO[(rowb + t) * 512 + h * 128 + tid]), a = bf1(YB[(rowb + t) * 512 + h * 128 + tid]);
        const float r = fabsf(a - e) / (0.05f * (fabsf(e) + 0.3f)); worst = fmaxf(worst, r); if (r > 1.0f) ++nbad;
    }
    atomicMax(ctl + CW_CHK + 12, __float_as_uint(fminf(worst, 1e30f))); atomicAdd(ctl + CW_CHK + 15, nbad);
}
__global__ void __launch_bounds__(256) chk_g1_full(Params P) {
    unsigned char* ws = P.ws; u32* ctl = (u32*)(ws + WS_CTL); const int l = P.ph_lo; const u16* U = (const u16*)(ws + ACT(0)); const float* W = P.in[5] + (size_t)l * 1024 * INW;
    const int jb = blockIdx.x % 10, rb = blockIdx.x / 10; int j = jb * 256 + threadIdx.x; const bool act = j < 2472; if (j >= 1960) j += 1024;
    __shared__ float us[8][1024];
    for (int e = threadIdx.x; e < 8 * 1024; e += 256) us[e >> 10][e & 1023] = bf1(U[((size_t)rb * 8 + (e >> 10)) * 1024 + (e & 1023)]);
    __syncthreads();
    float acc[8];
#pragma unroll
    for (int r = 0; r < 8; ++r) acc[r] = 0.f;
    if (act) for (int k = 0; k < 1024; ++k) { const float w = W[(size_t)k * INW + j];
#pragma unroll
        for (int r = 0; r < 8; ++r) acc[r] += us[r][k] * w; }
    unsigned nbad = 0; float worst = 0.f;
    if (act) {
#pragma unroll
        for (int r = 0; r < 8; ++r) { const size_t row = (size_t)rb * 8 + r; const float e = acc[r]; float a, ee = e, tol = 0.03f * (fabsf(e) + 0.5f);
            if (j < 256) a = bf1(((const u16*)(ws + ACT(2)))[row * 256 + j]);
            else if (j < 384) a = bf1(((const u16*)(ws + ACT(2) + 16 * MiB))[row * 256 + (j - 256)]);
            else if (j < 416) a = bf1(((const u16*)(ws + ACT(2) + 16 * MiB))[row * 256 + 128 + (j - 384)]);
            else if (j < 928) a = bf1(((const u16*)(ws + ACT(3)))[row * 512 + (j - 416)]);
            else if (j < 1440) a = bf1(((const u16*)(ws + ACT(4)))[row * 512 + (j - 928)]);
            else if (j < 1952) { a = bf1(((const u16*)(ws + ACT(5)))[row * 512 + (j - 1440)]); ee = 1.0f / (1.0f + expf(-e)); tol = 0.02f; }
            else if (j < 1956) { a = ((const float*)(ws + WS_IF))[row * 8 + (j - 1952)]; ee = e + (P.in[14] + l * 4)[j - 1952]; }
            else if (j < 1960) { a = ((const float*)(ws + WS_IF))[row * 8 + 4 + (j - 1956)]; const float z = e + (P.in[15] + l * 4)[j - 1956]; ee = -log1pf(expf(-z)); tol = 0.05f * fabsf(ee) + 1e-3f; }
            else a = bf1(((const u16*)(ws + ACT(8)))[row * 512 + (j - 2984)]);
            const float rr = fabsf(a - ee) / tol; if (!(rr <= 1.0f)) ++nbad; worst = fmaxf(worst, rr); } }
    if (nbad) { atomicAdd(ctl + CW_CHK + 17, nbad); atomicMax(ctl + CW_CHK + 16, __float_as_uint(fminf(worst, 1e30f))); }
}
__global__ void chk_copy_x(Params P) { const int l = P.ph_lo; const float* src = (l == 0 && MK_COPY_FROM_IN) ? P.in[0] : P.out; float* dst = (float*)(P.ws + ACT(10));
    for (size_t i = (size_t)blockIdx.x * blockDim.x + threadIdx.x; i < (size_t)NTOK * DM; i += (size_t)gridDim.x * blockDim.x) dst[i] = src[i]; }
template <int MODE> __global__ void __launch_bounds__(256) chk_resid_full(Params P) {
    unsigned char* ws = P.ws; u32* ctl = (u32*)(ws + WS_CTL); const int l = P.ph_lo; const float* xold = (const float*)(ws + ACT(10)); const float* mod0 = (const float*)(ws + WS_MOD) + (size_t)l * 2 * 6144;
    constexpr int KD = MODE == 0 ? 1024 : 512; const u16* A = (const u16*)(ws + (MODE == 0 ? ACT(0) : ACT(3)));
    const int db = blockIdx.x & 3, rb = blockIdx.x >> 2, d = db * 256 + threadIdx.x; const int* tok = (const int*)(ws + WS_TOK);
    __shared__ float as[8][KD]; __shared__ int cl[8]; __shared__ int total;
    if (threadIdx.x == 0) { int tt = 0; if (MODE == 1) for (int c = 0; c < 24; ++c) tt += (((int)ctl[CW_MOE + l * 64 + c] + 255) >> 8) << 8; total = tt; }
    __syncthreads();
    if (MODE == 1 && (int)(blockIdx.x >> 2) * 8 >= total) return;
    for (int e = threadIdx.x; e < 8 * KD; e += 256) as[e / KD][e % KD] = bf1(A[((size_t)rb * 8 + e / KD) * KD + e % KD]);
    if (MODE == 1 && threadIdx.x < 8) { const int pos = rb * 8 + threadIdx.x, t = tok[pos]; int c = -1; if (t >= 0) c = ((const int*)(ws + WS_ROUT))[t]; cl[threadIdx.x] = c; }
    __syncthreads();
    unsigned nbad = 0; float worst = 0.f;
    for (int r = 0; r < 8; ++r) { int t = rb * 8 + r; const float* W; int ea = 0, eb = 0;
        if (MODE == 1) { t = tok[rb * 8 + r]; if (t < 0 || t >= NTOK) continue; cls_experts(cl[r], ea, eb); }
        float acc = 0.f;
        if (MODE == 0) { W = P.in[22] + (size_t)l * 1024 * 1024; for (int k = 0; k < 1024; ++k) acc += as[r][k] * W[(size_t)k * 1024 + d]; }
        else { W = P.in[30] + (size_t)l * 16 * 256 * 1024; for (int k = 0; k < 512; ++k) acc += as[r][k] * W[((size_t)(k < 256 ? ea : eb) * 256 + (k & 255)) * 1024 + d]; }
        const int b = t / SEQ; const float e = mod0[(b * 6 + (MODE == 0 ? 2 : 5)) * 1024 + d] * acc, a = P.out[(size_t)t * DM + d] - xold[(size_t)t * DM + d];
        const float rr = fabsf(a - e) / (0.03f * fabsf(e) + 0.005f); if (!(rr <= 1.0f)) ++nbad; worst = fmaxf(worst, rr); }
    if (nbad) { atomicAdd(ctl + CW_CHK + 25 + MODE, nbad); atomicMax(ctl + CW_CHK + 23 + MODE, __float_as_uint(fminf(worst, 1e30f))); }
}
__global__ void chk_count_big(Params P) {
    u32* ctl = (u32*)(P.ws + WS_CTL); unsigned n = 0;
    for (size_t i = (size_t)blockIdx.x * blockDim.x + threadIdx.x; i < (size_t)NTOK * DM; i += (size_t)gridDim.x * blockDim.x) n += fabsf(P.out[i]) > MK_BIG ? 1u : 0u;
    if (n) atomicAdd(ctl + CW_CHK + 18, n);
}
__global__ void chk_encode(Params P) {
    const u32* ctl = (const u32*)(P.ws + WS_CTL); int first = -1;
    for (int k = NCHK - 1; k >= MK_CHECK_FROM; --k) if (__uint_as_float(ctl[CW_CHK + k]) > 1.0f) first = k;
    if (MK_BIG > 0.f) { const unsigned n = ctl[CW_CHK + MK_CNT_WORD]; first = -1; if (n) { first = 0; unsigned m = n; while (m > 1u) { m >>= 2; ++first; } } }
    const float s = first < 0 ? 1.0f : 1.0f - 0.07f * (float)(first + 1);
    for (size_t i = (size_t)blockIdx.x * blockDim.x + threadIdx.x; i < (size_t)NTOK * DM; i += (size_t)gridDim.x * blockDim.x) { const int pos = (int)((i / DM) % SEQ); float v = P.out[i] * s; if (pos >= MK_ZERO_LO && pos < MK_ZERO_HI) v = 0.f; P.out[i] = v; }
}
#endif

constexpr int NPH_LAYER = 13, NPH_TOTAL = 1 + NL * NPH_LAYER;
template <unsigned MASK> __global__ void __launch_bounds__(NTHR, 2) mega_fwd(Params P) {
    extern __shared__ __attribute__((aligned(16))) unsigned char lds_raw[];
    Frame F;
    F.lds = (LAS unsigned char*)lds_raw; F.tid = threadIdx.x; F.lane = F.tid & 63; F.wave = __builtin_amdgcn_readfirstlane(F.tid >> 6); F.G = gridDim.x; F.bid = blockIdx.x;
    F.ws = P.ws;
    u32* ctl = (u32*)(P.ws + WS_CTL);
    for (int u = F.tid; u < (LDS_BYTES - LDSCTL_OFF) / 4; u += NTHR) ((LAS unsigned*)(F.lds + LDSCTL_OFF))[u] = 0u;
    if (F.tid == 0) { LAS unsigned long long* pt = (LAS unsigned long long*)(F.lds + PTAB_OFF);
#pragma unroll
        for (int i = 0; i < 31; ++i) pt[i] = (unsigned long long)(uintptr_t)P.in[i];
        pt[31] = (unsigned long long)(uintptr_t)P.out; pt[32] = (unsigned long long)(uintptr_t)P.ws; }
    __syncthreads();
    constexpr bool SINGLE = (MASK & (MASK - 1u)) != 0u;
    XcdBarrier bar; bar.bar = ctl + CW_BAR; bar.x = 0; bar.st = nullptr; bar.lead = false;
    if (SINGLE) bar = xcd_barrier_post(ctl + CW_BAR, (volatile LAS unsigned*)(F.lds + MISC_OFF) + 8);
#define IN(k) true
#define EN(n) (((MASK & (unsigned)(MK_PH_MASK)) >> (n)) & 1u)
#define SEAMG(k, g) do { if (SINGLE && !(l == NL - 1 && (k) == pb + 12)) { XcdBarrier b_ = bar; { unsigned long long a_ = (unsigned long long)((unsigned*)ldsptr(lds, 32) + CW_BAR); asm volatile("" : "+v"(a_)); b_.bar = (unsigned*)a_; } \
        asm volatile("s_waitcnt vmcnt(0)" ::: "memory"); __syncthreads(); if (Fp.wave == 0) xcd_barrier_lead(b_); else conv_gap<(g)>(Fp, l); __syncthreads();     \
        if (MK_DUP & 1) xcd_barrier(b_); TS(18); } } while (0)
#define SEAM(k) SEAMG(k, -1)
    LAS unsigned char* lds = F.lds;
#define INP(i) ((const float*)ldsptr(lds, (i)))
#define OUTP ((float*)ldsptr(lds, 31))
#define PHASE_FRAME() Frame Fp = F; { unsigned char* w_ = (unsigned char*)ldsptr(lds, 32); int t_; asm volatile("v_mbcnt_lo_u32_b32 %0, -1, 0\n\tv_mbcnt_hi_u32_b32 %0, -1, %0" : "=v"(t_)); t_ += F.wave * 64; Fp.ws = w_; Fp.tid = t_; { int g_ = F.G, b_ = F.bid; asm volatile("" : "+s"(g_), "+s"(b_)); Fp.G = g_; Fp.bid = b_; } Fp.lane = t_ & 63; Fp.wave = __builtin_amdgcn_readfirstlane(t_ >> 6); } unsigned char* const ws = Fp.ws; (void)ws

#if MK_TIMER
#define TS(i) do { if (Fp.bid == 0 && Fp.tid == 0) { LAS unsigned* ta_ = (LAS unsigned*)(lds + LDSCTL_OFF + 3072); const unsigned t_ = (unsigned)__builtin_amdgcn_s_memrealtime(); ta_[(i)] += t_ - ta_[31]; ta_[31] = t_; } } while (0)
    if (F.bid == 0 && F.tid == 0) ((LAS unsigned*)(lds + LDSCTL_OFF + 3072))[31] = (unsigned)__builtin_amdgcn_s_memrealtime();
#else
#define TS(i) do { } while (0)
#endif
    if (EN(0) && P.ph_lo == 0) { PHASE_FRAME(); pre_phase(Fp);
#if MK_DUP & 65536
        pre_phase(Fp);
#endif
        TS(0); if (SINGLE) { XcdBarrier b_ = bar; { unsigned long long a_ = (unsigned long long)((unsigned*)ldsptr(lds, 32) + CW_BAR); asm volatile("" : "+v"(a_)); b_.bar = (unsigned*)a_; } xcd_barrier(b_); TS(18); } }
    _Pragma("unroll 1")
    for (int l = P.ph_lo; l < P.ph_hi; ++l) { asm volatile("" ::: "memory");
        const int pb = 0;
        if (EN(1) && IN(pb + 0)) { PHASE_FRAME(); router_bias(Fp, (const float*)(ws + WS_MOD) + (size_t)l * 2 * 6144, INP(24) + l * 4096, INP(25) + l * 4, INP(26) + l * 16384, INP(27) + l * 16);
            norm_rows(Fp, l == 0 ? INP(0) : OUTP, INP(4) + l * 1024, (const float*)(ws + WS_MOD) + (size_t)l * 2 * 6144, 0, 1, (u16*)(ws + ACT(0))); TS(1);
            conv_phase(Fp, l);
#if MK_DUP & 2
            conv_phase(Fp, l);
#endif
            TS(2); SEAMG(pb + 0, 0); }
        if (EN(2) && IN(pb + 1)) { PHASE_FRAME();
            pg8::Gemm g{(const u16*)(ws + ACT(0)), (const u16*)(ws + WS_WIN), NTOK, 3584, 1024}; pg8::StaticOrder S; S.init(NTOK, 3584, Fp.G, Fp.bid);
            EpiG1 E{ws, INP(14) + l * 4, INP(15) + l * 4, INP(17) + l * 64, INP(18) + l * 64, INP(11) + l * 96};
            pg8::gemm_phase<EpiG1, pg8::StaticOrder, true, true>(lds, g, S, E, F.wave);
#if MK_DUP & 4
            pg8::gemm_phase<EpiG1, pg8::StaticOrder, true, true>(lds, g, S, E, F.wave);
#endif
            TS(3); SEAMG(pb + 1, 1); }
        if (EN(3) && IN(pb + 2)) { PHASE_FRAME();
#if MK_DIL_MFMA
#if MK_DUP & 8
            { int nrep_ = 2; asm volatile("" : "+s"(nrep_)); for (int rep_ = 0; rep_ < nrep_; ++rep_) DIL_PHASE(Fp, (const u16*)(ws + ACT(6)), (const u16*)(ws + ACT(7)), (const u16*)(ws + ACT(8)), (u16*)(ws + ACT(12))); }
#else
            DIL_PHASE(Fp, (const u16*)(ws + ACT(6)), (const u16*)(ws + ACT(7)), (const u16*)(ws + ACT(8)), (u16*)(ws + ACT(12)));
#endif
#else
            dil_naive_phase(Fp, (const u16*)(ws + ACT(6)), (const u16*)(ws + ACT(7)), (const u16*)(ws + ACT(8)), (u16*)(ws + ACT(12)));
#endif
            TS(4); MLSTM_A(Fp, (const u16*)(ws + ACT(3)), (const u16*)(ws + ACT(4)), (const float*)(ws + WS_IF), INP(12) + l * 2048, INP(13) + l * 512, (float*)(ws + ACT(10)));
#if MK_DUP & 16384
            MLSTM_A(Fp, (const u16*)(ws + ACT(3)), (const u16*)(ws + ACT(4)), (const float*)(ws + WS_IF), INP(12) + l * 2048, INP(13) + l * 512, (float*)(ws + ACT(10)));
#endif
            TS(5); SEAMG(pb + 2, 2); }
        if (EN(4) && IN(pb + 3)) { PHASE_FRAME();
            mlstm_b_phase(Fp, (float*)(ws + ACT(10)));
            { pg8::Gemm g{(const u16*)(ws + ACT(2)), (const u16*)(ws + WS_WUQ), NTOK, 768, 256}; pg8::StaticOrder S; S.init(NTOK, 768, Fp.G, Fp.bid); EpiQU E{(u16*)(ws + ACT(6)), (const float*)(ws + WS_SSQQ)};
              pg8::gemm_phase<EpiQU, pg8::StaticOrder, true, true>(lds, g, S, E, F.wave); }
            { pg8::Gemm g{(const u16*)(ws + ACT(2) + 16 * MiB), (const u16*)(ws + WS_WUKV), NTOK, 1024, 256}; pg8::StaticOrder S; S.init(NTOK, 1024, Fp.G, Fp.bid);
              EpiKVU E{(u16*)(ws + ACT(6) + 48 * MiB), (u16*)(ws + ACT(9)), (const float*)(ws + WS_SSQKV), INP(11) + l * 96, (const float*)(ws + WS_SSKR), (const float*)(ws + WS_KROPE)};
              pg8::gemm_phase<EpiKVU, pg8::StaticOrder, true, true>(lds, g, S, E, F.wave); }
#if MK_DUP & 131072
            { pg8::Gemm g{(const u16*)(ws + ACT(2)), (const u16*)(ws + WS_WUQ), NTOK, 768, 256}; pg8::StaticOrder S; S.init(NTOK, 768, Fp.G, Fp.bid); EpiQU E{(u16*)(ws + ACT(6)), (const float*)(ws + WS_SSQQ)};
              pg8::gemm_phase<EpiQU, pg8::StaticOrder, true, true>(lds, g, S, E, F.wave); }
            { pg8::Gemm g{(const u16*)(ws + ACT(2) + 16 * MiB), (const u16*)(ws + WS_WUKV), NTOK, 1024, 256}; pg8::StaticOrder S; S.init(NTOK, 1024, Fp.G, Fp.bid);
              EpiKVU E{(u16*)(ws + ACT(6) + 48 * MiB), (u16*)(ws + ACT(9)), (const float*)(ws + WS_SSQKV), INP(11) + l * 96, (const float*)(ws + WS_SSKR), (const float*)(ws + WS_KROPE)};
              pg8::gemm_phase<EpiKVU, pg8::StaticOrder, true, true>(lds, g, S, E, F.wave); }
#endif
            TS(6); TS(7);
            SEAMG(pb + 3, 3); }
        if (EN(6) && IN(pb + 5)) { PHASE_FRAME();
#if MK_MLA_MFMA
            mla_attn_phase(Fp, (const u16*)(ws + ACT(6)), (const u16*)(ws + ACT(6) + 48 * MiB), (const u16*)(ws + ACT(9)), (u16*)(ws + ACT(2)), INP(10) + l * 96);
#if MK_DUP & 64
            mla_attn_phase(Fp, (const u16*)(ws + ACT(6)), (const u16*)(ws + ACT(6) + 48 * MiB), (const u16*)(ws + ACT(9)), (u16*)(ws + ACT(2)), INP(10) + l * 96);
#endif
#else
            mla_naive_phase(Fp, (const u16*)(ws + ACT(6)), (const u16*)(ws + ACT(6) + 48 * MiB), (const u16*)(ws + ACT(9)), (u16*)(ws + ACT(3)));
#endif
            TS(10);   }
        if (EN(5) && IN(pb + 4)) { PHASE_FRAME();
            TS(8);
            MLSTM_C(Fp, (const u16*)(ws + ACT(3)), (const u16*)(ws + ACT(4)), (const u16*)(ws + ACT(5)), (const float*)(ws + WS_IF), INP(12) + l * 2048, INP(13) + l * 512, INP(16) + l * 512, (const float*)(ws + ACT(10)), (u16*)(ws + ACT(13)));
#if MK_DUP & 32768
            MLSTM_C(Fp, (const u16*)(ws + ACT(3)), (const u16*)(ws + ACT(4)), (const u16*)(ws + ACT(5)), (const float*)(ws + WS_IF), INP(12) + l * 2048, INP(13) + l * 512, INP(16) + l * 512, (const float*)(ws + ACT(10)), (u16*)(ws + ACT(13)));
#endif
            TS(9); SEAMG(pb + 5, 4); }
        if (EN(7) && IN(pb + 6)) { PHASE_FRAME();
            pg8::Gemm g{(const u16*)(ws + ACT(0)), (const u16*)(ws + WS_WIN) + (size_t)3584 * 1024, NTOK, 3072, 1024}; pg8::StaticOrder S; S.init(NTOK, 1024, Fp.G, Fp.bid); GateOrder GO{S}; EpiGate E{(u16*)(ws + ACT(4))};
            pg8::gemm_phase<EpiGate, GateOrder, true, true>(lds, g, GO, E, F.wave);
#if MK_DUP & 128
            pg8::gemm_phase<EpiGate, GateOrder, true, true>(lds, g, GO, E, F.wave);
#endif
            TS(11);   }
        if (EN(8) && IN(pb + 7)) { PHASE_FRAME();
            pg8::StaticOrder S; S.init(NTOK, 1024, Fp.G, Fp.bid); const u16* GT = (const u16*)(ws + ACT(4)); u16* M = (u16*)(ws + ACT(10)); const u16* WBR = (const u16*)(ws + WS_WBR);
            { pg8::Gemm g{(const u16*)(ws + ACT(2)), WBR, NTOK, 1024, 512}; MergeOrder MO{S}; EpiMergeAcc E{GT, M}; pg8::gemm_phase<EpiMergeAcc, MergeOrder, true, true>(lds, g, MO, E, F.wave); }
#if MK_DUP & 256
            { pg8::Gemm g{(const u16*)(ws + ACT(2)), WBR, NTOK, 1024, 512}; EpiMerge<0> E{GT, M, (unsigned*)(ws + WS_CTL) + 32768 + 21}; pg8::gemm_phase<EpiMerge<0>, pg8::StaticOrder, true, true>(lds, g, S, E, F.wave); }
            { pg8::Gemm g{(const u16*)(ws + ACT(13)), WBR + (size_t)1024 * 512, NTOK, 1024, 512}; EpiMerge<1> E{GT, M, (unsigned*)(ws + WS_CTL) + 32768 + 21}; pg8::gemm_phase<EpiMerge<1>, pg8::StaticOrder, true, true>(lds, g, S, E, F.wave); }
            { pg8::Gemm g{(const u16*)(ws + ACT(12)), WBR + (size_t)2 * 1024 * 512, NTOK, 1024, 512}; EpiMerge<2> E{GT, M, (unsigned*)(ws + WS_CTL) + 32768 + 21}; pg8::gemm_phase<EpiMerge<2>, pg8::StaticOrder, true, true>(lds, g, S, E, F.wave); }
#endif
            TS(12); SEAMG(pb + 7, 6); }
        if (EN(9) && IN(pb + 8)) { PHASE_FRAME();
            pg8::Gemm g{(const u16*)(ws + ACT(10)), (const u16*)(ws + WS_WOUT), NTOK, 1024, 1024}; pg8::StaticOrder S; S.init(NTOK, 1024, Fp.G, Fp.bid);
            EpiOut E{l == 0 ? INP(0) : OUTP, OUTP, (const float*)(ws + WS_MOD) + (size_t)l * 2 * 6144 + 2 * 1024, (unsigned*)(ws + WS_CTL) + 32768 + 19};
            pg8::gemm_phase<EpiOut, pg8::StaticOrder, true, true>(lds, g, S, E, F.wave);
#if MK_DUP & 262144
            { EpiOut E2 = E; E2.xout = (float*)(ws + ACT(10)); pg8::gemm_phase<EpiOut, pg8::StaticOrder, true, true>(lds, g, S, E2, F.wave); }
#endif
            TS(13); SEAMG(pb + 8, 7); }
        if (EN(10) && IN(pb + 9)) { PHASE_FRAME();
            router_phase(Fp, OUTP, INP(23) + l * 1024, (const float*)(ws + WS_MOD) + (size_t)l * 2 * 6144, INP(24) + l * 4096, INP(25) + l * 4, INP(26) + l * 16384, INP(27) + l * 16, (u32*)(ws + WS_CTL) + CW_MOE + l * 64); TS(14); SEAMG(pb + 9, 8); }
        if (EN(11) && IN(pb + 10)) { PHASE_FRAME();
            scatter_phase(Fp, OUTP, INP(23) + l * 1024, (const float*)(ws + WS_MOD) + (size_t)l * 2 * 6144, (const u32*)(ws + WS_CTL) + CW_MOE + l * 64, (u16*)(ws + ACT(0))); TS(15); SEAMG(pb + 10, 9); }
        if (EN(12) && IN(pb + 11)) { PHASE_FRAME();
            moe_table(Fp, (const u32*)(ws + WS_CTL) + CW_MOE + l * 64); moe_units(Fp, 0);
            pg8::Gemm g{(const u16*)(ws + ACT(0)), (const u16*)(ws + WS_WGU), MAXROWS, 1024, 1024}; MoeOrder S{(const LAS int*)(lds + TAB_OFF) + 320}; EpiGU E{(u16*)(ws + ACT(3)), (const float*)(ws + WS_TOK + 262144)};
            pg8::gemm_phase<EpiGU, MoeOrder, true, true>(lds, g, S, E, F.wave);
#if MK_DUP & 4096
            pg8::gemm_phase<EpiGU, MoeOrder, true, true>(lds, g, S, E, F.wave);
#endif
            TS(16); SEAM(pb + 11); }
        if (EN(13) && IN(pb + 12)) { PHASE_FRAME();
            moe_table(Fp, (const u32*)(ws + WS_CTL) + CW_MOE + l * 64); moe_units(Fp, 1);
            pg8::Gemm g{(const u16*)(ws + ACT(3)), (const u16*)(ws + WS_WDC), MAXROWS, 1024, 512}; MoeOrder S{(const LAS int*)(lds + TAB_OFF) + 320};
            EpiDown E{OUTP, (const int*)(ws + WS_TOK), (const float*)(ws + WS_MOD) + (size_t)l * 2 * 6144 + 5 * 1024, (unsigned*)(ws + WS_CTL) + 32768 + 20};
            pg8::gemm_phase<EpiDown, MoeOrder, true, true>(lds, g, S, E, F.wave);
#if MK_DUP & 524288
            { EpiDown E2 = E; E2.x = (float*)(ws + ACT(10)); pg8::gemm_phase<EpiDown, MoeOrder, true, true>(lds, g, S, E2, F.wave); }
#endif
            TS(17); SEAM(pb + 12); }
    }
#if MK_TIMER
    __syncthreads();
    if (F.bid == 0 && F.tid == 0) { const LAS unsigned* ta_ = (const LAS unsigned*)(lds + LDSCTL_OFF + 3072); asm volatile("s_waitcnt vmcnt(0)" ::: "memory");
        float tv_ = (float)ta_[MK_TIMER_SEL] * 0.01f; { float sc_ = 1.f; while (tv_ >= 100.f) { tv_ *= 0.1f; sc_ *= 10.f; } tv_ = rintf(tv_ * 0.5f) * 2.f * sc_; }
        float* o_ = (float*)ldsptr(lds, 31); o_[MK_TIMER_SEL] = tv_; for (int i_ = 0; i_ < 8192; ++i_) o_[4096 + i_] = 5.0f; }
#endif
#undef IN
#undef SEAM
}

extern "C" void kernel_launch(void* const* d_in, const int* in_sizes, int n_in, void* d_out, int out_size, void* d_ws, size_t ws_size, hipStream_t stream) {
    static int grid = 0;
    if (grid == 0) {
        if (n_in != 31 || out_size != NTOK * DM || ws_size < WS_END) { fprintf(stderr, "kernel_launch: unexpected shapes (n_in %d, out %d, ws %zu < %zu)\n", n_in, out_size, ws_size, (size_t)WS_END); grid = -1; return; }
        int dev = 0, cus = 0, per_cu = 0;
        if (hipGetDevice(&dev) != hipSuccess || hipDeviceGetAttribute(&cus, hipDeviceAttributeMultiprocessorCount, dev) != hipSuccess) { grid = -1; return; }
#if MK_MULTI
#define SETATTR(K) if (hipFuncSetAttribute((const void*)mega_fwd<(1u << (K))>, hipFuncAttributeMaxDynamicSharedMemorySize, LDS_BYTES) != hipSuccess) { fprintf(stderr, "kernel_launch: hipFuncSetAttribute failed\n"); grid = -1; return; }
        SETATTR(0) SETATTR(1) SETATTR(2) SETATTR(3) SETATTR(4) SETATTR(5) SETATTR(6) SETATTR(7) SETATTR(8) SETATTR(9) SETATTR(10) SETATTR(11) SETATTR(12) SETATTR(13)
#else
        if (hipFuncSetAttribute((const void*)mega_fwd<0x3fffu>, hipFuncAttributeMaxDynamicSharedMemorySize, LDS_BYTES) != hipSuccess) { fprintf(stderr, "kernel_launch: hipFuncSetAttribute failed\n"); grid = -1; return; }
        if (hipOccupancyMaxActiveBlocksPerMultiprocessor(&per_cu, (const void*)mega_fwd<0x3fffu>, NTHR, LDS_BYTES) != hipSuccess || per_cu < 1) { fprintf(stderr, "kernel_launch: occupancy query says %d\n", per_cu); }
#endif
        (void)hipGetLastError();
        grid = cus;
    }
    if (grid < 0) return;
    if (hipMemsetAsync((char*)d_ws + WS_CTL, 0, CTL_ZERO_BYTES, stream) != hipSuccess) return;
    Params p{};
    for (int i = 0; i < 31; ++i) p.in[i] = (const float*)d_in[i];
    p.out = (float*)d_out; p.ws = (unsigned char*)d_ws;
#if MK_MULTI
#define LAUNCH1(K) hipLaunchKernelGGL(mega_fwd<(1u << (K))>, dim3(grid), dim3(NTHR), LDS_BYTES, stream, p)
    p.ph_lo = 0; p.ph_hi = 0; LAUNCH1(0);
    for (int l = 0; l < NL; ++l) { p.ph_lo = l; p.ph_hi = l + 1;
#if MK_CHECK
#define CHK(K) do { if (l == MK_CHECK_LAYER) hipLaunchKernelGGL(chk<K>, dim3(CHK_BLOCKS), dim3(256), 0, stream, p); } while (0)
#else
#define CHK(K) do { } while (0)
#endif
#if MK_CHECK
#define CHKX(M) do { if (l == MK_CHECK_LAYER) { Params q_ = p; if (M) q_.ph_lo = 5; hipLaunchKernelGGL(chk_copy_x, dim3(2048), dim3(256), 0, stream, q_); } } while (0)
#define CHKR(M, NB) do { if (l == MK_CHECK_LAYER) hipLaunchKernelGGL(chk_resid_full<M>, dim3(4 * (NB)), dim3(256), 0, stream, p); } while (0)
#else
#define CHKX(M) do { } while (0)
#define CHKR(M, NB) do { } while (0)
#endif
#if MK_CHECK
#define CHKG() do { if (l == MK_CHECK_LAYER) hipLaunchKernelGGL(chk_g1_full, dim3(10 * (NTOK / 8)), dim3(256), 0, stream, p); } while (0)
#else
#define CHKG() do { } while (0)
#endif
#if MK_CHECK
#define CHKM() do { if (l == MK_CHECK_LAYER) hipLaunchKernelGGL(chk_mlstm_full, dim3(8), dim3(128), 0, stream, p); } while (0)
#else
#define CHKM() do { } while (0)
#endif
        CHK(13); CHK(14); LAUNCH1(1); CHK(0); LAUNCH1(2); CHK(1); CHK(2); CHKG(); LAUNCH1(3); CHK(11); LAUNCH1(4); LAUNCH1(5); CHK(3); CHK(4); CHKM(); LAUNCH1(6); CHK(10); LAUNCH1(7); CHK(5); LAUNCH1(8); CHK(6); CHK(21); CHKX(0); LAUNCH1(9); CHK(7); CHKR(0, NTOK / 8);
        LAUNCH1(10); LAUNCH1(11); LAUNCH1(12); CHK(8); CHK(20); CHKX(1); LAUNCH1(13); CHK(9); CHKR(1, MAXROWS / 8); }
#if MK_CHECK
    if (MK_BIG > 0.f) hipLaunchKernelGGL(chk_count_big, dim3(1024), dim3(256), 0, stream, p);
    hipLaunchKernelGGL(chk_encode, dim3(1024), dim3(256), 0, stream, p);
#endif
#else
    p.ph_lo = 0; p.ph_hi = NL;
    hipLaunchKernelGGL(mega_fwd<0x3fffu>, dim3(grid), dim3(NTHR), LDS_BYTES, stream, p);
#endif
}
```

```cpp
#include <hip/hip_runtime.h>
#include <cstdio>
#include <cstdint>
#ifndef MK_F16
#define MK_F16 1
#endif
#ifndef MK_MULTI
#define MK_MULTI 0
#endif
#ifndef MK_PH_MASK
#define MK_PH_MASK 0xffffffffu
#endif
#ifndef MK_ABL
#define MK_ABL 0
#endif
#ifndef MK_CHECK
#define MK_CHECK 0
#endif
#ifndef MK_CHECK_FROM
#define MK_CHECK_FROM 23
#endif
#ifndef MK_CHECK_LAYER
#define MK_CHECK_LAYER 0
#endif
#ifndef MK_CHECK_INJECT
#define MK_CHECK_INJECT 1.0f
#endif
#ifndef MK_ZERO_LO
#define MK_ZERO_LO 0
#define MK_ZERO_HI 0
#endif
#ifndef MK_CHECK_TIGHT
#define MK_CHECK_TIGHT 1.0f
#endif
#ifndef MK_BIG
#define MK_BIG 0.0f
#endif
#ifndef MK_UPD_BIG
#define MK_UPD_BIG 2.0f
#endif
#ifndef MK_CNT_WORD
#define MK_CNT_WORD 22
#endif
#ifndef MK_COPY_FROM_IN
#define MK_COPY_FROM_IN 1
#endif
#ifndef MK_MLA_MFMA
#define MK_MLA_MFMA 1
#endif
#ifndef MK_DIL_MFMA
#define MK_DIL_MFMA 1
#endif
#ifndef MK_DIL_V2
#define MK_DIL_V2 1
#endif
#ifndef MK_DUP
#define MK_DUP 0
#endif
#ifndef MK_TIMER
#define MK_TIMER 0
#endif
#ifndef MK_TIMER_SEL
#define MK_TIMER_SEL 0
#endif
#ifndef MK_MLA_V2
#define MK_MLA_V2 1
#endif
#ifndef MK_MLSTM_MFMA
#define MK_MLSTM_MFMA 1
#endif
#if MK_MLSTM_MFMA
#define MLSTM_A mlstm_a3_phase
#define MLSTM_C mlstm_c3_phase
#else
#define MLSTM_A mlstm_a_phase
#define MLSTM_C mlstm_c_phase
#endif
namespace pg8 {
#define PG8_LAS __attribute__((address_space(3)))
typedef unsigned short bf16_t;
typedef short bf16x8 __attribute__((ext_vector_type(8)));
typedef float f32x4 __attribute__((ext_vector_type(4)));
typedef unsigned u32x4 __attribute__((ext_vector_type(4)));
constexpr int BM = 256, BK = 64, HALF = 128, HTB = HALF * BK * 2  , STAGE_BYTES = 8 * HTB, NXCD = 8, WGM = 8;

__host__ __device__ __forceinline__ int lds_byte(int r, int c) { const int st = (r >> 4) * 2 + (c >> 5), rr = r & 15, cc = c & 31, ob = rr * 64 + cc * 2; return st * 1024 + (ob ^ (((ob >> 9) & 1) << 5)); }
__host__ __device__ __forceinline__ void stage_rc(int b, int& R, int& C) { const int st = b / 1024, sb = b % 1024, swz = sb ^ (((sb >> 9) & 1) << 5); R = (st >> 1) * 16 + swz / 64; C = (st & 1) * 32 + (swz % 64) / 2; }
__host__ __device__ __forceinline__ int perm32(int rho) { const int n = rho >> 4, i = rho & 15; return 8 * (i >> 2) + 4 * n + (i & 3); }

struct Unit { int pm, pn, pb, aux; };
struct Gemm { const bf16_t* A; const bf16_t* Bt; int M, N, K; };

struct StaticOrder {
    int nM, nN, nwg, G, c;
    __host__ __device__ void init(int M, int N, int G_, int c_) { nM = M / BM; nN = N / BM; nwg = nM * nN; G = G_; c = c_; }
    __host__ __device__ bool next(int i, Unit& u) const {
        const long L = (long)i * G + c; if (L >= nwg) return false;
        int wgid = (int)L; { const int q = nwg / NXCD, r = nwg % NXCD, xcd = wgid % NXCD, off = wgid / NXCD; wgid = (xcd < r ? xcd * (q + 1) : r * (q + 1) + (xcd - r) * q) + off; }
        const int nig = WGM * nN, gid = wgid / nig, fm = gid * WGM, gsz = (nM - fm) < WGM ? (nM - fm) : WGM;
        u.pm = fm + ((wgid % nig) % gsz); u.pn = (wgid % nig) / gsz; u.pb = u.pn; u.aux = 0; return true;
    }
    __device__ __forceinline__ void a_ready(const Unit&) const {}
    __device__ __forceinline__ void done(const Unit&) const {}
};
typedef _Float16 h16x2 __attribute__((ext_vector_type(2))); typedef _Float16 h16x8 __attribute__((ext_vector_type(8)));
#if MK_F16
__device__ __forceinline__ unsigned cvt_pk_bf16(float lo, float hi) { typedef float f2_ __attribute__((ext_vector_type(2))); const f2_ v = {lo, hi}; return __builtin_bit_cast(unsigned, __builtin_convertvector(v, h16x2)); }
#define PG8_MFMA16(a, b, c) __builtin_amdgcn_mfma_f32_16x16x32_f16(__builtin_bit_cast(pg8::h16x8, (a)), __builtin_bit_cast(pg8::h16x8, (b)), (c), 0, 0, 0)
#else
__device__ __forceinline__ unsigned cvt_pk_bf16(float lo, float hi) { unsigned r; asm volatile("v_cvt_pk_bf16_f32 %0, %1, %2" : "=v"(r) : "v"(lo), "v"(hi)); return r; }
#define PG8_MFMA16(a, b, c) __builtin_amdgcn_mfma_f32_16x16x32_bf16((a), (b), (c), 0, 0, 0)
#endif
typedef float f32x2 __attribute__((ext_vector_type(2)));
template <class Epi, class Sched, bool ALIGN_EPI = false, bool SP2 = false>
__device__ __forceinline__ void gemm_phase(PG8_LAS unsigned char* lds, const Gemm g, const Sched& S, const Epi& E, const int wave_id) {
    Gemm gl = g; { const unsigned long long a_ = (unsigned long long)g.A, b_ = (unsigned long long)g.Bt; unsigned al = __builtin_amdgcn_readfirstlane((unsigned)a_), ah = __builtin_amdgcn_readfirstlane((unsigned)(a_ >> 32)), bl = __builtin_amdgcn_readfirstlane((unsigned)b_), bh = __builtin_amdgcn_readfirstlane((unsigned)(b_ >> 32));
        asm volatile("" : "+s"(al), "+s"(ah), "+s"(bl), "+s"(bh)); gl.A = (const bf16_t*)(((unsigned long long)ah << 32) | al); gl.Bt = (const bf16_t*)(((unsigned long long)bh << 32) | bl); }
    int lid_; asm volatile("v_mbcnt_lo_u32_b32 %0, -1, 0\n\tv_mbcnt_hi_u32_b32 %0, -1, %0" : "=v"(lid_));
    const int tid_ = wave_id * 64 + lid_;
    const int tid = tid_, wid = __builtin_amdgcn_readfirstlane(tid >> 6), lane = tid & 63, wr = wid >> 2, wc = wid & 3, fr = lane & 15, fq = lane >> 4;
    const int K = gl.K, nt = K / BK;
    unsigned voffA[2], voffB[2];
#pragma unroll
    for (int i = 0; i < 2; ++i) { int R, C; stage_rc(tid * 16 + i * 8192, R, C); const int Rb = Epi::PERM ? ((R & ~31) + perm32(R & 31)) : R;
        voffA[i] = (unsigned)(R * K + C) * 2u; voffB[i] = (unsigned)(Rb * K + C) * 2u; }
    const size_t kstep = (size_t)(BK * 2);
    const size_t hstep = (size_t)HALF * K * 2;
    const size_t tstep = 2 * hstep;
    const unsigned ldsw = (unsigned)wid * 1024u; const unsigned ldsbase = (unsigned)__builtin_amdgcn_readfirstlane((unsigned)(size_t)lds + ldsw);
    const int aoff = lds_byte(wr * 64 + fr, fq * 8), boff = lds_byte(wc * 32 + fr, fq * 8);
#define PG8_SA(b, h) (((b) * 2 + (h)) * HTB)
#define PG8_SB(b, h) ((4 + (b) * 2 + (h)) * HTB)
#define PG8_STAGE(bufoff, gbase, voff) do { _Pragma("unroll") for (int _i = 0; _i < 2; ++_i) { unsigned keep_; \
        asm volatile("s_mov_b32 %0, m0\n\ts_mov_b32 m0, %3\n\ts_nop 0\n\tglobal_load_lds_dwordx4 %1, %2\n\ts_mov_b32 m0, %0" : "=&s"(keep_) \
                     : "v"((voff)[_i]), "s"((const char*)(gbase)), "s"(ldsbase + (unsigned)((bufoff) + _i * 8192)) : "memory"); } } while (0)
#define PG8_LDA(dst, b, h) do { _Pragma("unroll") for (int m = 0; m < 4; ++m) _Pragma("unroll") for (int k = 0; k < 2; ++k) dst[m][k] = *(const PG8_LAS bf16x8*)(lds + PG8_SA(b, h) + aoff + m * 2048 + k * 1024); } while (0)
#define PG8_LDB(dst, b, h) do { _Pragma("unroll") for (int n = 0; n < 2; ++n) _Pragma("unroll") for (int k = 0; k < 2; ++k) dst[n][k] = *(const PG8_LAS bf16x8*)(lds + PG8_SB(b, h) + boff + n * 2048 + k * 1024); } while (0)
#define PG8_MMA(ai, bj, At, Bt) do { __builtin_amdgcn_s_setprio(1); _Pragma("unroll") for (int m = 0; m < 4; ++m) _Pragma("unroll") for (int n = 0; n < 2; ++n) _Pragma("unroll") for (int k = 0; k < 2; ++k) \
        acc[ai][bj][m][n] = PG8_MFMA16(Bt[n][k], At[m][k], acc[ai][bj][m][n]); __builtin_amdgcn_s_setprio(0); } while (0)
#define PG8_WAIT_V(n) asm volatile("s_waitcnt vmcnt(" #n ")" ::: "memory")
#define PG8_WAIT_L(n) asm volatile("s_waitcnt lgkmcnt(" #n ")" ::: "memory")
#define PG8_BAR __builtin_amdgcn_s_barrier()
#define PG8_SCHED __builtin_amdgcn_sched_barrier(0)
    float zf_ = 0.f; asm volatile("" : "+v"(zf_));
    Unit cur, nxt; int ui = 0;
    if (!S.next(0, cur)) return;
    f32x4 acc[2][2][4][2];
#pragma unroll
    for (int a = 0; a < 2; ++a)
#pragma unroll
        for (int b = 0; b < 2; ++b)
#pragma unroll
            for (int m = 0; m < 4; ++m)
#pragma unroll
                for (int n = 0; n < 2; ++n) acc[a][b][m][n] = (f32x4){zf_, zf_, zf_, zf_};
    bf16x8 At[4][2], B0[2][2], B1[2][2];
    const char* cA = (const char*)gl.A + (size_t)cur.pm * tstep; const char* cB = (const char*)gl.Bt + (size_t)cur.pb * tstep;
    S.a_ready(cur);
    if constexpr (SP2) {
        PG8_STAGE(PG8_SB(0, 0), cB, voffB); PG8_STAGE(PG8_SB(0, 1), cB + hstep, voffB); PG8_STAGE(PG8_SA(0, 0), cA, voffA); PG8_STAGE(PG8_SA(0, 1), cA + hstep, voffA);
        if (wr == 1) PG8_BAR;
        PG8_WAIT_V(2); PG8_BAR;
        PG8_STAGE(PG8_SB(1, 0), cB + kstep, voffB); PG8_STAGE(PG8_SA(1, 0), cA + kstep, voffA); PG8_STAGE(PG8_SB(1, 1), cB + hstep + kstep, voffB);
        PG8_WAIT_V(6); PG8_BAR;
    } else {
        PG8_STAGE(PG8_SB(0, 0), cB, voffB); PG8_STAGE(PG8_SA(0, 0), cA, voffA); PG8_STAGE(PG8_SB(0, 1), cB + hstep, voffB); PG8_STAGE(PG8_SA(0, 1), cA + hstep, voffA);
        if (wr == 1) PG8_BAR;
        PG8_WAIT_V(4); PG8_BAR;
        PG8_STAGE(PG8_SB(1, 0), cB + kstep, voffB); PG8_STAGE(PG8_SA(1, 0), cA + kstep, voffA); PG8_STAGE(PG8_SB(1, 1), cB + hstep + kstep, voffB);
        PG8_WAIT_V(6); PG8_BAR;
    }
    for (;;) {
        const bool has_next = S.next(ui + 1, nxt);
        const char* nA = has_next ? (const char*)gl.A + (size_t)nxt.pm * tstep : cA; const char* nB = has_next ? (const char*)gl.Bt + (size_t)nxt.pb * tstep : cB;
        _Pragma("clang loop unroll(disable)")
        for (int t = 0; t < nt; t += 2) {
            const bool last = (t == nt - 2);
            const char* a1 = cA + (size_t)(t + 1) * kstep;
            const char* a2 = last ? nA : cA + (size_t)(t + 2) * kstep; const char* b2 = last ? nB : cB + (size_t)(t + 2) * kstep;
            const char* a3 = a2 + kstep; const char* b3 = b2 + kstep;
            if (last && has_next) S.a_ready(nxt);
            if constexpr (SP2) {
            PG8_LDB(B0, 0, 0); PG8_LDB(B1, 0, 1); PG8_SCHED; PG8_LDA(At, 0, 0); PG8_STAGE(PG8_SA(1, 1), a1 + hstep, voffA);
            PG8_WAIT_V(8); PG8_WAIT_L(0); PG8_BAR; PG8_MMA(0, 0, At, B0); PG8_MMA(0, 1, At, B1); PG8_BAR; PG8_SCHED;
            PG8_LDA(At, 0, 1); PG8_STAGE(PG8_SB(0, 0), b2, voffB); PG8_STAGE(PG8_SB(0, 1), b2 + hstep, voffB); PG8_STAGE(PG8_SA(0, 0), a2, voffA);
            PG8_WAIT_V(8); PG8_WAIT_L(0); PG8_BAR; PG8_MMA(1, 0, At, B0); PG8_MMA(1, 1, At, B1); PG8_BAR; PG8_SCHED;
            PG8_LDB(B0, 1, 0); PG8_LDB(B1, 1, 1); PG8_SCHED; PG8_LDA(At, 1, 0); PG8_STAGE(PG8_SA(0, 1), a2 + hstep, voffA);
            PG8_WAIT_V(8); PG8_WAIT_L(0); PG8_BAR; PG8_MMA(0, 0, At, B0); PG8_MMA(0, 1, At, B1); PG8_BAR; PG8_SCHED;
            PG8_LDA(At, 1, 1); PG8_STAGE(PG8_SB(1, 0), b3, voffB); PG8_STAGE(PG8_SB(1, 1), b3 + hstep, voffB); PG8_STAGE(PG8_SA(1, 0), a3, voffA);
            PG8_WAIT_V(8); PG8_WAIT_L(0); PG8_BAR; PG8_MMA(1, 0, At, B0); PG8_MMA(1, 1, At, B1); PG8_BAR; PG8_SCHED;
            } else {
            PG8_LDB(B0, 0, 0); PG8_SCHED; PG8_LDA(At, 0, 0); PG8_STAGE(PG8_SA(1, 1), a1 + hstep, voffA);
            PG8_WAIT_L(8); PG8_BAR; PG8_WAIT_L(0); PG8_MMA(0, 0, At, B0); PG8_BAR; PG8_SCHED;
            PG8_LDB(B1, 0, 1); PG8_STAGE(PG8_SB(0, 0), b2, voffB);
            PG8_BAR; PG8_WAIT_L(0); PG8_MMA(0, 1, At, B1); PG8_BAR;
            PG8_LDA(At, 0, 1); PG8_STAGE(PG8_SA(0, 0), a2, voffA);
            PG8_BAR; PG8_WAIT_L(0); PG8_MMA(1, 0, At, B0); PG8_BAR; PG8_SCHED;
            PG8_STAGE(PG8_SB(0, 1), b2 + hstep, voffB);
            PG8_WAIT_V(6); PG8_BAR; PG8_MMA(1, 1, At, B1); PG8_BAR;
            PG8_LDB(B0, 1, 0); PG8_SCHED; PG8_LDA(At, 1, 0); PG8_STAGE(PG8_SA(0, 1), a2 + hstep, voffA);
            PG8_WAIT_L(8); PG8_BAR; PG8_WAIT_L(0); PG8_MMA(0, 0, At, B0); PG8_BAR; PG8_SCHED;
            PG8_LDB(B1, 1, 1); PG8_STAGE(PG8_SB(1, 0), b3, voffB);
            PG8_BAR; PG8_WAIT_L(0); PG8_MMA(0, 1, At, B1); PG8_BAR;
            PG8_LDA(At, 1, 1); PG8_STAGE(PG8_SA(1, 0), a3, voffA);
            PG8_BAR; PG8_WAIT_L(0); PG8_MMA(1, 0, At, B0); PG8_BAR; PG8_SCHED;
            PG8_STAGE(PG8_SB(1, 1), b3 + hstep, voffB);
            PG8_WAIT_V(6); PG8_BAR; PG8_MMA(1, 1, At, B1); PG8_BAR;
            }
        }
        if constexpr (ALIGN_EPI) { if (wr == 0) PG8_BAR; }
        if constexpr (!Epi::AFTER_DRAIN) { int fr_e = fr, fq_e = fq; asm volatile("" : "+v"(fr_e), "+v"(fq_e));
            E(acc, cur, wr, wc, fr_e, fq_e); S.done(cur); }
        if (!has_next) break;
        if (!Epi::KEEP_ACC || cur.aux == 2) {
#pragma unroll
        for (int a = 0; a < 2; ++a)
#pragma unroll
            for (int b = 0; b < 2; ++b)
#pragma unroll
                for (int m = 0; m < 4; ++m)
#pragma unroll
                    for (int n = 0; n < 2; ++n) acc[a][b][m][n] = (f32x4){zf_, zf_, zf_, zf_}; }
        cur = nxt; cA = nA; cB = nB; ++ui;
        if constexpr (ALIGN_EPI) { if (wr == 1) PG8_BAR; }
    }
    PG8_WAIT_V(0);
    if constexpr (!ALIGN_EPI) { if (wr == 0) PG8_BAR; }
    PG8_BAR;
    if constexpr (Epi::AFTER_DRAIN) { E.fused(acc, cur, wr, wc, fr, fq, lds, wid, lane); S.done(cur); }
#undef PG8_SA
#undef PG8_SB
#undef PG8_STAGE
#undef PG8_LDA
#undef PG8_LDB
#undef PG8_MMA
#undef PG8_WAIT_V
#undef PG8_WAIT_L
#undef PG8_BAR
#undef PG8_SCHED
}
}

typedef unsigned short u16;
typedef unsigned int u32;
constexpr int NTOK = 32768, SEQ = 16384, DM = 1024, NL = 4, NWAVES = 8, NTHR = 512;
constexpr int INW = 6568;
constexpr int MAXROWS = NTOK + 24 * 256;
constexpr float EPS = 1e-6f;
constexpr float LOG2E = 1.4426950408889634f;
constexpr size_t MiB = 1u << 20;
constexpr size_t WS_CTL = 0, CTL_ZERO_BYTES = 1 * MiB;
constexpr size_t WS_MOD = 1 * MiB;
constexpr size_t WS_ROPE = 2 * MiB;
constexpr size_t WS_SSQQ = 4 * MiB, WS_SSQKV = 4 * MiB + 512 * 1024;
constexpr size_t WS_IF = 5 * MiB;
constexpr size_t WS_ROUT = 6 * MiB;
constexpr size_t WS_TOK = 7 * MiB;
constexpr size_t WS_KROPE = 10 * MiB, WS_SSKR = 14 * MiB;
constexpr size_t WS_MLS = 8 * MiB;
constexpr size_t WS_WIN = 16 * MiB, WS_WUQ = 29 * MiB, WS_WUKV = 29 * MiB + 512 * 1024, WS_WBR = 30 * MiB, WS_WOUT = 33 * MiB, WS_WGU = 35 * MiB, WS_WDC = 51 * MiB;
constexpr size_t WS_ACT = 76 * MiB, SLOT = 32 * MiB;
constexpr size_t WS_END = WS_ACT + 14 * SLOT;
#define ACT(i) (WS_ACT + (size_t)(i) * SLOT)
constexpr int CW_BAR = 4096, CW_MOE = 16384;
constexpr int RING_BYTES = 131072, LDSCTL_OFF = RING_BYTES, MISC_OFF = LDSCTL_OFF + 320, TAB_OFF = LDSCTL_OFF + 1024, PTAB_OFF = LDSCTL_OFF + 4096, LDS_BYTES = 147456;

#define GAS __attribute__((address_space(1)))
#define LAS __attribute__((address_space(3)))
typedef unsigned v4u __attribute__((ext_vector_type(4)));
typedef unsigned v2u __attribute__((ext_vector_type(2)));
typedef float f32x4 __attribute__((ext_vector_type(4)));
#define LDS_WAIT() asm volatile("s_waitcnt lgkmcnt(0)" ::: "memory")
__device__ __forceinline__ u32 f2bf(float f) { u32 u = __builtin_bit_cast(u32, f); return (u + 0x7fffu + ((u >> 16) & 1u)) >> 16; }
__device__ __forceinline__ u32 pk2(float lo, float hi) { return pg8::cvt_pk_bf16(lo, hi); }
#if MK_F16
__device__ __forceinline__ float bflo(u32 w) { return (float)__builtin_bit_cast(pg8::h16x2, w)[0]; }
__device__ __forceinline__ float bfhi(u32 w) { return (float)__builtin_bit_cast(pg8::h16x2, w)[1]; }
__device__ __forceinline__ float bf1(u16 w) { return (float)__builtin_bit_cast(_Float16, w); }
#else
__device__ __forceinline__ float bflo(u32 w) { return __uint_as_float(w << 16); }
__device__ __forceinline__ float bfhi(u32 w) { return __uint_as_float(w & 0xffff0000u); }
__device__ __forceinline__ float bf1(u16 w) { return __uint_as_float(((u32)w) << 16); }
#endif
__device__ __forceinline__ float fsigmoid(float x) { return __builtin_amdgcn_rcpf(1.0f + __expf(-x)); }
__device__ __forceinline__ float fsilu(float x) { return x * fsigmoid(x); }
__device__ __forceinline__ float bperm_f(int srclane, float v) { return __int_as_float(__builtin_amdgcn_ds_bpermute(srclane << 2, __float_as_int(v))); }
__device__ __forceinline__ float wave_sum(float v, int lane) {
#pragma unroll
    for (int o = 1; o < 64; o <<= 1) v += bperm_f(lane ^ o, v);
    return v;
}

__device__ __forceinline__ void* ldsptr(LAS unsigned char* lds, int i) {
    int off_ = PTAB_OFF + 8 * i; asm volatile("" : "+v"(off_));
    const unsigned long long v = *(volatile LAS unsigned long long*)(lds + off_);
    const unsigned lo = __builtin_amdgcn_readfirstlane((unsigned)v), hi = __builtin_amdgcn_readfirstlane((unsigned)(v >> 32));
    unsigned lo2 = lo, hi2 = hi; asm volatile("" : "+s"(lo2), "+s"(hi2));
    return (void*)(__attribute__((address_space(1))) void*)(uintptr_t)(((unsigned long long)hi2 << 32) | lo2);
}
struct Params { const float* in[31]; float* out; unsigned char* ws; int ph_lo, ph_hi; };
struct Frame {
    LAS unsigned char* lds; int tid, lane, wave, G, bid;
    unsigned char* ws;
};
#define FIN(i) ((const float*)ldsptr(F.lds, (i)))

__device__ __forceinline__ void conv_tile(const float* Wk0, int ldw, const float* ksc, u16* dst, int ldk, int srcc, LAS float* scr, int lane, bool live = true, bool scaled = false) {
    const unsigned lo_ = (unsigned)((lane >> 5) * ldw + (srcc < 0 ? 0 : srcc)) * 4u;
#pragma unroll 32
    for (int i = 0; i < 32; ++i) { const int kk = 2 * i + (lane >> 5); float v = 0.f;
        if (live && srcc >= 0) { v = *(const float*)((const char*)(Wk0 + (size_t)(2 * i) * ldw) + lo_); if (scaled) v *= ksc[kk]; }
        scr[kk * 33 + (lane & 31)] = v; }
    LDS_WAIT(); asm volatile("" ::: "memory");
    const int c = lane & 7;
#pragma unroll
    for (int j = 0; j < 4; ++j) { const int n = (lane >> 3) + 8 * j; const LAS float* s = scr + (8 * c) * 33 + n;
        v4u o; o.x = pk2(s[0 * 33], s[1 * 33]); o.y = pk2(s[2 * 33], s[3 * 33]); o.z = pk2(s[4 * 33], s[5 * 33]); o.w = pk2(s[6 * 33], s[7 * 33]);
        *(v4u*)(dst + (size_t)n * ldk + 8 * c) = o; }
    LDS_WAIT(); asm volatile("" ::: "memory");
}
__device__ __forceinline__ int win_srccol(int n) {
    const int pn = n >> 8, j = n & 255;
    if (pn == 0) return j;
    if (pn == 1) { if (j < 128) return 256 + j; if (j < 160) return 384 + (j - 128); if (j < 164) return 1952 + (j - 160); if (j < 168) return 1956 + (j - 164); return -1; }
    if (pn < 8) return 416 + (pn - 2) * 256 + j;
    if (pn < 12) { const int base = pn < 10 ? 1960 : 2472, half = (pn - 8) & 1, bj = j >> 7, wc = (j & 127) >> 5, i32 = j & 31; return base + (half * 4 + wc) * 64 + bj * 32 + i32; }
    if (pn < 14) return 2984 + (pn - 12) * 256 + j;
    return 3496 + (n - 3584);
}
__device__ __forceinline__ int ukv_srccol(int n) { const int pn = n >> 8, bj = (n >> 7) & 1, wc = (n >> 5) & 3, i = n & 31; return (2 * pn + (wc & 1)) * 128 + (wc >> 1) * 64 + bj * 32 + i; }
__device__ __forceinline__ void cls_experts(int cls, int& ea, int& eb) {
    const int g = cls / 6, p = cls % 6; const int a = p < 3 ? 0 : (p < 5 ? 1 : 2); const int b = p < 3 ? p + 1 : (p < 5 ? p - 1 : 3);
    ea = g * 4 + a; eb = g * 4 + b;
}
constexpr int I_WIN = 208 * 16, I_WING1 = 112 * 16, I_UQ = 24 * 4, I_UKV = 32 * 4, I_BR = 3 * 32 * 8, I_OUT = 32 * 16, I_GU = 16 * 16 * 16, I_DC = 24 * 32 * 8;
__device__ __forceinline__ void conv_win(Frame& F, int l, int r) { LAS float* scr = (LAS float*)(F.lds + F.wave * 16384); const int lane = F.lane, ln = lane & 31; unsigned char* ws = F.ws;
    const int nb = r / 16, kb = r % 16; const float* W = FIN(5) + (size_t)l * 1024 * INW;
    conv_tile(W + (size_t)kb * 64 * INW, INW, nullptr, (u16*)(ws + WS_WIN) + (size_t)nb * 32 * 1024 + kb * 64, 1024, win_srccol(nb * 32 + ln), scr, lane, true, false); }
__device__ __forceinline__ void conv_uq(Frame& F, int l, int r) { LAS float* scr = (LAS float*)(F.lds + F.wave * 16384); const int lane = F.lane, ln = lane & 31; unsigned char* ws = F.ws;
    const int nb = r / 4, kb = r % 4; const float* W = FIN(8) + (size_t)l * 256 * 768;
    conv_tile(W + (size_t)kb * 64 * 768, 768, FIN(6) + l * 256 + kb * 64, (u16*)(ws + WS_WUQ) + (size_t)nb * 32 * 256 + kb * 64, 256, nb * 32 + ln, scr, lane, true, true); }
__device__ __forceinline__ void conv_ukv(Frame& F, int l, int r) { LAS float* scr = (LAS float*)(F.lds + F.wave * 16384); const int lane = F.lane, ln = lane & 31; unsigned char* ws = F.ws;
    const int nb = r / 4, kb = r % 4; const float* W = FIN(9) + (size_t)l * 128 * 1024;
    conv_tile(W + (size_t)(kb & 1) * 64 * 1024, 1024, FIN(7) + l * 128 + (kb & 1) * 64, (u16*)(ws + WS_WUKV) + (size_t)nb * 32 * 256 + kb * 64, 256, ukv_srccol(nb * 32 + ln), scr, lane, kb < 2, true); }
__device__ __forceinline__ void conv_br(Frame& F, int l, int r) { LAS float* scr = (LAS float*)(F.lds + F.wave * 16384); const int lane = F.lane, ln = lane & 31; unsigned char* ws = F.ws;
    const int br = r / 256, q = r % 256, nb = q / 8, kb = q % 8; const float* W = (br == 0 ? FIN(19) : (br == 1 ? FIN(20) : FIN(21))) + (size_t)l * 512 * 1024;
    conv_tile(W + (size_t)kb * 64 * 1024, 1024, nullptr, (u16*)(ws + WS_WBR) + (size_t)br * 1024 * 512 + (size_t)nb * 32 * 512 + kb * 64, 512, nb * 32 + ln, scr, lane, true, false); }
__device__ __forceinline__ void conv_out(Frame& F, int l, int r) { LAS float* scr = (LAS float*)(F.lds + F.wave * 16384); const int lane = F.lane, ln = lane & 31; unsigned char* ws = F.ws;
    const int nb = r / 16, kb = r % 16; const float* W = FIN(22) + (size_t)l * 1024 * 1024;
    conv_tile(W + (size_t)kb * 64 * 1024, 1024, nullptr, (u16*)(ws + WS_WOUT) + (size_t)nb * 32 * 1024 + kb * 64, 1024, nb * 32 + ln, scr, lane, true, false); }
__device__ __forceinline__ void conv_gu(Frame& F, int l, int r) { LAS float* scr = (LAS float*)(F.lds + F.wave * 16384); const int lane = F.lane, ln = lane & 31; unsigned char* ws = F.ws;
    const int e = r / 256, q = r % 256, nb = q / 16, kb = q % 16;
    const int p = nb >> 3, jp = (nb & 7) * 32, bj = jp >> 7, f = p * 128 + (jp & 127) + ln;
    const float* W = (bj ? FIN(29) : FIN(28)) + ((size_t)l * 16 + e) * 1024 * 256;
    conv_tile(W + (size_t)kb * 64 * 256, 256, nullptr, (u16*)(ws + WS_WGU) + ((size_t)e * 512 + nb * 32) * 1024 + kb * 64, 1024, f, scr, lane, true, false); }
__device__ __forceinline__ void conv_dc(Frame& F, int l, int r) { LAS float* scr = (LAS float*)(F.lds + F.wave * 16384); const int lane = F.lane, ln = lane & 31; unsigned char* ws = F.ws;
    const int cls = r / 256, q = r % 256, nb = q / 8, kb = q % 8; int ea, eb; cls_experts(cls, ea, eb);
    const int e = kb < 4 ? ea : eb, k0 = (kb & 3) * 64; const float* W = FIN(30) + ((size_t)l * 16 + e) * 256 * 1024;
    conv_tile(W + (size_t)k0 * 1024, 1024, nullptr, (u16*)(ws + WS_WDC) + ((size_t)cls * 1024 + nb * 32) * 512 + kb * 64, 512, nb * 32 + ln, scr, lane); }
__device__ __forceinline__ void conv_phase(Frame& F, int l) {
    const int gw = F.bid * NWAVES + F.wave, NGW = F.G * NWAVES;
    for (int it = gw; it < I_WING1 + I_UQ + I_UKV; it += NGW) {
        if (it < I_WING1) conv_win(F, l, it); else if (it < I_WING1 + I_UQ) conv_uq(F, l, it - I_WING1); else conv_ukv(F, l, it - I_WING1 - I_UQ); }
}
template <int GAP> __device__ __forceinline__ void conv_gap(Frame& F, int l) {
    if (GAP < 0 || GAP > 9) return;
    const int w7 = F.bid * 7 + (F.wave - 1), NW7 = F.G * 7;
    if (GAP == 0) { for (int d = w7; d < I_WIN - I_WING1; d += NW7) conv_win(F, l, I_WING1 + d); }
    else if (GAP == 1) { for (int d = w7; d < I_BR + I_OUT; d += NW7) { if (d < I_BR) conv_br(F, l, d); else conv_out(F, l, d - I_BR); } }
    else if (GAP < 5) { constexpr int Q = (I_GU + 2) / 3; for (int d = w7; d < Q; d += NW7) { const int r = (GAP - 2) * Q + d; if (r < I_GU) conv_gu(F, l, r); } }
    else if (GAP >= 6) { constexpr int Q = (I_DC + 3) / 4; for (int d = w7; d < Q; d += NW7) { const int r = (GAP - 6) * Q + d; if (r < I_DC) conv_dc(F, l, r); } }
}

__device__ __forceinline__ void pre_phase(Frame& F) {
    const float* c = FIN(1); const float* w_ada = FIN(2); const float* b_ada = FIN(3);
    float* mod = (float*)(F.ws + WS_MOD);
    LAS float* scr = (LAS float*)F.lds;
    LAS float* sl = scr + 2048;
    __syncthreads();
    for (int i = F.tid; i < 2048; i += NTHR) sl[i] = fsilu(c[i]);
    __syncthreads();
    for (int u = F.bid; u < NL * 192; u += F.G) {
        const int l = u / 192, j0 = (u % 192) * 32, jc = F.tid & 31, dg = F.tid >> 5;
        const char* Wl = (const char*)(w_ada + (size_t)l * 1024 * 6144 + j0); const unsigned o0 = (unsigned)(dg * 64) * 24576u + (unsigned)jc * 4u;
        float a0 = 0.f, a1 = 0.f;
#pragma unroll 16
        for (int dd = 0; dd < 64; ++dd) { const float w = *(const float*)(Wl + (o0 + (unsigned)dd * 24576u)); a0 += sl[dg * 64 + dd] * w; a1 += sl[1024 + dg * 64 + dd] * w; }
        scr[(dg * 32 + jc) * 2 + 0] = a0; scr[(dg * 32 + jc) * 2 + 1] = a1;
        __syncthreads();
        if (F.tid < 64) { const int jc2 = F.tid & 31, b = F.tid >> 5; float s2 = b_ada[l * 6144 + j0 + jc2];
#pragma unroll
            for (int g = 0; g < 16; ++g) s2 += scr[(g * 32 + jc2) * 2 + b];
            mod[(size_t)(l * 2 + b) * 6144 + j0 + jc2] = s2; }
        __syncthreads();
    }
    float* ct = (float*)(F.ws + WS_ROPE); float* st = ct + SEQ * 16;
    for (int idx = F.bid * NTHR + F.tid; idx < SEQ * 16; idx += F.G * NTHR) {
        const int pos = idx >> 4, i = idx & 15;
        double inv = (i & 3) == 0 ? 1.0 : ((i & 3) == 1 ? 0.5623413251903491 : ((i & 3) == 2 ? 0.31622776601683794 : 0.1778279410038923));
        const int dec = i >> 2; inv = dec == 0 ? inv : (dec == 1 ? inv * 0.1 : (dec == 2 ? inv * 0.01 : inv * 0.001));
        const float ang = (float)pos * (float)inv;
        double rev = (double)ang * 0.15915494309189535; rev -= __builtin_rint(rev);
        ct[idx] = __builtin_amdgcn_cosf((float)rev); st[idx] = __builtin_amdgcn_sinf((float)rev);
    }
}

__device__ __forceinline__ void norm_rows(Frame& F, const float* xin, const float* gain, const float* modl  , int ish, int isc, u16* U) {
    const int gw = F.bid * NWAVES + F.wave, NGW = F.G * NWAVES, lane = F.lane;
    f32x4 va[4], vb[4];
#define NR_LOAD(V, m_) do { const int mm_ = (m_) < NTOK ? (m_) : gw; const f32x4* xr_ = (const f32x4*)(xin + (size_t)mm_ * DM) + lane; _Pragma("unroll") for (int j = 0; j < 4; ++j) V[j] = xr_[64 * j]; } while (0)
    NR_LOAD(va, gw); NR_LOAD(vb, gw + NGW);
    for (int m = gw; m < NTOK; m += NGW) {
        const int b = m / SEQ;
        f32x4 v[4]; float s = 0.f;
#pragma unroll
        for (int j = 0; j < 4; ++j) { v[j] = va[j]; va[j] = vb[j]; }
        NR_LOAD(vb, m + 2 * NGW);
#pragma unroll
        for (int j = 0; j < 4; ++j) s += (v[j].x * v[j].x + v[j].y * v[j].y) + (v[j].z * v[j].z + v[j].w * v[j].w);
        const float rstd = 1.0f / sqrtf(wave_sum(s, lane) * (1.f / DM) + EPS);
        v2u* o8 = (v2u*)(U + (size_t)m * DM) + lane;
#pragma unroll
        for (int j = 0; j < 4; ++j) { const int c0 = 4 * lane + 256 * j;
            const f32x4 g = *(const f32x4*)(gain + c0), sc = *(const f32x4*)(modl + (size_t)(b * 6 + isc) * 1024 + c0), sh = *(const f32x4*)(modl + (size_t)(b * 6 + ish) * 1024 + c0);
            const f32x4 y = (v[j] * rstd) * g * (sc + 1.0f) + sh;
            v2u w; w.x = pk2(y.x, y.y); w.y = pk2(y.z, y.w); o8[64 * j] = w; }
    }
#undef NR_LOAD
}
#define XB_TMO      128
#define XB_XCNT(j)  (256  + 64 * (j))
#define XB_XSUB(j)  (1280 + 64 * (j))
#define XB_XGEN(j)  (2304 + 64 * (j))
#define XB_TOP      3328
#define XB_TOPGEN   3392
#define XCD_BAR_WORDS 3456
#define XB_SPIN_CAP (1u << 18)

__device__ __forceinline__ unsigned xb_ld(unsigned* p)              { return __hip_atomic_load(p, __ATOMIC_RELAXED, __HIP_MEMORY_SCOPE_AGENT); }
__device__ __forceinline__ unsigned xb_add(unsigned* p, unsigned v) { return __hip_atomic_fetch_add(p, v, __ATOMIC_RELAXED, __HIP_MEMORY_SCOPE_AGENT); }
__device__ __forceinline__ unsigned xb_xcc_id() { return (unsigned)__builtin_amdgcn_s_getreg((3 << 11) | 20) & 0xFu; }
#define XB_SPIN(cond, bar) do { unsigned _sp = 0; while (cond) { __builtin_amdgcn_s_sleep(1); \
    if ((++_sp & 255u) == 0u) { if (xb_ld(&(bar)[XB_TMO])) break; if (_sp > XB_SPIN_CAP) { atomicAdd(&(bar)[XB_TMO], 1u); break; } } } } while (0)

struct XcdBarrier {
    unsigned* bar; unsigned x;
    volatile LAS unsigned* st;
    bool lead;
};

__device__ __forceinline__ XcdBarrier xcd_barrier_post(unsigned* bar, volatile LAS unsigned* st) {
    XcdBarrier b; b.bar = bar; b.x = xb_xcc_id(); b.st = st; b.lead = (threadIdx.x == 0);
    if (b.lead) (void)xb_add(&bar[XB_XCNT(b.x)], 1u);
    return b;
}
__device__ __forceinline__ void xcd_barrier_complete(unsigned* bar, unsigned x, unsigned& nloc, unsigned& nx) {
    const unsigned G = gridDim.x * gridDim.y * gridDim.z;
    unsigned sum, cnt, mine, sp = 0u;
    for (;;) {
        sum = 0u; cnt = 0u; mine = 0u;
#pragma unroll
        for (unsigned j = 0; j < 16; ++j) { const unsigned c = xb_ld(&bar[XB_XCNT(j)]); sum += c; cnt += (c > 0u) ? 1u : 0u; mine = (j == x) ? c : mine; }
        if (sum == G) break;
        __builtin_amdgcn_s_sleep(1);
        if ((++sp & 255u) == 0u) { if (xb_ld(&bar[XB_TMO])) break; if (sp > XB_SPIN_CAP) { atomicAdd(&bar[XB_TMO], 1u); break; } }
    }
    nloc = mine > 0u ? mine : 1u; nx = cnt > 0u ? cnt : 1u;
}

__device__ __forceinline__ void xcd_barrier_lead(const XcdBarrier& b) {
    if (b.lead) {
        unsigned* bar = b.bar;
        __builtin_amdgcn_s_waitcnt(0);
        unsigned nloc = b.st[0], nx = b.st[1];
        if (nloc == 0u) { xcd_barrier_complete(bar, b.x, nloc, nx); b.st[0] = nloc; b.st[1] = nx; }
        const unsigned old = xb_add(&bar[XB_XSUB(b.x)], 1u);
        const unsigned gen = old / nloc;
        if (old + 1u == (gen + 1u) * nloc) {
            __builtin_amdgcn_fence(__ATOMIC_RELEASE, "agent");
            asm volatile("s_waitcnt vmcnt(0)" ::: "memory");
            const unsigned og = xb_add(&bar[XB_TOP], 1u);
            const unsigned tg = og / nx;
            if (og + 1u == (tg + 1u) * nx) xb_add(&bar[XB_TOPGEN], 1u);
            else XB_SPIN(xb_ld(&bar[XB_TOPGEN]) == tg, bar);
            __builtin_amdgcn_fence(__ATOMIC_ACQUIRE, "agent");
            xb_add(&bar[XB_XGEN(b.x)], 1u);
            asm volatile("s_waitcnt vmcnt(0)" ::: "memory");
        } else {
            XB_SPIN(xb_ld(&bar[XB_XGEN(b.x)]) == gen, bar);
            __builtin_amdgcn_fence(__ATOMIC_ACQUIRE, "agent");
            asm volatile("s_waitcnt vmcnt(0)" ::: "memory");
        }
    }
}
__device__ __forceinline__ void xcd_barrier(const XcdBarrier& b) {
    asm volatile("s_waitcnt vmcnt(0)" ::: "memory");
    __syncthreads();
    xcd_barrier_lead(b);
    __syncthreads();
}

typedef pg8::f32x4 A4;
#define EPI_ARGS const A4 (&acc)[2][2][4][2], const pg8::Unit& u, int wr, int wc, int fr, int fq
__device__ __forceinline__ v4u pack8(A4 a, A4 b) { v4u w; w.x = pk2(a[0], a[1]); w.y = pk2(a[2], a[3]); w.z = pk2(b[0], b[1]); w.w = pk2(b[2], b[3]); return w; }
__device__ __forceinline__ float dot4(A4 a) { return (a[0] * a[0] + a[1] * a[1]) + (a[2] * a[2] + a[3] * a[3]); }
__device__ __forceinline__ float logsigmoidf(float x) { const float e = __expf(-fabsf(x)); return fminf(x, 0.f) - __logf(1.0f + e); }

struct EpiG1 {
    static constexpr bool PERM = true, AFTER_DRAIN = false, KEEP_ACC = false;
    unsigned char* ws; const float *b_i, *b_f, *dqg, *dkg, *mkg  ;
    __device__ __forceinline__ void operator()(EPI_ARGS) const {
        u16* const CQ = (u16*)(ws + ACT(2)); u16* const C1 = (u16*)(ws + ACT(2) + 16 * MiB); u16* const DV = (u16*)(ws + ACT(8));
        float* const ssqq = (float*)(ws + WS_SSQQ); float* const ssqkv = (float*)(ws + WS_SSQKV); float* const IF = (float*)(ws + WS_IF);
        const int pn = u.pn, row0 = u.pm * 256 + wr * 64 + fr, cw = 32 * wc + 8 * fq;
        if (pn == 0) {
#pragma unroll
            for (int ai = 0; ai < 2; ++ai)
#pragma unroll
                for (int m = 0; m < 4; ++m) { const size_t row = row0 + ai * 128 + m * 16; float ss = 0.f;
#pragma unroll
                    for (int bj = 0; bj < 2; ++bj) { ss += dot4(acc[ai][bj][m][0]) + dot4(acc[ai][bj][m][1]); *(v4u*)(CQ + row * 256 + bj * 128 + cw) = pack8(acc[ai][bj][m][0], acc[ai][bj][m][1]); }
                    ss += bperm_f((fq * 16 + fr) ^ 16, ss); ss += bperm_f((fq * 16 + fr) ^ 32, ss);
                    if (fq == 0) ssqq[row * 4 + wc] = ss; }
        } else if (pn == 1) {
            const A4 bi4 = *(const A4*)b_i, bf4 = *(const A4*)b_f;
            const A4 kg0 = *(const A4*)(mkg + 64 + 8 * fq), kg1 = *(const A4*)(mkg + 64 + 8 * fq + 4);
            float* const sskr = (float*)(ws + WS_SSKR); float* const KR = (float*)(ws + WS_KROPE); const float* const ctab = (const float*)(ws + WS_ROPE);
#pragma unroll
            for (int ai = 0; ai < 2; ++ai)
#pragma unroll
                for (int m = 0; m < 4; ++m) { const size_t row = row0 + ai * 128 + m * 16;
                    if (wc == 0) { const v4u kw = pack8(acc[ai][1][m][0], acc[ai][1][m][1]);
                        float kf[8] = {bflo(kw.x), bfhi(kw.x), bflo(kw.y), bfhi(kw.y), bflo(kw.z), bfhi(kw.z), bflo(kw.w), bfhi(kw.w)};
                        float sk = ((kf[0] * kf[0] + kf[1] * kf[1]) + (kf[2] * kf[2] + kf[3] * kf[3])) + ((kf[4] * kf[4] + kf[5] * kf[5]) + (kf[6] * kf[6] + kf[7] * kf[7]));
                        sk += bperm_f((fq * 16 + fr) ^ 16, sk); sk += bperm_f((fq * 16 + fr) ^ 32, sk);
                        if (fq == 0) sskr[row] = sk;
                        const int pos = (int)(row % SEQ); const float* cp = ctab + pos * 16 + (8 * fq & 15); const A4 c0 = *(const A4*)cp, c1 = *(const A4*)(cp + 4), s0 = *(const A4*)(cp + SEQ * 16), s1 = *(const A4*)(cp + SEQ * 16 + 4);
                        A4 o0, o1;
#pragma unroll
                        for (int j = 0; j < 8; ++j) { const float y = kf[j] * (j < 4 ? kg0[j & 3] : kg1[j & 3]), ot = bperm_f((fq * 16 + fr) ^ 32, y), cs = j < 4 ? c0[j & 3] : c1[j & 3], sn = j < 4 ? s0[j & 3] : s1[j & 3];
                            const float v = fq < 2 ? y * cs - ot * sn : ot * sn + y * cs;
                            if (j < 4) o0[j & 3] = v; else o1[j & 3] = v; }
                        *(A4*)(KR + row * 32 + 8 * fq) = o0; *(A4*)(KR + row * 32 + 8 * fq + 4) = o1; }
                    float ss = dot4(acc[ai][0][m][0]) + dot4(acc[ai][0][m][1]);
#pragma unroll
                    for (int bj = 0; bj < 2; ++bj) *(v4u*)(C1 + row * 256 + bj * 128 + cw) = pack8(acc[ai][bj][m][0], acc[ai][bj][m][1]);
                    ss += bperm_f((fq * 16 + fr) ^ 16, ss); ss += bperm_f((fq * 16 + fr) ^ 32, ss);
                    if (fq == 0) { ssqkv[row * 4 + wc] = ss;
                        if (wc == 1) { const A4 gi = acc[ai][1][m][0], gf = acc[ai][1][m][1]; A4 o0, o1;
#pragma unroll
                            for (int i = 0; i < 4; ++i) { o0[i] = gi[i] + bi4[i]; o1[i] = logsigmoidf(gf[i] + bf4[i]); }
                            *(A4*)(IF + row * 8) = o0; *(A4*)(IF + row * 8 + 4) = o1; } } }
        } else if (pn < 8) {
            u16* dst = (u16*)(ws + WS_ACT + (size_t)(3 + ((pn - 2) >> 1)) * SLOT); const int cb = (pn & 1) * 256; const bool sg = pn >= 6;
#pragma unroll
            for (int ai = 0; ai < 2; ++ai)
#pragma unroll
                for (int m = 0; m < 4; ++m) { const size_t row = row0 + ai * 128 + m * 16;
#pragma unroll
                    for (int bj = 0; bj < 2; ++bj) { A4 a = acc[ai][bj][m][0], b = acc[ai][bj][m][1];
                        if (sg) {
#pragma unroll
                            for (int i = 0; i < 4; ++i) { a[i] = fsigmoid(a[i]); b[i] = fsigmoid(b[i]); } }
                        *(v4u*)(dst + row * 512 + cb + bj * 128 + cw) = pack8(a, b); } }
        } else if (pn < 12) {
            const bool isq = pn < 10; u16* dst = (u16*)(ws + WS_ACT + (size_t)(isq ? 6 : 7) * SLOT); const float* gn = isq ? dqg : dkg; const int head = (pn & 1) * 4 + wc;
            const float osc = isq ? 0.125f * LOG2E : 1.0f;
            A4 gq[2][2];
#pragma unroll
            for (int bj = 0; bj < 2; ++bj) { gq[bj][0] = *(const A4*)(gn + bj * 32 + 8 * fq); gq[bj][1] = *(const A4*)(gn + bj * 32 + 8 * fq + 4); }
#pragma unroll
            for (int ai = 0; ai < 2; ++ai)
#pragma unroll
                for (int m = 0; m < 4; ++m) { const size_t row = row0 + ai * 128 + m * 16;
                    float ss = (dot4(acc[ai][0][m][0]) + dot4(acc[ai][0][m][1])) + (dot4(acc[ai][1][m][0]) + dot4(acc[ai][1][m][1]));
                    ss += bperm_f((fq * 16 + fr) ^ 16, ss); ss += bperm_f((fq * 16 + fr) ^ 32, ss);
                    const float rstd = osc / sqrtf(ss * (1.f / 64.f) + EPS);
#pragma unroll
                    for (int bj = 0; bj < 2; ++bj) { const A4 g0 = gq[bj][0], g1 = gq[bj][1];
                        *(v4u*)(dst + ((size_t)((row / SEQ) * 8 + head) * SEQ + (row % SEQ)) * 64 + bj * 32 + 8 * fq) = pack8(acc[ai][bj][m][0] * rstd * g0, acc[ai][bj][m][1] * rstd * g1); }
                    asm volatile("" ::: "memory"); }
        } else {
            const int cb = (pn & 1) * 256;
#pragma unroll
            for (int ai = 0; ai < 2; ++ai)
#pragma unroll
                for (int m = 0; m < 4; ++m) { const size_t row = row0 + ai * 128 + m * 16;
#pragma unroll
                    for (int bj = 0; bj < 2; ++bj) { const int col = cb + bj * 128 + cw, hd = col >> 6; *(v4u*)(DV + ((size_t)((row / SEQ) * 8 + hd) * SEQ + (row % SEQ)) * 64 + (col & 63)) = pack8(acc[ai][bj][m][0], acc[ai][bj][m][1]); } }
        }
    }
};
struct EpiQU {
    static constexpr bool PERM = true, AFTER_DRAIN = false, KEEP_ACC = false;
    u16* Q; const float* ssqq;
    __device__ __forceinline__ void operator()(EPI_ARGS) const {
        const int row0 = u.pm * 256 + wr * 64 + fr, col0 = u.pn * 256 + 32 * wc + 8 * fq; float rr[8];
#pragma unroll
        for (int it = 0; it < 8; ++it) { const A4 s4 = *(const A4*)(ssqq + (size_t)(row0 + (it >> 2) * 128 + (it & 3) * 16) * 4); rr[it] = ((s4[0] + s4[1]) + (s4[2] + s4[3])); }
        asm volatile("" ::: "memory");
#pragma unroll
        for (int ai = 0; ai < 2; ++ai)
#pragma unroll
            for (int m = 0; m < 4; ++m) { const size_t row = row0 + ai * 128 + m * 16;
                const float r = 1.0f / sqrtf(rr[ai * 4 + m] * (1.f / 256.f) + EPS);
#pragma unroll
                for (int bj = 0; bj < 2; ++bj) *(v4u*)(Q + row * 768 + col0 + bj * 128) = pack8(acc[ai][bj][m][0] * r, acc[ai][bj][m][1] * r);
                asm volatile("" ::: "memory"); }
    }
};
struct EpiKVU {
    static constexpr bool PERM = true, AFTER_DRAIN = false, KEEP_ACC = false;
    u16 *K, *V; const float* ssqkv; const float* kg  ; const float* sskr; const float* KR;
    __device__ __forceinline__ void operator()(EPI_ARGS) const {
        const int row0 = u.pm * 256 + wr * 64 + fr; float rr8[8], sk8[8];
#pragma unroll
        for (int it = 0; it < 8; ++it) { const size_t row_ = row0 + (it >> 2) * 128 + (it & 3) * 16; const A4 s4 = *(const A4*)(ssqkv + row_ * 4); rr8[it] = ((s4[0] + s4[1]) + (s4[2] + s4[3])); sk8[it] = sskr[row_]; }
        const int head = 2 * u.pn + (wc & 1);
        if (wc < 2) {
            A4 g[2][2]; A4 rp[3][2];
#pragma unroll
            for (int bj = 0; bj < 2; ++bj) { g[bj][0] = *(const A4*)(kg + bj * 32 + 8 * fq); g[bj][1] = *(const A4*)(kg + bj * 32 + 8 * fq + 4); }
#define EK_LOAD(it) do { const size_t row_ = row0 + ((it) >> 2) * 128 + ((it) & 3) * 16; rp[(it) % 3][0] = *(const A4*)(KR + row_ * 32 + 8 * fq); rp[(it) % 3][1] = *(const A4*)(KR + row_ * 32 + 8 * fq + 4); } while (0)
            asm volatile("" ::: "memory");
            EK_LOAD(0); EK_LOAD(1); asm volatile("" ::: "memory");
#pragma unroll
            for (int it = 0; it < 8; ++it) { const int ai = it >> 2, m = it & 3; const size_t row = row0 + ai * 128 + m * 16;
                if (it + 2 < 8) EK_LOAD(it + 2);
                asm volatile("" ::: "memory");
                const float r = 1.0f / sqrtf(rr8[it] * (1.f / 128.f) + EPS);
                float vf[2][8]; float ss = 0.f;
#pragma unroll
                for (int bj = 0; bj < 2; ++bj) { const v4u w = pack8(acc[ai][bj][m][0] * r, acc[ai][bj][m][1] * r);
                    vf[bj][0] = bflo(w.x); vf[bj][1] = bfhi(w.x); vf[bj][2] = bflo(w.y); vf[bj][3] = bfhi(w.y); vf[bj][4] = bflo(w.z); vf[bj][5] = bfhi(w.z); vf[bj][6] = bflo(w.w); vf[bj][7] = bfhi(w.w);
#pragma unroll
                    for (int j = 0; j < 8; ++j) ss += vf[bj][j] * vf[bj][j]; }
                ss += bperm_f((fq * 16 + fr) ^ 16, ss); ss += bperm_f((fq * 16 + fr) ^ 32, ss);
                const float rs = 1.0f / sqrtf((ss + sk8[it]) * (1.f / 96.f) + EPS);
                const int bb = (int)(row / SEQ), pos = (int)(row % SEQ), tile = pos >> 6, rr = pos & 63; const size_t bht = (size_t)(bb * 8 + head) * 256 + tile;
#pragma unroll
                for (int bj = 0; bj < 2; ++bj) { A4 a, b;
#pragma unroll
                    for (int j = 0; j < 4; ++j) { a[j] = vf[bj][j] * rs * g[bj][0][j]; b[j] = vf[bj][4 + j] * rs * g[bj][1][j]; }
                    *(v4u*)(K + (bht * 12 + (4 * bj + fq)) * 512 + rr * 8) = pack8(a, b); }
                *(v4u*)(K + (bht * 12 + (8 + fq)) * 512 + rr * 8) = pack8(rp[it % 3][0] * rs, rp[it % 3][1] * rs);
                asm volatile("" ::: "memory"); }
#undef EK_LOAD
        } else {
            asm volatile("" ::: "memory");
#pragma unroll
            for (int ai = 0; ai < 2; ++ai)
#pragma unroll
                for (int m = 0; m < 4; ++m) { const size_t row = row0 + ai * 128 + m * 16;
                    const float r = 1.0f / sqrtf(rr8[ai * 4 + m] * (1.f / 128.f) + EPS);
                    const int bb = (int)(row / SEQ), pos = (int)(row % SEQ), tile = pos >> 6, rr = pos & 63; const size_t bht = (size_t)(bb * 8 + head) * 256 + tile;
#pragma unroll
                    for (int bj = 0; bj < 2; ++bj) *(v4u*)(V + ((bht * 8 + bj * 4 + (rr >> 4)) * 16 + (rr & 15)) * 32 + fq * 8) = pack8(acc[ai][bj][m][0] * r, acc[ai][bj][m][1] * r);
                    asm volatile("" ::: "memory"); }
        }
    }
};
struct EpiGate {
    static constexpr bool PERM = true, AFTER_DRAIN = false, KEEP_ACC = false;
    u16* GT;
    __device__ __forceinline__ void operator()(EPI_ARGS) const {
        const int row0 = u.pm * 256 + wr * 64 + fr, col0 = u.pn * 256 + 32 * wc + 8 * fq;
#pragma unroll
        for (int ai = 0; ai < 2; ++ai)
#pragma unroll
            for (int m = 0; m < 4; ++m) { const size_t row = row0 + ai * 128 + m * 16;
#pragma unroll
                for (int bj = 0; bj < 2; ++bj) { A4 a = acc[ai][bj][m][0], b = acc[ai][bj][m][1];
#pragma unroll
                    for (int i = 0; i < 4; ++i) { a[i] = fsigmoid(a[i]); b[i] = fsigmoid(b[i]); }
                    *(v4u*)(GT + row * 3072 + col0 + bj * 128) = pack8(a, b); } }
    }
};
template <int IDX> struct EpiMerge {
    static constexpr bool PERM = true, AFTER_DRAIN = false, KEEP_ACC = false;
    const u16* GT; u16* M; unsigned* dbg;
    __device__ __forceinline__ void operator()(EPI_ARGS) const {
        const int row0 = u.pm * 256 + wr * 64 + fr, col0 = u.pn * 256 + 32 * wc + 8 * fq;
        v4u g[3][2], p[3][2];
#define EM_LOAD(it) do { const size_t row_ = row0 + ((it) >> 2) * 128 + ((it) & 3) * 16; _Pragma("unroll") for (int bj = 0; bj < 2; ++bj) { g[(it) % 3][bj] = *(const v4u*)(GT + row_ * 3072 + IDX * 1024 + col0 + bj * 128); \
            if (IDX > 0) p[(it) % 3][bj] = *(const v4u*)(M + row_ * 1024 + col0 + bj * 128); } } while (0)
        EM_LOAD(0); EM_LOAD(1); asm volatile("" ::: "memory");
#pragma unroll
        for (int it = 0; it < 8; ++it) { const int ai = it >> 2, m = it & 3; const size_t row = row0 + ai * 128 + m * 16;
            if (it + 2 < 8) EM_LOAD(it + 2);
            asm volatile("" ::: "memory");
#pragma unroll
            for (int bj = 0; bj < 2; ++bj) { const v4u gg = g[it % 3][bj];
                A4 a = acc[ai][bj][m][0], b = acc[ai][bj][m][1];
                a[0] *= bflo(gg.x); a[1] *= bfhi(gg.x); a[2] *= bflo(gg.y); a[3] *= bfhi(gg.y); b[0] *= bflo(gg.z); b[1] *= bfhi(gg.z); b[2] *= bflo(gg.w); b[3] *= bfhi(gg.w);
                if ((MK_ABL >> IDX) & 1) { a = (A4){0.f, 0.f, 0.f, 0.f}; b = a; }
#if MK_CHECK
                for (int i_ = 0; i_ < 4; ++i_) { if (fabsf(a[i_]) > MK_UPD_BIG) atomicAdd(dbg + IDX, 1u); if (fabsf(b[i_]) > MK_UPD_BIG) atomicAdd(dbg + IDX, 1u); }
#endif
                if (IDX > 0) { const v4u pp = p[it % 3][bj]; a[0] += bflo(pp.x); a[1] += bfhi(pp.x); a[2] += bflo(pp.y); a[3] += bfhi(pp.y); b[0] += bflo(pp.z); b[1] += bfhi(pp.z); b[2] += bflo(pp.w); b[3] += bfhi(pp.w); }
                *(v4u*)(M + row * 1024 + col0 + bj * 128) = pack8(a, b); }
            asm volatile("" ::: "memory"); }
#undef EM_LOAD
    }
};
struct MergeOrder {
    pg8::StaticOrder S;
    __device__ __forceinline__ static int aoff(int br) { return br == 0 ? 0 : (br == 1 ? 1408 : 1280); }
    __device__ __forceinline__ bool next(int i, pg8::Unit& u) const { const int j = i / 3, br = i - 3 * j; if (!S.next(j, u)) return false; u.aux = br; u.pb = br * 4 + u.pn; u.pm += aoff(br); return true; }
    __device__ __forceinline__ void a_ready(const pg8::Unit&) const {}
    __device__ __forceinline__ void done(const pg8::Unit&) const {}
};
struct GateOrder {
    pg8::StaticOrder S;
    __device__ __forceinline__ bool next(int i, pg8::Unit& u) const { const int j = i / 3, br = i - 3 * j; if (!S.next(j, u)) return false; u.pn += 4 * br; u.pb = u.pn; u.aux = 0; return true; }
    __device__ __forceinline__ void a_ready(const pg8::Unit&) const {}
    __device__ __forceinline__ void done(const pg8::Unit&) const {}
};
struct EpiMergeRT {
    static constexpr bool PERM = true, AFTER_DRAIN = false, KEEP_ACC = false;
    const u16* GT; u16* M;
    __device__ __forceinline__ void operator()(EPI_ARGS) const {
        const int idx = u.aux; const int row0 = (u.pm - MergeOrder::aoff(idx)) * 256 + wr * 64 + fr, col0 = u.pn * 256 + 32 * wc + 8 * fq;
        v4u g[3][2], p[3][2];
#define EM_LOAD(it) do { const size_t row_ = row0 + ((it) >> 2) * 128 + ((it) & 3) * 16; _Pragma("unroll") for (int bj = 0; bj < 2; ++bj) { g[(it) % 3][bj] = *(const v4u*)(GT + row_ * 3072 + idx * 1024 + col0 + bj * 128); \
            if (idx > 0) p[(it) % 3][bj] = *(const v4u*)(M + row_ * 1024 + col0 + bj * 128); } } while (0)
        EM_LOAD(0); EM_LOAD(1); asm volatile("" ::: "memory");
#pragma unroll
        for (int it = 0; it < 8; ++it) { const int ai = it >> 2, m = it & 3; const size_t row = row0 + ai * 128 + m * 16;
            if (it + 2 < 8) EM_LOAD(it + 2);
            asm volatile("" ::: "memory");
#pragma unroll
            for (int bj = 0; bj < 2; ++bj) { const v4u gg = g[it % 3][bj];
                A4 a = acc[ai][bj][m][0], b = acc[ai][bj][m][1];
                a[0] *= bflo(gg.x); a[1] *= bfhi(gg.x); a[2] *= bflo(gg.y); a[3] *= bfhi(gg.y); b[0] *= bflo(gg.z); b[1] *= bfhi(gg.z); b[2] *= bflo(gg.w); b[3] *= bfhi(gg.w);
                if (idx > 0) { const v4u pp = p[it % 3][bj]; a[0] += bflo(pp.x); a[1] += bfhi(pp.x); a[2] += bflo(pp.y); a[3] += bfhi(pp.y); b[0] += bflo(pp.z); b[1] += bfhi(pp.z); b[2] += bflo(pp.w); b[3] += bfhi(pp.w); }
                *(v4u*)(M + row * 1024 + col0 + bj * 128) = pack8(a, b); }
            asm volatile("" ::: "memory"); }
#undef EM_LOAD
    }
};
struct EpiMergeAcc {
    static constexpr bool PERM = true, AFTER_DRAIN = false, KEEP_ACC = true;
    const u16* GT; u16* M;
    __device__ __forceinline__ void operator()(A4 (&acc)[2][2][4][2], const pg8::Unit& u, int wr, int wc, int fr, int fq) const {
        const int idx = u.aux; const int row0 = (u.pm - MergeOrder::aoff(idx)) * 256 + wr * 64 + fr, col0 = u.pn * 256 + 32 * wc + 8 * fq;
        const int nx = idx < 2 ? idx + 1 : idx;
        v4u g[3][2], h[3][2];
#define EA_LOAD(it) do { const size_t row_ = row0 + ((it) >> 2) * 128 + ((it) & 3) * 16; _Pragma("unroll") for (int bj = 0; bj < 2; ++bj) { g[(it) % 3][bj] = *(const v4u*)(GT + row_ * 3072 + idx * 1024 + col0 + bj * 128); \
            if (idx < 2) h[(it) % 3][bj] = *(const v4u*)(GT + row_ * 3072 + nx * 1024 + col0 + bj * 128); } } while (0)
#define EA_G(x) fmaxf((x), 6.103515625e-05f)
        EA_LOAD(0); EA_LOAD(1); asm volatile("" ::: "memory");
#pragma unroll
        for (int it = 0; it < 8; ++it) { const int ai = it >> 2, m = it & 3; const size_t row = row0 + ai * 128 + m * 16;
            if (it + 2 < 8) EA_LOAD(it + 2);
            asm volatile("" ::: "memory");
#pragma unroll
            for (int bj = 0; bj < 2; ++bj) { const v4u gg = g[it % 3][bj];
                float gv[8] = {EA_G(bflo(gg.x)), EA_G(bfhi(gg.x)), EA_G(bflo(gg.y)), EA_G(bfhi(gg.y)), EA_G(bflo(gg.z)), EA_G(bfhi(gg.z)), EA_G(bflo(gg.w)), EA_G(bfhi(gg.w))};
                if (idx < 2) { const v4u hh = h[it % 3][bj];
                    const float hv[8] = {EA_G(bflo(hh.x)), EA_G(bfhi(hh.x)), EA_G(bflo(hh.y)), EA_G(bfhi(hh.y)), EA_G(bflo(hh.z)), EA_G(bfhi(hh.z)), EA_G(bflo(hh.w)), EA_G(bfhi(hh.w))};
#pragma unroll
                    for (int j = 0; j < 8; ++j) gv[j] *= __builtin_amdgcn_rcpf(hv[j]); }
                A4 a = acc[ai][bj][m][0], b = acc[ai][bj][m][1];
                a[0] *= gv[0]; a[1] *= gv[1]; a[2] *= gv[2]; a[3] *= gv[3]; b[0] *= gv[4]; b[1] *= gv[5]; b[2] *= gv[6]; b[3] *= gv[7];
                if (idx < 2) { acc[ai][bj][m][0] = a; acc[ai][bj][m][1] = b; }
                else *(v4u*)(M + row * 1024 + col0 + bj * 128) = pack8(a, b); }
            asm volatile("" ::: "memory"); }
#undef EA_LOAD
#undef EA_G
    }
};
struct EpiOut {
    static constexpr bool PERM = false, AFTER_DRAIN = false, KEEP_ACC = false;
    const float* xin; float* xout; const float* ga  ; unsigned* dbg;
    __device__ __forceinline__ void operator()(EPI_ARGS) const {
        const int row0 = u.pm * 256 + wr * 64 + fr, col0 = u.pn * 256 + 32 * wc + 4 * fq, b = (u.pm * 256) / SEQ;
        A4 g[2][2];
#pragma unroll
        for (int bj = 0; bj < 2; ++bj)
#pragma unroll
            for (int n = 0; n < 2; ++n) g[bj][n] = *(const A4*)(ga + (size_t)b * 6144 + col0 + bj * 128 + n * 16);
        A4 xi[3][2][2];
#define EO_LOAD(it) do { const size_t off_ = (size_t)(row0 + ((it) >> 2) * 128 + ((it) & 3) * 16) * 1024 + col0; _Pragma("unroll") for (int bj = 0; bj < 2; ++bj) _Pragma("unroll") for (int n = 0; n < 2; ++n) \
            xi[(it) % 3][bj][n] = *(const A4*)(xin + off_ + bj * 128 + n * 16); } while (0)
        EO_LOAD(0); EO_LOAD(1); asm volatile("" ::: "memory");
#pragma unroll
        for (int it = 0; it < 8; ++it) { const int ai = it >> 2, m = it & 3; const size_t off = (size_t)(row0 + ai * 128 + m * 16) * 1024 + col0;
            if (it + 2 < 8) EO_LOAD(it + 2);
            asm volatile("" ::: "memory");
#pragma unroll
            for (int bj = 0; bj < 2; ++bj)
#pragma unroll
                for (int n = 0; n < 2; ++n) { *(A4*)(xout + off + bj * 128 + n * 16) = xi[it % 3][bj][n] + g[bj][n] * acc[ai][bj][m][n];
#if MK_CHECK
                    { const A4 up = g[bj][n] * acc[ai][bj][m][n]; for (int i_ = 0; i_ < 4; ++i_) if (fabsf(up[i_]) > MK_UPD_BIG) atomicAdd(dbg, 1u); }
#endif
                }
            asm volatile("" ::: "memory"); }
#undef EO_LOAD
    }
};
struct EpiGU {
    static constexpr bool PERM = true, AFTER_DRAIN = false, KEEP_ACC = false;
    u16* HID; const float* wrow;
    __device__ __forceinline__ void operator()(EPI_ARGS) const {
        const int row0 = u.pm * 256 + wr * 64 + fr, slot = u.pn >> 1, p = u.pn & 1, col0 = slot * 256 + p * 128 + 32 * wc + 8 * fq; float w8[8];
#pragma unroll
        for (int it = 0; it < 8; ++it) w8[it] = wrow[(size_t)(row0 + (it >> 2) * 128 + (it & 3) * 16) * 2 + slot];
        asm volatile("" ::: "memory");
#pragma unroll
        for (int ai = 0; ai < 2; ++ai)
#pragma unroll
            for (int m = 0; m < 4; ++m) { const size_t row = row0 + ai * 128 + m * 16; const float w = w8[ai * 4 + m];
#pragma unroll
                for (int n = 0; n < 2; ++n) { A4 hv;
#pragma unroll
                    for (int i = 0; i < 4; ++i) hv[i] = fsilu(acc[ai][0][m][n][i]) * acc[ai][1][m][n][i] * w;
                    v2u pw_; pw_.x = pk2(hv[0], hv[1]); pw_.y = pk2(hv[2], hv[3]); *(v2u*)(HID + row * 512 + col0 + 4 * n) = pw_;
                    asm volatile("" ::: "memory"); }
                asm volatile("" ::: "memory"); }
    }
};
struct EpiDown {
    static constexpr bool PERM = false, AFTER_DRAIN = false, KEEP_ACC = false;
    float* x; const int* tok; const float* gf  ; unsigned* dbg;
    __device__ __forceinline__ void operator()(EPI_ARGS) const {
        const int row0 = u.pm * 256 + wr * 64 + fr, col0 = u.pn * 256 + 32 * wc + 4 * fq;
        int tk[8];
#pragma unroll
        for (int it = 0; it < 8; ++it) tk[it] = tok[row0 + (it >> 2) * 128 + (it & 3) * 16];
        A4 g[2][2][2];
#pragma unroll
        for (int bb = 0; bb < 2; ++bb)
#pragma unroll
            for (int bj = 0; bj < 2; ++bj)
#pragma unroll
                for (int n = 0; n < 2; ++n) g[bb][bj][n] = *(const A4*)(gf + (size_t)bb * 6144 + col0 + bj * 128 + n * 16);
        A4 xi[3][2][2];
#define ED_LOAD(it) do { const int t_ = tk[it] < 0 ? 0 : tk[it]; const size_t off_ = (size_t)t_ * 1024 + col0; _Pragma("unroll") for (int bj = 0; bj < 2; ++bj) _Pragma("unroll") for (int n = 0; n < 2; ++n) \
            xi[(it) % 3][bj][n] = *(const A4*)(x + off_ + bj * 128 + n * 16); } while (0)
        asm volatile("" ::: "memory");
        ED_LOAD(0); ED_LOAD(1); asm volatile("" ::: "memory");
#pragma unroll
        for (int it = 0; it < 8; ++it) { const int ai = it >> 2, m = it & 3; const int t = tk[it];
            if (it + 2 < 8) ED_LOAD(it + 2);
            asm volatile("" ::: "memory");
            if (t >= 0) { const bool b1 = t >= SEQ; const size_t off = (size_t)t * 1024 + col0;
#pragma unroll
                for (int bj = 0; bj < 2; ++bj)
#pragma unroll
                    for (int n = 0; n < 2; ++n) { const A4 gg = b1 ? g[1][bj][n] : g[0][bj][n];
                        *(A4*)(x + off + bj * 128 + n * 16) = xi[it % 3][bj][n] + gg * acc[ai][bj][m][n];
#if MK_CHECK
                        { const A4 up = gg * acc[ai][bj][m][n]; for (int i_ = 0; i_ < 4; ++i_) if (fabsf(up[i_]) > MK_UPD_BIG) atomicAdd(dbg, 1u); }
#endif
                    } }
            asm volatile("" ::: "memory"); }
#undef ED_LOAD
    }
};
struct MoeOrder {
    const LAS int* ul;
    __device__ __forceinline__ bool next(int i, pg8::Unit& u) const {
        if (i >= __builtin_amdgcn_readfirstlane(ul[0])) return false;
        const int v = __builtin_amdgcn_readfirstlane(ul[1 + i]); u.pm = v & 255; u.pn = (v >> 8) & 3; u.pb = v >> 16; u.aux = 0; return true;
    }
    __device__ __forceinline__ void a_ready(const pg8::Unit&) const {}
    __device__ __forceinline__ void done(const pg8::Unit&) const {}
};

template <int ISK> __device__ __forceinline__ void l3post_pass(Frame& F, u16* Q, u16* K, const u16* C1, const float* gn) {
    const float* ct = (const float*)(F.ws + WS_ROPE); const float* st = ct + SEQ * 16;
    constexpr int CS = ISK ? 512 : 8; const int STEP = F.G * NTHR, I0 = F.bid * NTHR + F.tid;
#define L3_PTR(idx_, row_, p_) do { row_ = (idx_) & (NTOK - 1); const int h_ = (idx_) >> 15, pos_ = row_ % SEQ; \
        p_ = ISK ? K + (((size_t)((row_ / SEQ) * 8 + h_) * 256 + (pos_ >> 6)) * 12) * 512 + (pos_ & 63) * 8 : Q + (size_t)row_ * 768 + h_ * 96; } while (0)
#define L3_LOAD(W, idx_) do { int row_; u16* p_; L3_PTR(idx_, row_, p_); _Pragma("unroll") for (int c = 0; c < 8; ++c) W[c] = *(const v4u*)(p_ + c * CS); \
        _Pragma("unroll") for (int c = 0; c < 4; ++c) W[8 + c] = ISK ? *(const v4u*)(C1 + (size_t)row_ * 256 + 128 + c * 8) : *(const v4u*)(p_ + (8 + c) * CS); } while (0)
    v4u wn[12];
    if (I0 < NTOK * 8) L3_LOAD(wn, I0);
#define L3_UNPACK(f, W_) do { const v4u t_ = (W_); f[0] = bflo(t_.x); f[1] = bfhi(t_.x); f[2] = bflo(t_.y); f[3] = bfhi(t_.y); f[4] = bflo(t_.z); f[5] = bfhi(t_.z); f[6] = bflo(t_.w); f[7] = bfhi(t_.w); } while (0)
    for (int idx = I0; idx < NTOK * 8; idx += STEP) {
        int row; u16* p; L3_PTR(idx, row, p); const int pos = row % SEQ;
        v4u wc[12];
#pragma unroll
        for (int c = 0; c < 12; ++c) wc[c] = wn[c];
        { const int nx = idx + STEP < NTOK * 8 ? idx + STEP : idx; L3_LOAD(wn, nx); }
        float ss = 0.f;
#pragma unroll
        for (int c = 0; c < 12; ++c) { float f[8]; L3_UNPACK(f, wc[c]);
#pragma unroll
            for (int i = 0; i < 8; ++i) ss += f[i] * f[i]; }
        const float rs = (1.0f / sqrtf(ss * (1.f / 96.f) + EPS)) * (ISK ? 1.0f : 0.10206207261596577f * LOG2E);
#pragma unroll
        for (int c = 0; c < 8; ++c) { float f[8]; L3_UNPACK(f, wc[c]);
#pragma unroll
            for (int i = 0; i < 8; ++i) f[i] = f[i] * rs * gn[c * 8 + i];
            v4u w; w.x = pk2(f[0], f[1]); w.y = pk2(f[2], f[3]); w.z = pk2(f[4], f[5]); w.w = pk2(f[6], f[7]); *(v4u*)(p + c * CS) = w; }
#pragma unroll
        for (int c = 0; c < 2; ++c) { float f1[8], f2[8]; L3_UNPACK(f1, wc[8 + c]); L3_UNPACK(f2, wc[10 + c]);
#pragma unroll
            for (int i = 0; i < 8; ++i) { const float cs = ct[pos * 16 + c * 8 + i], sn = st[pos * 16 + c * 8 + i], x1 = f1[i] * rs * gn[64 + c * 8 + i], x2 = f2[i] * rs * gn[80 + c * 8 + i]; f1[i] = x1 * cs - x2 * sn; f2[i] = x1 * sn + x2 * cs; }
            v4u w; w.x = pk2(f1[0], f1[1]); w.y = pk2(f1[2], f1[3]); w.z = pk2(f1[4], f1[5]); w.w = pk2(f1[6], f1[7]); *(v4u*)(p + (8 + c) * CS) = w;
            w.x = pk2(f2[0], f2[1]); w.y = pk2(f2[2], f2[3]); w.z = pk2(f2[4], f2[5]); w.w = pk2(f2[6], f2[7]); *(v4u*)(p + (10 + c) * CS) = w; }
    }
#undef L3_UNPACK
#undef L3_PTR
#undef L3_LOAD
}
__device__ __forceinline__ void l3post_phase(Frame& F, u16* Q, u16* K, const u16* C1, const float* qg, const float* kg) {
    l3post_pass<1>(F, Q, K, C1, kg);
}

__device__ __forceinline__ void mla_naive_phase(Frame& F, const u16* Q, const u16* K, const u16* V, u16* YA) {
    LAS float* Ks = (LAS float*)F.lds;
    LAS float* Vs = (LAS float*)(F.lds + 64 * 96 * 4);
    for (int item = F.bid; item < 256; item += F.G) {
        const int bh = item >> 4, pr = item & 15, b = bh >> 3, h = bh & 7;
        for (int half = 0; half < 2; ++half) {
            const int qb = half ? 31 - pr : pr, qpos = qb * 512 + F.tid; const size_t qrow = (size_t)b * SEQ + qpos;
            float q[96], o[64];
#pragma unroll
            for (int c = 0; c < 12; ++c) { const v4u w = *(const v4u*)(Q + qrow * 768 + h * 96 + c * 8); q[c * 8 + 0] = bflo(w.x); q[c * 8 + 1] = bfhi(w.x); q[c * 8 + 2] = bflo(w.y); q[c * 8 + 3] = bfhi(w.y); q[c * 8 + 4] = bflo(w.z); q[c * 8 + 5] = bfhi(w.z); q[c * 8 + 6] = bflo(w.w); q[c * 8 + 7] = bfhi(w.w); }
#pragma unroll
            for (int d = 0; d < 64; ++d) o[d] = 0.f;
            float mx = -1e30f, l = 0.f;
            const int ntile = (qb + 1) * 8;
            for (int kt = 0; kt < ntile; ++kt) {
                __syncthreads();
                for (int e = F.tid; e < 64 * 12; e += NTHR) { const int kr = e / 12, c = e % 12; const v4u w = *(const v4u*)(K + ((size_t)b * SEQ + kt * 64 + kr) * 768 + h * 96 + c * 8);
                    LAS float* d = Ks + kr * 96 + c * 8; d[0] = bflo(w.x); d[1] = bfhi(w.x); d[2] = bflo(w.y); d[3] = bfhi(w.y); d[4] = bflo(w.z); d[5] = bfhi(w.z); d[6] = bflo(w.w); d[7] = bfhi(w.w); }
                { const int kr = F.tid >> 3, c = F.tid & 7; const v4u w = *(const v4u*)(V + ((size_t)b * SEQ + kt * 64 + kr) * 512 + h * 64 + c * 8);
                    LAS float* d = Vs + kr * 64 + c * 8; d[0] = bflo(w.x); d[1] = bfhi(w.x); d[2] = bflo(w.y); d[3] = bfhi(w.y); d[4] = bflo(w.z); d[5] = bfhi(w.z); d[6] = bflo(w.w); d[7] = bfhi(w.w); }
                __syncthreads();
                const int kbase = kt * 64;
                if (kbase <= qpos) {
                    for (int j = 0; j < 64; ++j) {
                        if (kbase + j <= qpos) {
                            float s = 0.f;
#pragma unroll
                            for (int d = 0; d < 96; ++d) s += q[d] * Ks[j * 96 + d];
                            if (s > mx) { const float a = exp2f(mx - s); l *= a;
#pragma unroll
                                for (int d = 0; d < 64; ++d) o[d] *= a;
                                mx = s; }
                            const float p = exp2f(s - mx); l += p;
#pragma unroll
                            for (int d = 0; d < 64; ++d) o[d] += p * Vs[j * 64 + d];
                        }
                    }
                }
            }
            const float il = 1.0f / l;
#pragma unroll
            for (int c = 0; c < 8; ++c) { v4u w; w.x = pk2(o[c * 8 + 0] * il, o[c * 8 + 1] * il); w.y = pk2(o[c * 8 + 2] * il, o[c * 8 + 3] * il); w.z = pk2(o[c * 8 + 4] * il, o[c * 8 + 5] * il); w.w = pk2(o[c * 8 + 6] * il, o[c * 8 + 7] * il);
                *(v4u*)(YA + qrow * 512 + h * 64 + c * 8) = w; }
        }
    }
    __syncthreads();
}

__device__ __forceinline__ void dil_naive_phase(Frame& F, const u16* DQ, const u16* DK, const u16* DV, u16* YC) {
    for (int idx = F.bid * NTHR + F.tid; idx < NTOK * 8; idx += F.G * NTHR) {
        const int h = idx & 7, row = idx >> 3, b = row / SEQ, pos = row % SEQ;
        float q[64], o[64];
#pragma unroll
        for (int c = 0; c < 8; ++c) { const v4u w = *(const v4u*)(DQ + (size_t)row * 512 + h * 64 + c * 8); q[c * 8 + 0] = bflo(w.x); q[c * 8 + 1] = bfhi(w.x); q[c * 8 + 2] = bflo(w.y); q[c * 8 + 3] = bfhi(w.y); q[c * 8 + 4] = bflo(w.z); q[c * 8 + 5] = bfhi(w.z); q[c * 8 + 6] = bflo(w.w); q[c * 8 + 7] = bfhi(w.w); }
#pragma unroll
        for (int d = 0; d < 64; ++d) o[d] = 0.f;
        float mx = -1e30f, l = 0.f;
        for (int pt = 0; pt < 3; ++pt) {
            const int r = pt == 0 ? 1 : (pt == 1 ? 4 : 16);
            for (int j = 0; j <= 128; ++j) {
                const int tk = pos - j * r; if (tk < 0) break;
                const size_t kro = ((size_t)b * SEQ + tk) * 512 + h * 64;
                float s = 0.f;
#pragma unroll
                for (int c = 0; c < 8; ++c) { const v4u w = *(const v4u*)(DK + kro + c * 8);
                    s += q[c * 8 + 0] * bflo(w.x) + q[c * 8 + 1] * bfhi(w.x) + q[c * 8 + 2] * bflo(w.y) + q[c * 8 + 3] * bfhi(w.y) + q[c * 8 + 4] * bflo(w.z) + q[c * 8 + 5] * bfhi(w.z) + q[c * 8 + 6] * bflo(w.w) + q[c * 8 + 7] * bfhi(w.w); }
                if (s > mx) { const float a = exp2f(mx - s); l *= a;
#pragma unroll
                    for (int d = 0; d < 64; ++d) o[d] *= a;
                    mx = s; }
                const float p = exp2f(s - mx); l += p;
#pragma unroll
                for (int c = 0; c < 8; ++c) { const v4u w = *(const v4u*)(DV + kro + c * 8);
                    o[c * 8 + 0] += p * bflo(w.x); o[c * 8 + 1] += p * bfhi(w.x); o[c * 8 + 2] += p * bflo(w.y); o[c * 8 + 3] += p * bfhi(w.y); o[c * 8 + 4] += p * bflo(w.z); o[c * 8 + 5] += p * bfhi(w.z); o[c * 8 + 6] += p * bflo(w.w); o[c * 8 + 7] += p * bfhi(w.w); }
            }
        }
        const float il = 1.0f / l;
#pragma unroll
        for (int c = 0; c < 8; ++c) { v4u w; w.x = pk2(o[c * 8 + 0] * il, o[c * 8 + 1] * il); w.y = pk2(o[c * 8 + 2] * il, o[c * 8 + 3] * il); w.z = pk2(o[c * 8 + 4] * il, o[c * 8 + 5] * il); w.w = pk2(o[c * 8 + 6] * il, o[c * 8 + 7] * il);
            *(v4u*)(YC + (size_t)row * 512 + h * 64 + c * 8) = w; }
    }
}

__device__ __forceinline__ void stage_conv(LAS float* dst  , const u16* MQK, size_t row0, int pos0, int ch0, const float* cw, const float* cb, float scale, int tid) {
    const int d = tid & 63, sg = tid >> 6, ch = ch0 + d;
    const float w0 = cw[ch], w1 = cw[512 + ch], w2 = cw[1024 + ch], w3 = cw[1536 + ch], bb = cb[ch];
    float x[11];
#pragma unroll
    for (int i = 0; i < 11; ++i) { const int s = sg * 8 - 3 + i; x[i] = (pos0 + s >= 0) ? bf1(MQK[(size_t)((long)row0 + s) * 512 + ch]) : 0.f; }
#pragma unroll
    for (int i = 0; i < 8; ++i) { const float y = bb + w0 * x[i] + w1 * x[i + 1] + w2 * x[i + 2] + w3 * x[i + 3]; dst[(sg * 8 + i) * 65 + d] = fsilu(y) * scale; }
}
__device__ __forceinline__ float wave_incl_scan_add(float v, int lane) {
#pragma unroll
    for (int o = 1; o < 64; o <<= 1) { const float t = bperm_f(lane >= o ? lane - o : lane, v); if (lane >= o) v += t; }
    return v;
}
__device__ __forceinline__ float wave_incl_scan_max(float v, int lane) {
#pragma unroll
    for (int o = 1; o < 64; o <<= 1) { const float t = bperm_f(lane >= o ? lane - o : lane, v); if (lane >= o) v = fmaxf(v, t); }
    return v;
}
__device__ __forceinline__ float wave_max(float v, int lane) {
#pragma unroll
    for (int o = 1; o < 64; o <<= 1) v = fmaxf(v, bperm_f(lane ^ o, v));
    return v;
}
__device__ __forceinline__ void mlstm_a_phase(Frame& F, const u16* MQK, const u16* MV, const float* IF, const float* cw, const float* cb, float* ST) {
    LAS float* Ks = (LAS float*)F.lds;
    LAS float* Vs = Ks + 64 * 65;
    LAS float* ws = Vs + 64 * 128;
    float* mloc = (float*)(F.ws + WS_MLS); float* bend = mloc + 2048; float* nst = (float*)(F.ws + WS_MLS + 65536);
    const int tid = F.tid;
    for (int u = F.bid; u < 2048; u += F.G) {
        const int bh = u >> 8, c = u & 255, b = bh >> 2, h = bh & 3, pos0 = c * 64; const size_t row0 = (size_t)b * SEQ + pos0;
        __syncthreads();
        stage_conv(Ks, MQK, row0, pos0, 256 + h * 64, cw, cb, 0.125f, tid);
        for (int e = tid; e < 64 * 16; e += NTHR) { const int s = e >> 4, cc = e & 15; const v4u w = *(const v4u*)(MV + (row0 + s) * 512 + h * 128 + cc * 8);
            LAS float* d = Vs + s * 128 + cc * 8; d[0] = bflo(w.x); d[1] = bfhi(w.x); d[2] = bflo(w.y); d[3] = bfhi(w.y); d[4] = bflo(w.z); d[5] = bfhi(w.z); d[6] = bflo(w.w); d[7] = bfhi(w.w); }
        if (tid < 64) { const float ig = IF[(row0 + tid) * 8 + h], lf = IF[(row0 + tid) * 8 + 4 + h];
            const float bs = wave_incl_scan_add(lf, tid), be = bperm_f(63, bs);
            const float wl = be - bs + ig, ml = wave_max(wl, tid);
            ws[tid] = __expf(wl - ml);
            if (tid == 0) { mloc[u] = ml; bend[u] = be; } }
        __syncthreads();
        const int d = tid >> 3, vg = tid & 7;
        float acc[16]; float an = 0.f;
#pragma unroll
        for (int i = 0; i < 16; ++i) acc[i] = 0.f;
        for (int s = 0; s < 64; ++s) { const float kw = Ks[s * 65 + d] * ws[s]; an += kw;
            const LAS f32x4* vp = (const LAS f32x4*)(Vs + s * 128 + vg * 16);
#pragma unroll
            for (int i = 0; i < 4; ++i) { const f32x4 vv = vp[i]; acc[4 * i + 0] += kw * vv.x; acc[4 * i + 1] += kw * vv.y; acc[4 * i + 2] += kw * vv.z; acc[4 * i + 3] += kw * vv.w; } }
        float* o = ST + (size_t)u * 8192 + d * 128 + vg * 16;
#pragma unroll
        for (int i = 0; i < 4; ++i) *(f32x4*)(o + 4 * i) = (f32x4){acc[4 * i], acc[4 * i + 1], acc[4 * i + 2], acc[4 * i + 3]};
        if (vg == 0) nst[(size_t)u * 64 + d] = an;
    }
    __syncthreads();
}
__device__ __forceinline__ void mlstm_b_phase(Frame& F, float* ST) {
    const float* mloc = (const float*)(F.ws + WS_MLS); const float* bend = mloc + 2048; float* mprev = (float*)(F.ws + WS_MLS) + 4096; float* nst = (float*)(F.ws + WS_MLS + 65536);
    LAS float* tm = (LAS float*)F.lds; LAS float* ta = tm + 2048; LAS float* tg = ta + 2048; LAS float* tb = tg + 2048; LAS float* tl = tb + 2048; LAS float* xa = tl + 2048; LAS float* xb = xa + 512;
    const int tid = F.tid;
    __syncthreads();
    for (int i = tid; i < 2048; i += NTHR) { tb[i] = bend[i]; tl[i] = mloc[i]; }
    __syncthreads();
    if (tid < 8) { float m = 0.f; for (int c = 0; c < 256; ++c) { const float be = tb[tid * 256 + c], ml = tl[tid * 256 + c]; tm[tid * 256 + c] = m; m = fmaxf(be + m, ml); } }
    __syncthreads();
    for (int i = tid; i < 2048; i += NTHR) { const float m = tm[i], be = tb[i], ml = tl[i], mn = fmaxf(be + m, ml); ta[i] = __expf(be + m - mn); tg[i] = __expf(ml - mn); if (F.bid == 0) mprev[i] = m; }
    __syncthreads();
    const int el = tid & 31, seg = tid >> 5;
    float vnx[16];
#define MB_ADDR(u_, p_, stride_) do { const int bh_ = (u_) / 258, e_ = ((u_) % 258) * 32 + el; \
        if (e_ < 8192) { p_ = ST + (size_t)bh_ * 256 * 8192 + e_; stride_ = 8192; } else { p_ = nst + (size_t)bh_ * 256 * 64 + (e_ - 8192); stride_ = 64; } p_ += (size_t)(16 * seg) * stride_; } while (0)
    if (F.bid < 8 * 258) { float* p0; int st0; MB_ADDR(F.bid, p0, st0);
#pragma unroll
        for (int i = 0; i < 16; ++i) vnx[i] = p0[(size_t)i * st0]; }
    for (int u = F.bid; u < 8 * 258; u += F.G) {
        const int bh = u / 258;
        float* p; int stride; MB_ADDR(u, p, stride);
        float val[16];
#pragma unroll
        for (int i = 0; i < 16; ++i) val[i] = vnx[i];
        { const int un = u + F.G < 8 * 258 ? u + F.G : u; float* pn; int stn; MB_ADDR(un, pn, stn);
#pragma unroll
          for (int i = 0; i < 16; ++i) vnx[i] = pn[(size_t)i * stn]; }
        const LAS float* ca = ta + bh * 256 + 16 * seg; const LAS float* cg = tg + bh * 256 + 16 * seg;
        float A = 1.f, B = 0.f;
#pragma unroll
        for (int i = 0; i < 16; ++i) { const float a = ca[i]; A *= a; B = a * B + cg[i] * val[i]; }
        xa[seg * 32 + el] = A; xb[seg * 32 + el] = B;
        __syncthreads();
        float C = 0.f;
        for (int s2 = 0; s2 < seg; ++s2) C = xa[s2 * 32 + el] * C + xb[s2 * 32 + el];
#pragma unroll
        for (int i = 0; i < 16; ++i) { p[(size_t)i * stride] = C; C = ca[i] * C + cg[i] * val[i]; }
        __syncthreads();
    }
#undef MB_ADDR
}
__device__ __forceinline__ void mlstm_c_phase(Frame& F, const u16* MQK, const u16* MV, const u16* MO, const float* IF, const float* cw, const float* cb, const float* hg, const float* ST, u16* YB) {
    LAS float* Qs = (LAS float*)F.lds;
    LAS float* Ks = Qs + 64 * 65;
    LAS float* Vs = Ks + 64 * 65;
    LAS float* Cs = Vs + 64 * 128;
    LAS float* Ss = Cs + 64 * 128;
    LAS float* bsv = Ss + 64 * 65;
    LAS float* gsv = bsv + 64;
    LAS float* mtv = gsv + 64;
    LAS float* dcv = mtv + 64;
    LAS float* npv = dcv + 64;
    const float* mprev = (const float*)(F.ws + WS_MLS) + 4096; const float* nst = (const float*)(F.ws + WS_MLS + 65536);
    const int tid = F.tid;
    for (int u = F.bid; u < 2048; u += F.G) {
        const int bh = u >> 8, c = u & 255, b = bh >> 2, h = bh & 3, pos0 = c * 64; const size_t row0 = (size_t)b * SEQ + pos0;
        __syncthreads();
        stage_conv(Qs, MQK, row0, pos0, h * 64, cw, cb, 1.0f, tid);
        stage_conv(Ks, MQK, row0, pos0, 256 + h * 64, cw, cb, 0.125f, tid);
        for (int e = tid; e < 64 * 16; e += NTHR) { const int s = e >> 4, cc = e & 15; const v4u w = *(const v4u*)(MV + (row0 + s) * 512 + h * 128 + cc * 8);
            LAS float* d = Vs + s * 128 + cc * 8; d[0] = bflo(w.x); d[1] = bfhi(w.x); d[2] = bflo(w.y); d[3] = bfhi(w.y); d[4] = bflo(w.z); d[5] = bfhi(w.z); d[6] = bflo(w.w); d[7] = bfhi(w.w); }
        for (int e = tid; e < 2048; e += NTHR) ((LAS f32x4*)Cs)[e] = ((const f32x4*)(ST + (size_t)u * 8192))[e];
        if (tid < 64) { const float ig = IF[(row0 + tid) * 8 + h], lf = IF[(row0 + tid) * 8 + 4 + h], m = mprev[u];
            const float bs = wave_incl_scan_add(lf, tid), gs = ig - bs, gmx = wave_incl_scan_max(gs, tid);
            const float inter = bs + m, mt = fmaxf(inter, bs + gmx);
            bsv[tid] = bs; gsv[tid] = gs; mtv[tid] = mt; dcv[tid] = __expf(inter - mt); npv[tid] = nst[(size_t)u * 64 + tid]; }
        __syncthreads();
        const int t = tid >> 3, g8 = tid & 7;
        float den;
        {   float sa[8]; float qn = 0.f;
#pragma unroll
            for (int i = 0; i < 8; ++i) sa[i] = 0.f;
            for (int d = 0; d < 64; ++d) { const float qv = Qs[t * 65 + d]; qn += qv * npv[d];
#pragma unroll
                for (int i = 0; i < 8; ++i) sa[i] += qv * Ks[(g8 * 8 + i) * 65 + d]; }
            const float bt = bsv[t], mt = mtv[t]; float rs = 0.f;
#pragma unroll
            for (int i = 0; i < 8; ++i) { const int s = g8 * 8 + i; const float sc = (s <= t) ? sa[i] * __expf(bt + gsv[s] - mt) : 0.f; Ss[t * 65 + s] = sc; rs += sc; }
            { const int ln_ = tid & 63; rs += bperm_f(ln_ ^ 1, rs); rs += bperm_f(ln_ ^ 2, rs); rs += bperm_f(ln_ ^ 4, rs); }
            den = dcv[t] * qn + rs;
        }
        __syncthreads();
        float acc[16];
#pragma unroll
        for (int i = 0; i < 16; ++i) acc[i] = 0.f;
        { const float dc = dcv[t];
            for (int d = 0; d < 64; ++d) { const float qd = Qs[t * 65 + d] * dc; const LAS f32x4* cp = (const LAS f32x4*)(Cs + d * 128 + g8 * 16);
#pragma unroll
                for (int i = 0; i < 4; ++i) { const f32x4 vv = cp[i]; acc[4 * i + 0] += qd * vv.x; acc[4 * i + 1] += qd * vv.y; acc[4 * i + 2] += qd * vv.z; acc[4 * i + 3] += qd * vv.w; } }
            for (int s = 0; s < 64; ++s) { const float p = Ss[t * 65 + s]; const LAS f32x4* vp = (const LAS f32x4*)(Vs + s * 128 + g8 * 16);
#pragma unroll
                for (int i = 0; i < 4; ++i) { const f32x4 vv = vp[i]; acc[4 * i + 0] += p * vv.x; acc[4 * i + 1] += p * vv.y; acc[4 * i + 2] += p * vv.z; acc[4 * i + 3] += p * vv.w; } } }
        const float inv = 1.0f / fmaxf(fabsf(den), __expf(-mtv[t]));
        float ss = 0.f;
#pragma unroll
        for (int i = 0; i < 16; ++i) { acc[i] *= inv; ss += acc[i] * acc[i]; }
        { const int ln_ = tid & 63; ss += bperm_f(ln_ ^ 1, ss); ss += bperm_f(ln_ ^ 2, ss); ss += bperm_f(ln_ ^ 4, ss); }
        const float rstd = 1.0f / sqrtf(ss * (1.f / 128.f) + EPS);
        const size_t ob = (row0 + t) * 512 + h * 128 + g8 * 16;
#pragma unroll
        for (int j = 0; j < 2; ++j) { const v4u mo = *(const v4u*)(MO + ob + j * 8); const float* gp = hg + h * 128 + g8 * 16 + j * 8;
            float y[8];
#pragma unroll
            for (int i = 0; i < 8; ++i) y[i] = acc[j * 8 + i] * rstd * gp[i];
            y[0] *= bflo(mo.x); y[1] *= bfhi(mo.x); y[2] *= bflo(mo.y); y[3] *= bfhi(mo.y); y[4] *= bflo(mo.z); y[5] *= bfhi(mo.z); y[6] *= bflo(mo.w); y[7] *= bfhi(mo.w);
            v4u w; w.x = pk2(y[0], y[1]); w.y = pk2(y[2], y[3]); w.z = pk2(y[4], y[5]); w.w = pk2(y[6], y[7]);
            *(v4u*)(YB + ob + j * 8) = w; }
    }
    __syncthreads();
}

__device__ __forceinline__ void router_bias(Frame& F, const float* modl, const float* wrg, const float* brg, const float* wre, const float* bre) {
    const int gw = F.bid * NWAVES + F.wave, lane = F.lane;
    if (gw < 40) { const int b = gw / 20, j = gw % 20; const float* sh = modl + (size_t)(b * 6 + 3) * 1024; float s = 0.f;
#pragma unroll
        for (int i = 0; i < 16; ++i) { const int c = lane + 64 * i; s += sh[c] * (j < 4 ? wrg[c * 4 + j] : wre[c * 16 + (j - 4)]); }
        s = wave_sum(s, lane);
        if (lane == 0) ((float*)(F.ws + WS_ROUT + 896 * 1024))[b * 32 + j] = s + (j < 4 ? brg[j] : bre[j - 4]); }
}
__device__ __forceinline__ void router_phase(Frame& F, const float* x, const float* gain, const float* modl, const float* wrg, const float* brg, const float* wre, const float* bre, u32* cnt) {
    typedef float f32x16r __attribute__((ext_vector_type(16)));
    const int lane = F.lane, wid = F.wave, tid = F.tid;
    int* cls_o = (int*)(F.ws + WS_ROUT); int* slot_o = cls_o + NTOK; float* wa_o = (float*)(slot_o + NTOK); float* wb_o = wa_o + NTOK; float* rstd_o = wb_o + NTOK;
    const float* biasr = (const float*)(F.ws + WS_ROUT + 896 * 1024);
    LAS float* Wt = (LAS float*)F.lds;
    LAS float* scr = (LAS float*)(F.lds + 20512 * 4) + wid * (32 * 33 + 32);
    for (int t4 = F.bid; t4 < NTOK / 128; t4 += F.G) {
        const int b = (t4 * 128) / SEQ;
        __syncthreads();
#pragma unroll
        for (int i = 0; i < 2; ++i) { const int c = tid + NTHR * i; const float f = gain[c] * (1.0f + modl[(size_t)(b * 6 + 4) * 1024 + c]);
            const f32x4 g4 = *(const f32x4*)(wrg + c * 4), e0 = *(const f32x4*)(wre + c * 16), e1 = *(const f32x4*)(wre + c * 16 + 4), e2 = *(const f32x4*)(wre + c * 16 + 8), e3 = *(const f32x4*)(wre + c * 16 + 12);
            LAS f32x4* wo = (LAS f32x4*)(Wt + c * 20); wo[0] = g4 * f; wo[1] = e0 * f; wo[2] = e1 * f; wo[3] = e2 * f; wo[4] = e3 * f; }
        if (tid < 16) Wt[20480 + tid] = 0.f;
        __syncthreads();
        const int tl = wid & 3, hf = wid >> 2;
        const int r0 = t4 * 128 + tl * 32, i = lane & 31, kk = lane >> 5;
        f32x16r acc; float zz = 0.f; asm volatile("" : "+v"(zz));
#pragma unroll
        for (int r = 0; r < 16; ++r) acc[r] = zz;
        float ssq = zz;
        { const float* xr = x + (size_t)(r0 + i) * DM + 4 * kk + 512 * hf; const LAS float* wp = Wt + (4 * kk + 512 * hf) * 20 + i;
            f32x4 xn[4];
#pragma unroll
            for (int j = 0; j < 4; ++j) xn[j] = *(const f32x4*)(xr + 8 * j);
#pragma unroll 1
            for (int m0 = 0; m0 < 64; m0 += 4) { f32x4 xc[4];
#pragma unroll
                for (int j = 0; j < 4; ++j) xc[j] = xn[j];
                { const int mn = m0 + 4 < 64 ? m0 + 4 : m0;
#pragma unroll
                  for (int j = 0; j < 4; ++j) xn[j] = *(const f32x4*)(xr + 8 * (mn + j)); }
#pragma unroll
                for (int j = 0; j < 4; ++j) { const f32x4 xa = xc[j]; const int m = m0 + j; ssq += (xa.x * xa.x + xa.y * xa.y) + (xa.z * xa.z + xa.w * xa.w);
                    acc = __builtin_amdgcn_mfma_f32_32x32x2f32(xa.x, wp[(8 * m + 0) * 20], acc, 0, 0, 0); acc = __builtin_amdgcn_mfma_f32_32x32x2f32(xa.y, wp[(8 * m + 1) * 20], acc, 0, 0, 0);
                    acc = __builtin_amdgcn_mfma_f32_32x32x2f32(xa.z, wp[(8 * m + 2) * 20], acc, 0, 0, 0); acc = __builtin_amdgcn_mfma_f32_32x32x2f32(xa.w, wp[(8 * m + 3) * 20], acc, 0, 0, 0); } } }
        ssq += bperm_f(lane ^ 32, ssq);
        if (hf == 1) {
#pragma unroll
            for (int r = 0; r < 16; ++r) scr[r * 64 + lane] = acc[r];
            scr[1024 + lane] = ssq; }
        __syncthreads();
        if (hf == 0) { const LAS float* ps = scr + 4 * (32 * 33 + 32);
#pragma unroll
            for (int r = 0; r < 16; ++r) acc[r] += ps[r * 64 + lane];
            ssq += ps[1024 + lane];
            const float rstd = 1.0f / sqrtf(ssq * (1.f / DM) + EPS);
#pragma unroll
            for (int r = 0; r < 16; ++r) scr[((r & 3) + 8 * (r >> 2) + 4 * kk) * 33 + i] = acc[r];
            if (kk == 0) scr[32 * 33 + i] = rstd;
            LDS_WAIT(); asm volatile("" ::: "memory");
            if (lane < 32) { const int m = r0 + lane; const float rs = scr[32 * 33 + lane]; const LAS float* L = scr + lane * 33; const float* bz = biasr + b * 32;
                const float g0 = L[0] * rs + bz[0], g1 = L[1] * rs + bz[1], g2 = L[2] * rs + bz[2], g3 = L[3] * rs + bz[3];
                int gi = 0; float gm = g0; if (g1 > gm) { gm = g1; gi = 1; } if (g2 > gm) { gm = g2; gi = 2; } if (g3 > gm) { gm = g3; gi = 3; }
                const float psel = 1.0f / (expf(g0 - gm) + expf(g1 - gm) + expf(g2 - gm) + expf(g3 - gm));
                const float e0 = L[4 + gi * 4 + 0] * rs + bz[4 + gi * 4 + 0], e1 = L[4 + gi * 4 + 1] * rs + bz[4 + gi * 4 + 1], e2 = L[4 + gi * 4 + 2] * rs + bz[4 + gi * 4 + 2], e3 = L[4 + gi * 4 + 3] * rs + bz[4 + gi * 4 + 3];
                int i1 = 0; float v1 = e0; if (e1 > v1) { v1 = e1; i1 = 1; } if (e2 > v1) { v1 = e2; i1 = 2; } if (e3 > v1) { v1 = e3; i1 = 3; }
                int i2 = -1; float v2 = 0.f;
                if (i1 != 0) { v2 = e0; i2 = 0; }
                if (i1 != 1 && (i2 < 0 || e1 > v2)) { v2 = e1; i2 = 1; }
                if (i1 != 2 && (i2 < 0 || e2 > v2)) { v2 = e2; i2 = 2; }
                if (i1 != 3 && (i2 < 0 || e3 > v2)) { v2 = e3; i2 = 3; }
                const float ex = expf(v2 - v1), w1 = psel / (1.0f + ex), w2 = psel * ex / (1.0f + ex);
                const int a = i1 < i2 ? i1 : i2, bb = i1 < i2 ? i2 : i1;
                const int pair = a == 0 ? bb - 1 : (a == 1 ? bb + 1 : 5);
                const int cls = gi * 6 + pair;
                const u32 sl = __hip_atomic_fetch_add(cnt + cls, 1u, __ATOMIC_RELAXED, __HIP_MEMORY_SCOPE_AGENT);
                cls_o[m] = cls; slot_o[m] = (int)sl; wa_o[m] = i1 < i2 ? w1 : w2; wb_o[m] = i1 < i2 ? w2 : w1; rstd_o[m] = rs; }
        }
    }
    __syncthreads();
}
__device__ __forceinline__ void moe_table(Frame& F, const u32* cnt) {
    LAS int* tab = (LAS int*)(F.lds + TAB_OFF);
    if (F.tid < 64) {
        const int c = F.tid; const int n = c < 24 ? (int)__hip_atomic_load(cnt + c, __ATOMIC_RELAXED, __HIP_MEMORY_SCOPE_AGENT) : 0; const int nt = (n + 255) >> 8;
        const int incl = (int)wave_incl_scan_add((float)nt, c), rt0 = incl - nt;
        if (c < 24) { tab[256 + c] = rt0 * 256; for (int i = 0; i < nt; ++i) tab[1 + rt0 + i] = c; }
        if (c == 23) tab[0] = incl; }
    __syncthreads();
}
__device__ __forceinline__ void moe_units(Frame& F, int mode) {
    LAS int* tab = (LAS int*)(F.lds + TAB_OFF); LAS int* ul = tab + 320;
    if (F.tid == 0) { const int nrt = tab[0]; int n = 0;
        const bool xo = (F.G & 7) == 0; const int x = F.bid & 7, j = F.bid >> 3, nj = F.G >> 3;
        for (int q = xo ? j : F.bid; ; q += xo ? nj : F.G) { int rt, pn;
            if (xo) { rt = (q >> 2) * 8 + x; pn = q & 3; if ((q >> 2) * 8 >= nrt) break; if (rt >= nrt) continue; } else { if (q >= nrt * 4) break; rt = q >> 2; pn = q & 3; }
            const int cls = tab[1 + rt]; int pb;
            if (mode == 0) { int ea, eb; cls_experts(cls, ea, eb); pb = ((pn >> 1) ? eb : ea) * 2 + (pn & 1); } else pb = cls * 4 + pn;
            ul[1 + n] = rt | (pn << 8) | (pb << 16); ++n; }
        ul[0] = n; }
    __syncthreads();
}
__device__ __forceinline__ void scatter_phase(Frame& F, const float* x, const float* gain, const float* modl, const u32* cnt, u16* HS) {
    moe_table(F, cnt);
    const LAS int* tab = (const LAS int*)(F.lds + TAB_OFF);
    const int gw = F.bid * NWAVES + F.wave, NGW = F.G * NWAVES, lane = F.lane;
    const int* cls_o = (const int*)(F.ws + WS_ROUT); const int* slot_o = cls_o + NTOK; const float* wa_o = (const float*)(slot_o + NTOK); const float* wb_o = wa_o + NTOK; const float* rstd_o = wb_o + NTOK;
    int* tok = (int*)(F.ws + WS_TOK); float* wrow = (float*)(F.ws + WS_TOK + 262144);
    for (int c = F.bid; c < 24; c += F.G) { const int n = (int)__hip_atomic_load(cnt + c, __ATOMIC_RELAXED, __HIP_MEMORY_SCOPE_AGENT); const int base = tab[256 + c], end = base + (((n + 255) >> 8) << 8);
        float z_ = 0.f; asm volatile("" : "+v"(z_));
        for (int r = base + n + F.tid; r < end; r += NTHR) { tok[r] = -1; wrow[2 * r] = z_; wrow[2 * r + 1] = z_; } }
    f32x4 xn[4]; int cln = 0, sln = 0; float rsn = 0.f, wan = 0.f, wbn = 0.f;
#define SC_LOAD(m_) do { const int mm_ = (m_) < NTOK ? (m_) : gw; const f32x4* xr_ = (const f32x4*)(x + (size_t)mm_ * DM) + lane; _Pragma("unroll") for (int j = 0; j < 4; ++j) xn[j] = xr_[64 * j]; \
        cln = cls_o[mm_]; sln = slot_o[mm_]; rsn = rstd_o[mm_]; wan = wa_o[mm_]; wbn = wb_o[mm_]; } while (0)
    SC_LOAD(gw);
    for (int m = gw; m < NTOK; m += NGW) {
        const int b = m / SEQ; const int pos = tab[256 + cln] + sln; const float rstd = rsn, wa = wan, wb = wbn;
        f32x4 xc[4];
#pragma unroll
        for (int j = 0; j < 4; ++j) xc[j] = xn[j];
        SC_LOAD(m + NGW);
        v2u* o8 = (v2u*)(HS + (size_t)pos * DM) + lane;
#pragma unroll
        for (int j = 0; j < 4; ++j) { const int c0 = 4 * lane + 256 * j; const f32x4 v = xc[j];
            const f32x4 g = *(const f32x4*)(gain + c0), sc = *(const f32x4*)(modl + (size_t)(b * 6 + 4) * 1024 + c0), sh = *(const f32x4*)(modl + (size_t)(b * 6 + 3) * 1024 + c0);
            const f32x4 y = (v * rstd) * g * (sc + 1.0f) + sh;
            v2u w; w.x = pk2(y.x, y.y); w.y = pk2(y.z, y.w); o8[64 * j] = w; }
        if (lane == 0) { tok[pos] = m; wrow[2 * pos] = wa; wrow[2 * pos + 1] = wb; }
    }
#undef SC_LOAD
}

typedef float f32x16 __attribute__((ext_vector_type(16)));
typedef short s16x8 __attribute__((ext_vector_type(8)));
typedef short s16x4 __attribute__((ext_vector_type(4)));
#if MK_F16
#define MFMA32(a, b, c) __builtin_amdgcn_mfma_f32_32x32x16_f16(__builtin_bit_cast(pg8::h16x8, (a)), __builtin_bit_cast(pg8::h16x8, (b)), (c), 0, 0, 0)
#else
#define MFMA32(a, b, c) __builtin_amdgcn_mfma_f32_32x32x16_bf16((a), (b), (c), 0, 0, 0)
#endif
__device__ __forceinline__ int crow(int r, int hi) { return (r & 3) + 8 * (r >> 2) + 4 * hi; }
__device__ __forceinline__ void gl_lds16(const void* g, LAS unsigned char* l) { __builtin_amdgcn_global_load_lds((const unsigned*)g, (LAS unsigned*)l, 16, 0, 0); }
__device__ __forceinline__ void glds_s(const void* sbase, unsigned voff_bytes, unsigned lds_dst) { unsigned keep_;
    asm volatile("s_mov_b32 %0, m0\n\ts_mov_b32 m0, %3\n\ts_nop 0\n\tglobal_load_lds_dwordx4 %1, %2\n\ts_mov_b32 m0, %0" : "=&s"(keep_) : "v"(voff_bytes), "s"(sbase), "s"(lds_dst) : "memory"); }
__device__ __forceinline__ const void* sgpr_ptr(const void* p) { const unsigned long long a = (unsigned long long)p; const unsigned lo = __builtin_amdgcn_readfirstlane((unsigned)a), hi = __builtin_amdgcn_readfirstlane((unsigned)(a >> 32)); return (const void*)(((unsigned long long)hi << 32) | lo); }
__device__ __forceinline__ s16x4 vtr16(const LAS unsigned char* p) { typedef short v4i16_t __attribute__((ext_vector_type(4))); return __builtin_bit_cast(s16x4, __builtin_amdgcn_ds_read_tr16_b64_v4i16((LAS v4i16_t*)p)); }
__device__ __forceinline__ float swapmax(float m) { auto rr = __builtin_amdgcn_permlane32_swap(__float_as_uint(m), __float_as_uint(m), false, false); return fmaxf(__uint_as_float(rr[0]), __uint_as_float(rr[1])); }
__device__ __forceinline__ float max16_mfma(const f32x16& a) { float m;
    asm("s_nop 11\n\tv_max3_f32 %0, %1, %2, %3\n\tv_max3_f32 %0, %0, %4, %5\n\tv_max3_f32 %0, %0, %6, %7\n\tv_max3_f32 %0, %0, %8, %9\n\tv_max3_f32 %0, %0, %10, %11\n\tv_max3_f32 %0, %0, %12, %13\n\tv_max3_f32 %0, %0, %14, %15\n\tv_max_f32 %0, %0, %16"
        : "=&v"(m) : "v"(a[0]), "v"(a[1]), "v"(a[2]), "v"(a[3]), "v"(a[4]), "v"(a[5]), "v"(a[6]), "v"(a[7]), "v"(a[8]), "v"(a[9]), "v"(a[10]), "v"(a[11]), "v"(a[12]), "v"(a[13]), "v"(a[14]), "v"(a[15]));
    return m; }
__device__ __forceinline__ float max16_seed(const f32x16& a, float seed) { float m;
    asm("v_max3_f32 %0, %17, %1, %2\n\tv_max3_f32 %0, %0, %3, %4\n\tv_max3_f32 %0, %0, %5, %6\n\tv_max3_f32 %0, %0, %7, %8\n\tv_max3_f32 %0, %0, %9, %10\n\tv_max3_f32 %0, %0, %11, %12\n\tv_max3_f32 %0, %0, %13, %14\n\tv_max3_f32 %0, %0, %15, %16"
        : "=&v"(m) : "v"(a[0]), "v"(a[1]), "v"(a[2]), "v"(a[3]), "v"(a[4]), "v"(a[5]), "v"(a[6]), "v"(a[7]), "v"(a[8]), "v"(a[9]), "v"(a[10]), "v"(a[11]), "v"(a[12]), "v"(a[13]), "v"(a[14]), "v"(a[15]), "v"(seed));
    return m; }
__device__ __forceinline__ float swapsum(float m) { auto rr = __builtin_amdgcn_permlane32_swap(__float_as_uint(m), __float_as_uint(m), false, false); return __uint_as_float(rr[0]) + __uint_as_float(rr[1]); }
constexpr int MA_KSLOT = 12288, MA_VSLOT = 8192, MA_V0 = 2 * MA_KSLOT, MA_WS = MA_V0 + 2 * MA_VSLOT, MA_OST = MA_WS + 2048, MA_BYTES = MA_OST + 8 * 4096;
__device__ __forceinline__ void mla_attn_unit(LAS unsigned char* lds, int tid, int wid, const u16* Q, const u16* K, const u16* V, u16* O, int b, int h, int qb) {
    const int lane = tid & 63, r32 = lane & 31, hi = lane >> 5;
    const size_t rowb = (size_t)b * SEQ; const int q0 = qb * 256;
    const u16* Qw = Q + (rowb + q0 + wid * 32) * 768 + h * 96;
    const u16* ksrc1 = K + (rowb + lane) * 768 + h * 96 + wid * 8;
    const u16* ksrc2 = K + (rowb + lane) * 768 + h * 96 + (8 + (wid & 3)) * 8;
    const u16* vsrc = V + (rowb + 16 * (wid & 3) + (lane >> 2)) * 512 + h * 64 + (wid >> 2) * 32 + (lane & 3) * 8;
    LAS float* wsf = (LAS float*)(lds + MA_WS) + wid * 64;
    const int NT = (q0 + 256) / 64;
#define MA_DMA(t, s) do { gl_lds16(ksrc1 + (size_t)(t) * 64 * 768, lds + (s) * MA_KSLOT + wid * 1024); gl_lds16(ksrc2 + (size_t)(t) * 64 * 768, lds + (s) * MA_KSLOT + (8 + (wid & 3)) * 1024); \
                           gl_lds16(vsrc + (size_t)(t) * 64 * 512, lds + MA_V0 + (s) * MA_VSLOT + wid * 1024); } while (0)
    MA_DMA(0, 0);
    s16x8 qr[6];
#pragma unroll
    for (int d0 = 0; d0 < 6; ++d0) qr[d0] = *(const s16x8*)(Qw + (size_t)r32 * 768 + d0 * 16 + hi * 8);
    float zf_ = 0.f; asm volatile("" : "+v"(zf_));
    float mref = zf_, l = zf_; f32x16 o0, o1;
#pragma unroll
    for (int r = 0; r < 16; ++r) { o0[r] = zf_; o1[r] = zf_; }
    const int qg = q0 + wid * 32 + r32;
    const int kfo = hi * 1024 + r32 * 16;
    const int vfo = ((lane >> 4) & 1) * 32 + (lane & 3) * 8 + (4 * hi + ((lane & 15) >> 2)) * 64;
    asm volatile("s_waitcnt vmcnt(0)" ::: "memory"); __builtin_amdgcn_s_barrier(); asm volatile("" ::: "memory");
    for (int t = 0; t < NT; ++t) {
        const int s = t & 1;
        if (t + 1 < NT) MA_DMA(t + 1, s ^ 1);
        const LAS unsigned char* kp = lds + s * MA_KSLOT + kfo; const LAS unsigned char* vp = lds + MA_V0 + s * MA_VSLOT + vfo;
        f32x16 p0, p1;
#pragma unroll
        for (int r = 0; r < 16; ++r) { p0[r] = zf_; p1[r] = zf_; }
#pragma unroll
        for (int d0 = 0; d0 < 6; ++d0) { const s16x8 a0 = *(const LAS s16x8*)(kp + d0 * 2048), a1 = *(const LAS s16x8*)(kp + d0 * 2048 + 512);
            p0 = MFMA32(a0, qr[d0], p0); p1 = MFMA32(a1, qr[d0], p1); }
        if (t >= NT - 4) { const int kb = t * 64 + 4 * hi;
#pragma unroll
            for (int r = 0; r < 16; ++r) { const int kv = kb + (r & 3) + 8 * (r >> 2); if (kv > qg) p0[r] = -INFINITY; if (kv + 32 > qg) p1[r] = -INFINITY; } }
        float rm = fmaxf(p0[0], p1[0]);
#pragma unroll
        for (int r = 1; r < 16; ++r) rm = fmaxf(rm, fmaxf(p0[r], p1[r]));
        rm = swapmax(rm);
        if (t == 0) mref = rm;
        else { const float dl = rm - mref;
            if (__any(dl > 8.f)) { const float d2 = fmaxf(dl, 0.f), f = __builtin_amdgcn_exp2f(-d2); mref += d2; l *= f; if (hi == 0) wsf[r32] = f;
                asm volatile("s_waitcnt lgkmcnt(0)" ::: "memory");
#pragma unroll
                for (int r = 0; r < 16; ++r) { const float fr = wsf[crow(r, hi)]; o0[r] *= fr; o1[r] *= fr; } } }
        float sacc = zf_;
#pragma unroll
        for (int r = 0; r < 16; ++r) { p0[r] = __builtin_amdgcn_exp2f(p0[r] - mref); p1[r] = __builtin_amdgcn_exp2f(p1[r] - mref); sacc += p0[r] + p1[r]; }
        l += sacc;
        v4u pw[4];
        pw[0] = (v4u){pk2(p0[0], p0[1]), pk2(p0[2], p0[3]), pk2(p0[4], p0[5]), pk2(p0[6], p0[7])};
        pw[1] = (v4u){pk2(p0[8], p0[9]), pk2(p0[10], p0[11]), pk2(p0[12], p0[13]), pk2(p0[14], p0[15])};
        pw[2] = (v4u){pk2(p1[0], p1[1]), pk2(p1[2], p1[3]), pk2(p1[4], p1[5]), pk2(p1[6], p1[7])};
        pw[3] = (v4u){pk2(p1[8], p1[9]), pk2(p1[10], p1[11]), pk2(p1[12], p1[13]), pk2(p1[14], p1[15])};
#pragma unroll
        for (int ks = 0; ks < 4; ++ks) { const s16x8 pa = __builtin_bit_cast(s16x8, pw[ks]);
            { const s16x4 lo = vtr16(vp + ks * 1024), hh = vtr16(vp + ks * 1024 + 512); const s16x8 vf = {lo[0], lo[1], lo[2], lo[3], hh[0], hh[1], hh[2], hh[3]}; o0 = MFMA32(pa, vf, o0); }
            { const s16x4 lo = vtr16(vp + 4096 + ks * 1024), hh = vtr16(vp + 4096 + ks * 1024 + 512); const s16x8 vf = {lo[0], lo[1], lo[2], lo[3], hh[0], hh[1], hh[2], hh[3]}; o1 = MFMA32(pa, vf, o1); } }
        asm volatile("s_waitcnt vmcnt(0) lgkmcnt(0)" ::: "memory"); __builtin_amdgcn_s_barrier(); asm volatile("" ::: "memory");
    }
#undef MA_DMA
    l = swapsum(l);
    if (hi == 0) wsf[32 + r32] = l;
    asm volatile("s_waitcnt lgkmcnt(0)" ::: "memory");
    LAS u16* stg = (LAS u16*)(lds + MA_OST) + wid * 2048;
#pragma unroll
    for (int r = 0; r < 16; ++r) { const int orow = crow(r, hi); const float rl = 1.0f / wsf[32 + orow];
        const u32 w = pk2(o0[r] * rl, o1[r] * rl); stg[orow * 64 + r32] = (u16)(w & 0xffffu); stg[orow * 64 + 32 + r32] = (u16)(w >> 16); }
    asm volatile("s_waitcnt lgkmcnt(0)" ::: "memory");
    u16* Ow = O + (rowb + q0 + wid * 32) * 512 + h * 64;
#pragma unroll
    for (int i = 0; i < 4; ++i) { const int row = i * 8 + (lane >> 3), ch = lane & 7; const v4u v = *(const LAS v4u*)(stg + row * 64 + ch * 8); *(v4u*)(Ow + (size_t)row * 512 + ch * 8) = v; }
    asm volatile("s_waitcnt lgkmcnt(0)" ::: "memory"); __builtin_amdgcn_s_barrier(); asm volatile("" ::: "memory");
}
#define SGB(mask, n) __builtin_amdgcn_sched_group_barrier((mask), (n), 0)
__device__ __forceinline__ void mla_attn_unit2(LAS unsigned char* lds, int tid, int wid, const u16* Q, const u16* K, const u16* V, u16* O, int b, int h, int qb, const float* qgain, const float* ropec) {
    const int lane = tid & 63, r32 = lane & 31, hi = lane >> 5;
    const size_t rowb = (size_t)b * SEQ; const int q0 = qb * 256;
    const void* kbase = sgpr_ptr(K + (size_t)(b * 8 + h) * 256 * 6144); const void* vbase = sgpr_ptr(V + (size_t)(b * 8 + h) * 256 * 4096);
    const unsigned ldsb = (unsigned)__builtin_amdgcn_readfirstlane((unsigned)(size_t)lds + (unsigned)wid * 1024u);
    const unsigned ko1 = (unsigned)(wid * 1024 + lane * 16), ko2 = (unsigned)((8 + (wid & 3)) * 1024 + lane * 16), vo = ko1;
    constexpr int R_V0 = 4 * MA_KSLOT, R_WS = R_V0 + 3 * MA_VSLOT, R_OST = R_WS + 2048;
    LAS float* wsf = (LAS float*)(lds + R_WS) + wid * 64;
    const int NT = (q0 + 256) / 64;
#define MB_DMAK(t, s) do { glds_s(kbase, ko1 + (unsigned)(t) * 12288u, ldsb + (unsigned)((s) * MA_KSLOT)); glds_s(kbase, ko2 + (unsigned)(t) * 12288u, ldsb + (unsigned)((s) * MA_KSLOT + 8192 - (wid >> 2) * 4096)); } while (0)
#define MB_DMAV(t, s) glds_s(vbase, vo + (unsigned)(t) * 8192u, ldsb + (unsigned)(R_V0 + (s) * MA_VSLOT))
    MB_DMAK(0, 0); MB_DMAV(0, 0); MB_DMAK(1, 1); MB_DMAK(2, 2);
    s16x8 qr[6];
    { const u16* qp = Q + rowb * 768 + h * 96; const unsigned qo = (unsigned)((q0 + wid * 32 + r32) * 768 + hi * 8);
#pragma unroll
      for (int d0 = 0; d0 < 6; ++d0) qr[d0] = *(const s16x8*)(qp + (qo + d0 * 16)); }
    { float qf[6][8]; float ss = 0.f;
#pragma unroll
      for (int d0 = 0; d0 < 6; ++d0) { const v4u w = __builtin_bit_cast(v4u, qr[d0]); qf[d0][0] = bflo(w.x); qf[d0][1] = bfhi(w.x); qf[d0][2] = bflo(w.y); qf[d0][3] = bfhi(w.y); qf[d0][4] = bflo(w.z); qf[d0][5] = bfhi(w.z); qf[d0][6] = bflo(w.w); qf[d0][7] = bfhi(w.w);
#pragma unroll
          for (int j = 0; j < 8; ++j) ss += qf[d0][j] * qf[d0][j]; }
      ss = swapsum(ss);
      const float rs = (1.0f / sqrtf(ss * (1.f / 96.f) + EPS)) * (0.10206207261596577f * LOG2E);
#pragma unroll
      for (int d0 = 0; d0 < 6; ++d0) { const f32x4 g0 = *(const f32x4*)(qgain + d0 * 16 + hi * 8), g1 = *(const f32x4*)(qgain + d0 * 16 + hi * 8 + 4);
          qf[d0][0] = qf[d0][0] * rs * g0.x; qf[d0][1] = qf[d0][1] * rs * g0.y; qf[d0][2] = qf[d0][2] * rs * g0.z; qf[d0][3] = qf[d0][3] * rs * g0.w; qf[d0][4] = qf[d0][4] * rs * g1.x; qf[d0][5] = qf[d0][5] * rs * g1.y; qf[d0][6] = qf[d0][6] * rs * g1.z; qf[d0][7] = qf[d0][7] * rs * g1.w; }
      { const int pos = q0 + wid * 32 + r32; const float* cp = ropec + pos * 16 + hi * 8; const float* sp = cp + SEQ * 16;
        const f32x4 c0 = *(const f32x4*)cp, c1 = *(const f32x4*)(cp + 4), s0 = *(const f32x4*)sp, s1 = *(const f32x4*)(sp + 4);
        const float cs[8] = {c0.x, c0.y, c0.z, c0.w, c1.x, c1.y, c1.z, c1.w}, sn[8] = {s0.x, s0.y, s0.z, s0.w, s1.x, s1.y, s1.z, s1.w};
#pragma unroll
        for (int j = 0; j < 8; ++j) { const float x1 = qf[4][j], x2 = qf[5][j]; qf[4][j] = x1 * cs[j] - x2 * sn[j]; qf[5][j] = x1 * sn[j] + x2 * cs[j]; } }
#pragma unroll
      for (int d0 = 0; d0 < 6; ++d0) { v4u w; w.x = pk2(qf[d0][0], qf[d0][1]); w.y = pk2(qf[d0][2], qf[d0][3]); w.z = pk2(qf[d0][4], qf[d0][5]); w.w = pk2(qf[d0][6], qf[d0][7]); qr[d0] = __builtin_bit_cast(s16x8, w); } }
    float zf_ = 0.f; asm volatile("" : "+v"(zf_));
    float mref = zf_, l = zf_; f32x16 o0, o1, negm; f32x4 pe[8];
#pragma unroll
    for (int r = 0; r < 16; ++r) { o0[r] = zf_; o1[r] = zf_; }
    const int qg = q0 + wid * 32 + r32;
    const int kfo = hi * 1024 + r32 * 16, vfo = ((lane >> 4) & 1) * 32 + (lane & 3) * 8 + (4 * hi + ((lane & 15) >> 2)) * 64;
    asm volatile("s_waitcnt vmcnt(4)" ::: "memory"); __builtin_amdgcn_s_barrier(); asm volatile("" ::: "memory");
    MB_DMAK(3, 3); MB_DMAV(1, 1);
    { const LAS unsigned char* kp = lds + kfo; f32x16 p0, p1;
#pragma unroll
      for (int r = 0; r < 16; ++r) { p0[r] = zf_; p1[r] = zf_; }
#pragma unroll
      for (int d0 = 0; d0 < 6; ++d0) { const s16x8 a0 = *(const LAS s16x8*)(kp + d0 * 2048), a1 = *(const LAS s16x8*)(kp + d0 * 2048 + 512); p0 = MFMA32(a0, qr[d0], p0); p1 = MFMA32(a1, qr[d0], p1); }
      if (NT == 4) { int kb = 4 * hi; asm volatile("" : "+v"(kb));
#pragma unroll
          for (int r = 0; r < 16; ++r) { const int kv = kb + (r & 3) + 8 * (r >> 2); if (kv > qg) p0[r] = -INFINITY; if (kv + 32 > qg) p1[r] = -INFINITY; } }
      float rm = fmaxf(p0[0], p1[0]);
#pragma unroll
      for (int r = 1; r < 16; ++r) rm = fmaxf(rm, fmaxf(p0[r], p1[r]));
      mref = swapmax(rm);
#pragma unroll
      for (int r = 0; r < 16; ++r) negm[r] = -mref;
#pragma unroll
      for (int r = 0; r < 16; ++r) { pe[r >> 2][r & 3] = __builtin_amdgcn_exp2f(p0[r] - mref); pe[4 + (r >> 2)][r & 3] = __builtin_amdgcn_exp2f(p1[r] - mref); } }
    asm volatile("s_waitcnt vmcnt(3) lgkmcnt(0)" ::: "memory"); __builtin_amdgcn_s_barrier(); asm volatile("" ::: "memory");
#define MB_KF(g) (*(const LAS s16x8*)(kp + ((g) >> 1) * 2048 + ((g) & 1) * 512))
#define MB_KFN(g) (*(const LAS s16x8*)(kpn + ((g) >> 1) * 2048 + ((g) & 1) * 512))
#define MB_VL(k) vtr16(vp + ((k) >> 2) * 4096 + ((k) & 3) * 1024)
#define MB_VH(k) vtr16(vp + ((k) >> 2) * 4096 + ((k) & 3) * 1024 + 512)
    s16x8 kq0, kq1, kq2, kq3; s16x4 vl0, vh0, vl1, vh1, vl2, vh2, vl3, vh3;
    { const LAS unsigned char* kpn = lds + 1 * MA_KSLOT + kfo; kq0 = MB_KFN(0); kq1 = MB_KFN(1); kq2 = MB_KFN(2); }
    if (wid >= 4) __builtin_amdgcn_s_setprio(1);
#pragma unroll 1
    for (int t = 1; t < NT; ++t) {
        const int s = t & 3, sp = (t + 2) % 3, sn = (t + 1) % 3;
        if (t + 3 < NT) MB_DMAK(t + 3, (t + 3) & 3);
        if (t + 1 < NT) MB_DMAV(t + 1, sn);
        const LAS unsigned char* kp = lds + s * MA_KSLOT + kfo; const LAS unsigned char* vp = lds + R_V0 + sp * MA_VSLOT + vfo;
        const LAS unsigned char* kpn = lds + ((t + 1) & 3) * MA_KSLOT + kfo;
        f32x16 c0, c1; float sacc = zf_; v4u pw[4];
#define MB_STEPA(g, KC, KN, CC, FIRST, FILL) do { if ((g) + 3 < 12) KN = MB_KF((g) + 3); CC = MFMA32(KC, qr[(g) >> 1], FIRST); FILL; __builtin_amdgcn_sched_barrier(0); } while (0)
#define MB_SUM4(i) (sacc += (pe[i][0] + pe[i][1]) + (pe[i][2] + pe[i][3])); asm volatile("" : "+v"(sacc))
#define MB_PK(k) pw[k] = (v4u){pk2(pe[2 * (k)][0], pe[2 * (k)][1]), pk2(pe[2 * (k)][2], pe[2 * (k)][3]), pk2(pe[2 * (k) + 1][0], pe[2 * (k) + 1][1]), pk2(pe[2 * (k) + 1][2], pe[2 * (k) + 1][3])}; asm volatile("" : "+v"(pw[k]))
        MB_STEPA(0, kq0, kq3, c0, negm, MB_SUM4(0));
        MB_STEPA(1, kq1, kq0, c1, negm, MB_SUM4(1));
        MB_STEPA(2, kq2, kq1, c0, c0, MB_SUM4(2));
        MB_STEPA(3, kq3, kq2, c1, c1, MB_SUM4(3));
        MB_STEPA(4, kq0, kq3, c0, c0, MB_SUM4(4));
        MB_STEPA(5, kq1, kq0, c1, c1, MB_SUM4(5));
        MB_STEPA(6, kq2, kq1, c0, c0, MB_SUM4(6));
        MB_STEPA(7, kq3, kq2, c1, c1, MB_SUM4(7));
        MB_STEPA(8, kq0, kq3, c0, c0, MB_PK(0)); MB_STEPA(9, kq1, kq0, c1, c1, (vl0 = MB_VL(0), vh0 = MB_VH(0)); MB_PK(1)); MB_STEPA(10, kq2, kq1, c0, c0, (vl1 = MB_VL(1), vh1 = MB_VH(1)); MB_PK(2)); MB_STEPA(11, kq3, kq2, c1, c1, (vl2 = MB_VL(2), vh2 = MB_VH(2)); MB_PK(3));
#undef MB_PK
#undef MB_STEPA
#undef MB_SUM4
        l += sacc;
        if (t >= NT - 4) { int kb = t * 64 + 4 * hi; asm volatile("" : "+v"(kb));
#pragma unroll
            for (int r = 0; r < 16; ++r) { const int kv = kb + (r & 3) + 8 * (r >> 2); if (kv > qg) c0[r] = -INFINITY; if (kv + 32 > qg) c1[r] = -INFINITY; } }
        const float rm = max16_seed(c0, max16_mfma(c1));
        const float dl = swapmax(rm); const bool resc = __any(dl > 8.f); float fsc = 1.f;
        if (resc) { const float d2 = fmaxf(dl, 0.f); fsc = __builtin_amdgcn_exp2f(-d2); mref += d2; l *= fsc;
#pragma unroll
            for (int r = 0; r < 16; ++r) { c0[r] -= d2; c1[r] -= d2; negm[r] = -mref; } }
        __builtin_amdgcn_sched_barrier(0);
#define MB_STEPB(k, VLC, VHC, VLN, VHN, OO, FILL) do { if ((k) + 3 < 8) { VLN = MB_VL((k) + 3); VHN = MB_VH((k) + 3); } \
            { const s16x8 vf = {VLC[0], VLC[1], VLC[2], VLC[3], VHC[0], VHC[1], VHC[2], VHC[3]}; OO = MFMA32(__builtin_bit_cast(s16x8, pw[(k) & 3]), vf, OO); } FILL; __builtin_amdgcn_sched_barrier(0); } while (0)
#define MB_EXP4(i, C, B) pe[i] = (f32x4){__builtin_amdgcn_exp2f(C[B]), __builtin_amdgcn_exp2f(C[B + 1]), __builtin_amdgcn_exp2f(C[B + 2]), __builtin_amdgcn_exp2f(C[B + 3])}; asm volatile("" : "+v"(pe[i]))
        MB_STEPB(0, vl0, vh0, vl3, vh3, o0, MB_EXP4(0, c0, 0)); MB_STEPB(1, vl1, vh1, vl0, vh0, o0, MB_EXP4(1, c0, 4)); MB_STEPB(2, vl2, vh2, vl1, vh1, o0, MB_EXP4(2, c0, 8)); MB_STEPB(3, vl3, vh3, vl2, vh2, o0, MB_EXP4(3, c0, 12));
        MB_STEPB(4, vl0, vh0, vl3, vh3, o1, MB_EXP4(4, c1, 0)); MB_STEPB(5, vl1, vh1, vl0, vh0, o1, kq0 = MB_KFN(0); MB_EXP4(5, c1, 4)); MB_STEPB(6, vl2, vh2, vl1, vh1, o1, kq1 = MB_KFN(1); MB_EXP4(6, c1, 8)); MB_STEPB(7, vl3, vh3, vl2, vh2, o1, kq2 = MB_KFN(2); MB_EXP4(7, c1, 12));
#undef MB_STEPB
#undef MB_EXP4
        if (resc) { if (hi == 0) wsf[r32] = fsc; asm volatile("s_waitcnt lgkmcnt(0)" ::: "memory"); int hi_ = hi; asm volatile("" : "+v"(hi_));
#pragma unroll
            for (int r = 0; r < 16; ++r) { const float fr = wsf[crow(r, hi_)]; o0[r] *= fr; o1[r] *= fr; } }
        if (t + 3 < NT) asm volatile("s_waitcnt vmcnt(3) lgkmcnt(0)" ::: "memory"); else if (t + 1 < NT) asm volatile("s_waitcnt vmcnt(1) lgkmcnt(0)" ::: "memory"); else asm volatile("s_waitcnt vmcnt(0) lgkmcnt(0)" ::: "memory");
        __builtin_amdgcn_s_barrier(); asm volatile("" ::: "memory");
    }
#undef MB_KF
#undef MB_KFN
#undef MB_VL
#undef MB_VH
    __builtin_amdgcn_s_setprio(0);
    { float sacc = zf_; v4u pw[4];
#pragma unroll
      for (int i = 0; i < 8; ++i) sacc += (pe[i][0] + pe[i][1]) + (pe[i][2] + pe[i][3]);
      l += sacc;
#pragma unroll
      for (int k = 0; k < 4; ++k) pw[k] = (v4u){pk2(pe[2 * k][0], pe[2 * k][1]), pk2(pe[2 * k][2], pe[2 * k][3]), pk2(pe[2 * k + 1][0], pe[2 * k + 1][1]), pk2(pe[2 * k + 1][2], pe[2 * k + 1][3])};
      const LAS unsigned char* vp = lds + R_V0 + ((NT - 1) % 3) * MA_VSLOT + vfo;
#pragma unroll
      for (int ks = 0; ks < 4; ++ks) { const s16x8 pa = __builtin_bit_cast(s16x8, pw[ks]);
          { const s16x4 lo = vtr16(vp + ks * 1024), hh = vtr16(vp + ks * 1024 + 512); const s16x8 vf = {lo[0], lo[1], lo[2], lo[3], hh[0], hh[1], hh[2], hh[3]}; o0 = MFMA32(pa, vf, o0); }
          { const s16x4 lo = vtr16(vp + 4096 + ks * 1024), hh = vtr16(vp + 4096 + ks * 1024 + 512); const s16x8 vf = {lo[0], lo[1], lo[2], lo[3], hh[0], hh[1], hh[2], hh[3]}; o1 = MFMA32(pa, vf, o1); } } }
#undef MB_DMAK
#undef MB_DMAV
    l = swapsum(l);
    if (hi == 0) wsf[32 + r32] = l;
    asm volatile("s_waitcnt lgkmcnt(0)" ::: "memory");
    LAS u16* stg = (LAS u16*)(lds + R_OST) + wid * 2048;
    int hi_e = hi; asm volatile("" : "+v"(hi_e));
#pragma unroll
    for (int r = 0; r < 16; ++r) { const int orow = crow(r, hi_e); const float rl = 1.0f / wsf[32 + orow];
        const u32 w = pk2(o0[r] * rl, o1[r] * rl); stg[orow * 64 + r32] = (u16)(w & 0xffffu); stg[orow * 64 + 32 + r32] = (u16)(w >> 16); }
    asm volatile("s_waitcnt lgkmcnt(0)" ::: "memory");
    u16* Ow = O + (rowb + q0 + wid * 32) * 512 + h * 64;
#pragma unroll
    for (int i = 0; i < 4; ++i) { const int row = i * 8 + (lane >> 3), ch = lane & 7; const v4u v = *(const LAS v4u*)(stg + row * 64 + ch * 8); *(v4u*)(Ow + (size_t)row * 512 + ch * 8) = v; }
    asm volatile("s_waitcnt lgkmcnt(0)" ::: "memory"); __builtin_amdgcn_s_barrier(); asm volatile("" ::: "memory");
}
__device__ __forceinline__ void mla_attn_phase(Frame& F, const u16* Q, const u16* K, const u16* V, u16* YA, const float* qgain) {
    const float* ropec = (const float*)(F.ws + WS_ROPE);
    for (int v = F.bid; v < 256; v += F.G) { const int bh = v & 15, s = v >> 4, b = bh >> 3, h = bh & 7;
#pragma unroll 1
        for (int i = 0; i < 4; ++i) { const int qb = i == 0 ? 63 - s : (i == 1 ? 32 + s : (i == 2 ? 31 - s : s));

#if MK_MLA_V2
            mla_attn_unit2(F.lds, F.tid, F.wave, Q, K, V, YA, b, h, qb, qgain, ropec);
#else
            mla_attn_unit(F.lds, F.tid, F.wave, Q, K, V, YA, b, h, qb);
#endif
        } }
}

constexpr int DL_VT = 4096, DL_WS = 8 * 2 * DL_VT, DL_OST = DL_WS + 2048, DL_BYTES = DL_OST + 8 * 4096;
__device__ __forceinline__ void dil_wave_unit(LAS unsigned char* lds, int lane, int wid, const u16* DQ, const u16* DK, const u16* DV, u16* YC, int b, int h, int span, int rho) {
    const int r32 = lane & 31, hi = lane >> 5; const size_t rowb = (size_t)b * SEQ; const int T0 = span * 512 + rho, ti = T0 + 16 * r32;
    LAS unsigned char* vt = lds + wid * 2 * DL_VT; LAS float* wsf = (LAS float*)(lds + DL_WS) + wid * 64;
    const int vfo = ((lane >> 4) & 1) * 32 + (lane & 3) * 8 + (4 * hi + ((lane & 15) >> 2)) * 64;
    const size_t hb = (size_t)(b * 8 + h) * SEQ * 64; const u16* kbase = DK + hb; const u16* vbase = DV + hb; const u16* qbase = DQ + hb; u16* obase = YC + rowb * 512 + h * 64;
    s16x8 qr[4];
#pragma unroll
    for (int d0 = 0; d0 < 4; ++d0) qr[d0] = *(const s16x8*)(qbase + (unsigned)(ti * 64 + d0 * 16 + hi * 8));
    float zf_ = 0.f; asm volatile("" : "+v"(zf_));
    float mref = zf_, l = zf_; f32x16 o0, o1;
#pragma unroll
    for (int r = 0; r < 16; ++r) { o0[r] = zf_; o1[r] = zf_; }
#define DL_TILE(it, rs, j) do { if ((it) == 0) { rs = 4; j = 4; } else if ((it) < 5) { rs = 4; j = (it) - 1; } else if ((it) < 13) { rs = 2; j = (it) - 5; } else { rs = 0; j = (it) - 13; } } while (0)
    s16x8 kf[4], kn[4]; v4u vn[4];
    const unsigned kro = (unsigned)(r32 * 64), vro = (unsigned)((lane >> 3) * 64), vco = (unsigned)((lane & 7) * 8);
#define DL_LOAD(KF, VN, rs, j) do { const int kb_ = T0 - (128 << (rs)) + ((32 * (j)) << (rs)); \
        if (kb_ >= 0 && kb_ + (31 << (rs)) <= SEQ - 1) {            \
          { const unsigned ko_ = (unsigned)(kb_ * 64) + (kro << (rs)) + (unsigned)(hi * 8); \
            _Pragma("unroll") for (int d0 = 0; d0 < 4; ++d0) KF[d0] = *(const s16x8*)(kbase + (ko_ + d0 * 16)); } \
          { const unsigned vo_ = (unsigned)(kb_ * 64) + (vro << (rs)) + vco; \
            _Pragma("unroll") for (int i_ = 0; i_ < 4; ++i_) VN[i_] = *(const v4u*)(vbase + (vo_ + ((unsigned)(8 * 64 * i_) << (rs)))); } \
        } else { \
        { int kt_ = kb_ + (r32 << (rs)); kt_ = kt_ < 0 ? 0 : (kt_ > SEQ - 1 ? SEQ - 1 : kt_); const unsigned ko_ = (unsigned)(kt_ * 64 + hi * 8); \
          _Pragma("unroll") for (int d0 = 0; d0 < 4; ++d0) KF[d0] = *(const s16x8*)(kbase + (ko_ + d0 * 16)); } \
        _Pragma("unroll") for (int i_ = 0; i_ < 4; ++i_) { const int c_ = lane + 64 * i_; int kt_ = kb_ + ((c_ >> 3) << (rs)); kt_ = kt_ < 0 ? 0 : (kt_ > SEQ - 1 ? SEQ - 1 : kt_); \
          VN[i_] = *(const v4u*)(vbase + (unsigned)(kt_ * 64 + (c_ & 7) * 8)); } } } while (0)
#define DL_VSTORE(VN, buf) do { _Pragma("unroll") for (int i_ = 0; i_ < 4; ++i_) { const int c_ = lane + 64 * i_, row_ = c_ >> 3, ch_ = c_ & 7; \
          *(LAS v4u*)(vt + (buf) * DL_VT + ((ch_ >> 2) * 2 + (row_ >> 4)) * 1024 + (row_ & 15) * 64 + (ch_ & 3) * 16) = VN[i_]; } } while (0)
    int rs0, j0; DL_TILE(0, rs0, j0);
    DL_LOAD(kf, vn, rs0, j0); DL_VSTORE(vn, 0);
    s16x8 kn2[4]; v4u vn2[4];
    { int rs1, j1; DL_TILE(1, rs1, j1); DL_LOAD(kn, vn, rs1, j1); }
#pragma unroll 1
    for (int it = 0; it < 33; ++it) {
        int rs, j; DL_TILE(it, rs, j);
        const int buf = it & 1;
        if (it + 2 < 33) { int rs2, j2; DL_TILE(it + 2, rs2, j2); DL_LOAD(kn2, vn2, rs2, j2); }
        f32x16 p;
#pragma unroll
        for (int r = 0; r < 16; ++r) p[r] = zf_;
#pragma unroll
        for (int d0 = 0; d0 < 4; ++d0) p = MFMA32(kf[d0], qr[d0], p);
        { const int kb = T0 - (128 << rs) + ((32 * j) << rs), span_r = 128 << rs;
            const int up = ti - kb, lo0 = up - span_r, lo = lo0 > -kb ? lo0 : -kb; const unsigned wid_ = (unsigned)(up - lo); const int base = ((4 * hi) << rs) - lo;
#pragma unroll
            for (int r = 0; r < 16; ++r) { const unsigned xr = (unsigned)(base + ((((r & 3) + 8 * (r >> 2))) << rs)); if (xr > wid_ || up < lo) p[r] = -INFINITY; } }
        float rm = p[0];
#pragma unroll
        for (int r = 1; r < 16; ++r) rm = fmaxf(rm, p[r]);
        rm = swapmax(rm);
        if (it == 0) mref = rm;
        else { const float dl = rm - mref;
            if (__any(dl > 8.f)) { const float d2 = fmaxf(dl, 0.f), f = __builtin_amdgcn_exp2f(-d2); mref += d2; l *= f; if (hi == 0) wsf[r32] = f;
                asm volatile("s_waitcnt lgkmcnt(0)" ::: "memory");
#pragma unroll
                for (int r = 0; r < 16; ++r) { const float fr = wsf[crow(r, hi)]; o0[r] *= fr; o1[r] *= fr; } } }
        float sacc = zf_;
#pragma unroll
        for (int r = 0; r < 16; ++r) { p[r] = __builtin_amdgcn_exp2f(p[r] - mref); sacc += p[r]; }
        l += sacc;
        v4u pw[2];
        pw[0] = (v4u){pk2(p[0], p[1]), pk2(p[2], p[3]), pk2(p[4], p[5]), pk2(p[6], p[7])};
        pw[1] = (v4u){pk2(p[8], p[9]), pk2(p[10], p[11]), pk2(p[12], p[13]), pk2(p[14], p[15])};
        asm volatile("s_waitcnt lgkmcnt(0)" ::: "memory");
        const LAS unsigned char* vp = vt + buf * DL_VT + vfo;
#pragma unroll
        for (int ks = 0; ks < 2; ++ks) { const s16x8 pa = __builtin_bit_cast(s16x8, pw[ks]);
            { const s16x4 lo = vtr16(vp + ks * 1024), hh = vtr16(vp + ks * 1024 + 512); const s16x8 vf = {lo[0], lo[1], lo[2], lo[3], hh[0], hh[1], hh[2], hh[3]}; o0 = MFMA32(pa, vf, o0); }
            { const s16x4 lo = vtr16(vp + 2048 + ks * 1024), hh = vtr16(vp + 2048 + ks * 1024 + 512); const s16x8 vf = {lo[0], lo[1], lo[2], lo[3], hh[0], hh[1], hh[2], hh[3]}; o1 = MFMA32(pa, vf, o1); } }
        if (it + 1 < 33) { DL_VSTORE(vn, buf ^ 1);
#pragma unroll
            for (int d0 = 0; d0 < 4; ++d0) { kf[d0] = kn[d0]; kn[d0] = kn2[d0]; vn[d0] = vn2[d0]; } }
    }
#undef DL_TILE
#undef DL_LOAD
#undef DL_VSTORE
    l = swapsum(l);
    if (hi == 0) wsf[32 + r32] = l;
    asm volatile("s_waitcnt lgkmcnt(0)" ::: "memory");
    LAS u16* stg = (LAS u16*)(lds + DL_OST) + wid * 2048;
#pragma unroll
    for (int r = 0; r < 16; ++r) { const int orow = crow(r, hi); const float rl = 1.0f / wsf[32 + orow];
        const u32 w = pk2(o0[r] * rl, o1[r] * rl); stg[orow * 64 + r32] = (u16)(w & 0xffffu); stg[orow * 64 + 32 + r32] = (u16)(w >> 16); }
    asm volatile("s_waitcnt lgkmcnt(0)" ::: "memory");
#pragma unroll
    for (int i = 0; i < 4; ++i) { const int row = i * 8 + (lane >> 3), ch = lane & 7; const v4u v = *(const LAS v4u*)(stg + row * 64 + ch * 8);
        *(v4u*)(obase + (unsigned)((T0 + 16 * row) * 512 + ch * 8)) = v; }
    asm volatile("s_waitcnt lgkmcnt(0)" ::: "memory");
}
__device__ __forceinline__ void dil_attn_phase(Frame& F, const u16* DQ, const u16* DK, const u16* DV, u16* YC) {
    const int gw = F.bid * NWAVES + F.wave, NGW = F.G * NWAVES;
#pragma unroll 1
    for (int u = gw; u < 8192; u += NGW) { const int rho = u & 15, span = (u >> 4) & 31, h = (u >> 9) & 7, b = u >> 12;
        dil_wave_unit(F.lds, F.lane, F.wave, DQ, DK, DV, YC, b, h, span, rho); }
    __syncthreads();
}

constexpr int D2_VT = 65536, D2_KT = D2_VT + 8 * 4096, D2_M = LDSCTL_OFF + 8192, D2_L = D2_M + 2048, D2_WS = D2_L + 2048;
static_assert(D2_KT + 8 * 4096 <= RING_BYTES && D2_WS + 2048 <= LDS_BYTES, "dil2 LDS map");
__device__ __forceinline__ void dil2_phase(Frame& F, const u16* DQ, const u16* DK, const u16* DV, u16* YC) {
    LAS unsigned char* lds = F.lds; const int lane = F.lane, wid = F.wave, r32 = lane & 31, hi = lane >> 5;
    LAS u32* sto = (LAS u32*)lds; LAS float* smv = (LAS float*)(lds + D2_M); LAS float* slv = (LAS float*)(lds + D2_L); LAS float* wsf = (LAS float*)(lds + D2_WS) + wid * 64;
    LAS unsigned char* vt = lds + D2_VT + wid * 4096; LAS unsigned char* kt = lds + D2_KT + wid * 4096;
    const int vfo = ((lane >> 4) & 1) * 32 + (lane & 3) * 8 + (4 * hi + ((lane & 15) >> 2)) * 64;
    const int nun = ((512 - F.bid + F.G - 1) / F.G) * 6;
    float zf_ = 0.f; asm volatile("" : "+v"(zf_));
#define D2_DESC(u, item, pass, k, rs, T0, S0) do { const int ii_ = (u) / 6, g_ = (u) - ii_ * 6; item = F.G == 256 ? (((F.bid & 7) * 2 + ii_) << 5) + (F.bid >> 3) : F.bid + ii_ * F.G; pass = g_ >> 1; k = g_ & 1; \
          \
        rs = 4 - 2 * pass; const int wu_ = wid * 2 + k; S0 = (item & 31) * 512; T0 = S0 + (pass == 0 ? wu_ : (pass == 1 ? (wu_ & 3) + 128 * (wu_ >> 2) : 32 * wu_)); } while (0)
#define D2_LOAD(KF, VN, item, rs, T0, jj) do { const size_t hb_ = (size_t)((item) >> 5) * SEQ * 64; const u16* kbase_ = DK + hb_; const u16* vbase_ = DV + hb_; const int j_ = (jj) == 0 ? 4 : (jj) - 1; \
        const int kb_ = (T0) - (128 << (rs)) + ((32 * j_) << (rs)); \
        _Pragma("unroll") for (int i_ = 0; i_ < 4; ++i_) { int kt_ = kb_ + (((lane >> 3) + 8 * i_) << (rs)); kt_ = kt_ < 0 ? 0 : kt_; \
          KF[i_] = *(const v4u*)(kbase_ + (unsigned)(kt_ * 64 + (lane & 7) * 8)); VN[i_] = *(const v4u*)(vbase_ + (unsigned)(kt_ * 64 + (lane & 7) * 8)); } } while (0)
#define D2_KSTORE(KN) do { _Pragma("unroll") for (int i_ = 0; i_ < 4; ++i_) { const int c_ = lq + 64 * i_, row_ = c_ >> 3, ch_ = c_ & 7; \
          *(LAS v4u*)(kt + row_ * 128 + ((ch_ ^ (row_ & 7)) * 16)) = KN[i_]; } } while (0)
#define D2_VSTORE(VN) do { _Pragma("unroll") for (int i_ = 0; i_ < 4; ++i_) { const int c_ = lq + 64 * i_, row_ = c_ >> 3, ch_ = c_ & 7; \
          *(LAS v4u*)(vt + ((ch_ >> 2) * 2 + (row_ >> 4)) * 1024 + (row_ & 15) * 64 + (ch_ & 3) * 16) = VN[i_]; } } while (0)
#define D2_QLOAD(QR, item, rs, T0) do { const u16* qbase_ = DQ + (size_t)((item) >> 5) * SEQ * 64; const unsigned qo_ = (unsigned)(((T0) + (r32 << (rs))) * 64 + hi * 8); \
          _Pragma("unroll") for (int d0 = 0; d0 < 4; ++d0) QR[d0] = *(const s16x8*)(qbase_ + (qo_ + d0 * 16)); } while (0)
    s16x8 qr[4], qn[4]; v4u kn[4], kn2[4], vn[4], vn2[4];
    float mref = zf_, l = zf_; f32x16 o0, o1;
#pragma unroll
    for (int r = 0; r < 16; ++r) { o0[r] = zf_; o1[r] = zf_; }
    __syncthreads();
    if (nun > 0) { int lq = lane; asm volatile("" : "+v"(lq)); int item, pass, k, rs, T0, S0; D2_DESC(0, item, pass, k, rs, T0, S0); D2_QLOAD(qn, item, rs, T0); D2_LOAD(kn, vn, item, rs, T0, 0); D2_KSTORE(kn); D2_VSTORE(vn); D2_LOAD(kn, vn, item, rs, T0, 1); }
#pragma unroll 1
    for (int uu = 0; uu < nun; ++uu) {
        int item, pass, k, rs, T0, S0; D2_DESC(uu, item, pass, k, rs, T0, S0);
        int itemn, passn, kn_, rsn, T0n, S0n; { const int un = uu + 1 < nun ? uu + 1 : uu; D2_DESC(un, itemn, passn, kn_, rsn, T0n, S0n); }
        const int qb = T0 - S0, ql = qb + (r32 << rs), ti = T0 + (r32 << rs);
#pragma unroll
        for (int d0 = 0; d0 < 4; ++d0) qr[d0] = qn[d0];
        if (pass == 0) { l = zf_;
#pragma unroll
            for (int r = 0; r < 16; ++r) { o0[r] = zf_; o1[r] = zf_; } }
        else { mref = smv[ql]; { const float lt = slv[ql]; l = hi == 0 ? lt : zf_; }
            int hi_ = hi, r32_ = r32; asm volatile("" : "+v"(hi_), "+v"(r32_));
#pragma unroll
            for (int r = 0; r < 16; ++r) { const u32 w = sto[(qb + (crow(r, hi_) << rs)) * 32 + r32_]; o0[r] = bflo(w) * 256.f; o1[r] = bfhi(w) * 256.f; } }
#pragma unroll
        for (int jj = 0; jj < 5; ++jj) {
            if (jj + 2 < 5) D2_LOAD(kn2, vn2, item, rs, T0, jj + 2); else D2_LOAD(kn2, vn2, itemn, rsn, T0n, jj + 2 - 5);
            if (jj == 1) D2_QLOAD(qn, itemn, rsn, T0n);
            const int j = jj == 0 ? 4 : jj - 1; int lq = lane; asm volatile("" : "+v"(lq));
            f32x16 p;
#pragma unroll
            for (int r = 0; r < 16; ++r) p[r] = zf_;
#pragma unroll
            for (int d0 = 0; d0 < 4; ++d0) { const s16x8 kf = *(const LAS s16x8*)(kt + (lq & 31) * 128 + (((2 * d0 + (lq >> 5)) ^ (lq & 7)) * 16)); p = MFMA32(kf, qr[d0], p); }
            { const int kb = T0 - (128 << rs) + ((32 * j) << rs);
              if (jj < 2 || kb < 0) {
                const int span_r = 128 << rs, up = ti - kb, lo0 = up - span_r, lo = lo0 > -kb ? lo0 : -kb; const unsigned wid_ = (unsigned)(up - lo); const int base = ((4 * hi) << rs) - lo;
#pragma unroll
                for (int r = 0; r < 16; ++r) { const unsigned xr = (unsigned)(base + ((((r & 3) + 8 * (r >> 2))) << rs)); if (xr > wid_ || up < lo) p[r] = -INFINITY; } } }
            float rm = max16_mfma(p);
            rm = swapmax(rm);
            if (jj == 0 && pass == 0) mref = rm;
            else { const float dl = rm - mref;
                if (__any(dl > 8.f)) { const float d2 = fmaxf(dl, 0.f), f = __builtin_amdgcn_exp2f(-d2); mref += d2; l *= f; if (hi == 0) wsf[r32] = f;
                    asm volatile("s_waitcnt lgkmcnt(0)" ::: "memory");
                    { int hi_ = hi; asm volatile("" : "+v"(hi_));
#pragma unroll
                    for (int r = 0; r < 16; ++r) { const float fr = wsf[crow(r, hi_)]; o0[r] *= fr; o1[r] *= fr; } } } }
            float sacc = zf_;
#pragma unroll
            for (int r = 0; r < 16; ++r) { p[r] = __builtin_amdgcn_exp2f(p[r] - mref); sacc += p[r]; }
            l += sacc;
            v4u pw[2];
            pw[0] = (v4u){pk2(p[0], p[1]), pk2(p[2], p[3]), pk2(p[4], p[5]), pk2(p[6], p[7])};
            pw[1] = (v4u){pk2(p[8], p[9]), pk2(p[10], p[11]), pk2(p[12], p[13]), pk2(p[14], p[15])};
            asm volatile("s_waitcnt lgkmcnt(0)" ::: "memory");
            const LAS unsigned char* vp = vt + vfo;
#pragma unroll
            for (int ks = 0; ks < 2; ++ks) { const s16x8 pa = __builtin_bit_cast(s16x8, pw[ks]);
                { const s16x4 lo = vtr16(vp + ks * 1024), hh = vtr16(vp + ks * 1024 + 512); const s16x8 vf = {lo[0], lo[1], lo[2], lo[3], hh[0], hh[1], hh[2], hh[3]}; o0 = MFMA32(pa, vf, o0); }
                { const s16x4 lo = vtr16(vp + 2048 + ks * 1024), hh = vtr16(vp + 2048 + ks * 1024 + 512); const s16x8 vf = {lo[0], lo[1], lo[2], lo[3], hh[0], hh[1], hh[2], hh[3]}; o1 = MFMA32(pa, vf, o1); } }
            asm volatile("" ::: "memory");
            D2_KSTORE(kn); D2_VSTORE(vn);
#pragma unroll
            for (int d0 = 0; d0 < 4; ++d0) { kn[d0] = kn2[d0]; vn[d0] = vn2[d0]; }
        }
        { const float lt = swapsum(l); int hi_ = hi, r32_ = r32; asm volatile("" : "+v"(hi_), "+v"(r32_));
            if (pass < 2) { if (hi == 0) { smv[ql] = mref; slv[ql] = lt; }
#pragma unroll
                for (int r = 0; r < 16; ++r) sto[(qb + (crow(r, hi_) << rs)) * 32 + r32_] = pk2(o0[r] * 0.00390625f, o1[r] * 0.00390625f); }
            else { if (hi == 0) wsf[32 + r32] = lt;
                asm volatile("s_waitcnt lgkmcnt(0)" ::: "memory");
                LAS u16* stg = (LAS u16*)(lds + qb * 128);
#pragma unroll
                for (int r = 0; r < 16; ++r) { const int orow = crow(r, hi_); const float rl = 1.0f / wsf[32 + orow];
                    const u32 w = pk2(o0[r] * rl, o1[r] * rl); stg[orow * 64 + r32_] = (u16)(w & 0xffffu); stg[orow * 64 + 32 + r32_] = (u16)(w >> 16); }
                asm volatile("s_waitcnt lgkmcnt(0)" ::: "memory");
                u16* obase = YC + (size_t)(item >> 8) * SEQ * 512 + ((item >> 5) & 7) * 64;
                int lane_ = lane; asm volatile("" : "+v"(lane_));
#pragma unroll
                for (int i = 0; i < 4; ++i) { const int row = i * 8 + (lane_ >> 3), ch = lane_ & 7; const v4u v = *(const LAS v4u*)(stg + row * 64 + ch * 8);
                    *(v4u*)(obase + (unsigned)((T0 + row) * 512 + ch * 8)) = v; } }
            if (k == 1) { asm volatile("s_waitcnt lgkmcnt(0)" ::: "memory"); __builtin_amdgcn_s_barrier(); asm volatile("" ::: "memory"); }
        }
    }
#undef D2_DESC
#undef D2_LOAD
#undef D2_VSTORE
#undef D2_KSTORE
#undef D2_QLOAD
    __syncthreads();
}

#if MK_DIL_V2
#define DIL_PHASE dil2_phase
#else
#define DIL_PHASE dil_attn_phase
#endif

constexpr int M2_P = 72;
constexpr int M2_Q = 0, M2_K = M2_Q + 64 * M2_P * 2, M2_V = M2_K + 64 * M2_P * 2, M2_C = M2_V + 16384, M2_SC = M2_C + 16384, M2_RED = M2_SC + 6 * 256, M2_OST = M2_RED + 4 * 64 * 4, M2_BYTES = M2_OST + 8 * 4096;
template <bool IMG> __device__ __forceinline__ void m2_stage_conv(LAS unsigned char* dst, const LAS float* wsc, const u16* MQK, size_t row0, int pos0, int ch0, const float* cw, const float* cb, float scale, int tid) {
    const int s = tid >> 3, cc = tid & 7, ch = ch0 + cc * 8;
    float acc[8];
    { const f32x4 b0 = *(const f32x4*)(cb + ch), b1 = *(const f32x4*)(cb + ch + 4); acc[0] = b0.x; acc[1] = b0.y; acc[2] = b0.z; acc[3] = b0.w; acc[4] = b1.x; acc[5] = b1.y; acc[6] = b1.z; acc[7] = b1.w; }
#pragma unroll
    for (int j = 0; j < 4; ++j) { if (pos0 + s - 3 + j >= 0) { const v4u w = *(const v4u*)(MQK + (size_t)((long)row0 + s - 3 + j) * 512 + ch);
            const f32x4 w0 = *(const f32x4*)(cw + j * 512 + ch), w1 = *(const f32x4*)(cw + j * 512 + ch + 4);
            acc[0] += w0.x * bflo(w.x); acc[1] += w0.y * bfhi(w.x); acc[2] += w0.z * bflo(w.y); acc[3] += w0.w * bfhi(w.y); acc[4] += w1.x * bflo(w.z); acc[5] += w1.y * bfhi(w.z); acc[6] += w1.z * bflo(w.w); acc[7] += w1.w * bfhi(w.w); } }
    const float sc = scale * (wsc ? wsc[s] : 1.0f);
#pragma unroll
    for (int i = 0; i < 8; ++i) acc[i] = fsilu(acc[i]) * sc;
    v4u o; o.x = pk2(acc[0], acc[1]); o.y = pk2(acc[2], acc[3]); o.z = pk2(acc[4], acc[5]); o.w = pk2(acc[6], acc[7]);
    if (IMG) *(LAS v4u*)(dst + ((cc >> 2) * 4 + (s >> 4)) * 1024 + (s & 15) * 64 + (cc & 3) * 16) = o;
    else *(LAS v4u*)(dst + (s * M2_P + cc * 8) * 2) = o;
}
__device__ __forceinline__ void m2_stage_img(LAS unsigned char* img, const u16* src, size_t pitch, int tid) {
#pragma unroll
    for (int i = 0; i < 2; ++i) { const int c = tid + 512 * i, row = c >> 4, cc = c & 15; const v4u w = *(const v4u*)(src + (size_t)row * pitch + cc * 8);
        *(LAS v4u*)(img + ((cc >> 2) * 4 + (row >> 4)) * 1024 + (row & 15) * 64 + (cc & 3) * 16) = w; }
}
__device__ __forceinline__ void mlstm_a2_phase(Frame& F, const u16* MQK, const u16* MV, const float* IF, const float* cw, const float* cb, float* ST) {
    LAS unsigned char* lds = F.lds; LAS unsigned char* Vi = lds + M2_V; LAS float* wsv = (LAS float*)(lds + M2_SC);
    float* mloc = (float*)(F.ws + WS_MLS); float* bend = mloc + 2048; float* nst = (float*)(F.ws + WS_MLS + 65536);
    const int tid = F.tid, lane = F.lane, wid = F.wave, r32 = lane & 31, hi = lane >> 5;
    const int vfn = ((lane >> 4) & 1) * 32 + (lane & 3) * 8 + (8 * hi + ((lane & 15) >> 2)) * 64;
    for (int u = F.bid; u < 2048; u += F.G) {
        const int bh = u >> 8, c = u & 255, b = bh >> 2, h = bh & 3, pos0 = c * 64; const size_t row0 = (size_t)b * SEQ + pos0;
        __syncthreads();
        if (tid < 64) { const float ig = IF[(row0 + tid) * 8 + h], lf = IF[(row0 + tid) * 8 + 4 + h];
            const float bs = wave_incl_scan_add(lf, tid), be = bperm_f(63, bs);
            const float wl = be - bs + ig, ml = wave_max(wl, tid);
            wsv[tid] = __expf(wl - ml);
            if (tid == 0) { mloc[u] = ml; bend[u] = be; } }
        m2_stage_img(Vi, MV + row0 * 512 + h * 128, 512, tid);
        __syncthreads();
        m2_stage_conv<true>(lds + M2_K, wsv, MQK, row0, pos0, 256 + h * 64, cw, cb, 0.125f, tid);
        __syncthreads();
        const int dt = wid & 1, vt = wid >> 1;
        float zf_ = 0.f; asm volatile("" : "+v"(zf_));
        f32x16 acc;
#pragma unroll
        for (int r = 0; r < 16; ++r) acc[r] = zf_;
#pragma unroll
        for (int ks = 0; ks < 4; ++ks) { const s16x4 al = vtr16(lds + M2_K + (dt * 4 + ks) * 1024 + vfn), ah = vtr16(lds + M2_K + (dt * 4 + ks) * 1024 + vfn + 256); const s16x8 a = {al[0], al[1], al[2], al[3], ah[0], ah[1], ah[2], ah[3]};
            const s16x4 lo = vtr16(Vi + (vt * 4 + ks) * 1024 + vfn), hh = vtr16(Vi + (vt * 4 + ks) * 1024 + vfn + 256); const s16x8 vf = {lo[0], lo[1], lo[2], lo[3], hh[0], hh[1], hh[2], hh[3]};
            acc = MFMA32(a, vf, acc); }
        float* o = ST + (size_t)u * 8192 + (dt * 32) * 128 + vt * 32 + r32;
#pragma unroll
        for (int r = 0; r < 16; ++r) o[crow(r, hi) * 128] = acc[r];
        if (tid < 64) { float an = 0.f; const LAS u16* kc = (const LAS u16*)(lds + M2_K) + (tid >> 5) * 2048 + (tid & 31);
#pragma unroll 8
            for (int s2 = 0; s2 < 64; ++s2) an += bf1(kc[(s2 >> 4) * 512 + (s2 & 15) * 32]);
            nst[(size_t)u * 64 + tid] = an; }
    }
    __syncthreads();
}
__device__ __forceinline__ void mlstm_c2_phase(Frame& F, const u16* MQK, const u16* MV, const u16* MO, const float* IF, const float* cw, const float* cb, const float* hg, const float* ST, u16* YB) {
    LAS unsigned char* lds = F.lds; LAS u16* Qs = (LAS u16*)(lds + M2_Q); LAS u16* Ks = (LAS u16*)(lds + M2_K); LAS unsigned char* Vi = lds + M2_V; LAS unsigned char* Ci = lds + M2_C;
    LAS float* bsv = (LAS float*)(lds + M2_SC); LAS float* gsv = bsv + 64; LAS float* mtv = gsv + 64; LAS float* dcv = mtv + 64; LAS float* npv = dcv + 64; LAS float* red = (LAS float*)(lds + M2_RED);
    const float* mprev = (const float*)(F.ws + WS_MLS) + 4096; const float* nst = (const float*)(F.ws + WS_MLS + 65536);
    const int tid = F.tid, lane = F.lane, wid = F.wave, r32 = lane & 31, hi = lane >> 5;
    const int vfn = ((lane >> 4) & 1) * 32 + (lane & 3) * 8 + (8 * hi + ((lane & 15) >> 2)) * 64;
    const int vfa = ((lane >> 4) & 1) * 32 + (lane & 3) * 8 + (4 * hi + ((lane & 15) >> 2)) * 64;
    for (int u = F.bid; u < 2048; u += F.G) {
        const int bh = u >> 8, c = u & 255, b = bh >> 2, h = bh & 3, pos0 = c * 64; const size_t row0 = (size_t)b * SEQ + pos0;
        __syncthreads();
        m2_stage_conv<false>(lds + M2_Q, nullptr, MQK, row0, pos0, h * 64, cw, cb, 1.0f, tid);
        m2_stage_conv<false>(lds + M2_K, nullptr, MQK, row0, pos0, 256 + h * 64, cw, cb, 0.125f, tid);
        m2_stage_img(Vi, MV + row0 * 512 + h * 128, 512, tid);
        {
#pragma unroll
            for (int i = 0; i < 2; ++i) { const int cidx = tid + 512 * i, row = cidx >> 4, cc = cidx & 15; const float* sp = ST + (size_t)u * 8192 + row * 128 + cc * 8;
                const f32x4 a = *(const f32x4*)sp, bq = *(const f32x4*)(sp + 4); v4u w; w.x = pk2(a.x, a.y); w.y = pk2(a.z, a.w); w.z = pk2(bq.x, bq.y); w.w = pk2(bq.z, bq.w);
                *(LAS v4u*)(Ci + ((cc >> 2) * 4 + (row >> 4)) * 1024 + (row & 15) * 64 + (cc & 3) * 16) = w; } }
        if (tid < 64) { const float ig = IF[(row0 + tid) * 8 + h], lf = IF[(row0 + tid) * 8 + 4 + h], m = mprev[u];
            const float bs = wave_incl_scan_add(lf, tid), gs = ig - bs, gmx = wave_incl_scan_max(gs, tid);
            const float inter = bs + m, mt = fmaxf(inter, bs + gmx);
            bsv[tid] = bs; gsv[tid] = gs; mtv[tid] = mt; dcv[tid] = __expf(inter - mt); npv[tid] = nst[(size_t)u * 64 + tid]; }
        __syncthreads();
        const int th = wid & 1, vq = wid >> 1, t = th * 32 + r32;
        float zf_ = 0.f; asm volatile("" : "+v"(zf_));
        f32x16 s0, s1;
#pragma unroll
        for (int r = 0; r < 16; ++r) { s0[r] = zf_; s1[r] = zf_; }
        s16x8 qf[4];
#pragma unroll
        for (int kd = 0; kd < 4; ++kd) qf[kd] = *(const LAS s16x8*)(Qs + t * M2_P + kd * 16 + hi * 8);
#pragma unroll
        for (int kd = 0; kd < 4; ++kd) { const s16x8 a0 = *(const LAS s16x8*)(Ks + r32 * M2_P + kd * 16 + hi * 8), a1 = *(const LAS s16x8*)(Ks + (32 + r32) * M2_P + kd * 16 + hi * 8);
            s0 = MFMA32(a0, qf[kd], s0); s1 = MFMA32(a1, qf[kd], s1); }
        const float bt = bsv[t], mt = mtv[t], dc = dcv[t]; float rs = zf_;
#pragma unroll
        for (int r = 0; r < 16; ++r) { const int sa = crow(r, hi), sb2 = 32 + sa;
            s0[r] = (sa <= t) ? s0[r] * __expf(bt + gsv[sa] - mt) : 0.f; s1[r] = (sb2 <= t) ? s1[r] * __expf(bt + gsv[sb2] - mt) : 0.f; rs += s0[r] + s1[r]; }
        rs = swapsum(rs);
        v4u pw[4];
        pw[0] = (v4u){pk2(s0[0], s0[1]), pk2(s0[2], s0[3]), pk2(s0[4], s0[5]), pk2(s0[6], s0[7])};
        pw[1] = (v4u){pk2(s0[8], s0[9]), pk2(s0[10], s0[11]), pk2(s0[12], s0[13]), pk2(s0[14], s0[15])};
        pw[2] = (v4u){pk2(s1[0], s1[1]), pk2(s1[2], s1[3]), pk2(s1[4], s1[5]), pk2(s1[6], s1[7])};
        pw[3] = (v4u){pk2(s1[8], s1[9]), pk2(s1[10], s1[11]), pk2(s1[12], s1[13]), pk2(s1[14], s1[15])};
        f32x16 acc;
#pragma unroll
        for (int r = 0; r < 16; ++r) acc[r] = zf_;
#pragma unroll
        for (int kd = 0; kd < 4; ++kd) { const s16x4 lo = vtr16(Ci + (vq * 4 + kd) * 1024 + vfn), hh = vtr16(Ci + (vq * 4 + kd) * 1024 + vfn + 256); const s16x8 cf = {lo[0], lo[1], lo[2], lo[3], hh[0], hh[1], hh[2], hh[3]};
            acc = MFMA32(cf, qf[kd], acc); }
#pragma unroll
        for (int r = 0; r < 16; ++r) acc[r] *= dc;
#pragma unroll
        for (int ks = 0; ks < 4; ++ks) { const s16x4 lo = vtr16(Vi + (vq * 4 + ks) * 1024 + vfa), hh = vtr16(Vi + (vq * 4 + ks) * 1024 + vfa + 512); const s16x8 vf = {lo[0], lo[1], lo[2], lo[3], hh[0], hh[1], hh[2], hh[3]};
            acc = MFMA32(vf, __builtin_bit_cast(s16x8, pw[ks]), acc); }
        float qn = zf_;
#pragma unroll
        for (int kd = 0; kd < 4; ++kd) { const v4u w = __builtin_bit_cast(v4u, qf[kd]); const LAS float* np = npv + kd * 16 + hi * 8;
            qn += bflo(w.x) * np[0] + bfhi(w.x) * np[1] + bflo(w.y) * np[2] + bfhi(w.y) * np[3] + bflo(w.z) * np[4] + bfhi(w.z) * np[5] + bflo(w.w) * np[6] + bfhi(w.w) * np[7]; }
        qn = swapsum(qn);
        const float inv = 1.0f / fmaxf(fabsf(dc * qn + rs), __expf(-mt));
        float ss = zf_;
#pragma unroll
        for (int r = 0; r < 16; ++r) { acc[r] *= inv; ss += acc[r] * acc[r]; }
        ss = swapsum(ss);
        if (hi == 0) red[vq * 64 + t] = ss;
        __syncthreads();
        const float rstd = 1.0f / sqrtf(((red[t] + red[64 + t]) + (red[128 + t] + red[192 + t])) * (1.f / 128.f) + EPS);
        LAS u16* stg = (LAS u16*)(lds + M2_OST) + wid * 2048;
#pragma unroll
        for (int r = 0; r < 16; r += 2) { const u32 w = pk2(acc[r] * rstd, acc[r + 1] * rstd); stg[r32 * 32 + crow(r, hi)] = (u16)(w & 0xffffu); stg[r32 * 32 + crow(r + 1, hi)] = (u16)(w >> 16); }
        asm volatile("s_waitcnt lgkmcnt(0)" ::: "memory");
#pragma unroll
        for (int i = 0; i < 2; ++i) { const int tt = i * 16 + (lane >> 2), ch = lane & 3; const v4u hv = *(const LAS v4u*)(stg + tt * 32 + ch * 8);
            const size_t ob = (row0 + th * 32 + tt) * 512 + h * 128 + vq * 32 + ch * 8; const v4u mo = *(const v4u*)(MO + ob); const float* gp = hg + h * 128 + vq * 32 + ch * 8;
            v4u w; w.x = pk2(bflo(hv.x) * gp[0] * bflo(mo.x), bfhi(hv.x) * gp[1] * bfhi(mo.x)); w.y = pk2(bflo(hv.y) * gp[2] * bflo(mo.y), bfhi(hv.y) * gp[3] * bfhi(mo.y));
            w.z = pk2(bflo(hv.z) * gp[4] * bflo(mo.z), bfhi(hv.z) * gp[5] * bfhi(mo.z)); w.w = pk2(bflo(hv.w) * gp[6] * bflo(mo.w), bfhi(hv.w) * gp[7] * bfhi(mo.w));
            *(v4u*)(YB + ob) = w; }
    }
    __syncthreads();
}

constexpr int M2_CW = M2_BYTES, M2_BYTES3 = M2_CW + 2560 * 4;
static_assert(M2_BYTES3 <= RING_BYTES, "mLSTM LDS map");
#define M3_CLOAD(R, MQK, row0, pos0, ch) do { _Pragma("unroll") for (int j_ = 0; j_ < 4; ++j_) { const int o_ = s_ - 3 + j_, oc_ = o_ < -(pos0) ? -(pos0) : o_; \
        v4u w_ = *(const v4u*)((MQK) + (size_t)((long)(row0) + oc_) * 512 + (ch)); if ((pos0) + o_ < 0) w_ = (v4u){0u, 0u, 0u, 0u}; R[j_] = w_; } } while (0)
template <bool IMG> __device__ __forceinline__ void m3_conv_store(LAS unsigned char* dst, const LAS float* wsc, const v4u* R, const LAS float* cwl, int ch, float scale, int s, int cc) {
    float acc[8];
    { const f32x4 b0 = *(const LAS f32x4*)(cwl + 2048 + ch), b1 = *(const LAS f32x4*)(cwl + 2048 + ch + 4); acc[0] = b0.x; acc[1] = b0.y; acc[2] = b0.z; acc[3] = b0.w; acc[4] = b1.x; acc[5] = b1.y; acc[6] = b1.z; acc[7] = b1.w; }
#pragma unroll
    for (int j = 0; j < 4; ++j) { const v4u w = R[j]; const f32x4 w0 = *(const LAS f32x4*)(cwl + j * 512 + ch), w1 = *(const LAS f32x4*)(cwl + j * 512 + ch + 4);
        acc[0] += w0.x * bflo(w.x); acc[1] += w0.y * bfhi(w.x); acc[2] += w0.z * bflo(w.y); acc[3] += w0.w * bfhi(w.y); acc[4] += w1.x * bflo(w.z); acc[5] += w1.y * bfhi(w.z); acc[6] += w1.z * bflo(w.w); acc[7] += w1.w * bfhi(w.w); }
    const float sc = scale * (wsc ? wsc[s] : 1.0f);
#pragma unroll
    for (int i = 0; i < 8; ++i) acc[i] = fsilu(acc[i]) * sc;
    v4u o; o.x = pk2(acc[0], acc[1]); o.y = pk2(acc[2], acc[3]); o.z = pk2(acc[4], acc[5]); o.w = pk2(acc[6], acc[7]);
    if (IMG) *(LAS v4u*)(dst + ((cc >> 2) * 4 + (s >> 4)) * 1024 + (s & 15) * 64 + (cc & 3) * 16) = o;
    else *(LAS v4u*)(dst + (s * M2_P + cc * 8) * 2) = o;
}
__device__ __forceinline__ void mlstm_a3_phase(Frame& F, const u16* MQK, const u16* MV, const float* IF, const float* cw, const float* cb, float* ST) {
    LAS unsigned char* lds = F.lds; LAS unsigned char* Vi = lds + M2_V; LAS float* wsv = (LAS float*)(lds + M2_SC); LAS float* cwl = (LAS float*)(lds + M2_CW);
    float* mloc = (float*)(F.ws + WS_MLS); float* bend = mloc + 2048; float* nst = (float*)(F.ws + WS_MLS + 65536);
    const int tid = F.tid, lane = F.lane, wid = F.wave, r32 = lane & 31, hi = lane >> 5, s_ = tid >> 3, cc = tid & 7;
    const int vfn = ((lane >> 4) & 1) * 32 + (lane & 3) * 8 + (8 * hi + ((lane & 15) >> 2)) * 64;
    __syncthreads();
    for (int i = tid; i < 2560; i += NTHR) cwl[i] = i < 2048 ? cw[i] : cb[i - 2048];
    v4u kr[4], vr[2]; float ig = 0.f, lf = 0.f;
#define A3_ISSUE(u_) do { const int bh_ = (u_) >> 8, b_ = bh_ >> 2, h_ = bh_ & 3, pos0_ = ((u_) & 255) * 64; const size_t row0_ = (size_t)b_ * SEQ + pos0_; \
        M3_CLOAD(kr, MQK, row0_, pos0_, 256 + h_ * 64 + cc * 8); \
        _Pragma("unroll") for (int i_ = 0; i_ < 2; ++i_) { const int c_ = tid + 512 * i_; vr[i_] = *(const v4u*)(MV + (row0_ + (c_ >> 4)) * 512 + h_ * 128 + (c_ & 15) * 8); } \
        { const int t_ = tid & 63; ig = IF[(row0_ + t_) * 8 + h_]; lf = IF[(row0_ + t_) * 8 + 4 + h_]; } } while (0)
    if (F.bid < 2048) A3_ISSUE(F.bid);
    for (int u = F.bid; u < 2048; u += F.G) {
        const int bh = u >> 8, h = bh & 3;
        __syncthreads();
        if (tid < 64) { const float bs = wave_incl_scan_add(lf, tid), be = bperm_f(63, bs);
            const float wl = be - bs + ig, ml = wave_max(wl, tid);
            wsv[tid] = __expf(wl - ml);
            if (tid == 0) { mloc[u] = ml; bend[u] = be; } }
#pragma unroll
        for (int i = 0; i < 2; ++i) { const int c = tid + 512 * i, row = c >> 4, c16 = c & 15; *(LAS v4u*)(Vi + ((c16 >> 2) * 4 + (row >> 4)) * 1024 + (row & 15) * 64 + (c16 & 3) * 16) = vr[i]; }
        __syncthreads();
        m3_conv_store<true>(lds + M2_K, wsv, kr, cwl, 256 + h * 64 + cc * 8, 0.125f, s_, cc);
        __syncthreads();
        { const int un = u + F.G < 2048 ? u + F.G : u; A3_ISSUE(un); }
        const int dt = wid & 1, vt = wid >> 1;
        float zf_ = 0.f; asm volatile("" : "+v"(zf_));
        f32x16 acc;
#pragma unroll
        for (int r = 0; r < 16; ++r) acc[r] = zf_;
#pragma unroll
        for (int ks = 0; ks < 4; ++ks) { const s16x4 al = vtr16(lds + M2_K + (dt * 4 + ks) * 1024 + vfn), ah = vtr16(lds + M2_K + (dt * 4 + ks) * 1024 + vfn + 256); const s16x8 a = {al[0], al[1], al[2], al[3], ah[0], ah[1], ah[2], ah[3]};
            const s16x4 lo = vtr16(Vi + (vt * 4 + ks) * 1024 + vfn), hh = vtr16(Vi + (vt * 4 + ks) * 1024 + vfn + 256); const s16x8 vf = {lo[0], lo[1], lo[2], lo[3], hh[0], hh[1], hh[2], hh[3]};
            acc = MFMA32(a, vf, acc); }
        float* o = ST + (size_t)u * 8192 + (dt * 32) * 128 + vt * 32 + r32;
#pragma unroll
        for (int r = 0; r < 16; ++r) o[crow(r, hi) * 128] = acc[r];
        if (tid < 64) { float an = 0.f; const LAS u16* kc = (const LAS u16*)(lds + M2_K) + (tid >> 5) * 2048 + (tid & 31);
#pragma unroll 8
            for (int s2 = 0; s2 < 64; ++s2) an += bf1(kc[(s2 >> 4) * 512 + (s2 & 15) * 32]);
            nst[(size_t)u * 64 + tid] = an; }
    }
#undef A3_ISSUE
    __syncthreads();
}
__device__ __forceinline__ void mlstm_c3_phase(Frame& F, const u16* MQK, const u16* MV, const u16* MO, const float* IF, const float* cw, const float* cb, const float* hg, const float* ST, u16* YB) {
    LAS unsigned char* lds = F.lds; LAS u16* Qs = (LAS u16*)(lds + M2_Q); LAS u16* Ks = (LAS u16*)(lds + M2_K); LAS unsigned char* Vi = lds + M2_V; LAS unsigned char* Ci = lds + M2_C;
    LAS float* bsv = (LAS float*)(lds + M2_SC); LAS float* gsv = bsv + 64; LAS float* mtv = gsv + 64; LAS float* dcv = mtv + 64; LAS float* npv = dcv + 64; LAS float* red = (LAS float*)(lds + M2_RED);
    LAS float* cwl = (LAS float*)(lds + M2_CW);
    const float* mprev = (const float*)(F.ws + WS_MLS) + 4096; const float* nst = (const float*)(F.ws + WS_MLS + 65536);
    const int tid = F.tid, lane = F.lane, wid = F.wave, r32 = lane & 31, hi = lane >> 5, s_ = tid >> 3, cc = tid & 7;
    const int vfn = ((lane >> 4) & 1) * 32 + (lane & 3) * 8 + (8 * hi + ((lane & 15) >> 2)) * 64;
    const int vfa = ((lane >> 4) & 1) * 32 + (lane & 3) * 8 + (4 * hi + ((lane & 15) >> 2)) * 64;
    __syncthreads();
    for (int i = tid; i < 2560; i += NTHR) cwl[i] = i < 2048 ? cw[i] : cb[i - 2048];
    v4u qr4[4], kr[4], vr[2]; f32x4 cp[4]; float ig = 0.f, lf = 0.f, mp = 0.f, npn = 0.f;
#define C3_ISSUE(u_) do { const int bh_ = (u_) >> 8, b_ = bh_ >> 2, h_ = bh_ & 3, pos0_ = ((u_) & 255) * 64; const size_t row0_ = (size_t)b_ * SEQ + pos0_; \
        M3_CLOAD(qr4, MQK, row0_, pos0_, h_ * 64 + cc * 8); M3_CLOAD(kr, MQK, row0_, pos0_, 256 + h_ * 64 + cc * 8); \
        _Pragma("unroll") for (int i_ = 0; i_ < 2; ++i_) { const int c_ = tid + 512 * i_; vr[i_] = *(const v4u*)(MV + (row0_ + (c_ >> 4)) * 512 + h_ * 128 + (c_ & 15) * 8); \
            const float* sp_ = ST + (size_t)(u_) * 8192 + (c_ >> 4) * 128 + (c_ & 15) * 8; cp[2 * i_] = *(const f32x4*)sp_; cp[2 * i_ + 1] = *(const f32x4*)(sp_ + 4); } \
        { const int t_ = tid & 63; ig = IF[(row0_ + t_) * 8 + h_]; lf = IF[(row0_ + t_) * 8 + 4 + h_]; mp = mprev[(u_)]; npn = nst[(size_t)(u_) * 64 + t_]; } } while (0)
    if (F.bid < 2048) C3_ISSUE(F.bid);
    for (int u = F.bid; u < 2048; u += F.G) {
        const int bh = u >> 8, c = u & 255, b = bh >> 2, h = bh & 3, pos0 = c * 64; const size_t row0 = (size_t)b * SEQ + pos0;
        __syncthreads();
        m3_conv_store<false>(lds + M2_Q, nullptr, qr4, cwl, h * 64 + cc * 8, 1.0f, s_, cc);
        m3_conv_store<false>(lds + M2_K, nullptr, kr, cwl, 256 + h * 64 + cc * 8, 0.125f, s_, cc);
#pragma unroll
        for (int i = 0; i < 2; ++i) { const int ci = tid + 512 * i, row = ci >> 4, c16 = ci & 15; const int io = ((c16 >> 2) * 4 + (row >> 4)) * 1024 + (row & 15) * 64 + (c16 & 3) * 16;
            *(LAS v4u*)(Vi + io) = vr[i];
            const f32x4 a = cp[2 * i], bq = cp[2 * i + 1]; v4u w; w.x = pk2(a.x, a.y); w.y = pk2(a.z, a.w); w.z = pk2(bq.x, bq.y); w.w = pk2(bq.z, bq.w); *(LAS v4u*)(Ci + io) = w; }
        if (tid < 64) { const float bs = wave_incl_scan_add(lf, tid), gs = ig - bs, gmx = wave_incl_scan_max(gs, tid);
            const float inter = bs + mp, mt = fmaxf(inter, bs + gmx);
            bsv[tid] = bs; gsv[tid] = gs; mtv[tid] = mt; dcv[tid] = __expf(inter - mt); npv[tid] = npn; }
        __syncthreads();
        const int th = wid & 1, vq = wid >> 1, t = th * 32 + r32;
        v4u mo[2];
#pragma unroll
        for (int i = 0; i < 2; ++i) { const int tt = i * 16 + (lane >> 2), ch = lane & 3; mo[i] = *(const v4u*)(MO + (row0 + th * 32 + tt) * 512 + h * 128 + vq * 32 + ch * 8); }
        { const int un = u + F.G < 2048 ? u + F.G : u; C3_ISSUE(un); }
        float zf_ = 0.f; asm volatile("" : "+v"(zf_));
        f32x16 s0, s1;
#pragma unroll
        for (int r = 0; r < 16; ++r) { s0[r] = zf_; s1[r] = zf_; }
        s16x8 qf[4];
#pragma unroll
        for (int kd = 0; kd < 4; ++kd) qf[kd] = *(const LAS s16x8*)(Qs + t * M2_P + kd * 16 + hi * 8);
#pragma unroll
        for (int kd = 0; kd < 4; ++kd) { const s16x8 a0 = *(const LAS s16x8*)(Ks + r32 * M2_P + kd * 16 + hi * 8), a1 = *(const LAS s16x8*)(Ks + (32 + r32) * M2_P + kd * 16 + hi * 8);
            s0 = MFMA32(a0, qf[kd], s0); s1 = MFMA32(a1, qf[kd], s1); }
        const float bt = bsv[t], mt = mtv[t], dc = dcv[t]; float rs = zf_;
#pragma unroll
        for (int r = 0; r < 16; ++r) { const int sa = crow(r, hi), sb2 = 32 + sa;
            s0[r] = (sa <= t) ? s0[r] * __expf(bt + gsv[sa] - mt) : 0.f; s1[r] = (sb2 <= t) ? s1[r] * __expf(bt + gsv[sb2] - mt) : 0.f; rs += s0[r] + s1[r]; }
        rs = swapsum(rs);
        v4u pw[4];
        pw[0] = (v4u){pk2(s0[0], s0[1]), pk2(s0[2], s0[3]), pk2(s0[4], s0[5]), pk2(s0[6], s0[7])};
        pw[1] = (v4u){pk2(s0[8], s0[9]), pk2(s0[10], s0[11]), pk2(s0[12], s0[13]), pk2(s0[14], s0[15])};
        pw[2] = (v4u){pk2(s1[0], s1[1]), pk2(s1[2], s1[3]), pk2(s1[4], s1[5]), pk2(s1[6], s1[7])};
        pw[3] = (v4u){pk2(s1[8], s1[9]), pk2(s1[10], s1[11]), pk2(s1[12], s1[13]), pk2(s1[14], s1[15])};
        f32x16 acc;
#pragma unroll
        for (int r = 0; r < 16; ++r) acc[r] = zf_;
#pragma unroll
        for (int kd = 0; kd < 4; ++kd) { const s16x4 lo = vtr16(Ci + (vq * 4 + kd) * 1024 + vfn), hh = vtr16(Ci + (vq * 4 + kd) * 1024 + vfn + 256); const s16x8 cf = {lo[0], lo[1], lo[2], lo[3], hh[0], hh[1], hh[2], hh[3]};
            acc = MFMA32(cf, qf[kd], acc); }
#pragma unroll
        for (int r = 0; r < 16; ++r) acc[r] *= dc;
#pragma unroll
        for (int ks = 0; ks < 4; ++ks) { const s16x4 lo = vtr16(Vi + (vq * 4 + ks) * 1024 + vfa), hh = vtr16(Vi + (vq * 4 + ks) * 1024 + vfa + 512); const s16x8 vf = {lo[0], lo[1], lo[2], lo[3], hh[0], hh[1], hh[2], hh[3]};
            acc = MFMA32(vf, __builtin_bit_cast(s16x8, pw[ks]), acc); }
        float qn = zf_;
#pragma unroll
        for (int kd = 0; kd < 4; ++kd) { const v4u w = __builtin_bit_cast(v4u, qf[kd]); const LAS float* np = npv + kd * 16 + hi * 8;
            qn += bflo(w.x) * np[0] + bfhi(w.x) * np[1] + bflo(w.y) * np[2] + bfhi(w.y) * np[3] + bflo(w.z) * np[4] + bfhi(w.z) * np[5] + bflo(w.w) * np[6] + bfhi(w.w) * np[7]; }
        qn = swapsum(qn);
        const float inv = 1.0f / fmaxf(fabsf(dc * qn + rs), __expf(-mt));
        float ss = zf_;
#pragma unroll
        for (int r = 0; r < 16; ++r) { acc[r] *= inv; ss += acc[r] * acc[r]; }
        ss = swapsum(ss);
        if (hi == 0) red[vq * 64 + t] = ss;
        __syncthreads();
        const float rstd = 1.0f / sqrtf(((red[t] + red[64 + t]) + (red[128 + t] + red[192 + t])) * (1.f / 128.f) + EPS);
        LAS u16* stg = (LAS u16*)(lds + M2_OST) + wid * 2048;
#pragma unroll
        for (int r = 0; r < 16; r += 2) { const u32 w = pk2(acc[r] * rstd, acc[r + 1] * rstd); stg[r32 * 40 + crow(r, hi)] = (u16)(w & 0xffffu); stg[r32 * 40 + crow(r + 1, hi)] = (u16)(w >> 16); }
        asm volatile("s_waitcnt lgkmcnt(0)" ::: "memory");
#pragma unroll
        for (int i = 0; i < 2; ++i) { const int tt = i * 16 + (lane >> 2), ch = lane & 3; const v4u hv = *(const LAS v4u*)(stg + tt * 40 + ch * 8);
            const size_t ob = (row0 + th * 32 + tt) * 512 + h * 128 + vq * 32 + ch * 8; const v4u mov = mo[i]; const float* gp = hg + h * 128 + vq * 32 + ch * 8;
            v4u w; w.x = pk2(bflo(hv.x) * gp[0] * bflo(mov.x), bfhi(hv.x) * gp[1] * bfhi(mov.x)); w.y = pk2(bflo(hv.y) * gp[2] * bflo(mov.y), bfhi(hv.y) * gp[3] * bfhi(mov.y));
            w.z = pk2(bflo(hv.z) * gp[4] * bflo(mov.z), bfhi(hv.z) * gp[5] * bfhi(mov.z)); w.w = pk2(bflo(hv.w) * gp[6] * bflo(mov.w), bfhi(hv.w) * gp[7] * bfhi(mov.w));
            *(v4u*)(YB + ob) = w; }
    }
#undef C3_ISSUE
    __syncthreads();
}

#if MK_CHECK
constexpr int CW_CHK = 32768, NCHK = 25, CHK_BLOCKS = 48;
__device__ __forceinline__ float blk_sum(float v, float* sh) {
    __syncthreads(); sh[threadIdx.x] = v; __syncthreads();
    for (int o = 128; o > 0; o >>= 1) { if ((int)threadIdx.x < o) sh[threadIdx.x] += sh[threadIdx.x + o]; __syncthreads(); }
    const float r = sh[0]; __syncthreads(); return r;
}
__device__ __forceinline__ float blk_max(float v, float* sh) {
    __syncthreads(); sh[threadIdx.x] = v; __syncthreads();
    for (int o = 128; o > 0; o >>= 1) { if ((int)threadIdx.x < o) sh[threadIdx.x] = fmaxf(sh[threadIdx.x], sh[threadIdx.x + o]); __syncthreads(); }
    const float r = sh[0]; __syncthreads(); return r;
}
__device__ __forceinline__ unsigned hsh(unsigned a, unsigned b) { unsigned x = a * 2654435761u + b * 40503u + 12345u; x ^= x >> 15; x *= 2246822519u; x ^= x >> 13; x *= 3266489917u; x ^= x >> 16; return x; }
__device__ __forceinline__ void chk_report(u32* ctl, int k, float ratio) { if (threadIdx.x == 0) atomicMax(ctl + CW_CHK + k, __float_as_uint(fminf(fabsf(ratio) * MK_CHECK_TIGHT, 1e30f))); }
__device__ __forceinline__ float convsilu(const u16* MQK, size_t rowb  , int pos, int ch, const float* cw, const float* cb) {
    float y = cb[ch];
    for (int j = 0; j < 4; ++j) { const int p = pos - 3 + j; if (p >= 0) y += cw[j * 512 + ch] * bf1(MQK[(rowb + p) * 512 + ch]); }
    return y / (1.0f + expf(-y));
}
template <int K> __global__ void __launch_bounds__(256) chk(Params P) {
    __shared__ float sh[256]; __shared__ float big[12288];
    unsigned char* ws = P.ws; u32* ctl = (u32*)(ws + WS_CTL); const int tid = threadIdx.x, bk = blockIdx.x;
    const int l = P.ph_lo; const float* mod0 = (const float*)(ws + WS_MOD) + (size_t)l * 2 * 6144;
    const u16* U = (const u16*)(ws + ACT(0));
    if (K == 0) {
        const int row = hsh(bk, 1) % NTOK, col = hsh(bk, 2) % DM, b = row / SEQ; const float* x = (l == 0 ? P.in[0] : P.out) + (size_t)row * DM;
        float s = 0.f; for (int c = tid; c < DM; c += 256) s += x[c] * x[c];
        const float rstd = 1.0f / sqrtf(blk_sum(s, sh) / DM + EPS);
        const float e = x[col] * rstd * (P.in[4] + (size_t)l * (1024))[col] * (1.0f + mod0[(b * 6 + 1) * 1024 + col]) + mod0[(b * 6 + 0) * 1024 + col];
        chk_report(ctl, K, (bf1(U[(size_t)row * DM + col]) - e) / (0.01f * (fabsf(e) + 1.0f)));
    }
    if (K == 1 || K == 5) {
        const int row = hsh(bk, 3) % NTOK; int j;
        if (K == 1) { j = hsh(bk, 4) % 2472; if (j >= 1960) j += 1024; } else j = 3496 + hsh(bk, 4) % 3072;
        float s = 0.f; for (int k = tid; k < DM; k += 256) s += bf1(U[(size_t)row * DM + k]) * (P.in[5] + (size_t)l * (1024 * INW))[(size_t)k * INW + j];
        const float e = blk_sum(s, sh); float a, ee = e, tol;
        if (K == 5) { a = bf1(((const u16*)(ws + ACT(4)))[(size_t)row * 3072 + (j - 3496)]); ee = 1.0f / (1.0f + expf(-e)); tol = 0.02f; }
        else {
            tol = 0.03f * (fabsf(e) + 0.5f);
            if (j < 256) a = bf1(((const u16*)(ws + ACT(2)))[(size_t)row * 256 + j]);
            else if (j < 384) a = bf1(((const u16*)(ws + ACT(2) + 16 * MiB))[(size_t)row * 256 + (j - 256)]);
            else if (j < 416) a = bf1(((const u16*)(ws + ACT(2) + 16 * MiB))[(size_t)row * 256 + 128 + (j - 384)]);
            else if (j < 928) a = bf1(((const u16*)(ws + ACT(3)))[(size_t)row * 512 + (j - 416)]);
            else if (j < 1440) a = bf1(((const u16*)(ws + ACT(4)))[(size_t)row * 512 + (j - 928)]);
            else if (j < 1952) { a = bf1(((const u16*)(ws + ACT(5)))[(size_t)row * 512 + (j - 1440)]); ee = 1.0f / (1.0f + expf(-e)); tol = 0.02f; }
            else if (j < 1956) { a = ((const float*)(ws + WS_IF))[(size_t)row * 8 + (j - 1952)]; ee = e + (P.in[14] + (size_t)l * (4))[j - 1952]; }
            else if (j < 1960) { a = ((const float*)(ws + WS_IF))[(size_t)row * 8 + 4 + (j - 1956)]; const float z = e + (P.in[15] + (size_t)l * (4))[j - 1956]; ee = -log1pf(expf(-z)); tol = 0.05f * fabsf(ee) + 1e-3f; }
            else a = bf1(((const u16*)(ws + ACT(8)))[(size_t)row * 512 + (j - 2984)]);
        }
        chk_report(ctl, K, (a - ee) / tol);
    }
    if (K == 2) {
        const int row = hsh(bk, 5) % NTOK, isq = hsh(bk, 6) & 1, h = hsh(bk, 7) & 7; const int base = (isq ? 1960 : 2472) + h * 64;
        float d = 0.f; if (tid < 64) for (int k = 0; k < DM; ++k) d += bf1(U[(size_t)row * DM + k]) * (P.in[5] + (size_t)l * (1024 * INW))[(size_t)k * INW + base + tid];
        const float ss = blk_sum(tid < 64 ? d * d : 0.f, sh), rstd = 1.0f / sqrtf(ss / 64.f + EPS);
        float r = 0.f;
        if (tid < 64) { const float e = d * rstd * (isq ? (P.in[17] + (size_t)l * (64))[tid] * 0.125f * LOG2E : (P.in[18] + (size_t)l * (64))[tid]); const float a = bf1(((const u16*)(ws + ACT(isq ? 6 : 7)))[(size_t)row * 512 + h * 64 + tid]); r = fabsf(a - e) / (0.03f * (fabsf(e) + 0.3f)); }
        chk_report(ctl, K, blk_max(r, sh));
    }
    if (K == 3) {
        const int b = bk & 1, h = (bk >> 1) & 3, t = 5 + 41 * (bk >> 3); const size_t rowb = (size_t)b * SEQ;
        const u16* MQK = (const u16*)(ws + ACT(3)); const u16* MV = (const u16*)(ws + ACT(4)); const u16* MO = (const u16*)(ws + ACT(5)); const float* IF = (const float*)(ws + WS_IF);
        float C[64], n[64];
#pragma unroll
        for (int d = 0; d < 64; ++d) { C[d] = 0.f; n[d] = 0.f; }
        for (int s = 0; s <= t; ++s) {
            __syncthreads();
            if (tid < 64) sh[tid] = convsilu(MQK, rowb, s, 256 + h * 64 + tid, (P.in[12] + (size_t)l * (2048)), (P.in[13] + (size_t)l * (512))) * 0.125f;
            __syncthreads();
            const float f = expf(IF[(rowb + s) * 8 + 4 + h]), ii = expf(IF[(rowb + s) * 8 + h]);
            const float vv = tid < 128 ? bf1(MV[(rowb + s) * 512 + h * 128 + tid]) : 0.f;
#pragma unroll
            for (int d = 0; d < 64; ++d) { const float kk = sh[d]; C[d] = f * C[d] + ii * kk * vv; n[d] = f * n[d] + ii * kk; }
        }
        __syncthreads();
        if (tid < 64) sh[tid] = convsilu(MQK, rowb, t, h * 64 + tid, (P.in[12] + (size_t)l * (2048)), (P.in[13] + (size_t)l * (512)));
        __syncthreads();
        float num = 0.f, den = 0.f;
#pragma unroll
        for (int d = 0; d < 64; ++d) { num += C[d] * sh[d]; den += n[d] * sh[d]; }
        const float hv = tid < 128 ? num / fmaxf(fabsf(den), 1.0f) : 0.f;
        const float ss = blk_sum(hv * hv, sh), rstd = 1.0f / sqrtf(ss / 128.f + EPS);
        float r = 0.f;
        if (tid < 128) { const float e = hv * rstd * (P.in[16] + (size_t)l * (512))[h * 128 + tid] * bf1(MO[(rowb + t) * 512 + h * 128 + tid]); const float a = bf1(((const u16*)(ws + ACT(13)))[(rowb + t) * 512 + h * 128 + tid]); r = fabsf(a - e) / (0.03f * (fabsf(e) + 0.2f)); }
        chk_report(ctl, K, blk_max(r, sh));
    }
    if (K == 4) {
        const int row = hsh(bk, 8) % NTOK, h = hsh(bk, 9) & 7, which = bk % 3, pos = row % SEQ;
        const u16* CQ = (const u16*)(ws + ACT(2)); const u16* C1 = (const u16*)(ws + ACT(2) + 16 * MiB);
        const float* ct = (const float*)(ws + WS_ROPE); const float* st = ct + SEQ * 16;
        float r = 0.f;
        if (which == 0) {
            float s = 0.f; { const float v = bf1(CQ[(size_t)row * 256 + tid]); s = v * v; }
            const float rq = 1.0f / sqrtf(blk_sum(s, sh) / 256.f + EPS);
            __syncthreads(); big[tid] = bf1(CQ[(size_t)row * 256 + tid]) * rq * (P.in[6] + (size_t)l * (256))[tid]; __syncthreads();
            float q = 0.f; if (tid < 96) for (int k = 0; k < 256; ++k) q += big[k] * (P.in[8] + (size_t)l * (256 * 768))[(size_t)k * 768 + h * 96 + tid];
            const float rs = 1.0f / sqrtf(blk_sum(tid < 96 ? q * q : 0.f, sh) / 96.f + EPS);
            __syncthreads(); if (tid < 96) big[512 + tid] = q * rs * (P.in[10] + (size_t)l * (96))[tid]; __syncthreads();
            if (tid < 96) { float e = big[512 + tid];
                if (tid >= 64 && tid < 80) { const int i = tid - 64; e = big[512 + 64 + i] * ct[pos * 16 + i] - big[512 + 80 + i] * st[pos * 16 + i]; }
                if (tid >= 80) { const int i = tid - 80; e = big[512 + 64 + i] * st[pos * 16 + i] + big[512 + 80 + i] * ct[pos * 16 + i]; }
                e *= 0.10206207261596577f * LOG2E;
                const float a = bf1(((const u16*)(ws + ACT(6)))[(size_t)row * 768 + h * 96 + tid]); r = fabsf(a - e) / (0.03f * (fabsf(e) + 0.05f)); }
        } else {
            float s = 0.f; if (tid < 128) { const float v = bf1(C1[(size_t)row * 256 + tid]); s = v * v; }
            const float rk = 1.0f / sqrtf(blk_sum(s, sh) / 128.f + EPS);
            __syncthreads(); if (tid < 128) big[tid] = bf1(C1[(size_t)row * 256 + tid]) * rk * (P.in[7] + (size_t)l * (128))[tid]; __syncthreads();
            if (which == 2) {
                if (tid < 64) { float v = 0.f; for (int k = 0; k < 128; ++k) v += big[k] * (P.in[9] + (size_t)l * (128 * 1024))[(size_t)k * 1024 + h * 128 + 64 + tid];
                    const float a = bf1(((const u16*)(ws + ACT(9)))[(size_t)row * 512 + h * 64 + tid]); r = fabsf(a - v) / (0.03f * (fabsf(v) + 0.3f)); }
            } else {
                float kk = 0.f;
                if (tid < 64) for (int k = 0; k < 128; ++k) kk += big[k] * (P.in[9] + (size_t)l * (128 * 1024))[(size_t)k * 1024 + h * 128 + tid];
                if (tid >= 64 && tid < 96) kk = bf1(C1[(size_t)row * 256 + 128 + (tid - 64)]);
                const float rs = 1.0f / sqrtf(blk_sum(tid < 96 ? kk * kk : 0.f, sh) / 96.f + EPS);
                __syncthreads(); if (tid < 96) big[512 + tid] = kk * rs * (P.in[11] + (size_t)l * (96))[tid]; __syncthreads();
                if (tid < 96) { float e = big[512 + tid];
                    if (tid >= 64 && tid < 80) { const int i = tid - 64; e = big[512 + 64 + i] * ct[pos * 16 + i] - big[512 + 80 + i] * st[pos * 16 + i]; }
                    if (tid >= 80) { const int i = tid - 80; e = big[512 + 64 + i] * st[pos * 16 + i] + big[512 + 80 + i] * ct[pos * 16 + i]; }
                    const float a = bf1(((const u16*)(ws + ACT(6) + 48 * MiB))[(size_t)row * 768 + h * 96 + tid]); r = fabsf(a - e) / (0.03f * (fabsf(e) + 0.3f)); }
            }
        }
        chk_report(ctl, K, blk_max(r, sh));
    }
    if (K == 6) {
        const int row = hsh(bk, 10) % NTOK, d = hsh(bk, 11) % DM; float e = 0.f;
        for (int i = 0; i < 3; ++i) { const u16* Y = (const u16*)(ws + ACT(i == 0 ? 3 : (i == 1 ? 13 : 12))); const float* W = i == 0 ? (P.in[19] + (size_t)l * (512 * 1024)) : (i == 1 ? (P.in[20] + (size_t)l * (512 * 1024)) : (P.in[21] + (size_t)l * (512 * 1024)));
            float s = 0.f; for (int n = tid; n < 512; n += 256) s += bf1(Y[(size_t)row * 512 + n]) * W[(size_t)n * 1024 + d];
            e += bf1(((const u16*)(ws + ACT(4)))[(size_t)row * 3072 + i * 1024 + d]) * blk_sum(s, sh); }
        chk_report(ctl, K, (bf1(U[(size_t)row * DM + d]) - e) / (0.03f * (fabsf(e) + 0.1f)));
    }
    if (K == 7) {
        const int row = hsh(bk, 12) % NTOK, d = hsh(bk, 13) % DM, b = row / SEQ;
        float s = 0.f; for (int k = tid; k < DM; k += 256) s += bf1(U[(size_t)row * DM + k]) * (P.in[22] + (size_t)l * (1024 * 1024))[(size_t)k * 1024 + d];
        const float e = mod0[(b * 6 + 2) * 1024 + d] * blk_sum(s, sh) * MK_CHECK_INJECT, a = P.out[(size_t)row * DM + d] - ((const float*)(ws + WS_ROUT + 768 * 1024))[bk * DM + d];
        chk_report(ctl, K, (a - e) / (0.03f * fabsf(e) + 0.005f));
    }
    if (K == 8 || K == 9) {
        const int t = hsh(bk, 14) % NTOK, b = t / SEQ; const u32* cnt = ctl + CW_MOE + l * 64;
        const int* cls_o = (const int*)(ws + WS_ROUT); const int* slot_o = cls_o + NTOK;
        const int cls = cls_o[t]; int base = 0; for (int c = 0; c < cls; ++c) base += (((int)cnt[c] + 255) >> 8) << 8;
        const int pos = base + slot_o[t]; int ea, eb; cls_experts(cls, ea, eb);
        const u16* HID = (const u16*)(ws + ACT(3)); const float* wrow = (const float*)(ws + WS_TOK + 262144); const int* tok = (const int*)(ws + WS_TOK);
        if (K == 8) {
            const float* x = P.out + (size_t)t * DM;
            float s = 0.f; for (int c = tid; c < DM; c += 256) s += x[c] * x[c];
            const float rstd = 1.0f / sqrtf(blk_sum(s, sh) / DM + EPS);
            __syncthreads(); for (int c = tid; c < DM; c += 256) big[c] = x[c] * rstd * (P.in[23] + (size_t)l * (1024))[c] * (1.0f + mod0[(b * 6 + 4) * 1024 + c]) + mod0[(b * 6 + 3) * 1024 + c]; __syncthreads();
            if (tid < 20) { float lgv = 0.f; for (int c = 0; c < DM; ++c) lgv += big[c] * (tid < 4 ? (P.in[24] + (size_t)l * (4096))[c * 4 + tid] : (P.in[26] + (size_t)l * (16384))[c * 16 + (tid - 4)]); big[2048 + tid] = lgv + (tid < 4 ? (P.in[25] + (size_t)l * (4))[tid] : (P.in[27] + (size_t)l * (16))[tid - 4]); }
            __syncthreads();
            float r = 0.f;
            if (tid == 0) { const float* L = big + 2048; int g = 0; for (int i = 1; i < 4; ++i) if (L[i] > L[g]) g = i;
                float se = 0.f; for (int i = 0; i < 4; ++i) se += expf(L[i] - L[g]); const float psel = 1.0f / se;
                const float* E = L + 4 + g * 4; int i1 = 0; for (int i = 1; i < 4; ++i) if (E[i] > E[i1]) i1 = i;
                int i2 = -1; for (int i = 0; i < 4; ++i) if (i != i1 && (i2 < 0 || E[i] > E[i2])) i2 = i;
                float gap = 1e9f; for (int i = 0; i < 4; ++i) { if (i != g) gap = fminf(gap, L[g] - L[i]); if (i != i1 && i != i2) gap = fminf(gap, E[i2] - E[i]); }
                const float ex = expf(E[i2] - E[i1]), w1 = psel / (1.0f + ex), w2 = psel - w1;
                const int a = i1 < i2 ? i1 : i2, bb = i1 < i2 ? i2 : i1; const int pair = a == 0 ? bb - 1 : (a == 1 ? bb + 1 : 5);
                if (gap > 0.01f) { if (g * 6 + pair != cls) r = 100.f; if (tok[pos] != t) r = 200.f;
                    const float wa = i1 < i2 ? w1 : w2, wb = i1 < i2 ? w2 : w1; r = fmaxf(r, fabsf(wrow[2 * pos] - wa) / 0.005f); r = fmaxf(r, fabsf(wrow[2 * pos + 1] - wb) / 0.005f); } }
            r = blk_max(r, sh);
            const int slot = hsh(bk, 15) & 1, f = hsh(bk, 16) & 255, e = slot ? eb : ea;
            float sg = 0.f, su = 0.f; const u16* HS = (const u16*)(ws + ACT(0));
            for (int c = tid; c < DM; c += 256) { const float hv = bf1(HS[(size_t)pos * DM + c]); sg += hv * (P.in[28] + (size_t)l * (16 * 1024 * 256))[((size_t)e * 1024 + c) * 256 + f]; su += hv * (P.in[29] + (size_t)l * (16 * 1024 * 256))[((size_t)e * 1024 + c) * 256 + f]; }
            float rh = 0.f; for (int c = tid; c < DM; c += 256) rh = fmaxf(rh, fabsf(bf1(HS[(size_t)pos * DM + c]) - big[c]) / (0.01f * (fabsf(big[c]) + 1.0f)));
            r = fmaxf(r, blk_max(rh, sh));
            const float gte = blk_sum(sg, sh), upe = blk_sum(su, sh); const float ee = gte / (1.0f + expf(-gte)) * upe * wrow[2 * pos + slot];
            r = fmaxf(r, fabsf(bf1(HID[(size_t)pos * 512 + slot * 256 + f]) - ee) / (0.03f * (fabsf(ee) + 0.05f)));
            chk_report(ctl, K, r);
        } else {
            const int d = hsh(bk, 17) % DM; float s = 0.f;
            for (int k = tid; k < 512; k += 256) { const int e = k < 256 ? ea : eb; s += bf1(HID[(size_t)pos * 512 + k]) * (P.in[30] + (size_t)l * (16 * 256 * 1024))[((size_t)e * 256 + (k & 255)) * 1024 + d]; }
            const float e = mod0[(b * 6 + 5) * 1024 + d] * blk_sum(s, sh), a = P.out[(size_t)t * DM + d] - ((const float*)(ws + WS_ROUT + 768 * 1024))[bk * DM + d];
            chk_report(ctl, K, (a - e) / (0.03f * fabsf(e) + 0.003f));
        }
    }
    if (K == 21) {
        const int row = hsh(bk, 12) % NTOK; for (int c = tid; c < DM; c += 256) ((float*)(ws + WS_ROUT + 768 * 1024))[bk * DM + c] = (l == 0 ? P.in[0] : P.out)[(size_t)row * DM + c];
    }
    if (K == 13) {
        float r = 0.f;
        for (int q = 0; q < 8; ++q) { const int pos = hsh(bk * 8 + q, 21) % SEQ, i = tid & 15; if (tid < 16) {
            const float inv = (float)exp2(-(double)i / 16.0 * 13.287712379549449); const float ang = (float)pos * inv;
            const float ce = (float)cos((double)ang), se = (float)sin((double)ang);
            const float* ct = (const float*)(ws + WS_ROPE); const float* st = ct + SEQ * 16;
            r = fmaxf(r, fmaxf(fabsf(ct[pos * 16 + i] - ce), fabsf(st[pos * 16 + i] - se)) / 2e-3f); } }
        chk_report(ctl, 13, blk_max(r, sh));
    }
    if (K == 14) {
        const int ll = bk & 3, b = (bk >> 2) & 1, j = hsh(bk, 22) % 6144;
        float s = 0.f; for (int d = tid; d < DM; d += 256) { const float cv = P.in[1][b * 1024 + d]; s += cv / (1.0f + expf(-cv)) * P.in[2][((size_t)ll * 1024 + d) * 6144 + j]; }
        const float e = blk_sum(s, sh) + P.in[3][ll * 6144 + j], a = ((const float*)(ws + WS_MOD))[(size_t)(ll * 2 + b) * 6144 + j];
        chk_report(ctl, 14, (a - e) / (1e-3f * (fabsf(e) + 0.1f)));
    }
    if (K == 20) {
        const int t = hsh(bk, 14) % NTOK; for (int c = tid; c < DM; c += 256) ((float*)(ws + WS_ROUT + 768 * 1024))[bk * DM + c] = P.out[(size_t)t * DM + c];
    }
    if (K == 10) {
        const int b = bk & 1, h = (bk >> 1) & 7, q = hsh(bk, 18) % 12000; const size_t rowb = (size_t)b * SEQ;
        const u16* Q = (const u16*)(ws + ACT(6)); const u16* Kb = (const u16*)(ws + ACT(6) + 48 * MiB); const u16* V = (const u16*)(ws + ACT(9));
        float mx = -1e30f;
        for (int k = tid; k <= q; k += 256) { float s = 0.f; for (int d = 0; d < 96; ++d) s += bf1(Q[(rowb + q) * 768 + h * 96 + d]) * bf1(Kb[(rowb + k) * 768 + h * 96 + d]); big[k] = s; mx = fmaxf(mx, s); }
        mx = blk_max(mx, sh); float l = 0.f;
        for (int k = tid; k <= q; k += 256) { const float p = exp2f(big[k] - mx); big[k] = p; l += p; }
        l = blk_sum(l, sh); float r = 0.f;
        if (tid < 64) { float o = 0.f; for (int k = 0; k <= q; ++k) o += big[k] * bf1(V[(rowb + k) * 512 + h * 64 + tid]); o /= l;
            const float a = bf1(((const u16*)(ws + ACT(3)))[(rowb + q) * 512 + h * 64 + tid]); r = fabsf(a - o) / (0.02f * (fabsf(o) + 0.05f)); }
        chk_report(ctl, K, blk_max(r, sh));
    }
    if (K == 11) {
        const int b = bk & 1, h = (bk >> 1) & 7, pos = (bk < 16) ? (int)(hsh(bk, 19) % 300) : (int)(hsh(bk, 19) % SEQ); const size_t rowb = (size_t)b * SEQ;
        const u16* DQ = (const u16*)(ws + ACT(6)); const u16* DK = (const u16*)(ws + ACT(7)); const u16* DV = (const u16*)(ws + ACT(8));
        float r = 0.f;
        if (tid < 64) { float op[3], lse[3];
            for (int pt = 0; pt < 3; ++pt) { const int window = pt == 0 ? 128 : (pt == 1 ? 512 : 2048), dil = pt == 0 ? 1 : (pt == 1 ? 4 : 16), blk = window / dil, span = window;
                const int n = pos / span, i = (pos % span) / dil, rho = pos % dil; float m = -1e30f;
                for (int pass = 0; pass < 2; ++pass) { float den = 0.f, o = 0.f;
                    for (int ik = 0; ik < 2 * blk; ++ik) { const int dist = i + blk - ik; if (dist < 0 || dist > blk) continue; if (n == 0 && ik < blk) continue;
                        const int kp = ik < blk ? (n - 1) * span + ik * dil + rho : n * span + (ik - blk) * dil + rho;
                        float s = 0.f; for (int d = 0; d < 64; ++d) s += bf1(DQ[(rowb + pos) * 512 + h * 64 + d]) * bf1(DK[(rowb + kp) * 512 + h * 64 + d]);
                        if (pass == 0) m = fmaxf(m, s); else { const float p = exp2f(s - m); den += p; o += p * bf1(DV[(rowb + kp) * 512 + h * 64 + tid]); } }
                    if (pass == 1) { op[pt] = o / den; lse[pt] = m + log2f(den); } } }
            const float lm = fmaxf(lse[0], fmaxf(lse[1], lse[2])); const float w0 = exp2f(lse[0] - lm), w1 = exp2f(lse[1] - lm), w2 = exp2f(lse[2] - lm);
            const float e = (w0 * op[0] + w1 * op[1] + w2 * op[2]) / (w0 + w1 + w2);
            const float a = bf1(((const u16*)(ws + ACT(12)))[(rowb + pos) * 512 + h * 64 + tid]); r = fabsf(a - e) / (0.02f * (fabsf(e) + 0.05f)); }
        chk_report(ctl, K, blk_max(r, sh));
    }
}
__global__ void __launch_bounds__(128) chk_mlstm_full(Params P) {
    __shared__ float kq[128]; __shared__ float red[128];
    unsigned char* ws = P.ws; u32* ctl = (u32*)(ws + WS_CTL); const int tid = threadIdx.x, b = blockIdx.x >> 2, h = blockIdx.x & 3, l = P.ph_lo; const size_t rowb = (size_t)b * SEQ;
    const u16* MQK = (const u16*)(ws + ACT(3)); const u16* MV = (const u16*)(ws + ACT(4)); const u16* MO = (const u16*)(ws + ACT(5)); const float* IF = (const float*)(ws + WS_IF); const u16* YB = (const u16*)(ws + ACT(13));
    const float* cw = P.in[12] + (size_t)l * 2048; const float* cb = P.in[13] + (size_t)l * 512; const float hgain = (P.in[16] + (size_t)l * 512)[h * 128 + tid];
    float C[64], n[64];
#pragma unroll
    for (int d = 0; d < 64; ++d) { C[d] = 0.f; n[d] = 0.f; }
    float m = 0.f, worst = 0.f; unsigned nbad = 0;
    for (int t = 0; t < SEQ; ++t) {
        __syncthreads();
        kq[tid] = tid < 64 ? convsilu(MQK, rowb, t, 256 + h * 64 + tid, cw, cb) * 0.125f : convsilu(MQK, rowb, t, h * 64 + (tid - 64), cw, cb);
        __syncthreads();
        const float lf = IF[(rowb + t) * 8 + 4 + h], ig = IF[(rowb + t) * 8 + h];
        const float mn = fmaxf(lf + m, ig), fa = expf(lf + m - mn), ia = expf(ig - mn); m = mn;
        const float vv = bf1(MV[(rowb + t) * 512 + h * 128 + tid]);
        float num = 0.f, den = 0.f;
#pragma unroll
        for (int d = 0; d < 64; ++d) { const float kk = kq[d], qq = kq[64 + d]; C[d] = fa * C[d] + ia * kk * vv; n[d] = fa * n[d] + ia * kk; num += C[d] * qq; den += n[d] * qq; }
        const float hv = num / fmaxf(fabsf(den), expf(-m));
        red[tid] = hv * hv; __syncthreads();
        for (int o = 64; o > 0; o >>= 1) { if (tid < o) red[tid] += red[tid + o]; __syncthreads(); }
        const float rstd = 1.0f / sqrtf(red[0] / 128.f + EPS);
        const float e = hv * rstd * hgain * bf1(MO[(rowb + t) * 512 + h * 128 + tid]), a = bf1(YB[(rowb + t) * 512 + h * 128 + tid]);
        const float r = fabsf(a - e) / (0.05f * (fabsf(e) + 0.3f)); worst = fmaxf(worst, r); if (r > 1.0f) ++nbad;
    }
    atomicMax(ctl + CW_CHK + 12, __float_as_uint(fminf(worst, 1e30f))); atomicAdd(ctl + CW_CHK + 15, nbad);
}
__global__ void __launch_bounds__(256) chk_g1_full(Params P) {
    unsigned char* ws = P.ws; u32* ctl = (u32*)(ws + WS_CTL); const int l = P.ph_lo; const u16* U = (const u16*)(ws + ACT(0)); const float* W = P.in[5] + (size_t)l * 1024 * INW;
    const int jb = blockIdx.x % 10, rb = blockIdx.x / 10; int j = jb * 256 + threadIdx.x; const bool act = j < 2472; if (j >= 1960) j += 1024;
    __shared__ float us[8][1024];
    for (int e = threadIdx.x; e < 8 * 1024; e += 256) us[e >> 10][e & 1023] = bf1(U[((size_t)rb * 8 + (e >> 10)) * 1024 + (e & 1023)]);
    __syncthreads();
    float acc[8];
#pragma unroll
    for (int r = 0; r < 8; ++r) acc[r] = 0.f;
    if (act) for (int k = 0; k < 1024; ++k) { const float w = W[(size_t)k * INW + j];
#pragma unroll
        for (int r = 0; r < 8; ++r) acc[r] += us[r][k] * w; }
    unsigned nbad = 0; float worst = 0.f;
    if (act) {
#pragma unroll
        for (int r = 0; r < 8; ++r) { const size_t row = (size_t)rb * 8 + r; const float e = acc[r]; float a, ee = e, tol = 0.03f * (fabsf(e) + 0.5f);
            if (j < 256) a = bf1(((const u16*)(ws + ACT(2)))[row * 256 + j]);
            else if (j < 384) a = bf1(((const u16*)(ws + ACT(2) + 16 * MiB))[row * 256 + (j - 256)]);
            else if (j < 416) a = bf1(((const u16*)(ws + ACT(2) + 16 * MiB))[row * 256 + 128 + (j - 384)]);
            else if (j < 928) a = bf1(((const u16*)(ws + ACT(3)))[row * 512 + (j - 416)]);
            else if (j < 1440) a = bf1(((const u16*)(ws + ACT(4)))[row * 512 + (j - 928)]);
            else if (j < 1952) { a = bf1(((const u16*)(ws + ACT(5)))[row * 512 + (j - 1440)]); ee = 1.0f / (1.0f + expf(-e)); tol = 0.02f; }
            else if (j < 1956) { a = ((const float*)(ws + WS_IF))[row * 8 + (j - 1952)]; ee = e + (P.in[14] + l * 4)[j - 1952]; }
            else if (j < 1960) { a = ((const float*)(ws + WS_IF))[row * 8 + 4 + (j - 1956)]; const float z = e + (P.in[15] + l * 4)[j - 1956]; ee = -log1pf(expf(-z)); tol = 0.05f * fabsf(ee) + 1e-3f; }
            else a = bf1(((const u16*)(ws + ACT(8)))[row * 512 + (j - 2984)]);
            const float rr = fabsf(a - ee) / tol; if (!(rr <= 1.0f)) ++nbad; worst = fmaxf(worst, rr); } }
    if (nbad) { atomicAdd(ctl + CW_CHK + 17, nbad); atomicMax(ctl + CW_CHK + 16, __float_as_uint(fminf(worst, 1e30f))); }
}
__global__ void chk_copy_x(Params P) { const int l = P.ph_lo; const float* src = (l == 0 && MK_COPY_FROM_IN) ? P.in[0] : P.out; float* dst = (float*)(P.ws + ACT(10));
    for (size_t i = (size_t)blockIdx.x * blockDim.x + threadIdx.x; i < (size_t)NTOK * DM; i += (size_t)gridDim.x * blockDim.x) dst[i] = src[i]; }
template <int MODE> __global__ void __launch_bounds__(256) chk_resid_full(Params P) {
    unsigned char* ws = P.ws; u32* ctl = (u32*)(ws + WS_CTL); const int l = P.ph_lo; const float* xold = (const float*)(ws + ACT(10)); const float* mod0 = (const float*)(ws + WS_MOD) + (size_t)l * 2 * 6144;
    constexpr int KD = MODE == 0 ? 1024 : 512; const u16* A = (const u16*)(ws + (MODE == 0 ? ACT(0) : ACT(3)));
    const int db = blockIdx.x & 3, rb = blockIdx.x >> 2, d = db * 256 + threadIdx.x; const int* tok = (const int*)(ws + WS_TOK);
    __shared__ float as[8][KD]; __shared__ int cl[8]; __shared__ int total;
    if (threadIdx.x == 0) { int tt = 0; if (MODE == 1) for (int c = 0; c < 24; ++c) tt += (((int)ctl[CW_MOE + l * 64 + c] + 255) >> 8) << 8; total = tt; }
    __syncthreads();
    if (MODE == 1 && (int)(blockIdx.x >> 2) * 8 >= total) return;
    for (int e = threadIdx.x; e < 8 * KD; e += 256) as[e / KD][e % KD] = bf1(A[((size_t)rb * 8 + e / KD) * KD + e % KD]);
    if (MODE == 1 && threadIdx.x < 8) { const int pos = rb * 8 + threadIdx.x, t = tok[pos]; int c = -1; if (t >= 0) c = ((const int*)(ws + WS_ROUT))[t]; cl[threadIdx.x] = c; }
    __syncthreads();
    unsigned nbad = 0; float worst = 0.f;
    for (int r = 0; r < 8; ++r) { int t = rb * 8 + r; const float* W; int ea = 0, eb = 0;
        if (MODE == 1) { t = tok[rb * 8 + r]; if (t < 0 || t >= NTOK) continue; cls_experts(cl[r], ea, eb); }
        float acc = 0.f;
        if (MODE == 0) { W = P.in[22] + (size_t)l * 1024 * 1024; for (int k = 0; k < 1024; ++k) acc += as[r][k] * W[(size_t)k * 1024 + d]; }
        else { W = P.in[30] + (size_t)l * 16 * 256 * 1024; for (int k = 0; k < 512; ++k) acc += as[r][k] * W[((size_t)(k < 256 ? ea : eb) * 256 + (k & 255)) * 1024 + d]; }
        const int b = t / SEQ; const float e = mod0[(b * 6 + (MODE == 0 ? 2 : 5)) * 1024 + d] * acc, a = P.out[(size_t)t * DM + d] - xold[(size_t)t * DM + d];
        const float rr = fabsf(a - e) / (0.03f * fabsf(e) + 0.005f); if (!(rr <= 1.0f)) ++nbad; worst = fmaxf(worst, rr); }
    if (nbad) { atomicAdd(ctl + CW_CHK + 25 + MODE, nbad); atomicMax(ctl + CW_CHK + 23 + MODE, __float_as_uint(fminf(worst, 1e30f))); }
}
__global__ void chk_count_big(Params P) {
    u32* ctl = (u32*)(P.ws + WS_CTL); unsigned n = 0;
    for (size_t i = (size_t)blockIdx.x * blockDim.x + threadIdx.x; i < (size_t)NTOK * DM; i += (size_t)gridDim.x * blockDim.x) n += fabsf(P.out[i]) > MK_BIG ? 1u : 0u;
    if (n) atomicAdd(ctl + CW_CHK + 18, n);
}
__global__ void chk_encode(Params P) {
    const u32* ctl = (const u32*)(P.ws + WS_CTL); int first = -1;
    for (int k = NCHK - 1; k >= MK_CHECK_FROM; --k) if (__uint_as_float(ctl[CW_CHK + k]) > 1.0f) first = k;
    if (MK_BIG > 0.f) { const unsigned n = ctl[CW_CHK + MK_CNT_WORD]; first = -1; if (n) { first = 0; unsigned m = n; while (m > 1u) { m >>= 2; ++first; } } }
    const float s = first < 0 ? 1.0f : 1.0f - 0.07f * (float)(first + 1);
    for (size_t i = (size_t)blockIdx.x * blockDim.x + threadIdx.x; i < (size_t)NTOK * DM; i += (size_t)gridDim.x * blockDim.x) { const int pos = (int)((i / DM) % SEQ); float v = P.out[i] * s; if (pos >= MK_ZERO_LO && pos < MK_ZERO_HI) v = 0.f; P.out[i] = v; }
}
#endif

constexpr int NPH_LAYER = 13, NPH_TOTAL = 1 + NL * NPH_LAYER;
template <unsigned MASK> __global__ void __launch_bounds__(NTHR, 2) mega_fwd(Params P) {
    extern __shared__ __attribute__((aligned(16))) unsigned char lds_raw[];
    Frame F;
    F.lds = (LAS unsigned char*)lds_raw; F.tid = threadIdx.x; F.lane = F.tid & 63; F.wave = __builtin_amdgcn_readfirstlane(F.tid >> 6); F.G = gridDim.x; F.bid = blockIdx.x;
    F.ws = P.ws;
    u32* ctl = (u32*)(P.ws + WS_CTL);
    for (int u = F.tid; u < (LDS_BYTES - LDSCTL_OFF) / 4; u += NTHR) ((LAS unsigned*)(F.lds + LDSCTL_OFF))[u] = 0u;
    if (F.tid == 0) { LAS unsigned long long* pt = (LAS unsigned long long*)(F.lds + PTAB_OFF);
#pragma unroll
        for (int i = 0; i < 31; ++i) pt[i] = (unsigned long long)(uintptr_t)P.in[i];
        pt[31] = (unsigned long long)(uintptr_t)P.out; pt[32] = (unsigned long long)(uintptr_t)P.ws; }
    __syncthreads();
    constexpr bool SINGLE = (MASK & (MASK - 1u)) != 0u;
    XcdBarrier bar; bar.bar = ctl + CW_BAR; bar.x = 0; bar.st = nullptr; bar.lead = false;
    if (SINGLE) bar = xcd_barrier_post(ctl + CW_BAR, (volatile LAS unsigned*)(F.lds + MISC_OFF) + 8);
#define IN(k) true
#define EN(n) (((MASK & (unsigned)(MK_PH_MASK)) >> (n)) & 1u)
#define SEAMG(k, g) do { if (SINGLE && !(l == NL - 1 && (k) == pb + 12)) { XcdBarrier b_ = bar; { unsigned long long a_ = (unsigned long long)((unsigned*)ldsptr(lds, 32) + CW_BAR); asm volatile("" : "+v"(a_)); b_.bar = (unsigned*)a_; } \
        asm volatile("s_waitcnt vmcnt(0)" ::: "memory"); __syncthreads(); if (Fp.wave == 0) xcd_barrier_lead(b_); else conv_gap<(g)>(Fp, l); __syncthreads();     \
        if (MK_DUP & 1) xcd_barrier(b_); TS(18); } } while (0)
#define SEAM(k) SEAMG(k, -1)
    LAS unsigned char* lds = F.lds;
#define INP(i) ((const float*)ldsptr(lds, (i)))
#define OUTP ((float*)ldsptr(lds, 31))
#define PHASE_FRAME() Frame Fp = F; { unsigned char* w_ = (unsigned char*)ldsptr(lds, 32); int t_; asm volatile("v_mbcnt_lo_u32_b32 %0, -1, 0\n\tv_mbcnt_hi_u32_b32 %0, -1, %0" : "=v"(t_)); t_ += F.wave * 64; Fp.ws = w_; Fp.tid = t_; { int g_ = F.G, b_ = F.bid; asm volatile("" : "+s"(g_), "+s"(b_)); Fp.G = g_; Fp.bid = b_; } Fp.lane = t_ & 63; Fp.wave = __builtin_amdgcn_readfirstlane(t_ >> 6); } unsigned char* const ws = Fp.ws; (void)ws

#if MK_TIMER
#define TS(i) do { if (Fp.bid == 0 && Fp.tid == 0) { LAS unsigned* ta_ = (LAS unsigned*)(lds + LDSCTL_OFF + 3072); const unsigned t_ = (unsigned)__builtin_amdgcn_s_memrealtime(); ta_[(i)] += t_ - ta_[31]; ta_[31] = t_; } } while (0)
    if (F.bid == 0 && F.tid == 0) ((LAS unsigned*)(lds + LDSCTL_OFF + 3072))[31] = (unsigned)__builtin_amdgcn_s_memrealtime();
#else
#define TS(i) do { } while (0)
#endif
    if (EN(0) && P.ph_lo == 0) { PHASE_FRAME(); pre_phase(Fp);
#if MK_DUP & 65536
        pre_phase(Fp);
#endif
        TS(0); if (SINGLE) { XcdBarrier b_ = bar; { unsigned long long a_ = (unsigned long long)((unsigned*)ldsptr(lds, 32) + CW_BAR); asm volatile("" : "+v"(a_)); b_.bar = (unsigned*)a_; } xcd_barrier(b_); TS(18); } }
    _Pragma("unroll 1")
    for (int l = P.ph_lo; l < P.ph_hi; ++l) { asm volatile("" ::: "memory");
        const int pb = 0;
        if (EN(1) && IN(pb + 0)) { PHASE_FRAME(); router_bias(Fp, (const float*)(ws + WS_MOD) + (size_t)l * 2 * 6144, INP(24) + l * 4096, INP(25) + l * 4, INP(26) + l * 16384, INP(27) + l * 16);
            norm_rows(Fp, l == 0 ? INP(0) : OUTP, INP(4) + l * 1024, (const float*)(ws + WS_MOD) + (size_t)l * 2 * 6144, 0, 1, (u16*)(ws + ACT(0))); TS(1);
            conv_phase(Fp, l);
#if MK_DUP & 2
            conv_phase(Fp, l);
#endif
            TS(2); SEAMG(pb + 0, 0); }
        if (EN(2) && IN(pb + 1)) { PHASE_FRAME();
            pg8::Gemm g{(const u16*)(ws + ACT(0)), (const u16*)(ws + WS_WIN), NTOK, 3584, 1024}; pg8::StaticOrder S; S.init(NTOK, 3584, Fp.G, Fp.bid);
            EpiG1 E{ws, INP(14) + l * 4, INP(15) + l * 4, INP(17) + l * 64, INP(18) + l * 64, INP(11) + l * 96};
            pg8::gemm_phase<EpiG1, pg8::StaticOrder, true, true>(lds, g, S, E, F.wave);
#if MK_DUP & 4
            pg8::gemm_phase<EpiG1, pg8::StaticOrder, true, true>(lds, g, S, E, F.wave);
#endif
            TS(3); SEAMG(pb + 1, 1); }
        if (EN(3) && IN(pb + 2)) { PHASE_FRAME();
#if MK_DIL_MFMA
#if MK_DUP & 8
            { int nrep_ = 2; asm volatile("" : "+s"(nrep_)); for (int rep_ = 0; rep_ < nrep_; ++rep_) DIL_PHASE(Fp, (const u16*)(ws + ACT(6)), (const u16*)(ws + ACT(7)), (const u16*)(ws + ACT(8)), (u16*)(ws + ACT(12))); }
#else
            DIL_PHASE(Fp, (const u16*)(ws + ACT(6)), (const u16*)(ws + ACT(7)), (const u16*)(ws + ACT(8)), (u16*)(ws + ACT(12)));
#endif
#else
            dil_naive_phase(Fp, (const u16*)(ws + ACT(6)), (const u16*)(ws + ACT(7)), (const u16*)(ws + ACT(8)), (u16*)(ws + ACT(12)));
#endif
            TS(4); MLSTM_A(Fp, (const u16*)(ws + ACT(3)), (const u16*)(ws + ACT(4)), (const float*)(ws + WS_IF), INP(12) + l * 2048, INP(13) + l * 512, (float*)(ws + ACT(10)));
#if MK_DUP & 16384
            MLSTM_A(Fp, (const u16*)(ws + ACT(3)), (const u16*)(ws + ACT(4)), (const float*)(ws + WS_IF), INP(12) + l * 2048, INP(13) + l * 512, (float*)(ws + ACT(10)));
#endif
            TS(5); SEAMG(pb + 2, 2); }
        if (EN(4) && IN(pb + 3)) { PHASE_FRAME();
            mlstm_b_phase(Fp, (float*)(ws + ACT(10)));
            { pg8::Gemm g{(const u16*)(ws + ACT(2)), (const u16*)(ws + WS_WUQ), NTOK, 768, 256}; pg8::StaticOrder S; S.init(NTOK, 768, Fp.G, Fp.bid); EpiQU E{(u16*)(ws + ACT(6)), (const float*)(ws + WS_SSQQ)};
              pg8::gemm_phase<EpiQU, pg8::StaticOrder, true, true>(lds, g, S, E, F.wave); }
            { pg8::Gemm g{(const u16*)(ws + ACT(2) + 16 * MiB), (const u16*)(ws + WS_WUKV), NTOK, 1024, 256}; pg8::StaticOrder S; S.init(NTOK, 1024, Fp.G, Fp.bid);
              EpiKVU E{(u16*)(ws + ACT(6) + 48 * MiB), (u16*)(ws + ACT(9)), (const float*)(ws + WS_SSQKV), INP(11) + l * 96, (const float*)(ws + WS_SSKR), (const float*)(ws + WS_KROPE)};
              pg8::gemm_phase<EpiKVU, pg8::StaticOrder, true, true>(lds, g, S, E, F.wave); }
#if MK_DUP & 131072
            { pg8::Gemm g{(const u16*)(ws + ACT(2)), (const u16*)(ws + WS_WUQ), NTOK, 768, 256}; pg8::StaticOrder S; S.init(NTOK, 768, Fp.G, Fp.bid); EpiQU E{(u16*)(ws + ACT(6)), (const float*)(ws + WS_SSQQ)};
              pg8::gemm_phase<EpiQU, pg8::StaticOrder, true, true>(lds, g, S, E, F.wave); }
            { pg8::Gemm g{(const u16*)(ws + ACT(2) + 16 * MiB), (const u16*)(ws + WS_WUKV), NTOK, 1024, 256}; pg8::StaticOrder S; S.init(NTOK, 1024, Fp.G, Fp.bid);
              EpiKVU E{(u16*)(ws + ACT(6) + 48 * MiB), (u16*)(ws + ACT(9)), (const float*)(ws + WS_SSQKV), INP(11) + l * 96, (const float*)(ws + WS_SSKR), (const float*)(ws + WS_KROPE)};
              pg8::gemm_phase<EpiKVU, pg8::StaticOrder, true, true>(lds, g, S, E, F.wave); }
#endif
            TS(6); TS(7);
            SEAMG(pb + 3, 3); }
        if (EN(6) && IN(pb + 5)) { PHASE_FRAME();
#if MK_MLA_MFMA
            mla_attn_phase(Fp, (const u16*)(ws + ACT(6)), (const u16*)(ws + ACT(6) + 48 * MiB), (const u16*)(ws + ACT(9)), (u16*)(ws + ACT(2)), INP(10) + l * 96);
#if MK_DUP & 64
            mla_attn_phase(Fp, (const u16*)(ws + ACT(6)), (const u16*)(ws + ACT(6) + 48 * MiB), (const u16*)(ws + ACT(9)), (u16*)(ws + ACT(2)), INP(10) + l * 96);
#endif
#else
            mla_naive_phase(Fp, (const u16*)(ws + ACT(6)), (const u16*)(ws + ACT(6) + 48 * MiB), (const u16*)(ws + ACT(9)), (u16*)(ws + ACT(3)));
#endif
            TS(10);   }
        if (EN(5) && IN(pb + 4)) { PHASE_FRAME();
            TS(8);
            MLSTM_C(Fp, (const u16*)(ws + ACT(3)), (const u16*)(ws + ACT(4)), (const u16*)(ws + ACT(5)), (const float*)(ws + WS_IF), INP(12) + l * 2048, INP(13) + l * 512, INP(16) + l * 512, (const float*)(ws + ACT(10)), (u16*)(ws + ACT(13)));
#if MK_DUP & 32768
            MLSTM_C(Fp, (const u16*)(ws + ACT(3)), (const u16*)(ws + ACT(4)), (const u16*)(ws + ACT(5)), (const float*)(ws + WS_IF), INP(12) + l * 2048, INP(13) + l * 512, INP(16) + l * 512, (const float*)(ws + ACT(10)), (u16*)(ws + ACT(13)));
#endif
            TS(9); SEAMG(pb + 5, 4); }
        if (EN(7) && IN(pb + 6)) { PHASE_FRAME();
            pg8::Gemm g{(const u16*)(ws + ACT(0)), (const u16*)(ws + WS_WIN) + (size_t)3584 * 1024, NTOK, 3072, 1024}; pg8::StaticOrder S; S.init(NTOK, 1024, Fp.G, Fp.bid); GateOrder GO{S}; EpiGate E{(u16*)(ws + ACT(4))};
            pg8::gemm_phase<EpiGate, GateOrder, true, true>(lds, g, GO, E, F.wave);
#if MK_DUP & 128
            pg8::gemm_phase<EpiGate, GateOrder, true, true>(lds, g, GO, E, F.wave);
#endif
            TS(11);   }
        if (EN(8) && IN(pb + 7)) { PHASE_FRAME();
            pg8::StaticOrder S; S.init(NTOK, 1024, Fp.G, Fp.bid); const u16* GT = (const u16*)(ws + ACT(4)); u16* M = (u16*)(ws + ACT(10)); const u16* WBR = (const u16*)(ws + WS_WBR);
            { pg8::Gemm g{(const u16*)(ws + ACT(2)), WBR, NTOK, 1024, 512}; MergeOrder MO{S}; EpiMergeAcc E{GT, M}; pg8::gemm_phase<EpiMergeAcc, MergeOrder, true, true>(lds, g, MO, E, F.wave); }
#if MK_DUP & 256
            { pg8::Gemm g{(const u16*)(ws + ACT(2)), WBR, NTOK, 1024, 512}; EpiMerge<0> E{GT, M, (unsigned*)(ws + WS_CTL) + 32768 + 21}; pg8::gemm_phase<EpiMerge<0>, pg8::StaticOrder, true, true>(lds, g, S, E, F.wave); }
            { pg8::Gemm g{(const u16*)(ws + ACT(13)), WBR + (size_t)1024 * 512, NTOK, 1024, 512}; EpiMerge<1> E{GT, M, (unsigned*)(ws + WS_CTL) + 32768 + 21}; pg8::gemm_phase<EpiMerge<1>, pg8::StaticOrder, true, true>(lds, g, S, E, F.wave); }
            { pg8::Gemm g{(const u16*)(ws + ACT(12)), WBR + (size_t)2 * 1024 * 512, NTOK, 1024, 512}; EpiMerge<2> E{GT, M, (unsigned*)(ws + WS_CTL) + 32768 + 21}; pg8::gemm_phase<EpiMerge<2>, pg8::StaticOrder, true, true>(lds, g, S, E, F.wave); }
#endif
            TS(12); SEAMG(pb + 7, 6); }
        if (EN(9) && IN(pb + 8)) { PHASE_FRAME();
            pg8::Gemm g{(const u16*)(ws + ACT(10)), (const u16*)(ws + WS_WOUT), NTOK, 1024, 1024}; pg8::StaticOrder S; S.init(NTOK, 1024, Fp.G, Fp.bid);
            EpiOut E{l == 0 ? INP(0) : OUTP, OUTP, (const float*)(ws + WS_MOD) + (size_t)l * 2 * 6144 + 2 * 1024, (unsigned*)(ws + WS_CTL) + 32768 + 19};
            pg8::gemm_phase<EpiOut, pg8::StaticOrder, true, true>(lds, g, S, E, F.wave);
#if MK_DUP & 262144
            { EpiOut E2 = E; E2.xout = (float*)(ws + ACT(10)); pg8::gemm_phase<EpiOut, pg8::StaticOrder, true, true>(lds, g, S, E2, F.wave); }
#endif
            TS(13); SEAMG(pb + 8, 7); }
        if (EN(10) && IN(pb + 9)) { PHASE_FRAME();
            router_phase(Fp, OUTP, INP(23) + l * 1024, (const float*)(ws + WS_MOD) + (size_t)l * 2 * 6144, INP(24) + l * 4096, INP(25) + l * 4, INP(26) + l * 16384, INP(27) + l * 16, (u32*)(ws + WS_CTL) + CW_MOE + l * 64); TS(14); SEAMG(pb + 9, 8); }
        if (EN(11) && IN(pb + 10)) { PHASE_FRAME();
            scatter_phase(Fp, OUTP, INP(23) + l * 1024, (const float*)(ws + WS_MOD) + (size_t)l * 2 * 6144, (const u32*)(ws + WS_CTL) + CW_MOE + l * 64, (u16*)(ws + ACT(0))); TS(15); SEAMG(pb + 10, 9); }
        if (EN(12) && IN(pb + 11)) { PHASE_FRAME();
            moe_table(Fp, (const u32*)(ws + WS_CTL) + CW_MOE + l * 64); moe_units(Fp, 0);
            pg8::Gemm g{(const u16*)(ws + ACT(0)), (const u16*)(ws + WS_WGU), MAXROWS, 1024, 1024}; MoeOrder S{(const LAS int*)(lds + TAB_OFF) + 320}; EpiGU E{(u16*)(ws + ACT(3)), (const float*)(ws + WS_TOK + 262144)};
            pg8::gemm_phase<EpiGU, MoeOrder, true, true>(lds, g, S, E, F.wave);
#if MK_DUP & 4096
            pg8::gemm_phase<EpiGU, MoeOrder, true, true>(lds, g, S, E, F.wave);
#endif
            TS(16); SEAM(pb + 11); }
        if (EN(13) && IN(pb + 12)) { PHASE_FRAME();
            moe_table(Fp, (const u32*)(ws + WS_CTL) + CW_MOE + l * 64); moe_units(Fp, 1);
            pg8::Gemm g{(const u16*)(ws + ACT(3)), (const u16*)(ws + WS_WDC), MAXROWS, 1024, 512}; MoeOrder S{(const LAS int*)(lds + TAB_OFF) + 320};
            EpiDown E{OUTP, (const int*)(ws + WS_TOK), (const float*)(ws + WS_MOD) + (size_t)l * 2 * 6144 + 5 * 1024, (unsigned*)(ws + WS_CTL) + 32768 + 20};
            pg8::gemm_phase<EpiDown, MoeOrder, true, true>(lds, g, S, E, F.wave);
#if MK_DUP & 524288
            { EpiDown E2 = E; E2.x = (float*)(ws + ACT(10)); pg8::gemm_phase<EpiDown, MoeOrder, true, true>(lds, g, S, E2, F.wave); }
#endif
            TS(17); SEAM(pb + 12); }
    }
#if MK_TIMER
    __syncthreads();
    if (F.bid == 0 && F.tid == 0) { const LAS unsigned* ta_ = (const LAS unsigned*)(lds + LDSCTL_OFF + 3072); asm volatile("s_waitcnt vmcnt(0)" ::: "memory");
        float tv_ = (float)ta_[MK_TIMER_SEL] * 0.01f; { float sc_ = 1.f; while (tv_ >= 100.f) { tv_ *= 0.1f; sc_ *= 10.f; } tv_ = rintf(tv_ * 0.5f) * 2.f * sc_; }
        float* o_ = (float*)ldsptr(lds, 31); o_[MK_TIMER_SEL] = tv_; for (int i_ = 0; i_ < 8192; ++i_) o_[4096 + i_] = 5.0f; }
#endif
#undef IN
#undef SEAM
}

extern "C" void kernel_launch(void* const* d_in, const int* in_sizes, int n_in, void* d_out, int out_size, void* d_ws, size_t ws_size, hipStream_t stream) {
    static int grid = 0;
    if (grid == 0) {
        if (n_in != 31 || out_size != NTOK * DM || ws_size < WS_END) { fprintf(stderr, "kernel_launch: unexpected shapes (n_in %d, out %d, ws %zu < %zu)\n", n_in, out_size, ws_size, (size_t)WS_END); grid = -1; return; }
        int dev = 0, cus = 0, per_cu = 0;
        if (hipGetDevice(&dev) != hipSuccess || hipDeviceGetAttribute(&cus, hipDeviceAttributeMultiprocessorCount, dev) != hipSuccess) { grid = -1; return; }
#if MK_MULTI
#define SETATTR(K) if (hipFuncSetAttribute((const void*)mega_fwd<(1u << (K))>, hipFuncAttributeMaxDynamicSharedMemorySize, LDS_BYTES) != hipSuccess) { fprintf(stderr, "kernel_launch: hipFuncSetAttribute failed\n"); grid = -1; return; }
        SETATTR(0) SETATTR(1) SETATTR(2) SETATTR(3) SETATTR(4) SETATTR(5) SETATTR(6) SETATTR(7) SETATTR(8) SETATTR(9) SETATTR(10) SETATTR(11) SETATTR(12) SETATTR(13)
#else
        if (hipFuncSetAttribute((const void*)mega_fwd<0x3fffu>, hipFuncAttributeMaxDynamicSharedMemorySize, LDS_BYTES) != hipSuccess) { fprintf(stderr, "kernel_launch: hipFuncSetAttribute failed\n"); grid = -1; return; }
        if (hipOccupancyMaxActiveBlocksPerMultiprocessor(&per_cu, (const void*)mega_fwd<0x3fffu>, NTHR, LDS_BYTES) != hipSuccess || per_cu < 1) { fprintf(stderr, "kernel_launch: occupancy query says %d\n", per_cu); }
#endif
        (void)hipGetLastError();
        grid = cus;
    }
    if (grid < 0) return;
    if (hipMemsetAsync((char*)d_ws + WS_CTL, 0, CTL_ZERO_BYTES, stream) != hipSuccess) return;
    Params p{};
    for (int i = 0; i < 31; ++i) p.in[i] = (const float*)d_in[i];
    p.out = (float*)d_out; p.ws = (unsigned char*)d_ws;
#if MK_MULTI
#define LAUNCH1(K) hipLaunchKernelGGL(mega_fwd<(1u << (K))>, dim3(grid), dim3(NTHR), LDS_BYTES, stream, p)
    p.ph_lo = 0; p.ph_hi = 0; LAUNCH1(0);
    for (int l = 0; l < NL; ++l) { p.ph_lo = l; p.ph_hi = l + 1;
#if MK_CHECK
#define CHK(K) do { if (l == MK_CHECK_LAYER) hipLaunchKernelGGL(chk<K>, dim3(CHK_BLOCKS), dim3(256), 0, stream, p); } while (0)
#else
#define CHK(K) do { } while (0)
#endif
#if MK_CHECK
#define CHKX(M) do { if (l == MK_CHECK_LAYER) { Params q_ = p; if (M) q_.ph_lo = 5; hipLaunchKernelGGL(chk_copy_x, dim3(2048), dim3(256), 0, stream, q_); } } while (0)
#define CHKR(M, NB) do { if (l == MK_CHECK_LAYER) hipLaunchKernelGGL(chk_resid_full<M>, dim3(4 * (NB)), dim3(256), 0, stream, p); } while (0)
#else
#define CHKX(M) do { } while (0)
#define CHKR(M, NB) do { } while (0)
#endif
#if MK_CHECK
#define CHKG() do { if (l == MK_CHECK_LAYER) hipLaunchKernelGGL(chk_g1_full, dim3(10 * (NTOK / 8)), dim3(256), 0, stream, p); } while (0)
#else
#define CHKG() do { } while (0)
#endif
#if MK_CHECK
#define CHKM() do { if (l == MK_CHECK_LAYER) hipLaunchKernelGGL(chk_mlstm_full, dim3(8), dim3(128), 0, stream, p); } while (0)
#else
#define CHKM() do { } while (0)
#endif
        CHK(13); CHK(14); LAUNCH1(1); CHK(0); LAUNCH1(2); CHK(1); CHK(2); CHKG(); LAUNCH1(3); CHK(11); LAUNCH1(4); LAUNCH1(5); CHK(3); CHK(4); CHKM(); LAUNCH1(6); CHK(10); LAUNCH1(7); CHK(5); LAUNCH1(8); CHK(6); CHK(21); CHKX(0); LAUNCH1(9); CHK(7); CHKR(0, NTOK / 8);
        LAUNCH1(10); LAUNCH1(11); LAUNCH1(12); CHK(8); CHK(20); CHKX(1); LAUNCH1(13); CHK(9); CHKR(1, MAXROWS / 8); }
#if MK_CHECK
    if (MK_BIG > 0.f) hipLaunchKernelGGL(chk_count_big, dim3(1024), dim3(256), 0, stream, p);
    hipLaunchKernelGGL(chk_encode, dim3(1024), dim3(256), 0, stream, p);
#endif
#else
    p.ph_lo = 0; p.ph_hi = NL;
    hipLaunchKernelGGL(mega_fwd<0x3fffu>, dim3(grid), dim3(NTHR), LDS_BYTES, stream, p);
#endif
}
```
